# Optimizing an MI355X kernel written in HIP

```python
import math
import jax, jax.numpy as jnp
from jax import lax
import numpy as np

D_MODEL = 1024
BATCH = 8
SEQ = 4096
DEPTH = 2

MLA_HEADS = 6
MLA_NOPE = 64
MLA_ROPE = 32
MLA_V = 64
MLA_Q_RANK = 256
MLA_KV_RANK = 128
ROPE_THETA = 10000.0
Q_BLOCK = 128
MLA_WIDTH = MLA_HEADS * MLA_V

HY_GROUPS = 6
HY_GROUP_W = 64
HY_WIDTH = HY_GROUPS * HY_GROUP_W
HY_ORDER = 2
HY_SHORT = 3
HY_BANDS = 8
HY_EMB = 1 + 2 * HY_BANDS
HY_FFN = 64
HY_FILTER_SCALE = 0.05
HY_FAST_DECAY = 0.3
HY_SLOW_DECAY = 1.5
HY_TARGET = 1e-2

NA_HEADS = 4
NA_HEAD_DIM = 64
NA_WIDTH = NA_HEADS * NA_HEAD_DIM
GRID_W = 64
NA_KH = 8
NA_KW = 16

D_MIX = MLA_WIDTH + HY_WIDTH + NA_WIDTH
IN_SIZES = (MLA_Q_RANK, MLA_KV_RANK, MLA_ROPE, 3 * HY_WIDTH, NA_WIDTH, NA_WIDTH, NA_WIDTH)
IN_COLS = MLA_Q_RANK + MLA_KV_RANK + MLA_ROPE + 3 * HY_WIDTH + 3 * NA_WIDTH
D_FF = ((8 * D_MODEL // 3 + 255) // 256) * 256
NORM_EPS = 1e-6

kernel_name = "hymba_style_mla_hyena_natten_encoder"


def rms_norm(x, g):
    xf = x.astype(jnp.float32)
    y = xf * lax.rsqrt(jnp.mean(xf * xf, axis=-1, keepdims=True) + NORM_EPS)
    return (y * g.astype(jnp.float32)).astype(x.dtype)


def split_cols(a, sizes):
    idx = np.cumsum(np.array(sizes))[:-1].tolist()
    return jnp.split(a, idx, axis=-1)


def rope_tables(S):
    pos = jnp.arange(S, dtype=jnp.float32)
    inv = ROPE_THETA ** (-jnp.arange(0, MLA_ROPE, 2, dtype=jnp.float32) / MLA_ROPE)
    ang = pos[:, None] * inv[None, :]
    return jnp.cos(ang), jnp.sin(ang)


def apply_rope(x, cos, sin):
    xf = x.astype(jnp.float32)
    half = xf.shape[-1] // 2
    x1, x2 = xf[..., :half], xf[..., half:]
    return jnp.concatenate([x1 * cos - x2 * sin, x1 * sin + x2 * cos], axis=-1).astype(x.dtype)


def mla_mixer(c_q, c_kv, k_pe, q_norm_g, w_uq, kv_norm_g, w_ukv):
    B, S, _ = c_q.shape
    q = (rms_norm(c_q, q_norm_g) @ w_uq).reshape(B, S, MLA_HEADS, MLA_NOPE + MLA_ROPE)
    kv = (rms_norm(c_kv, kv_norm_g) @ w_ukv).reshape(B, S, MLA_HEADS, MLA_NOPE + MLA_V)
    q_nope, q_pe = q[..., :MLA_NOPE], q[..., MLA_NOPE:]
    k_nope, v = kv[..., :MLA_NOPE], kv[..., MLA_NOPE:]
    cos, sin = rope_tables(S)
    q_pe = apply_rope(q_pe, cos[:, None, :], sin[:, None, :])
    k_pe = apply_rope(k_pe, cos, sin)
    scale = 1.0 / math.sqrt(MLA_NOPE + MLA_ROPE)
    nb = S // Q_BLOCK
    qn = q_nope.reshape(B, nb, Q_BLOCK, MLA_HEADS, MLA_NOPE).transpose(1, 0, 2, 3, 4)
    qp = q_pe.reshape(B, nb, Q_BLOCK, MLA_HEADS, MLA_ROPE).transpose(1, 0, 2, 3, 4)

    def block(args):
        qn_b, qp_b = args
        s = (jnp.einsum('bqhd,bkhd->bhqk', qn_b, k_nope)
             + jnp.einsum('bqhr,bkr->bhqk', qp_b, k_pe))
        p = jax.nn.softmax(s.astype(jnp.float32) * scale, axis=-1).astype(v.dtype)
        return jnp.einsum('bhqk,bkhd->bqhd', p, v)

    o = lax.map(block, (qn, qp))
    return o.transpose(1, 0, 2, 3, 4).reshape(B, S, MLA_WIDTH)


def hyena_filters(L, w1, b1, f1, w2, b2, f2, w3):
    t_idx = jnp.arange(L, dtype=jnp.float32)[:, None]
    t_norm = jnp.linspace(0.0, 1.0, L, dtype=jnp.float32)[:, None]
    bands = jnp.linspace(1e-4, HY_BANDS - 1, HY_BANDS, dtype=jnp.float32)[None, :]
    ang = 2.0 * math.pi * t_idx * bands / L
    z = jnp.concatenate([t_norm, jnp.cos(ang), jnp.sin(ang)], axis=-1)
    f32 = jnp.float32
    h = jnp.sin(f1.astype(f32) * (z @ w1.astype(f32) + b1.astype(f32)))
    h = jnp.sin(f2.astype(f32) * (h @ w2.astype(f32) + b2.astype(f32)))
    h = (h @ w3.astype(f32)).reshape(L, HY_ORDER, 2, HY_WIDTH)
    deltas = jnp.linspace(math.log(HY_TARGET) / HY_SLOW_DECAY,
                          math.log(HY_TARGET) / HY_FAST_DECAY, HY_WIDTH, dtype=jnp.float32)
    decay = jnp.exp(-t_norm * jnp.abs(deltas)[None, :])
    return h * decay[:, None, None, :]


def bidir_long_conv(u, h_f, h_b, skip):
    L = u.shape[1]
    n = 2 * L
    Hf = jnp.fft.rfft(h_f, n=n, axis=0)[None]
    Hb = jnp.fft.rfft(h_b, n=n, axis=0)[None]
    y_f = jnp.fft.irfft(jnp.fft.rfft(u, n=n, axis=1) * Hf, n=n, axis=1)[:, :L]
    ur = u[:, ::-1]
    y_b = jnp.fft.irfft(jnp.fft.rfft(ur, n=n, axis=1) * Hb, n=n, axis=1)[:, :L][:, ::-1]
    return y_f + y_b + skip[None, None, :] * u


def hyena_mixer(xh, conv_w, conv_b, w1, b1, f1, w2, b2, f2, w3, skip):
    B, L, _ = xh.shape
    xp = jnp.pad(xh, ((0, 0), (1, 1), (0, 0)))
    uc = conv_w[0] * xp[:, :-2] + conv_w[1] * xp[:, 1:-1] + conv_w[2] * xp[:, 2:] + conv_b
    v, x1, x2 = jnp.split(uc.astype(jnp.float32), 3, axis=-1)
    h = hyena_filters(L, w1, b1, f1, w2, b2, f2, w3)
    sk = skip.astype(jnp.float32)
    z = v
    for o, gate in enumerate((x1, x2)):
        z = gate * bidir_long_conv(z, h[:, o, 0], h[:, o, 1], sk[o])
    return z.astype(xh.dtype)


def natten_mixer(q, k, v, rpb):
    B, S, _ = q.shape
    R = S // GRID_W
    KH = min(NA_KH, R)
    KW = NA_KW
    qg = q.reshape(B, R, GRID_W, NA_HEADS, NA_HEAD_DIM)
    kg = k.reshape(B, R, GRID_W, NA_HEADS, NA_HEAD_DIM)
    vg = v.reshape(B, R, GRID_W, NA_HEADS, NA_HEAD_DIM)
    r = jnp.arange(R)
    row_idx = jnp.clip(r - KH // 2, 0, R - KH)[:, None] + jnp.arange(KH)[None, :]
    c = jnp.arange(GRID_W)
    col_idx = jnp.clip(c - KW // 2, 0, GRID_W - KW)[:, None] + jnp.arange(KW)[None, :]
    k_rows = kg[:, row_idx]
    v_rows = vg[:, row_idx]
    onehot = (col_idx[:, :, None] == c[None, None, :]).astype(q.dtype)
    s_rows = jnp.einsum('brwhd,brkvhd->brhwkv', qg, k_rows)
    s = jnp.einsum('brhwkv,wjv->brhwkj', s_rows, onehot)
    dr = row_idx - r[:, None] + (NA_KH - 1)
    dc = col_idx - c[:, None] + (NA_KW - 1)
    bias = rpb[:, dr[:, None, :, None], dc[None, :, None, :]]
    bias = bias.transpose(1, 0, 2, 3, 4)[None]
    logits = s.astype(jnp.float32) * (1.0 / math.sqrt(NA_HEAD_DIM)) + bias.astype(jnp.float32)
    shp = logits.shape
    p = jax.nn.softmax(logits.reshape(shp[:-2] + (KH * KW,)), axis=-1).reshape(shp).astype(v.dtype)
    p_rows = jnp.einsum('brhwkj,wjv->brhwkv', p, onehot)
    o = jnp.einsum('brhwkv,brkvhd->brwhd', p_rows, v_rows)
    return o.reshape(B, S, NA_WIDTH)


def setup_inputs(seed: int = 0) -> dict:
    key = jax.random.key(seed)
    ks = iter(jax.random.split(key, 32))
    f32 = jnp.float32

    def w(shape, fan_in, scale=1.0):
        return jax.random.normal(next(ks), shape, f32) * (scale * fan_in ** -0.5)

    def gain(shape):
        return jnp.ones(shape, f32) + 0.02 * jax.random.normal(next(ks), shape, f32)

    def small(shape, s=0.02):
        return s * jax.random.normal(next(ks), shape, f32)

    return {
        "x": jax.random.normal(next(ks), (BATCH, SEQ, D_MODEL), f32),
        "norm1_g": gain((DEPTH, D_MODEL)),
        "w_in": w((DEPTH, D_MODEL, IN_COLS), D_MODEL),
        "mla_q_norm_g": gain((DEPTH, MLA_Q_RANK)),
        "mla_w_uq": w((DEPTH, MLA_Q_RANK, MLA_HEADS * (MLA_NOPE + MLA_ROPE)), MLA_Q_RANK),
        "mla_kv_norm_g": gain((DEPTH, MLA_KV_RANK)),
        "mla_w_ukv": w((DEPTH, MLA_KV_RANK, MLA_HEADS * (MLA_NOPE + MLA_V)), MLA_KV_RANK),
        "hy_conv_w": w((DEPTH, HY_SHORT, 3 * HY_WIDTH), HY_SHORT),
        "hy_conv_b": small((DEPTH, 3 * HY_WIDTH)),
        "hy_filt_w1": w((DEPTH, HY_EMB, HY_FFN), HY_EMB),
        "hy_filt_b1": small((DEPTH, HY_FFN)),
        "hy_filt_freq1": gain((DEPTH, HY_FFN)),
        "hy_filt_w2": w((DEPTH, HY_FFN, HY_FFN), HY_FFN),
        "hy_filt_b2": small((DEPTH, HY_FFN)),
        "hy_filt_freq2": gain((DEPTH, HY_FFN)),
        "hy_filt_w3": w((DEPTH, HY_FFN, HY_ORDER * 2 * HY_WIDTH), HY_FFN, HY_FILTER_SCALE),
        "hy_skip": small((DEPTH, HY_ORDER, HY_WIDTH), 0.1),
        "na_rpb": small((DEPTH, NA_HEADS, 2 * NA_KH - 1, 2 * NA_KW - 1)),
        "mix_norm_g": gain((DEPTH, D_MIX)),
        "w_out": w((DEPTH, D_MIX, D_MODEL), D_MIX),
        "norm2_g": gain((DEPTH, D_MODEL)),
        "ffn_w_gate": w((DEPTH, D_MODEL, D_FF), D_MODEL),
        "ffn_w_up": w((DEPTH, D_MODEL, D_FF), D_MODEL),
        "ffn_w_down": w((DEPTH, D_FF, D_MODEL), D_FF),
        "final_norm_g": gain((D_MODEL,)),
    }


def reference(x, norm1_g, w_in, mla_q_norm_g, mla_w_uq, mla_kv_norm_g, mla_w_ukv,
              hy_conv_w, hy_conv_b, hy_filt_w1, hy_filt_b1, hy_filt_freq1, hy_filt_w2,
              hy_filt_b2, hy_filt_freq2, hy_filt_w3, hy_skip, na_rpb, mix_norm_g, w_out,
              norm2_g, ffn_w_gate, ffn_w_up, ffn_w_down, final_norm_g):
    for l in range(DEPTH):
        h = rms_norm(x, norm1_g[l])
        proj = h @ w_in[l]
        c_q, c_kv, k_pe, hy_in, na_q, na_k, na_v = split_cols(proj, IN_SIZES)
        y_a = mla_mixer(c_q, c_kv, k_pe, mla_q_norm_g[l], mla_w_uq[l],
                        mla_kv_norm_g[l], mla_w_ukv[l])
        y_b = hyena_mixer(hy_in, hy_conv_w[l], hy_conv_b[l], hy_filt_w1[l], hy_filt_b1[l],
                          hy_filt_freq1[l], hy_filt_w2[l], hy_filt_b2[l], hy_filt_freq2[l],
                          hy_filt_w3[l], hy_skip[l])
        y_c = natten_mixer(na_q, na_k, na_v, na_rpb[l])
        g = mix_norm_g[l]
        y = jnp.concatenate([
            rms_norm(y_a, g[:MLA_WIDTH]),
            rms_norm(y_b, g[MLA_WIDTH:MLA_WIDTH + HY_WIDTH]),
            rms_norm(y_c, g[MLA_WIDTH + HY_WIDTH:]),
        ], axis=-1)
        x = x + y @ w_out[l]
        h2 = rms_norm(x, norm2_g[l])
        x = x + (jax.nn.silu(h2 @ ffn_w_gate[l]) * (h2 @ ffn_w_up[l])) @ ffn_w_down[l]
    return rms_norm(x, final_norm_g)
```

```cpp
#include <hip/hip_runtime.h>
#include <hip/hip_cooperative_groups.h>
#include <cstdio>
#include <cstring>
#include <cstdint>
#include <cmath>
#include <type_traits>
namespace cg = cooperative_groups;


typedef unsigned short bf16_t;
typedef short bf16x8 __attribute__((ext_vector_type(8)));
typedef float f32x4 __attribute__((ext_vector_type(4)));
typedef unsigned u32x4 __attribute__((ext_vector_type(4)));
typedef unsigned u32x2 __attribute__((ext_vector_type(2)));

constexpr int NTOK = 32768, SEQ = 4096;
constexpr int NTHREADS = 512;
constexpr int LDS_BYTES = 147456;
constexpr int TW_LDS_OFF = 69632;
#define PADI(i) ((i) + ((i) >> 4))

struct P {
  const float *x, *norm1_g, *w_in, *q_norm_g, *w_uq, *kv_norm_g, *w_ukv, *conv_w, *conv_b, *fw1, *fb1, *ff1, *fw2, *fb2,
      *ff2, *fw3, *skip, *rpb, *mix_g, *w_out, *norm2_g, *w_gate, *w_up, *w_down, *final_g;
  float* out;
  bf16_t *Win, *Wuq, *Wukv, *Wout, *Wgu, *Wdown;
  bf16_t *xb, *projA, *hyT, *na, *qb, *kb, *vT, *o_a, *o_c, *y, *hidden, *ybT, *naVT;
  float2* H2;
  float* filtT;
  bf16_t* z1T;
  float *part_x, *part_q, *part_kv;
  float2* ropecs;
  float2* tw;
  unsigned* bar;
  unsigned pad0_, pad1_;
};

typedef __bf16 bf16v2_t __attribute__((ext_vector_type(2)));
typedef float f32x2_t __attribute__((ext_vector_type(2)));
__device__ __forceinline__ unsigned cvt_pk_bf16(float lo, float hi) {
  const f32x2_t v = {lo, hi};
  const bf16v2_t r = __builtin_convertvector(v, bf16v2_t);
  return __builtin_bit_cast(unsigned, r);
}
__device__ __forceinline__ bf16_t f2bf(float f) { return (bf16_t)(cvt_pk_bf16(f, 0.f) & 0xffffu); }
__device__ __forceinline__ float bf2f(bf16_t h) { return __uint_as_float(((unsigned)h) << 16); }
__device__ __forceinline__ float bflo(unsigned u) { return __uint_as_float(u << 16); }
__device__ __forceinline__ float bfhi(unsigned u) { return __uint_as_float(u & 0xffff0000u); }

__device__ __forceinline__ void fast_sincos_rev(float rev, float* s, float* c) {
  const float fr = rev - rintf(rev);
  *s = __builtin_amdgcn_sinf(fr);
  *c = __builtin_amdgcn_cosf(fr);
}
__device__ __forceinline__ float fast_sin(float x) {
  const float rev = x * 0.15915494309189535f;
  const float fr = rev - rintf(rev);
  return __builtin_amdgcn_sinf(fr);
}

__device__ __forceinline__ int vblock() {
  const int G = gridDim.x, b = blockIdx.x;
  return ((G & 7) == 0) ? ((b & 7) * (G >> 3) + (b >> 3)) : b;
}

__device__ void conv_w(const float* __restrict__ W, int K, int N, int Npad, const float* __restrict__ g, bf16_t* Bt,
                       int mode, char* smem) {
  float* tile = (float*)smem;
  int tid_ = threadIdx.x;
  asm volatile("" : "+v"(tid_));
  const int tid = tid_;
  const int nkt = K / 64, nnt = Npad / 64;
  for (int job = blockIdx.x; job < nkt * nnt; job += gridDim.x) {
    const int kt = job % nkt, ntile = job / nkt;
    const int k0 = kt * 64, n0 = ntile * 64;
    __syncthreads();
#pragma unroll 4
    for (int i = 0; i < 8; ++i) {
      const int k = (tid >> 6) + 8 * i, n = n0 + (tid & 63);
      float v = 0.f;
      if (n < N) {
        v = W[(size_t)(k0 + k) * N + n];
        if (g) v *= g[k0 + k];
      }
      tile[k * 65 + (tid & 63)] = v;
    }
    __syncthreads();
    {
      const int c = tid, n = c >> 3, kc = c & 7;
      float e[8];
#pragma unroll
      for (int q = 0; q < 8; ++q) e[q] = tile[(kc * 8 + q) * 65 + n];
      u32x4 w;
      w.x = cvt_pk_bf16(e[0], e[1]);
      w.y = cvt_pk_bf16(e[2], e[3]);
      w.z = cvt_pk_bf16(e[4], e[5]);
      w.w = cvt_pk_bf16(e[6], e[7]);
      const int nn = n0 + n;
      int dest = nn;
      if (mode == 1) dest = 32 * (nn >> 4) + (nn & 15);
      if (mode == 2) dest = 32 * (nn >> 4) + 16 + (nn & 15);
      *(u32x4*)(Bt + (size_t)dest * K + k0 + kc * 8) = w;
    }
  }
}

__device__ void filt_mlp(const P& p, int l, char* smem) {
  float* zf = (float*)smem;
  float* h1 = zf + 16 * 17;
  float* h2 = h1 + 64 * 16;
  int tid_ = threadIdx.x;
  asm volatile("" : "+v"(tid_));
  const int tid = tid_, tl = tid & 15, kk = tid >> 4;
  const float* w1 = p.fw1 + l * 17 * 64;
  const float* b1 = p.fb1 + l * 64;
  const float* f1 = p.ff1 + l * 64;
  const float* w2 = p.fw2 + l * 64 * 64;
  const float* b2 = p.fb2 + l * 64;
  const float* f2 = p.ff2 + l * 64;
  const float* w3 = p.fw3 + (size_t)l * 64 * 1536;
  for (int job = blockIdx.x; job < 256; job += gridDim.x) {
    const int t0 = job * 16;
    __syncthreads();
    {
      const int t = t0 + tl;
      if (kk < 8) {
        const float band = 1e-4f + (float)kk * ((7.0f - 1e-4f) / 7.0f);
        const float ang = ((6.283185307179586f * (float)t) * band) / 4096.0f;
        float s, c;
        fast_sincos_rev(ang * 0.15915494309189535f, &s, &c);
        zf[tl * 17 + 1 + kk] = c;
        zf[tl * 17 + 9 + kk] = s;
      } else if (kk == 8) {
        zf[tl * 17] = (float)t / 4095.0f;
      }
    }
    __syncthreads();
#pragma unroll
    for (int m = 0; m < 2; ++m) {
      const int j = kk + 32 * m;
      float a = b1[j];
#pragma unroll 1
      for (int f = 0; f < 17; ++f) a += zf[tl * 17 + f] * w1[f * 64 + j];
      h1[j * 16 + tl] = fast_sin(f1[j] * a);
    }
    __syncthreads();
#pragma unroll
    for (int m = 0; m < 2; ++m) {
      const int j = kk + 32 * m;
      float a = b2[j];
#pragma unroll 16
      for (int i = 0; i < 64; ++i) a += h1[i * 16 + tl] * w2[i * 64 + j];
      h2[j * 16 + tl] = fast_sin(f2[j] * a);
    }
    __syncthreads();
#pragma unroll 1
    for (int mm = 0; mm < 3; ++mm) {
      const int col = tid + 512 * mm;
      float acc[16];
#pragma unroll
      for (int q = 0; q < 16; ++q) acc[q] = 0.f;
#pragma unroll 1
      for (int j0 = 0; j0 < 64; j0 += 8) {
        float wv[8];
#pragma unroll
        for (int q = 0; q < 8; ++q) wv[q] = w3[(size_t)(j0 + q) * 1536 + col];
#pragma unroll
        for (int q = 0; q < 8; ++q) {
          const float w = wv[q];
          const f32x4* hp = (const f32x4*)(h2 + (j0 + q) * 16);
          const f32x4 a0 = hp[0], a1 = hp[1], a2 = hp[2], a3 = hp[3];
          acc[0] += a0[0] * w; acc[1] += a0[1] * w; acc[2] += a0[2] * w; acc[3] += a0[3] * w;
          acc[4] += a1[0] * w; acc[5] += a1[1] * w; acc[6] += a1[2] * w; acc[7] += a1[3] * w;
          acc[8] += a2[0] * w; acc[9] += a2[1] * w; acc[10] += a2[2] * w; acc[11] += a2[3] * w;
          acc[12] += a3[0] * w; acc[13] += a3[1] * w; acc[14] += a3[2] * w; acc[15] += a3[3] * w;
        }
      }
      const int c = col % 384;
      const float lo = -3.0701134573253945f, hi = -15.350567286626972f;
      const float delta = fabsf(lo + (hi - lo) * ((float)c / 383.0f));
      float* dst = p.filtT + (size_t)col * 4096 + t0;
#pragma unroll
      for (int q = 0; q < 16; ++q) {
        const float tn = (float)(t0 + q) / 4095.0f;
        dst[q] = acc[q] * __expf(-tn * delta);
      }
    }
  }
}

__device__ void prep_phase(const P& p, int l, char* smem) {
  for (int w = 0; w < 7; ++w) {
    const float* W; const float* g; bf16_t* Bt; int K, N, Npad, mode = 0;
    switch (w) {
      case 0: W = p.w_in + (size_t)l * 1024 * 2336; K = 1024; N = 2336; Npad = 2560; g = p.norm1_g + l * 1024; Bt = p.Win; break;
      case 1: W = p.w_uq + (size_t)l * 256 * 576; K = 256; N = 576; Npad = 768; g = p.q_norm_g + l * 256; Bt = p.Wuq; break;
      case 2: W = p.w_ukv + (size_t)l * 128 * 768; K = 128; N = 768; Npad = 768; g = p.kv_norm_g + l * 128; Bt = p.Wukv; break;
      case 3: W = p.w_out + (size_t)l * 1024 * 1024; K = 1024; N = 1024; Npad = 1024; g = p.mix_g + l * 1024; Bt = p.Wout; break;
      case 4: W = p.w_gate + (size_t)l * 1024 * 2816; K = 1024; N = 2816; Npad = 2816; g = p.norm2_g + l * 1024; Bt = p.Wgu; mode = 1; break;
      case 5: W = p.w_up + (size_t)l * 1024 * 2816; K = 1024; N = 2816; Npad = 2816; g = p.norm2_g + l * 1024; Bt = p.Wgu; mode = 2; break;
      default: W = p.w_down + (size_t)l * 2816 * 1024; K = 2816; N = 1024; Npad = 1024; g = nullptr; Bt = p.Wdown; break;
    }
    conv_w(W, K, N, Npad, g, Bt, mode, smem);
  }
  filt_mlp(p, l, smem);
  if (l == 0) {
    int tid_ = threadIdx.x;
  asm volatile("" : "+v"(tid_));
  const int tid = tid_, lane = tid & 63, wave = tid >> 6;
    for (int row = blockIdx.x * 8 + wave; row < NTOK; row += gridDim.x * 8) {
      const float* xr = p.x + (size_t)row * 1024;
      bf16_t* xo = p.xb + (size_t)row * 1024;
      float s = 0.f;
#pragma unroll
      for (int i = 0; i < 4; ++i) {
        const f32x4 v = *(const f32x4*)(xr + lane * 4 + 256 * i);
        s += v[0] * v[0] + v[1] * v[1] + v[2] * v[2] + v[3] * v[3];
        u32x2 w;
        w.x = cvt_pk_bf16(v[0], v[1]);
        w.y = cvt_pk_bf16(v[2], v[3]);
        *(u32x2*)(xo + lane * 4 + 256 * i) = w;
      }
#pragma unroll
      for (int o = 1; o < 64; o <<= 1) s += __shfl_xor(s, o);
      if (lane < 16) p.part_x[(size_t)row * 16 + lane] = (lane == 0) ? s : 0.f;
    }
    for (int i = blockIdx.x * 512 + tid; i < 65536 + 8192; i += gridDim.x * 512) {
      if (i < 65536) {
        const int pos = i >> 4, k = i & 15;
        const float ang = (float)pos * __builtin_amdgcn_exp2f(-(float)k * 0.8304820237218405f);
        float s, c;
        fast_sincos_rev(ang * 0.15915494309189535f, &s, &c);
        p.ropecs[i] = make_float2(c, s);
      } else {
        const int k = i - 65536;
        const int ms = 1 << (31 - __clz(k + 1));
        const int pp = k + 1 - ms;
        float s, c;
        fast_sincos_rev((float)pp / (float)(2 * ms), &s, &c);
        p.tw[k] = make_float2(c, -s);
      }
    }
  }
}

template <int LOGR, int MTOP, bool INV, bool ZIN = false, bool HOUT = false>
__device__ __forceinline__ void fft_pass(float2* sm, const float2* tw) {
  constexpr int R = 1 << LOGR;
  constexpr int q = MTOP >> (LOGR - 1);
  constexpr int ntask = 8192 / R;
  for (int T = threadIdx.x; T < ntask; T += NTHREADS) {
    const int i = T & (q - 1);
    const int blk = T / q;
    const int base = blk * (2 * MTOP) + i;
    float2 v[R];
#pragma unroll
    for (int e = 0; e < R; ++e) {
      if (ZIN && e >= R / 2) v[e] = make_float2(0.f, 0.f);
      else v[e] = sm[PADI(base + e * q)];
    }
    if (!INV) {
#pragma unroll
      for (int s = 0; s < LOGR; ++s) {
        constexpr int dummy = 0;
        (void)dummy;
        const int hs = 1 << (LOGR - 1 - s);
        const int ms = MTOP >> s;
#pragma unroll
        for (int e = 0; e < R; ++e) {
          if ((e & hs) == 0) {
            const int pp = i + (e & (hs - 1)) * q;
            const float2 w = tw[(ms - 1) + pp];
            const float2 a = v[e], b = v[e + hs];
            v[e] = make_float2(a.x + b.x, a.y + b.y);
            const float dx = a.x - b.x, dy = a.y - b.y;
            v[e + hs] = make_float2(dx * w.x - dy * w.y, dx * w.y + dy * w.x);
          }
        }
      }
    } else {
#pragma unroll
      for (int s = LOGR - 1; s >= 0; --s) {
        const int hs = 1 << (LOGR - 1 - s);
        const int ms = MTOP >> s;
#pragma unroll
        for (int e = 0; e < R; ++e) {
          if ((e & hs) == 0) {
            const int pp = i + (e & (hs - 1)) * q;
            const float2 w = tw[(ms - 1) + pp];
            const float2 a = v[e], b = v[e + hs];
            const float tx = b.x * w.x + b.y * w.y, ty = b.y * w.x - b.x * w.y;
            v[e] = make_float2(a.x + tx, a.y + ty);
            v[e + hs] = make_float2(a.x - tx, a.y - ty);
          }
        }
      }
    }
#pragma unroll
    for (int e = 0; e < R; ++e) {
      if (HOUT && e >= R / 2) continue;
      sm[PADI(base + e * q)] = v[e];
    }
  }
  __syncthreads();
}

__device__ __forceinline__ void fft_fwd(float2* sm, const float2* tw) {
  fft_pass<4, 4096, false>(sm, tw);
  fft_pass<4, 256, false>(sm, tw);
  fft_pass<4, 16, false>(sm, tw);
  fft_pass<1, 1, false>(sm, tw);
}
__device__ __forceinline__ void fft_inv(float2* sm, const float2* tw) {
  fft_pass<1, 1, true>(sm, tw);
  fft_pass<3, 8, true>(sm, tw);
  fft_pass<3, 64, true>(sm, tw);
  fft_pass<3, 512, true>(sm, tw);
  fft_pass<3, 4096, true>(sm, tw);
}

__device__ void filt_fft_phase(const P& p, int l, char* smem) {
  float2* sm = (float2*)smem;
  float2* tws = (float2*)(smem + TW_LDS_OFF);
  int tid_ = threadIdx.x;
  asm volatile("" : "+v"(tid_));
  const int tid = tid_;
  for (int i = tid; i < 8192; i += NTHREADS) tws[i] = p.tw[i];
  for (int jj = blockIdx.x; jj < 768; jj += gridDim.x) {
    const int job = jj;
    const int o = job / 384, c = job % 384;
    const float* hf = p.filtT + ((size_t)((o * 2 + 0) * 384 + c)) * 4096;
    const float* hb = p.filtT + ((size_t)((o * 2 + 1) * 384 + c)) * 4096;
    const float sk = p.skip[(l * 2 + o) * 384 + c];
    __syncthreads();
    for (int n = tid; n < 8192; n += NTHREADS) {
      float v;
      if (n == 0) v = hf[0] + hb[0] + sk;
      else if (n < 4096) v = hf[n];
      else if (n == 4096) v = 0.f;
      else v = hb[8192 - n];
      sm[PADI(n)] = make_float2(v, 0.f);
    }
    __syncthreads();
    fft_fwd(sm, tws);
    float2* dst = p.H2 + (size_t)job * 8192;
    const float sc = 1.0f / 8192.0f;
    for (int n = tid; n < 8192; n += NTHREADS) {
      const float2 v = sm[PADI(n)];
      dst[n] = make_float2(v.x * sc, v.y * sc);
    }
  }
}

__device__ __forceinline__ float short_conv(const bf16_t* row, int t, float w0, float w1, float w2, float bias) {
  const float xm = (t > 0) ? bf2f(row[t - 1]) : 0.f;
  const float x0 = bf2f(row[t]);
  const float xp = (t < SEQ - 1) ? bf2f(row[t + 1]) : 0.f;
  return w0 * xm + w1 * x0 + w2 * xp + bias;
}

__device__ __forceinline__ void conv8(const bf16_t* row, int t0, float w0, float w1, float w2, float bias, float (&out)[8]) {
  const u32x4 v = *(const u32x4*)(row + t0);
  float x[10];
  x[0] = (t0 > 0) ? bf2f(row[t0 - 1]) : 0.f;
  x[1] = bflo(v.x); x[2] = bfhi(v.x); x[3] = bflo(v.y); x[4] = bfhi(v.y);
  x[5] = bflo(v.z); x[6] = bfhi(v.z); x[7] = bflo(v.w); x[8] = bfhi(v.w);
  x[9] = (t0 + 8 < SEQ) ? bf2f(row[t0 + 8]) : 0.f;
#pragma unroll
  for (int k = 0; k < 8; ++k) out[k] = w0 * x[k] + w1 * x[k + 1] + w2 * x[k + 2] + bias;
}

__device__ __forceinline__ void fft_mid(float2* sm, const float2* __restrict__ H) {
  for (int T = threadIdx.x; T < 4096; T += NTHREADS) {
    const float2 a = sm[PADI(2 * T)], b = sm[PADI(2 * T + 1)];
    const f32x4 h = *(const f32x4*)(H + 2 * T);
    const float sx = a.x + b.x, sy = a.y + b.y, dx = a.x - b.x, dy = a.y - b.y;
    const float Ax = sx * h[0] - sy * h[1], Ay = sx * h[1] + sy * h[0];
    const float Bx = dx * h[2] - dy * h[3], By = dx * h[3] + dy * h[2];
    sm[PADI(2 * T)] = make_float2(Ax + Bx, Ay + By);
    sm[PADI(2 * T + 1)] = make_float2(Ax - Bx, Ay - By);
  }
  __syncthreads();
}

template <int ORD>
__device__ void hyena_phase(const P& p, int l, char* smem) {
  float2* sm = (float2*)smem;
  float2* tws = (float2*)(smem + TW_LDS_OFF);
  int tid_ = threadIdx.x;
  asm volatile("" : "+v"(tid_));
  const int tid = tid_;
  for (int i = tid; i < 8192; i += NTHREADS) tws[i] = p.tw[i];
  const float* cw = p.conv_w + (size_t)l * 3 * 1152;
  const float* cb = p.conv_b + (size_t)l * 1152;
  const int t0 = tid * 8;
  for (int job = vblock(); job < 1536; job += gridDim.x) {
    const int pair = job & 3, c = job >> 2;
    const int b1 = pair * 2, b2 = b1 + 1;
    __syncthreads();
    {
      float u1[8], u2[8];
      if (ORD == 0) {
        const bf16_t* r1 = p.hyT + ((size_t)(b1 * 1152 + c)) * 4096;
        const bf16_t* r2 = p.hyT + ((size_t)(b2 * 1152 + c)) * 4096;
        const float w0 = cw[c], w1 = cw[1152 + c], w2 = cw[2304 + c], bi = cb[c];
        conv8(r1, t0, w0, w1, w2, bi, u1);
        conv8(r2, t0, w0, w1, w2, bi, u2);
      } else {
        const u32x4 a0 = *(const u32x4*)(p.z1T + ((size_t)(b1 * 384 + c)) * 4096 + t0);
        const u32x4 c0_ = *(const u32x4*)(p.z1T + ((size_t)(b2 * 384 + c)) * 4096 + t0);
        u1[0] = bflo(a0.x); u1[1] = bfhi(a0.x); u1[2] = bflo(a0.y); u1[3] = bfhi(a0.y); u1[4] = bflo(a0.z); u1[5] = bfhi(a0.z); u1[6] = bflo(a0.w); u1[7] = bfhi(a0.w);
        u2[0] = bflo(c0_.x); u2[1] = bfhi(c0_.x); u2[2] = bflo(c0_.y); u2[3] = bfhi(c0_.y); u2[4] = bflo(c0_.z); u2[5] = bfhi(c0_.z); u2[6] = bflo(c0_.w); u2[7] = bfhi(c0_.w);
      }
#pragma unroll
      for (int k = 0; k < 8; ++k) {
        sm[PADI(t0 + k)] = make_float2(u1[k], u2[k]);
      }
    }
    __syncthreads();
    fft_pass<4, 4096, false, true, false>(sm, tws);
    fft_pass<4, 256, false>(sm, tws);
    fft_pass<4, 16, false>(sm, tws);
    fft_mid(sm, p.H2 + ((size_t)(ORD * 384 + c)) * 8192);
    fft_pass<4, 16, true>(sm, tws);
    fft_pass<4, 256, true>(sm, tws);
    fft_pass<4, 4096, true, false, true>(sm, tws);
    {
      const int gc = (ORD == 0 ? 384 : 768) + c;
      const bf16_t* g1 = p.hyT + ((size_t)(b1 * 1152 + gc)) * 4096;
      const bf16_t* g2 = p.hyT + ((size_t)(b2 * 1152 + gc)) * 4096;
      const float w0 = cw[gc], w1 = cw[1152 + gc], w2 = cw[2304 + gc], bi = cb[gc];
      float q1[8], q2[8];
      conv8(g1, t0, w0, w1, w2, bi, q1);
      conv8(g2, t0, w0, w1, w2, bi, q2);
#pragma unroll
      for (int k = 0; k < 8; ++k) {
        const float2 yv = sm[PADI(t0 + k)];
        q1[k] *= yv.x;
        q2[k] *= yv.y;
      }
      {
        bf16_t* dbase = (ORD == 0) ? p.z1T : p.ybT;
        u32x4 w1_, w2_;
        w1_.x = cvt_pk_bf16(q1[0], q1[1]); w1_.y = cvt_pk_bf16(q1[2], q1[3]); w1_.z = cvt_pk_bf16(q1[4], q1[5]); w1_.w = cvt_pk_bf16(q1[6], q1[7]);
        w2_.x = cvt_pk_bf16(q2[0], q2[1]); w2_.y = cvt_pk_bf16(q2[2], q2[3]); w2_.z = cvt_pk_bf16(q2[4], q2[5]); w2_.w = cvt_pk_bf16(q2[6], q2[7]);
        *(u32x4*)(dbase + ((size_t)(b1 * 384 + c)) * 4096 + t0) = w1_;
        *(u32x4*)(dbase + ((size_t)(b2 * 384 + c)) * 4096 + t0) = w2_;
      }
    }
  }
}

constexpr int KROW = 208;
constexpr int VROW = 136;
constexpr int KBUF = 64 * KROW, VBUF = 64 * VROW;

constexpr int NK_ROW = 528;
constexpr int NK_BUF = 32 * NK_ROW;
constexpr int NV_ROW = 72;
constexpr int NV_BUF = 256 * NV_ROW;
constexpr int NRPB_OFF = 2 * NK_BUF + 2 * NV_BUF;

__device__ void natten_phase(const P& p, int l, char* smem) {
  int tid_ = threadIdx.x;
  asm volatile("" : "+v"(tid_));
  const int tid = tid_, lane = tid & 63, wave = tid >> 6, l15 = lane & 15, g = lane >> 4;
  const int hw = wave >> 1, qh = wave & 1;
  char* Ks = smem;
  char* Vs = smem + 2 * NK_BUF;
  float* rp = (float*)(smem + NRPB_OFF);
  __syncthreads();
  for (int i = tid; i < 4 * 15 * 31; i += NTHREADS) rp[i] = p.rpb[(size_t)l * 4 * 15 * 31 + i] * 1.4426950408889634f;
  const float qscale = 0.125f * 1.4426950408889634f;
  for (int job = blockIdx.x; job < 512; job += gridDim.x) {
    const int r = job & 63, b = job >> 6;
    const int r0 = min(max(r - 4, 0), 56);
    bf16x8 qf[2][2];
    int cq[2], c0[2];
#pragma unroll
    for (int nt = 0; nt < 2; ++nt) {
      cq[nt] = qh * 32 + nt * 16 + l15;
      c0[nt] = min(max(cq[nt] - 8, 0), 48);
      const bf16_t* qp = p.na + (size_t)(b * 4096 + r * 64 + cq[nt]) * 768 + hw * 64;
#pragma unroll
      for (int ks = 0; ks < 2; ++ks) qf[nt][ks] = *(const bf16x8*)(qp + ks * 32 + g * 8);
    }
    f32x4 o[4][2];
#pragma unroll
    for (int a = 0; a < 4; ++a)
#pragma unroll
      for (int n = 0; n < 2; ++n) o[a][n] = (f32x4){0.f, 0.f, 0.f, 0.f};
    float mrow[2] = {-1e30f, -1e30f}, lrow[2] = {0.f, 0.f};
    u32x4 rk[2], rv[2];
    auto gload = [&](int t) {
      const int kr = r0 + (t >> 1), kh = (t & 1) * 32;
      const bf16_t* kbase = p.na + (size_t)(b * 4096 + kr * 64 + kh) * 768 + 256;
#pragma unroll
      for (int i = 0; i < 2; ++i) {
        const int c = tid + 512 * i, key = c >> 5, cc = c & 31;
        rk[i] = *(const u32x4*)(kbase + (size_t)key * 768 + cc * 8);
      }
#pragma unroll
      for (int i = 0; i < 2; ++i) {
        const int c = tid + 512 * i, row = c >> 2, cc = c & 3;
        rv[i] = *(const u32x4*)(p.naVT + ((size_t)(b * 256 + row)) * 4096 + kr * 64 + kh + cc * 8);
      }
    };
    auto lstore = [&](int buf) {
      char* kb_ = Ks + buf * NK_BUF;
      char* vb_ = Vs + buf * NV_BUF;
#pragma unroll
      for (int i = 0; i < 2; ++i) {
        const int c = tid + 512 * i, key = c >> 5, cc = c & 31;
        *(u32x4*)(kb_ + key * NK_ROW + cc * 16) = rk[i];
      }
#pragma unroll
      for (int i = 0; i < 2; ++i) {
        const int c = tid + 512 * i, row = c >> 2, cc = c & 3;
        u32x2 lo, hi;
        lo.x = rv[i].x; lo.y = rv[i].y; hi.x = rv[i].z; hi.y = rv[i].w;
        *(u32x2*)(vb_ + row * NV_ROW + cc * 16) = lo;
        *(u32x2*)(vb_ + row * NV_ROW + cc * 16 + 8) = hi;
      }
    };
    gload(0);
    __syncthreads();
    lstore(0);
    __syncthreads();
    for (int t = 0; t < 16; ++t) {
      if (t + 1 < 16) gload(t + 1);
      __builtin_amdgcn_sched_barrier(0);
      const char* kb_ = Ks + (t & 1) * NK_BUF;
      const char* vb_ = Vs + (t & 1) * NV_BUF + hw * 64 * NV_ROW;
      const int kh = (t & 1) * 32;
      f32x4 s[2][2];
#pragma unroll
      for (int a = 0; a < 2; ++a)
#pragma unroll
        for (int n = 0; n < 2; ++n) s[a][n] = (f32x4){0.f, 0.f, 0.f, 0.f};
#pragma unroll
      for (int mt = 0; mt < 2; ++mt)
#pragma unroll
        for (int ks = 0; ks < 2; ++ks) {
          const bf16x8 kf = *(const bf16x8*)(kb_ + (mt * 16 + l15) * NK_ROW + hw * 128 + ks * 64 + g * 16);
#pragma unroll
          for (int nt = 0; nt < 2; ++nt)
            s[mt][nt] = __builtin_amdgcn_mfma_f32_16x16x32_bf16(kf, qf[nt][ks], s[mt][nt], 0, 0, 0);
        }
      const float* brow = rp + (hw * 15 + (r0 + (t >> 1) - r + 7)) * 31;
      bf16x8 pf[2];
#pragma unroll
      for (int nt = 0; nt < 2; ++nt) {
        float mx = -1e30f;
#pragma unroll
        for (int mt = 0; mt < 2; ++mt)
#pragma unroll
          for (int j = 0; j < 4; ++j) {
            const int kc = kh + mt * 16 + g * 4 + j;
            const bool valid = (unsigned)(kc - c0[nt]) < 16u;
            const int dc = min(max(kc - cq[nt] + 15, 0), 30);
            const float sc = valid ? (s[mt][nt][j] * qscale + brow[dc]) : -1e30f;
            s[mt][nt][j] = sc;
            mx = fmaxf(mx, sc);
          }
        mx = fmaxf(mx, __shfl_xor(mx, 16));
        mx = fmaxf(mx, __shfl_xor(mx, 32));
        const float mnew = fmaxf(mrow[nt], mx);
        const float alpha = __builtin_amdgcn_exp2f(mrow[nt] - mnew);
        mrow[nt] = mnew;
        float ls = 0.f;
#pragma unroll
        for (int mt = 0; mt < 2; ++mt)
#pragma unroll
          for (int j = 0; j < 4; ++j) {
            const float e = (s[mt][nt][j] > -1e29f) ? __builtin_amdgcn_exp2f(s[mt][nt][j] - mnew) : 0.f;
            s[mt][nt][j] = e;
            ls += e;
          }
        lrow[nt] = lrow[nt] * alpha + ls;
#pragma unroll
        for (int a = 0; a < 4; ++a) o[a][nt] *= alpha;
        u32x4 w;
        w.x = cvt_pk_bf16(s[0][nt][0], s[0][nt][1]);
        w.y = cvt_pk_bf16(s[0][nt][2], s[0][nt][3]);
        w.z = cvt_pk_bf16(s[1][nt][0], s[1][nt][1]);
        w.w = cvt_pk_bf16(s[1][nt][2], s[1][nt][3]);
        pf[nt] = __builtin_bit_cast(bf16x8, w);
      }
#pragma unroll
      for (int mt = 0; mt < 4; ++mt) {
        const u32x2 lo = *(const u32x2*)(vb_ + (mt * 16 + l15) * NV_ROW + (4 * g) * 2);
        const u32x2 hi = *(const u32x2*)(vb_ + (mt * 16 + l15) * NV_ROW + (16 + 4 * g) * 2);
        u32x4 w;
        w.x = lo.x; w.y = lo.y; w.z = hi.x; w.w = hi.y;
        const bf16x8 vf = __builtin_bit_cast(bf16x8, w);
#pragma unroll
        for (int nt = 0; nt < 2; ++nt)
          o[mt][nt] = __builtin_amdgcn_mfma_f32_16x16x32_bf16(vf, pf[nt], o[mt][nt], 0, 0, 0);
      }
      if (t + 1 < 16) lstore((t + 1) & 1);
      __syncthreads();
    }
#pragma unroll
    for (int nt = 0; nt < 2; ++nt) {
      float lt = lrow[nt];
      lt += __shfl_xor(lt, 16);
      lt += __shfl_xor(lt, 32);
      const float inv = 1.0f / lt;
      const int tok = b * 4096 + r * 64 + cq[nt];
#pragma unroll
      for (int mt = 0; mt < 4; ++mt) {
        u32x2 w;
        w.x = cvt_pk_bf16(o[mt][nt][0] * inv, o[mt][nt][1] * inv);
        w.y = cvt_pk_bf16(o[mt][nt][2] * inv, o[mt][nt][3] * inv);
        *(u32x2*)(p.o_c + (size_t)tok * 256 + hw * 64 + mt * 16 + g * 4) = w;
      }
    }
  }
}


__device__ void attn_phase(const P& p, char* smem) {
  int tid_ = threadIdx.x;
  asm volatile("" : "+v"(tid_));
  const int tid = tid_, lane = tid & 63, wave = tid >> 6, l15 = lane & 15, g = lane >> 4;
  char* Ks = smem;
  char* Vs = smem + 2 * KBUF;
  for (int job = vblock(); job < 768; job += gridDim.x) {
    const int qblk = job & 15, bh = job >> 4;
    const int b = bh / 6, h = bh % 6;
    const bf16_t* Q = p.qb + (size_t)bh * 4096 * 96;
    const bf16_t* Kg = p.kb + (size_t)bh * 4096 * 96;
    const bf16_t* Vt = p.vT + (size_t)bh * 64 * 4096;
    const int q0 = qblk * 256 + wave * 32;
    bf16x8 qf[2][3];
#pragma unroll
    for (int nt = 0; nt < 2; ++nt)
#pragma unroll
      for (int ks = 0; ks < 3; ++ks)
        qf[nt][ks] = *(const bf16x8*)(Q + (size_t)(q0 + nt * 16 + l15) * 96 + ks * 32 + g * 8);
    f32x4 o[4][2];
#pragma unroll
    for (int a = 0; a < 4; ++a)
#pragma unroll
      for (int n = 0; n < 2; ++n) o[a][n] = (f32x4){0.f, 0.f, 0.f, 0.f};
    float mrow[2] = {-1e30f, -1e30f}, lrow[2] = {0.f, 0.f};

    u32x4 rk[2];
    u32x4 rv;
    const int kr1 = (tid + 512) / 12, kc1 = (tid + 512) - kr1 * 12;
    const int kr0 = tid / 12, kc0 = tid - kr0 * 12;
    auto gload = [&](int kt) {
      const u32x4* kp = (const u32x4*)(Kg + (size_t)kt * 64 * 96);
      rk[0] = kp[tid];
      if (tid < 256) rk[1] = kp[tid + 512];
      rv = *(const u32x4*)(Vt + (size_t)(tid >> 3) * 4096 + kt * 64 + (tid & 7) * 8);
    };
    auto lstore = [&](int buf) {
      char* kb_ = Ks + buf * KBUF;
      char* vb_ = Vs + buf * VBUF;
      *(u32x4*)(kb_ + kr0 * KROW + kc0 * 16) = rk[0];
      if (tid < 256) *(u32x4*)(kb_ + kr1 * KROW + kc1 * 16) = rk[1];
      u32x2 lo, hi;
      lo.x = rv.x; lo.y = rv.y; hi.x = rv.z; hi.y = rv.w;
      *(u32x2*)(vb_ + (tid >> 3) * VROW + (tid & 7) * 16) = lo;
      *(u32x2*)(vb_ + (tid >> 3) * VROW + (tid & 7) * 16 + 8) = hi;
    };
    const int NKT = 64;
    gload(0);
    __syncthreads();
    lstore(0);
    __syncthreads();
    for (int kt = 0; kt < NKT; ++kt) {
      if (kt + 1 < NKT) gload(kt + 1);
      __builtin_amdgcn_sched_barrier(0);
      const char* kb_ = Ks + (kt & 1) * KBUF;
      const char* vb_ = Vs + (kt & 1) * VBUF;
      f32x4 s[4][2];
#pragma unroll
      for (int a = 0; a < 4; ++a)
#pragma unroll
        for (int n = 0; n < 2; ++n) s[a][n] = (f32x4){0.f, 0.f, 0.f, 0.f};
#pragma unroll
      for (int mt = 0; mt < 4; ++mt)
#pragma unroll
        for (int ks = 0; ks < 3; ++ks) {
          const bf16x8 kf = *(const bf16x8*)(kb_ + (mt * 16 + l15) * KROW + (ks * 32 + g * 8) * 2);
#pragma unroll
          for (int nt = 0; nt < 2; ++nt)
            s[mt][nt] = __builtin_amdgcn_mfma_f32_16x16x32_bf16(kf, qf[nt][ks], s[mt][nt], 0, 0, 0);
        }
      bf16x8 pf[2][2];
#pragma unroll
      for (int nt = 0; nt < 2; ++nt) {
        float mx = s[0][nt][0];
#pragma unroll
        for (int mt = 0; mt < 4; ++mt)
#pragma unroll
          for (int j = 0; j < 4; ++j) mx = fmaxf(mx, s[mt][nt][j]);
        mx = fmaxf(mx, __shfl_xor(mx, 16));
        mx = fmaxf(mx, __shfl_xor(mx, 32));
        if (__any(mx > mrow[nt] + 8.0f)) {
          const float mnew = fmaxf(mrow[nt], mx);
          const float alpha = __builtin_amdgcn_exp2f(mrow[nt] - mnew);
          mrow[nt] = mnew;
          lrow[nt] *= alpha;
#pragma unroll
          for (int a = 0; a < 4; ++a) o[a][nt] *= alpha;
        }
        const float mref = mrow[nt];
        float ls = 0.f;
#pragma unroll
        for (int mt = 0; mt < 4; ++mt)
#pragma unroll
          for (int j = 0; j < 4; ++j) {
            const float e = __builtin_amdgcn_exp2f(s[mt][nt][j] - mref);
            s[mt][nt][j] = e;
            ls += e;
          }
        lrow[nt] += ls;
#pragma unroll
        for (int kk = 0; kk < 2; ++kk) {
          u32x4 w;
          w.x = cvt_pk_bf16(s[2 * kk][nt][0], s[2 * kk][nt][1]);
          w.y = cvt_pk_bf16(s[2 * kk][nt][2], s[2 * kk][nt][3]);
          w.z = cvt_pk_bf16(s[2 * kk + 1][nt][0], s[2 * kk + 1][nt][1]);
          w.w = cvt_pk_bf16(s[2 * kk + 1][nt][2], s[2 * kk + 1][nt][3]);
          pf[kk][nt] = __builtin_bit_cast(bf16x8, w);
        }
      }
#pragma unroll
      for (int kk = 0; kk < 2; ++kk)
#pragma unroll
        for (int mt = 0; mt < 4; ++mt) {
          const u32x2 lo = *(const u32x2*)(vb_ + (mt * 16 + l15) * VROW + (32 * kk + 4 * g) * 2);
          const u32x2 hi = *(const u32x2*)(vb_ + (mt * 16 + l15) * VROW + (32 * kk + 16 + 4 * g) * 2);
          u32x4 w;
          w.x = lo.x; w.y = lo.y; w.z = hi.x; w.w = hi.y;
          const bf16x8 vf = __builtin_bit_cast(bf16x8, w);
#pragma unroll
          for (int nt = 0; nt < 2; ++nt)
            o[mt][nt] = __builtin_amdgcn_mfma_f32_16x16x32_bf16(vf, pf[kk][nt], o[mt][nt], 0, 0, 0);
        }
      if (kt + 1 < NKT) lstore((kt + 1) & 1);
      __syncthreads();
    }
#pragma unroll
    for (int nt = 0; nt < 2; ++nt) {
      float lt = lrow[nt];
      lt += __shfl_xor(lt, 16);
      lt += __shfl_xor(lt, 32);
      const float inv = 1.0f / lt;
      const int tok = b * 4096 + q0 + nt * 16 + l15;
#pragma unroll
      for (int mt = 0; mt < 4; ++mt) {
        u32x2 w;
        w.x = cvt_pk_bf16(o[mt][nt][0] * inv, o[mt][nt][1] * inv);
        w.y = cvt_pk_bf16(o[mt][nt][2] * inv, o[mt][nt][3] * inv);
        *(u32x2*)(p.o_a + (size_t)tok * 384 + h * 64 + mt * 16 + g * 4) = w;
      }
    }
  }
}

__device__ void mixnorm_phase(const P& p, char* smem) {
  int tid_ = threadIdx.x;
  asm volatile("" : "+v"(tid_));
  const int tid = tid_;
  for (int job = blockIdx.x; job < NTOK / 32; job += gridDim.x) {
    const int tok0 = job * 32, b = tok0 >> 12, s0 = tok0 & 4095;
    __syncthreads();
#pragma unroll
    for (int i = 0; i < 3; ++i) {
      const int c = tid + 512 * i, row = c / 48, cc = c % 48;
      *(u32x4*)(smem + row * 2048 + cc * 16) = *(const u32x4*)(p.o_a + (size_t)(tok0 + row) * 384 + cc * 8);
    }
#pragma unroll
    for (int i = 0; i < 2; ++i) {
      const int c = tid + 512 * i, row = c >> 5, cc = c & 31;
      *(u32x4*)(smem + row * 2048 + 1536 + cc * 16) = *(const u32x4*)(p.o_c + (size_t)(tok0 + row) * 256 + cc * 8);
    }
#pragma unroll
    for (int i = 0; i < 3; ++i) {
      const int c = tid + 512 * i, ch = c >> 2, tc = c & 3;
      const u32x4 v = *(const u32x4*)(p.ybT + ((size_t)(b * 384 + ch)) * 4096 + s0 + tc * 8);
      bf16_t* dst = (bf16_t*)smem + (size_t)(tc * 8) * 1024 + 384 + ch;
      dst[0 * 1024] = (bf16_t)(v.x & 0xffff); dst[1 * 1024] = (bf16_t)(v.x >> 16);
      dst[2 * 1024] = (bf16_t)(v.y & 0xffff); dst[3 * 1024] = (bf16_t)(v.y >> 16);
      dst[4 * 1024] = (bf16_t)(v.z & 0xffff); dst[5 * 1024] = (bf16_t)(v.z >> 16);
      dst[6 * 1024] = (bf16_t)(v.w & 0xffff); dst[7 * 1024] = (bf16_t)(v.w >> 16);
    }
    __syncthreads();
    const int tok = tid >> 4, sub = tid & 15;
    float ss[3] = {0.f, 0.f, 0.f};
#pragma unroll
    for (int gi = 0; gi < 3; ++gi) {
      const int i0 = (gi == 0) ? 0 : (gi == 1 ? 3 : 6), i1 = (gi == 0) ? 3 : (gi == 1 ? 6 : 8);
      float acc = 0.f;
#pragma unroll 2
      for (int i = i0; i < i1; ++i) {
        const u32x4 v = *(const u32x4*)(smem + tok * 2048 + (sub + 16 * i) * 16);
        float a;
        a = bflo(v.x); acc += a * a; a = bfhi(v.x); acc += a * a;
        a = bflo(v.y); acc += a * a; a = bfhi(v.y); acc += a * a;
        a = bflo(v.z); acc += a * a; a = bfhi(v.z); acc += a * a;
        a = bflo(v.w); acc += a * a; a = bfhi(v.w); acc += a * a;
      }
      acc += __shfl_xor(acc, 1);
      acc += __shfl_xor(acc, 2);
      acc += __shfl_xor(acc, 4);
      acc += __shfl_xor(acc, 8);
      ss[gi] = acc;
    }
    float rs[3];
    rs[0] = rsqrtf(ss[0] * (1.0f / 384.0f) + 1e-6f);
    rs[1] = rsqrtf(ss[1] * (1.0f / 384.0f) + 1e-6f);
    rs[2] = rsqrtf(ss[2] * (1.0f / 256.0f) + 1e-6f);
#pragma unroll
    for (int gi = 0; gi < 3; ++gi) {
      const int i0 = (gi == 0) ? 0 : (gi == 1 ? 3 : 6), i1 = (gi == 0) ? 3 : (gi == 1 ? 6 : 8);
      const float r = rs[gi];
#pragma unroll 2
      for (int i = i0; i < i1; ++i) {
        const u32x4 v = *(const u32x4*)(smem + tok * 2048 + (sub + 16 * i) * 16);
        u32x4 w;
        w.x = cvt_pk_bf16(bflo(v.x) * r, bfhi(v.x) * r);
        w.y = cvt_pk_bf16(bflo(v.y) * r, bfhi(v.y) * r);
        w.z = cvt_pk_bf16(bflo(v.z) * r, bfhi(v.z) * r);
        w.w = cvt_pk_bf16(bflo(v.w) * r, bfhi(v.w) * r);
        *(u32x4*)(p.y + (size_t)(tok0 + tok) * 1024 + (sub + 16 * i) * 8) = w;
      }
    }
  }
}

enum { EPI_INPROJ = 0, EPI_QUP = 1, EPI_KVUP = 2, EPI_OUTPROJ = 3, EPI_SWIGLU = 4, EPI_DOWN = 5 };

template <int EPI>
__device__ void gemm_phase(const P& p, int l, const bf16_t* __restrict__ A, int lda, const bf16_t* __restrict__ Bt,
                           int K, int nN, char* smem) {
  int tid_ = threadIdx.x;
  asm volatile("" : "+v"(tid_));
  const int tid = tid_, lane = tid & 63, wave = tid >> 6, wm = wave >> 2, wn = wave & 3, l15 = lane & 15,
            g = lane >> 4;
  const int ntiles = 128 * nN;
  const int srow = tid >> 3, skc = tid & 7;
  const int sw_off = srow * 128 + ((skc ^ ((srow >> 1) & 7)) * 16);
  const int rsw = (l15 >> 1) & 7;
  for (int tile = vblock(); tile < ntiles; tile += gridDim.x) {
    const int gsz_ = 4 * nN, grp_ = tile / gsz_, w_ = tile - grp_ * gsz_;
    const int ni = w_ >> 2, mi = grp_ * 4 + (w_ & 3);
    const int m0 = mi * 256, n0 = ni * 256;
    f32x4 acc[8][4];
#pragma unroll
    for (int a = 0; a < 8; ++a)
#pragma unroll
      for (int b = 0; b < 4; ++b) acc[a][b] = (f32x4){0.f, 0.f, 0.f, 0.f};
    const bf16_t* Ag = A + (size_t)(m0 + srow) * lda + skc * 8;
    const bf16_t* Bg = Bt + (size_t)(n0 + srow) * K + skc * 8;
    u32x4 ra[4], rb[4];
    auto gl = [&](int kt) {
#pragma unroll
      for (int i = 0; i < 4; ++i) ra[i] = *(const u32x4*)(Ag + (size_t)i * 64 * lda + kt * 64);
#pragma unroll
      for (int i = 0; i < 4; ++i) rb[i] = *(const u32x4*)(Bg + (size_t)i * 64 * K + kt * 64);
    };
    auto st = [&](int buf) {
      char* nb = smem + buf * 65536;
#pragma unroll
      for (int i = 0; i < 4; ++i) *(u32x4*)(nb + sw_off + i * 8192) = ra[i];
#pragma unroll
      for (int i = 0; i < 4; ++i) *(u32x4*)(nb + 32768 + sw_off + i * 8192) = rb[i];
    };
    const int nk = K / 64;
    gl(0);
    __syncthreads();
    st(0);
    __syncthreads();
    for (int kt = 0; kt < nk; ++kt) {
      if (kt + 1 < nk) gl(kt + 1);
      __builtin_amdgcn_sched_barrier(0);
      const char* Ab = smem + (kt & 1) * 65536;
      const char* Bb = Ab + 32768;
#pragma unroll
      for (int ks = 0; ks < 2; ++ks) {
        bf16x8 bfr[4];
#pragma unroll
        for (int nt = 0; nt < 4; ++nt)
          bfr[nt] = *(const bf16x8*)(Bb + (wn * 64 + nt * 16 + l15) * 128 + (((ks * 4 + g) ^ rsw) * 16));
        bf16x8 af[2][2];
#pragma unroll
        for (int mt = 0; mt < 2; ++mt)
          af[0][mt] = *(const bf16x8*)(Ab + (wm * 128 + mt * 16 + l15) * 128 + (((ks * 4 + g) ^ rsw) * 16));
#pragma unroll
        for (int mh = 0; mh < 4; ++mh) {
          if (mh < 3) {
#pragma unroll
            for (int mt = 0; mt < 2; ++mt)
              af[(mh + 1) & 1][mt] = *(const bf16x8*)(Ab + (wm * 128 + ((mh + 1) * 2 + mt) * 16 + l15) * 128 + (((ks * 4 + g) ^ rsw) * 16));
          }
          __builtin_amdgcn_sched_barrier(0);
#pragma unroll
          for (int mt = 0; mt < 2; ++mt)
#pragma unroll
            for (int nt = 0; nt < 4; ++nt)
              acc[mh * 2 + mt][nt] = __builtin_amdgcn_mfma_f32_16x16x32_bf16(bfr[nt], af[mh & 1][mt], acc[mh * 2 + mt][nt], 0, 0, 0);
          __builtin_amdgcn_sched_barrier(0);
        }
      }
      if (kt + 1 < nk) st((kt + 1) & 1);
      __syncthreads();
    }
    int opq_ = 0;
    asm volatile("" : "+v"(opq_));
    const int rbase = m0 + wm * 128 + l15 + opq_;
    const int cbase = n0 + wn * 64 + g * 4 + opq_;
    if (EPI == EPI_INPROJ) {
      const int wc0 = n0 + wn * 64;
#pragma unroll
      for (int mt = 0; mt < 8; ++mt) {
        __builtin_amdgcn_sched_barrier(0);
        const int row = rbase + mt * 16;
        const f32x4* pp = (const f32x4*)(p.part_x + (size_t)row * 16);
        const f32x4 a0 = pp[0], a1 = pp[1], a2 = pp[2], a3 = pp[3];
        const float tot = (a0[0] + a0[1] + a0[2] + a0[3]) + (a1[0] + a1[1] + a1[2] + a1[3]) +
                          (a2[0] + a2[1] + a2[2] + a2[3]) + (a3[0] + a3[1] + a3[2] + a3[3]);
        const float rs = rsqrtf(tot * (1.0f / 1024.0f) + 1e-6f);
        const int bb = row >> 12, ss = row & 4095;
        float sq = 0.f;
#pragma unroll
        for (int nt = 0; nt < 4; ++nt) {
          const int ct = wc0 + nt * 16;
          const int col = cbase + nt * 16;
          f32x4 v = acc[mt][nt] * rs;
          if (ct < 384) {
            sq += v[0] * v[0] + v[1] * v[1] + v[2] * v[2] + v[3] * v[3];
            u32x2 w;
            w.x = cvt_pk_bf16(v[0], v[1]);
            w.y = cvt_pk_bf16(v[2], v[3]);
            *(u32x2*)(p.projA + (size_t)row * 416 + col) = w;
          } else if (ct == 384) {
            if (nt < 3) {
              const f32x4 v2 = acc[mt][(nt + 1) & 3] * rs;
              const int i0 = col - 384;
              const float2* cs = p.ropecs + ss * 16 + i0;
              float o1[4], o2[4];
#pragma unroll
              for (int j = 0; j < 4; ++j) {
                const float2 c_s = cs[j];
                o1[j] = v[j] * c_s.x - v2[j] * c_s.y;
                o2[j] = v[j] * c_s.y + v2[j] * c_s.x;
              }
              u32x2 w;
              w.x = cvt_pk_bf16(o1[0], o1[1]);
              w.y = cvt_pk_bf16(o1[2], o1[3]);
              *(u32x2*)(p.projA + (size_t)row * 416 + 384 + i0) = w;
              w.x = cvt_pk_bf16(o2[0], o2[1]);
              w.y = cvt_pk_bf16(o2[2], o2[3]);
              *(u32x2*)(p.projA + (size_t)row * 416 + 400 + i0) = w;
            }
          } else if (ct == 400) {
          } else if (ct < 1568) {
            const int hc = col - 416;
            bf16_t* dst = p.hyT + ((size_t)(bb * 1152 + hc)) * 4096 + ss;
            dst[0] = f2bf(v[0]);
            dst[4096] = f2bf(v[1]);
            dst[2 * 4096] = f2bf(v[2]);
            dst[3 * 4096] = f2bf(v[3]);
          } else if (ct < 2080) {
            u32x2 w;
            w.x = cvt_pk_bf16(v[0], v[1]);
            w.y = cvt_pk_bf16(v[2], v[3]);
            *(u32x2*)(p.na + (size_t)row * 768 + (col - 1568)) = w;
          } else if (ct < 2336) {
            const int vc = col - 2080;
            bf16_t* dst = p.naVT + ((size_t)(bb * 256 + vc)) * 4096 + ss;
            dst[0] = f2bf(v[0]);
            dst[4096] = f2bf(v[1]);
            dst[2 * 4096] = f2bf(v[2]);
            dst[3 * 4096] = f2bf(v[3]);
          }
        }
        if (wc0 < 384) {
          sq += __shfl_xor(sq, 16);
          sq += __shfl_xor(sq, 32);
          if (g == 0) {
            if (wc0 < 256) p.part_q[(size_t)row * 4 + (wc0 >> 6)] = sq;
            else p.part_kv[(size_t)row * 2 + ((wc0 - 256) >> 6)] = sq;
          }
        }
      }
    } else if (EPI == EPI_QUP) {
      const int wc0 = n0 + wn * 64;
      const float qscale = 0.10206207261596575f * 1.4426950408889634f;
#pragma unroll
      for (int mt = 0; mt < 8; ++mt) {
        __builtin_amdgcn_sched_barrier(0);
        const int row = rbase + mt * 16;
        const f32x4 a0 = *(const f32x4*)(p.part_q + (size_t)row * 4);
        const float rs = rsqrtf((a0[0] + a0[1] + a0[2] + a0[3]) * (1.0f / 256.0f) + 1e-6f) * qscale;
        const int bb = row >> 12, ss = row & 4095;
#pragma unroll
        for (int nt = 0; nt < 4; ++nt) {
          const int T = (wc0 >> 4) + nt;
          if (T < 36) {
            const int hh = T / 6, tt = T % 6;
            bf16_t* qrow = p.qb + ((size_t)((bb * 6 + hh) * 4096 + ss)) * 96;
            const f32x4 v = acc[mt][nt] * rs;
            if (tt < 4) {
              u32x2 w;
              w.x = cvt_pk_bf16(v[0], v[1]);
              w.y = cvt_pk_bf16(v[2], v[3]);
              *(u32x2*)(qrow + tt * 16 + g * 4) = w;
            } else if (tt == 4) {
              if (nt < 3) {
                const f32x4 v2 = acc[mt][(nt + 1) & 3] * rs;
                const float2* cs = p.ropecs + ss * 16 + g * 4;
                float o1[4], o2[4];
#pragma unroll
                for (int j = 0; j < 4; ++j) {
                  const float2 c_s = cs[j];
                  o1[j] = v[j] * c_s.x - v2[j] * c_s.y;
                  o2[j] = v[j] * c_s.y + v2[j] * c_s.x;
                }
                u32x2 w;
                w.x = cvt_pk_bf16(o1[0], o1[1]);
                w.y = cvt_pk_bf16(o1[2], o1[3]);
                *(u32x2*)(qrow + 64 + g * 4) = w;
                w.x = cvt_pk_bf16(o2[0], o2[1]);
                w.y = cvt_pk_bf16(o2[2], o2[3]);
                *(u32x2*)(qrow + 80 + g * 4) = w;
              }
            }
          }
        }
      }
    } else if (EPI == EPI_KVUP) {
      const int hh = ni * 2 + (wn >> 1);
#pragma unroll
      for (int mt = 0; mt < 8; ++mt) {
        __builtin_amdgcn_sched_barrier(0);
        const int row = rbase + mt * 16;
        const float2 a0 = *(const float2*)(p.part_kv + (size_t)row * 2);
        const float rs = rsqrtf((a0.x + a0.y) * (1.0f / 128.0f) + 1e-6f);
        const int bb = row >> 12, ss = row & 4095;
#pragma unroll
        for (int nt = 0; nt < 4; ++nt) {
          const f32x4 v = acc[mt][nt] * rs;
          if ((wn & 1) == 0) {
            u32x2 w;
            w.x = cvt_pk_bf16(v[0], v[1]);
            w.y = cvt_pk_bf16(v[2], v[3]);
            *(u32x2*)(p.kb + ((size_t)((bb * 6 + hh) * 4096 + ss)) * 96 + nt * 16 + g * 4) = w;
          } else {
            const int dv = nt * 16 + g * 4;
            bf16_t* dst = p.vT + ((size_t)((bb * 6 + hh) * 64 + dv)) * 4096 + ss;
            dst[0] = f2bf(v[0]);
            dst[4096] = f2bf(v[1]);
            dst[2 * 4096] = f2bf(v[2]);
            dst[3 * 4096] = f2bf(v[3]);
          }
        }
      }
#pragma unroll
      for (int i = 0; i < 2; ++i) {
        const int c = tid + 512 * i, rr = c >> 2, cc = c & 3;
        const int row = m0 + rr, bb = row >> 12, ss = row & 4095;
        const u32x4 v = *(const u32x4*)(p.projA + (size_t)row * 416 + 384 + cc * 8);
        *(u32x4*)(p.kb + ((size_t)((bb * 6 + ni * 2) * 4096 + ss)) * 96 + 64 + cc * 8) = v;
        *(u32x4*)(p.kb + ((size_t)((bb * 6 + ni * 2 + 1) * 4096 + ss)) * 96 + 64 + cc * 8) = v;
      }
    } else if (EPI == EPI_OUTPROJ || EPI == EPI_DOWN) {
      const bool last_upd = (EPI == EPI_DOWN && l == 1);
      const int slot = (n0 + wn * 64) >> 6;
#pragma unroll
      for (int mt = 0; mt < 8; ++mt) {
        __builtin_amdgcn_sched_barrier(0);
        const int row = rbase + mt * 16;
        float sq = 0.f;
#pragma unroll
        for (int nt = 0; nt < 4; ++nt) {
          const int col = cbase + nt * 16;
          const u32x2 xr = *(const u32x2*)(p.xb + (size_t)row * 1024 + col);
          const f32x4 xo = (f32x4){bflo(xr.x), bfhi(xr.x), bflo(xr.y), bfhi(xr.y)};
          const f32x4 v = acc[mt][nt] + xo;
          sq += v[0] * v[0] + v[1] * v[1] + v[2] * v[2] + v[3] * v[3];
          if (last_upd) {
            *(f32x4*)(p.out + (size_t)row * 1024 + col) = v;
          } else {
            u32x2 w;
            w.x = cvt_pk_bf16(v[0], v[1]);
            w.y = cvt_pk_bf16(v[2], v[3]);
            *(u32x2*)(p.xb + (size_t)row * 1024 + col) = w;
          }
        }
        sq += __shfl_xor(sq, 16);
        sq += __shfl_xor(sq, 32);
        if (g == 0) p.part_x[(size_t)row * 16 + slot] = sq;
      }
    } else if (EPI == EPI_SWIGLU) {
      const int fbase = ((n0 + wn * 64) >> 1) + g * 4;
#pragma unroll
      for (int mt = 0; mt < 8; ++mt) {
        __builtin_amdgcn_sched_barrier(0);
        const int row = rbase + mt * 16;
        const f32x4* pp = (const f32x4*)(p.part_x + (size_t)row * 16);
        const f32x4 a0 = pp[0], a1 = pp[1], a2 = pp[2], a3 = pp[3];
        const float tot = (a0[0] + a0[1] + a0[2] + a0[3]) + (a1[0] + a1[1] + a1[2] + a1[3]) +
                          (a2[0] + a2[1] + a2[2] + a2[3]) + (a3[0] + a3[1] + a3[2] + a3[3]);
        const float rs = rsqrtf(tot * (1.0f / 1024.0f) + 1e-6f);
#pragma unroll
        for (int i = 0; i < 2; ++i) {
          const f32x4 gt = acc[mt][2 * i] * rs, up = acc[mt][2 * i + 1] * rs;
          float hv[4];
#pragma unroll
          for (int j = 0; j < 4; ++j) hv[j] = gt[j] * __builtin_amdgcn_rcpf(1.0f + __expf(-gt[j])) * up[j];
          u32x2 w;
          w.x = cvt_pk_bf16(hv[0], hv[1]);
          w.y = cvt_pk_bf16(hv[2], hv[3]);
          *(u32x2*)(p.hidden + (size_t)row * 2816 + fbase + i * 16) = w;
        }
      }
    }
  }
}

__device__ void final_norm_phase(const P& p) {
  int tid_ = threadIdx.x;
  asm volatile("" : "+v"(tid_));
  const int tid = tid_, lane = tid & 63, wave = tid >> 6;
  for (int row = blockIdx.x * 8 + wave; row < NTOK; row += gridDim.x * 8) {
    const f32x4* pp = (const f32x4*)(p.part_x + (size_t)row * 16);
    const f32x4 a0 = pp[0], a1 = pp[1], a2 = pp[2], a3 = pp[3];
    const float tot = (a0[0] + a0[1] + a0[2] + a0[3]) + (a1[0] + a1[1] + a1[2] + a1[3]) +
                      (a2[0] + a2[1] + a2[2] + a2[3]) + (a3[0] + a3[1] + a3[2] + a3[3]);
    const float rs = rsqrtf(tot * (1.0f / 1024.0f) + 1e-6f);
    float* xr = p.out + (size_t)row * 1024;
#pragma unroll
    for (int i = 0; i < 4; ++i) {
      f32x4 v = *(const f32x4*)(xr + lane * 4 + 256 * i);
      const f32x4 gg = *(const f32x4*)(p.final_g + lane * 4 + 256 * i);
      v = v * rs * gg;
      *(f32x4*)(xr + lane * 4 + 256 * i) = v;
    }
  }
}


template <int S>
__device__ __forceinline__ void run_stage(const P& p, int l, char* smem) {
  if (S == 0) prep_phase(p, l, smem);
  if (S == 1) {
    filt_fft_phase(p, l, smem);
    gemm_phase<EPI_INPROJ>(p, l, p.xb, 1024, p.Win, 1024, 10, smem);
  }
  if (S == 2) {
    hyena_phase<0>(p, l, smem);
    gemm_phase<EPI_QUP>(p, l, p.projA, 416, p.Wuq, 256, 3, smem);
    gemm_phase<EPI_KVUP>(p, l, p.projA + 256, 416, p.Wukv, 128, 3, smem);
    natten_phase(p, l, smem);
  }
  if (S == 3) {
    hyena_phase<1>(p, l, smem);
    attn_phase(p, smem);
  }
  if (S == 4) mixnorm_phase(p, smem);
  if (S == 5) gemm_phase<EPI_OUTPROJ>(p, l, p.y, 1024, p.Wout, 1024, 4, smem);
  if (S == 6) gemm_phase<EPI_SWIGLU>(p, l, p.xb, 1024, p.Wgu, 1024, 22, smem);
  if (S == 7) gemm_phase<EPI_DOWN>(p, l, p.hidden, 2816, p.Wdown, 2816, 4, smem);
  if (S == 8) final_norm_phase(p);
}

__device__ __forceinline__ void grid_barrier(unsigned* bar, unsigned target) {
  asm volatile("s_waitcnt vmcnt(0)" ::: "memory");
  __syncthreads();
  if (threadIdx.x == 0) {
    __builtin_amdgcn_fence(__ATOMIC_RELEASE, "agent");
    asm volatile("s_waitcnt vmcnt(0)" ::: "memory");
    __hip_atomic_fetch_add(bar, 1u, __ATOMIC_RELAXED, __HIP_MEMORY_SCOPE_AGENT);
    unsigned spins = 0;
    while (__hip_atomic_load(bar, __ATOMIC_RELAXED, __HIP_MEMORY_SCOPE_AGENT) < target && spins < (1u << 22)) {
      __builtin_amdgcn_s_sleep(1);
      ++spins;
    }
    __builtin_amdgcn_fence(__ATOMIC_ACQUIRE, "agent");
    asm volatile("s_waitcnt vmcnt(0)" ::: "memory");
  }
  __syncthreads();
}

__global__ void __launch_bounds__(NTHREADS) k_main(P p) {
  extern __shared__ __attribute__((aligned(16))) char smem[];
  cg::grid_group grid = cg::this_grid();
  if (blockIdx.x == 0 && threadIdx.x == 0) __hip_atomic_store(p.bar, 0u, __ATOMIC_RELAXED, __HIP_MEMORY_SCOPE_AGENT);
  run_stage<0>(p, 0, smem); grid.sync();
  run_stage<1>(p, 0, smem); grid_barrier(p.bar, 1u * gridDim.x);
  run_stage<2>(p, 0, smem); grid_barrier(p.bar, 2u * gridDim.x);
  run_stage<3>(p, 0, smem); grid_barrier(p.bar, 3u * gridDim.x);
  run_stage<4>(p, 0, smem); grid_barrier(p.bar, 4u * gridDim.x);
  run_stage<5>(p, 0, smem); grid_barrier(p.bar, 5u * gridDim.x);
  run_stage<6>(p, 0, smem); grid_barrier(p.bar, 6u * gridDim.x);
  run_stage<7>(p, 0, smem); grid_barrier(p.bar, 7u * gridDim.x);
  run_stage<0>(p, 1, smem); grid_barrier(p.bar, 8u * gridDim.x);
  run_stage<1>(p, 1, smem); grid_barrier(p.bar, 9u * gridDim.x);
  run_stage<2>(p, 1, smem); grid_barrier(p.bar, 10u * gridDim.x);
  run_stage<3>(p, 1, smem); grid_barrier(p.bar, 11u * gridDim.x);
  run_stage<4>(p, 1, smem); grid_barrier(p.bar, 12u * gridDim.x);
  run_stage<5>(p, 1, smem); grid_barrier(p.bar, 13u * gridDim.x);
  run_stage<6>(p, 1, smem); grid_barrier(p.bar, 14u * gridDim.x);
  run_stage<7>(p, 1, smem); grid_barrier(p.bar, 15u * gridDim.x);
  run_stage<8>(p, 1, smem);
}


extern "C" void kernel_launch(void* const* d_in, const int* in_sizes, int n_in, void* d_out, int out_size, void* d_ws,
                              size_t ws_size, hipStream_t stream) {
  static int grid_blocks = 0;
  if (!grid_blocks) {
    int dev = 0, cus = 0;
    (void)hipGetDevice(&dev);
    (void)hipDeviceGetAttribute(&cus, hipDeviceAttributeMultiprocessorCount, dev);
    if (cus <= 0) cus = 256;
    int per_cu = 0;
    (void)hipFuncSetAttribute((const void*)k_main, hipFuncAttributeMaxDynamicSharedMemorySize, LDS_BYTES);
    (void)hipOccupancyMaxActiveBlocksPerMultiprocessor(&per_cu, k_main, NTHREADS, LDS_BYTES);
    if (per_cu > 1) per_cu = 1;
    if (per_cu < 1) per_cu = 1;
    grid_blocks = cus * per_cu;
  }
  P p;
  memset(&p, 0, sizeof(p));
  const float* const* in = (const float* const*)d_in;
  p.x = in[0]; p.norm1_g = in[1]; p.w_in = in[2]; p.q_norm_g = in[3]; p.w_uq = in[4]; p.kv_norm_g = in[5];
  p.w_ukv = in[6]; p.conv_w = in[7]; p.conv_b = in[8]; p.fw1 = in[9]; p.fb1 = in[10]; p.ff1 = in[11];
  p.fw2 = in[12]; p.fb2 = in[13]; p.ff2 = in[14]; p.fw3 = in[15]; p.skip = in[16]; p.rpb = in[17];
  p.mix_g = in[18]; p.w_out = in[19]; p.norm2_g = in[20]; p.w_gate = in[21]; p.w_up = in[22]; p.w_down = in[23];
  p.final_g = in[24];
  p.out = (float*)d_out;
  char* ws = (char*)d_ws;
  size_t off = 0;
  auto take = [&](size_t bytes) {
    char* r = ws + off;
    off += (bytes + 255) & ~(size_t)255;
    return r;
  };
  p.Win = (bf16_t*)take((size_t)2560 * 1024 * 2);
  p.Wuq = (bf16_t*)take((size_t)768 * 256 * 2);
  p.Wukv = (bf16_t*)take((size_t)768 * 128 * 2);
  p.Wout = (bf16_t*)take((size_t)1024 * 1024 * 2);
  p.Wgu = (bf16_t*)take((size_t)5632 * 1024 * 2);
  p.Wdown = (bf16_t*)take((size_t)1024 * 2816 * 2);
  p.ropecs = (float2*)take((size_t)65536 * 8);
  p.tw = (float2*)take((size_t)8192 * 8);
  p.bar = (unsigned*)take(256);
  p.part_x = (float*)take((size_t)NTOK * 16 * 4);
  p.part_q = (float*)take((size_t)NTOK * 4 * 4);
  p.part_kv = (float*)take((size_t)NTOK * 2 * 4);
  p.xb = (bf16_t*)take((size_t)NTOK * 1024 * 2);
  p.H2 = (float2*)take((size_t)768 * 8192 * 8);
  p.z1T = (bf16_t*)take((size_t)1536 * 4096 * 4);
  p.filtT = (float*)p.z1T;
  p.vT = (bf16_t*)take((size_t)8 * 6 * 64 * 4096 * 2);
  p.o_a = (bf16_t*)take((size_t)NTOK * 384 * 2);
  p.o_c = (bf16_t*)take((size_t)NTOK * 256 * 2);
  char* big = take(0);
  p.projA = (bf16_t*)take((size_t)NTOK * 416 * 2);
  p.hyT = (bf16_t*)take((size_t)8 * 1152 * 4096 * 2);
  p.na = (bf16_t*)take((size_t)NTOK * 768 * 2);
  p.qb = (bf16_t*)take((size_t)8 * 6 * 4096 * 96 * 2);
  p.kb = (bf16_t*)take((size_t)8 * 6 * 4096 * 96 * 2);
  p.hidden = (bf16_t*)big;
  p.ybT = (bf16_t*)take((size_t)8 * 384 * 4096 * 2);
  p.naVT = (bf16_t*)take((size_t)8 * 4 * 64 * 4096 * 2);
  p.y = p.qb;
  if (off > ws_size) {
    fprintf(stderr, "workspace too small: need %zu have %zu\n", off, ws_size);
    return;
  }
  void* args[] = {&p};
  hipError_t e = hipLaunchCooperativeKernel((void*)k_main, dim3(grid_blocks), dim3(NTHREADS), args, LDS_BYTES, stream);
  if (e != hipSuccess) fprintf(stderr, "cooperative launch failed: %s (grid %d)\n", hipGetErrorString(e), grid_blocks);
}
```

```cpp
#include <hip/hip_runtime.h>
#include <hip/hip_cooperative_groups.h>
#include <cstdio>
#include <cstring>
#include <cstdint>
#include <cmath>
#include <type_traits>
namespace cg = cooperative_groups;


typedef unsigned short bf16_t;
typedef short bf16x8 __attribute__((ext_vector_type(8)));
typedef float f32x4 __attribute__((ext_vector_type(4)));
typedef unsigned u32x4 __attribute__((ext_vector_type(4)));
typedef unsigned u32x2 __attribute__((ext_vector_type(2)));

constexpr int NTOK = 32768, SEQ = 4096;
constexpr int NTHREADS = 512;
constexpr int LDS_BYTES = 147456;
constexpr int TW_LDS_OFF = 69632;
#define PADI(i) ((i) + ((i) >> 4))

struct P {
  const float *x, *norm1_g, *w_in, *q_norm_g, *w_uq, *kv_norm_g, *w_ukv, *conv_w, *conv_b, *fw1, *fb1, *ff1, *fw2, *fb2,
      *ff2, *fw3, *skip, *rpb, *mix_g, *w_out, *norm2_g, *w_gate, *w_up, *w_down, *final_g;
  float* out;
  bf16_t *Win, *Wuq, *Wukv, *Wout, *Wgu, *Wdown;
  bf16_t *xb, *projA, *hyT, *na, *qb, *kb, *vT, *o_a, *o_c, *y, *hidden, *ybT, *naVT;
  float2* H2;
  float* filtT;
  bf16_t* z1T;
  float *part_x, *part_q, *part_kv;
  float2* ropecs;
  float2* tw;
  unsigned* bar;
  unsigned pad0_, pad1_;
};

typedef __bf16 bf16v2_t __attribute__((ext_vector_type(2)));
typedef float f32x2_t __attribute__((ext_vector_type(2)));
__device__ __forceinline__ unsigned cvt_pk_bf16(float lo, float hi) {
  const f32x2_t v = {lo, hi};
  const bf16v2_t r = __builtin_convertvector(v, bf16v2_t);
  return __builtin_bit_cast(unsigned, r);
}
__device__ __forceinline__ bf16_t f2bf(float f) { return (bf16_t)(cvt_pk_bf16(f, 0.f) & 0xffffu); }
__device__ __forceinline__ float bf2f(bf16_t h) { return __uint_as_float(((unsigned)h) << 16); }
__device__ __forceinline__ float bflo(unsigned u) { return __uint_as_float(u << 16); }
__device__ __forceinline__ float bfhi(unsigned u) { return __uint_as_float(u & 0xffff0000u); }

__device__ __forceinline__ void fast_sincos_rev(float rev, float* s, float* c) {
  const float fr = rev - rintf(rev);
  *s = __builtin_amdgcn_sinf(fr);
  *c = __builtin_amdgcn_cosf(fr);
}
__device__ __forceinline__ float fast_sin(float x) {
  const float rev = x * 0.15915494309189535f;
  const float fr = rev - rintf(rev);
  return __builtin_amdgcn_sinf(fr);
}

__device__ __forceinline__ int vblock() {
  const int G = gridDim.x, b = blockIdx.x;
  return ((G & 7) == 0) ? ((b & 7) * (G >> 3) + (b >> 3)) : b;
}

__device__ void conv_w(const float* __restrict__ W, int K, int N, int Npad, const float* __restrict__ g, bf16_t* Bt,
                       int mode, char* smem) {
  float* tile = (float*)smem;
  int tid_ = threadIdx.x;
  asm volatile("" : "+v"(tid_));
  const int tid = tid_;
  const int nkt = K / 64, nnt = Npad / 64;
  for (int job = blockIdx.x; job < nkt * nnt; job += gridDim.x) {
    const int kt = job % nkt, ntile = job / nkt;
    const int k0 = kt * 64, n0 = ntile * 64;
    __syncthreads();
#pragma unroll
    for (int i = 0; i < 2; ++i) {
      const int k = (tid >> 4) + 32 * i, nq = (tid & 15) * 4, n = n0 + nq;
      f32x4 v = {0.f, 0.f, 0.f, 0.f};
      if (n < N) {
        v = *(const f32x4*)(W + (size_t)(k0 + k) * N + n);
        if (g) v = v * g[k0 + k];
      }
      tile[k * 65 + nq + 0] = v[0];
      tile[k * 65 + nq + 1] = v[1];
      tile[k * 65 + nq + 2] = v[2];
      tile[k * 65 + nq + 3] = v[3];
    }
    __syncthreads();
    {
      const int c = tid, n = c >> 3, kc = c & 7;
      float e[8];
#pragma unroll
      for (int q = 0; q < 8; ++q) e[q] = tile[(kc * 8 + q) * 65 + n];
      u32x4 w;
      w.x = cvt_pk_bf16(e[0], e[1]);
      w.y = cvt_pk_bf16(e[2], e[3]);
      w.z = cvt_pk_bf16(e[4], e[5]);
      w.w = cvt_pk_bf16(e[6], e[7]);
      const int nn = n0 + n;
      int dest = nn;
      if (mode == 1) dest = 32 * (nn >> 4) + (nn & 15);
      if (mode == 2) dest = 32 * (nn >> 4) + 16 + (nn & 15);
      *(u32x4*)(Bt + (size_t)dest * K + k0 + kc * 8) = w;
    }
  }
}

__device__ void filt_mlp(const P& p, int l, char* smem) {
  float* zf = (float*)smem;
  float* h1 = zf + 16 * 17;
  float* h2 = h1 + 64 * 16;
  int tid_ = threadIdx.x;
  asm volatile("" : "+v"(tid_));
  const int tid = tid_, tl = tid & 15, kk = tid >> 4;
  const float* w1 = p.fw1 + l * 17 * 64;
  const float* b1 = p.fb1 + l * 64;
  const float* f1 = p.ff1 + l * 64;
  const float* w2 = p.fw2 + l * 64 * 64;
  const float* b2 = p.fb2 + l * 64;
  const float* f2 = p.ff2 + l * 64;
  const float* w3 = p.fw3 + (size_t)l * 64 * 1536;
  for (int job = blockIdx.x; job < 256; job += gridDim.x) {
    const int t0 = job * 16;
    __syncthreads();
    {
      const int t = t0 + tl;
      if (kk < 8) {
        const float band = 1e-4f + (float)kk * ((7.0f - 1e-4f) / 7.0f);
        const float ang = ((6.283185307179586f * (float)t) * band) / 4096.0f;
        float s, c;
        fast_sincos_rev(ang * 0.15915494309189535f, &s, &c);
        zf[tl * 17 + 1 + kk] = c;
        zf[tl * 17 + 9 + kk] = s;
      } else if (kk == 8) {
        zf[tl * 17] = (float)t / 4095.0f;
      }
    }
    __syncthreads();
#pragma unroll
    for (int m = 0; m < 2; ++m) {
      const int j = kk + 32 * m;
      float a = b1[j];
#pragma unroll 1
      for (int f = 0; f < 17; ++f) a += zf[tl * 17 + f] * w1[f * 64 + j];
      h1[j * 16 + tl] = fast_sin(f1[j] * a);
    }
    __syncthreads();
#pragma unroll
    for (int m = 0; m < 2; ++m) {
      const int j = kk + 32 * m;
      float a = b2[j];
#pragma unroll 16
      for (int i = 0; i < 64; ++i) a += h1[i * 16 + tl] * w2[i * 64 + j];
      h2[j * 16 + tl] = fast_sin(f2[j] * a);
    }
    __syncthreads();
#pragma unroll 1
    for (int mm = 0; mm < 3; ++mm) {
      const int col = tid + 512 * mm;
      float acc[16];
#pragma unroll
      for (int q = 0; q < 16; ++q) acc[q] = 0.f;
#pragma unroll 1
      for (int j0 = 0; j0 < 64; j0 += 8) {
        float wv[8];
#pragma unroll
        for (int q = 0; q < 8; ++q) wv[q] = w3[(size_t)(j0 + q) * 1536 + col];
#pragma unroll
        for (int q = 0; q < 8; ++q) {
          const float w = wv[q];
          const f32x4* hp = (const f32x4*)(h2 + (j0 + q) * 16);
          const f32x4 a0 = hp[0], a1 = hp[1], a2 = hp[2], a3 = hp[3];
          acc[0] += a0[0] * w; acc[1] += a0[1] * w; acc[2] += a0[2] * w; acc[3] += a0[3] * w;
          acc[4] += a1[0] * w; acc[5] += a1[1] * w; acc[6] += a1[2] * w; acc[7] += a1[3] * w;
          acc[8] += a2[0] * w; acc[9] += a2[1] * w; acc[10] += a2[2] * w; acc[11] += a2[3] * w;
          acc[12] += a3[0] * w; acc[13] += a3[1] * w; acc[14] += a3[2] * w; acc[15] += a3[3] * w;
        }
      }
      const int c = col % 384;
      const float lo = -3.0701134573253945f, hi = -15.350567286626972f;
      const float delta = fabsf(lo + (hi - lo) * ((float)c / 383.0f));
      float* dst = p.filtT + (size_t)col * 4096 + t0;
#pragma unroll
      for (int q = 0; q < 16; ++q) {
        const float tn = (float)(t0 + q) / 4095.0f;
        dst[q] = acc[q] * __expf(-tn * delta);
      }
    }
  }
}

__device__ void prep_phase(const P& p, int l, char* smem) {
  for (int w = 0; w < 7; ++w) {
    const float* W; const float* g; bf16_t* Bt; int K, N, Npad, mode = 0;
    switch (w) {
      case 0: W = p.w_in + (size_t)l * 1024 * 2336; K = 1024; N = 2336; Npad = 2560; g = p.norm1_g + l * 1024; Bt = p.Win; break;
      case 1: W = p.w_uq + (size_t)l * 256 * 576; K = 256; N = 576; Npad = 768; g = p.q_norm_g + l * 256; Bt = p.Wuq; break;
      case 2: W = p.w_ukv + (size_t)l * 128 * 768; K = 128; N = 768; Npad = 768; g = p.kv_norm_g + l * 128; Bt = p.Wukv; break;
      case 3: W = p.w_out + (size_t)l * 1024 * 1024; K = 1024; N = 1024; Npad = 1024; g = p.mix_g + l * 1024; Bt = p.Wout; break;
      case 4: W = p.w_gate + (size_t)l * 1024 * 2816; K = 1024; N = 2816; Npad = 2816; g = p.norm2_g + l * 1024; Bt = p.Wgu; mode = 1; break;
      case 5: W = p.w_up + (size_t)l * 1024 * 2816; K = 1024; N = 2816; Npad = 2816; g = p.norm2_g + l * 1024; Bt = p.Wgu; mode = 2; break;
      default: W = p.w_down + (size_t)l * 2816 * 1024; K = 2816; N = 1024; Npad = 1024; g = nullptr; Bt = p.Wdown; break;
    }
    conv_w(W, K, N, Npad, g, Bt, mode, smem);
  }
  filt_mlp(p, l, smem);
  if (l == 0) {
    int tid_ = threadIdx.x;
  asm volatile("" : "+v"(tid_));
  const int tid = tid_, lane = tid & 63, wave = tid >> 6;
    for (int row = blockIdx.x * 8 + wave; row < NTOK; row += gridDim.x * 8) {
      const float* xr = p.x + (size_t)row * 1024;
      bf16_t* xo = p.xb + (size_t)row * 1024;
      float s = 0.f;
#pragma unroll
      for (int i = 0; i < 4; ++i) {
        const f32x4 v = *(const f32x4*)(xr + lane * 4 + 256 * i);
        s += v[0] * v[0] + v[1] * v[1] + v[2] * v[2] + v[3] * v[3];
        u32x2 w;
        w.x = cvt_pk_bf16(v[0], v[1]);
        w.y = cvt_pk_bf16(v[2], v[3]);
        *(u32x2*)(xo + lane * 4 + 256 * i) = w;
      }
#pragma unroll
      for (int o = 1; o < 64; o <<= 1) s += __shfl_xor(s, o);
      if (lane < 16) p.part_x[(size_t)row * 16 + lane] = (lane == 0) ? s : 0.f;
    }
    for (int i = blockIdx.x * 512 + tid; i < 65536 + 8192; i += gridDim.x * 512) {
      if (i < 65536) {
        const int pos = i >> 4, k = i & 15;
        const float ang = (float)pos * __builtin_amdgcn_exp2f(-(float)k * 0.8304820237218405f);
        float s, c;
        fast_sincos_rev(ang * 0.15915494309189535f, &s, &c);
        p.ropecs[i] = make_float2(c, s);
      } else {
        const int k = i - 65536;
        const int ms = 1 << (31 - __clz(k + 1));
        const int pp = k + 1 - ms;
        float s, c;
        fast_sincos_rev((float)pp / (float)(2 * ms), &s, &c);
        p.tw[k] = make_float2(c, -s);
      }
    }
  }
}

template <int LOGR, int MTOP, bool INV, bool ZIN = false, bool HOUT = false>
__device__ __forceinline__ void fft_pass(float2* sm, const float2* tw) {
  constexpr int R = 1 << LOGR;
  constexpr int q = MTOP >> (LOGR - 1);
  constexpr int ntask = 8192 / R;
  for (int T = threadIdx.x; T < ntask; T += NTHREADS) {
    const int i = T & (q - 1);
    const int blk = T / q;
    const int base = blk * (2 * MTOP) + i;
    float2 v[R];
#pragma unroll
    for (int e = 0; e < R; ++e) {
      if (ZIN && e >= R / 2) v[e] = make_float2(0.f, 0.f);
      else v[e] = sm[PADI(base + e * q)];
    }
    if (!INV) {
#pragma unroll
      for (int s = 0; s < LOGR; ++s) {
        constexpr int dummy = 0;
        (void)dummy;
        const int hs = 1 << (LOGR - 1 - s);
        const int ms = MTOP >> s;
#pragma unroll
        for (int e = 0; e < R; ++e) {
          if ((e & hs) == 0) {
            const int pp = i + (e & (hs - 1)) * q;
            const float2 w = tw[(ms - 1) + pp];
            const float2 a = v[e], b = v[e + hs];
            v[e] = make_float2(a.x + b.x, a.y + b.y);
            const float dx = a.x - b.x, dy = a.y - b.y;
            v[e + hs] = make_float2(dx * w.x - dy * w.y, dx * w.y + dy * w.x);
          }
        }
      }
    } else {
#pragma unroll
      for (int s = LOGR - 1; s >= 0; --s) {
        const int hs = 1 << (LOGR - 1 - s);
        const int ms = MTOP >> s;
#pragma unroll
        for (int e = 0; e < R; ++e) {
          if ((e & hs) == 0) {
            const int pp = i + (e & (hs - 1)) * q;
            const float2 w = tw[(ms - 1) + pp];
            const float2 a = v[e], b = v[e + hs];
            const float tx = b.x * w.x + b.y * w.y, ty = b.y * w.x - b.x * w.y;
            v[e] = make_float2(a.x + tx, a.y + ty);
            v[e + hs] = make_float2(a.x - tx, a.y - ty);
          }
        }
      }
    }
#pragma unroll
    for (int e = 0; e < R; ++e) {
      if (HOUT && e >= R / 2) continue;
      sm[PADI(base + e * q)] = v[e];
    }
  }
  __syncthreads();
}

__device__ __forceinline__ void fft_fwd(float2* sm, const float2* tw) {
  fft_pass<4, 4096, false>(sm, tw);
  fft_pass<4, 256, false>(sm, tw);
  fft_pass<4, 16, false>(sm, tw);
  fft_pass<1, 1, false>(sm, tw);
}
__device__ __forceinline__ void fft_inv(float2* sm, const float2* tw) {
  fft_pass<1, 1, true>(sm, tw);
  fft_pass<3, 8, true>(sm, tw);
  fft_pass<3, 64, true>(sm, tw);
  fft_pass<3, 512, true>(sm, tw);
  fft_pass<3, 4096, true>(sm, tw);
}

__device__ void filt_fft_phase(const P& p, int l, char* smem) {
  float2* sm = (float2*)smem;
  float2* tws = (float2*)(smem + TW_LDS_OFF);
  int tid_ = threadIdx.x;
  asm volatile("" : "+v"(tid_));
  const int tid = tid_;
  for (int i = tid; i < 8192; i += NTHREADS) tws[i] = p.tw[i];
  for (int jj = blockIdx.x; jj < 384; jj += gridDim.x) {
    const int o = jj / 192, c = jj % 192;
    const int jobF = o * 384 + c, jobG = jobF + 192;
    const float* hf1 = p.filtT + ((size_t)((o * 2 + 0) * 384 + c)) * 4096;
    const float* hb1 = p.filtT + ((size_t)((o * 2 + 1) * 384 + c)) * 4096;
    const float* hf2 = hf1 + (size_t)192 * 4096;
    const float* hb2 = hb1 + (size_t)192 * 4096;
    const float sk1 = p.skip[(l * 2 + o) * 384 + c], sk2 = p.skip[(l * 2 + o) * 384 + c + 192];
    __syncthreads();
    for (int n = tid; n < 8192; n += NTHREADS) {
      float v1, v2;
      if (n == 0) { v1 = hf1[0] + hb1[0] + sk1; v2 = hf2[0] + hb2[0] + sk2; }
      else if (n < 4096) { v1 = hf1[n]; v2 = hf2[n]; }
      else if (n == 4096) { v1 = 0.f; v2 = 0.f; }
      else { v1 = hb1[8192 - n]; v2 = hb2[8192 - n]; }
      sm[PADI(n)] = make_float2(v1, v2);
    }
    __syncthreads();
    fft_fwd(sm, tws);
    float2* dF = p.H2 + (size_t)jobF * 8192;
    float2* dG = p.H2 + (size_t)jobG * 8192;
    const float sc = 0.5f / 8192.0f;
    for (int n = tid; n < 8192; n += NTHREADS) {
      const int k = (int)(__brev((unsigned)n) >> 19);
      const int np = (int)(__brev((unsigned)((8192 - k) & 8191)) >> 19);
      const float2 a = sm[PADI(n)], b = sm[PADI(np)];
      dF[n] = make_float2((a.x + b.x) * sc, (a.y - b.y) * sc);
      dG[n] = make_float2((a.y + b.y) * sc, (b.x - a.x) * sc);
    }
  }
}

__device__ __forceinline__ float short_conv(const bf16_t* row, int t, float w0, float w1, float w2, float bias) {
  const float xm = (t > 0) ? bf2f(row[t - 1]) : 0.f;
  const float x0 = bf2f(row[t]);
  const float xp = (t < SEQ - 1) ? bf2f(row[t + 1]) : 0.f;
  return w0 * xm + w1 * x0 + w2 * xp + bias;
}

__device__ __forceinline__ void conv8(const bf16_t* row, int t0, float w0, float w1, float w2, float bias, float (&out)[8]) {
  const u32x4 v = *(const u32x4*)(row + t0);
  float x[10];
  x[0] = (t0 > 0) ? bf2f(row[t0 - 1]) : 0.f;
  x[1] = bflo(v.x); x[2] = bfhi(v.x); x[3] = bflo(v.y); x[4] = bfhi(v.y);
  x[5] = bflo(v.z); x[6] = bfhi(v.z); x[7] = bflo(v.w); x[8] = bfhi(v.w);
  x[9] = (t0 + 8 < SEQ) ? bf2f(row[t0 + 8]) : 0.f;
#pragma unroll
  for (int k = 0; k < 8; ++k) out[k] = w0 * x[k] + w1 * x[k + 1] + w2 * x[k + 2] + bias;
}

__device__ __forceinline__ void fft_mid(float2* sm, const float2* __restrict__ H) {
  for (int T = threadIdx.x; T < 4096; T += NTHREADS) {
    const float2 a = sm[PADI(2 * T)], b = sm[PADI(2 * T + 1)];
    const f32x4 h = *(const f32x4*)(H + 2 * T);
    const float sx = a.x + b.x, sy = a.y + b.y, dx = a.x - b.x, dy = a.y - b.y;
    const float Ax = sx * h[0] - sy * h[1], Ay = sx * h[1] + sy * h[0];
    const float Bx = dx * h[2] - dy * h[3], By = dx * h[3] + dy * h[2];
    sm[PADI(2 * T)] = make_float2(Ax + Bx, Ay + By);
    sm[PADI(2 * T + 1)] = make_float2(Ax - Bx, Ay - By);
  }
  __syncthreads();
}

template <int ORD>
__device__ void hyena_phase(const P& p, int l, char* smem) {
  float2* sm = (float2*)smem;
  float2* tws = (float2*)(smem + TW_LDS_OFF);
  int tid_ = threadIdx.x;
  asm volatile("" : "+v"(tid_));
  const int tid = tid_;
  for (int i = tid; i < 8192; i += NTHREADS) tws[i] = p.tw[i];
  const float* cw = p.conv_w + (size_t)l * 3 * 1152;
  const float* cb = p.conv_b + (size_t)l * 1152;
  const int t0 = tid * 8;
  for (int job = vblock(); job < 1536; job += gridDim.x) {
    const int pair = job & 3, c = job >> 2;
    const int b1 = pair * 2, b2 = b1 + 1;
    __syncthreads();
    {
      float u1[8], u2[8];
      if (ORD == 0) {
        const bf16_t* r1 = p.hyT + ((size_t)(b1 * 1152 + c)) * 4096;
        const bf16_t* r2 = p.hyT + ((size_t)(b2 * 1152 + c)) * 4096;
        const float w0 = cw[c], w1 = cw[1152 + c], w2 = cw[2304 + c], bi = cb[c];
        conv8(r1, t0, w0, w1, w2, bi, u1);
        conv8(r2, t0, w0, w1, w2, bi, u2);
      } else {
        const u32x4 a0 = *(const u32x4*)(p.z1T + ((size_t)(b1 * 384 + c)) * 4096 + t0);
        const u32x4 c0_ = *(const u32x4*)(p.z1T + ((size_t)(b2 * 384 + c)) * 4096 + t0);
        u1[0] = bflo(a0.x); u1[1] = bfhi(a0.x); u1[2] = bflo(a0.y); u1[3] = bfhi(a0.y); u1[4] = bflo(a0.z); u1[5] = bfhi(a0.z); u1[6] = bflo(a0.w); u1[7] = bfhi(a0.w);
        u2[0] = bflo(c0_.x); u2[1] = bfhi(c0_.x); u2[2] = bflo(c0_.y); u2[3] = bfhi(c0_.y); u2[4] = bflo(c0_.z); u2[5] = bfhi(c0_.z); u2[6] = bflo(c0_.w); u2[7] = bfhi(c0_.w);
      }
#pragma unroll
      for (int k = 0; k < 8; ++k) {
        sm[PADI(t0 + k)] = make_float2(u1[k], u2[k]);
      }
    }
    __syncthreads();
    fft_pass<4, 4096, false, true, false>(sm, tws);
    fft_pass<4, 256, false>(sm, tws);
    fft_pass<4, 16, false>(sm, tws);
    fft_mid(sm, p.H2 + ((size_t)(ORD * 384 + c)) * 8192);
    fft_pass<4, 16, true>(sm, tws);
    fft_pass<4, 256, true>(sm, tws);
    fft_pass<4, 4096, true, false, true>(sm, tws);
    {
      const int gc = (ORD == 0 ? 384 : 768) + c;
      const bf16_t* g1 = p.hyT + ((size_t)(b1 * 1152 + gc)) * 4096;
      const bf16_t* g2 = p.hyT + ((size_t)(b2 * 1152 + gc)) * 4096;
      const float w0 = cw[gc], w1 = cw[1152 + gc], w2 = cw[2304 + gc], bi = cb[gc];
      float q1[8], q2[8];
      conv8(g1, t0, w0, w1, w2, bi, q1);
      conv8(g2, t0, w0, w1, w2, bi, q2);
#pragma unroll
      for (int k = 0; k < 8; ++k) {
        const float2 yv = sm[PADI(t0 + k)];
        q1[k] *= yv.x;
        q2[k] *= yv.y;
      }
      {
        bf16_t* dbase = (ORD == 0) ? p.z1T : p.ybT;
        u32x4 w1_, w2_;
        w1_.x = cvt_pk_bf16(q1[0], q1[1]); w1_.y = cvt_pk_bf16(q1[2], q1[3]); w1_.z = cvt_pk_bf16(q1[4], q1[5]); w1_.w = cvt_pk_bf16(q1[6], q1[7]);
        w2_.x = cvt_pk_bf16(q2[0], q2[1]); w2_.y = cvt_pk_bf16(q2[2], q2[3]); w2_.z = cvt_pk_bf16(q2[4], q2[5]); w2_.w = cvt_pk_bf16(q2[6], q2[7]);
        *(u32x4*)(dbase + ((size_t)(b1 * 384 + c)) * 4096 + t0) = w1_;
        *(u32x4*)(dbase + ((size_t)(b2 * 384 + c)) * 4096 + t0) = w2_;
      }
    }
  }
}

constexpr int KROW = 208;
constexpr int VROW = 136;
constexpr int KBUF = 64 * KROW, VBUF = 64 * VROW;

constexpr int NK_ROW = 528;
constexpr int NK_BUF = 32 * NK_ROW;
constexpr int NV_ROW = 72;
constexpr int NV_BUF = 256 * NV_ROW;
constexpr int NRPB_OFF = 2 * NK_BUF + 2 * NV_BUF;

__device__ void natten_phase(const P& p, int l, char* smem) {
  int tid_ = threadIdx.x;
  asm volatile("" : "+v"(tid_));
  const int tid = tid_, lane = tid & 63, wave = tid >> 6, l15 = lane & 15, g = lane >> 4;
  const int hw = wave >> 1, qh = wave & 1;
  char* Ks = smem;
  char* Vs = smem + 2 * NK_BUF;
  float* rp = (float*)(smem + NRPB_OFF);
  __syncthreads();
  for (int i = tid; i < 4 * 15 * 31; i += NTHREADS) rp[i] = p.rpb[(size_t)l * 4 * 15 * 31 + i] * 1.4426950408889634f;
  const float qscale = 0.125f * 1.4426950408889634f;
  for (int job = blockIdx.x; job < 512; job += gridDim.x) {
    const int r = job & 63, b = job >> 6;
    const int r0 = min(max(r - 4, 0), 56);
    bf16x8 qf[2][2];
    int cq[2], c0[2];
#pragma unroll
    for (int nt = 0; nt < 2; ++nt) {
      cq[nt] = qh * 32 + nt * 16 + l15;
      c0[nt] = min(max(cq[nt] - 8, 0), 48);
      const bf16_t* qp = p.na + (size_t)(b * 4096 + r * 64 + cq[nt]) * 768 + hw * 64;
#pragma unroll
      for (int ks = 0; ks < 2; ++ks) qf[nt][ks] = *(const bf16x8*)(qp + ks * 32 + g * 8);
    }
    f32x4 o[4][2];
#pragma unroll
    for (int a = 0; a < 4; ++a)
#pragma unroll
      for (int n = 0; n < 2; ++n) o[a][n] = (f32x4){0.f, 0.f, 0.f, 0.f};
    float mrow[2] = {-1e30f, -1e30f}, lrow[2] = {0.f, 0.f};
    u32x4 rk[2], rv[2];
    auto gload = [&](int t) {
      const int kr = r0 + (t >> 1), kh = (t & 1) * 32;
      const bf16_t* kbase = p.na + (size_t)(b * 4096 + kr * 64 + kh) * 768 + 256;
#pragma unroll
      for (int i = 0; i < 2; ++i) {
        const int c = tid + 512 * i, key = c >> 5, cc = c & 31;
        rk[i] = *(const u32x4*)(kbase + (size_t)key * 768 + cc * 8);
      }
#pragma unroll
      for (int i = 0; i < 2; ++i) {
        const int c = tid + 512 * i, row = c >> 2, cc = c & 3;
        rv[i] = *(const u32x4*)(p.naVT + ((size_t)(b * 256 + row)) * 4096 + kr * 64 + kh + cc * 8);
      }
    };
    auto lstore = [&](int buf) {
      char* kb_ = Ks + buf * NK_BUF;
      char* vb_ = Vs + buf * NV_BUF;
#pragma unroll
      for (int i = 0; i < 2; ++i) {
        const int c = tid + 512 * i, key = c >> 5, cc = c & 31;
        *(u32x4*)(kb_ + key * NK_ROW + cc * 16) = rk[i];
      }
#pragma unroll
      for (int i = 0; i < 2; ++i) {
        const int c = tid + 512 * i, row = c >> 2, cc = c & 3;
        u32x2 lo, hi;
        lo.x = rv[i].x; lo.y = rv[i].y; hi.x = rv[i].z; hi.y = rv[i].w;
        *(u32x2*)(vb_ + row * NV_ROW + cc * 16) = lo;
        *(u32x2*)(vb_ + row * NV_ROW + cc * 16 + 8) = hi;
      }
    };
    gload(0);
    __syncthreads();
    lstore(0);
    __syncthreads();
    for (int t = 0; t < 16; ++t) {
      if (t + 1 < 16) gload(t + 1);
      __builtin_amdgcn_sched_barrier(0);
      const char* kb_ = Ks + (t & 1) * NK_BUF;
      const char* vb_ = Vs + (t & 1) * NV_BUF + hw * 64 * NV_ROW;
      const int kh = (t & 1) * 32;
      f32x4 s[2][2];
#pragma unroll
      for (int a = 0; a < 2; ++a)
#pragma unroll
        for (int n = 0; n < 2; ++n) s[a][n] = (f32x4){0.f, 0.f, 0.f, 0.f};
#pragma unroll
      for (int mt = 0; mt < 2; ++mt)
#pragma unroll
        for (int ks = 0; ks < 2; ++ks) {
          const bf16x8 kf = *(const bf16x8*)(kb_ + (mt * 16 + l15) * NK_ROW + hw * 128 + ks * 64 + g * 16);
#pragma unroll
          for (int nt = 0; nt < 2; ++nt)
            s[mt][nt] = __builtin_amdgcn_mfma_f32_16x16x32_bf16(kf, qf[nt][ks], s[mt][nt], 0, 0, 0);
        }
      const float* brow = rp + (hw * 15 + (r0 + (t >> 1) - r + 7)) * 31;
      bf16x8 pf[2];
#pragma unroll
      for (int nt = 0; nt < 2; ++nt) {
        float mx = -1e30f;
#pragma unroll
        for (int mt = 0; mt < 2; ++mt)
#pragma unroll
          for (int j = 0; j < 4; ++j) {
            const int kc = kh + mt * 16 + g * 4 + j;
            const bool valid = (unsigned)(kc - c0[nt]) < 16u;
            const int dc = min(max(kc - cq[nt] + 15, 0), 30);
            const float sc = valid ? (s[mt][nt][j] * qscale + brow[dc]) : -1e30f;
            s[mt][nt][j] = sc;
            mx = fmaxf(mx, sc);
          }
        mx = fmaxf(mx, __shfl_xor(mx, 16));
        mx = fmaxf(mx, __shfl_xor(mx, 32));
        const float mnew = fmaxf(mrow[nt], mx);
        const float alpha = __builtin_amdgcn_exp2f(mrow[nt] - mnew);
        mrow[nt] = mnew;
        float ls = 0.f;
#pragma unroll
        for (int mt = 0; mt < 2; ++mt)
#pragma unroll
          for (int j = 0; j < 4; ++j) {
            const float e = (s[mt][nt][j] > -1e29f) ? __builtin_amdgcn_exp2f(s[mt][nt][j] - mnew) : 0.f;
            s[mt][nt][j] = e;
            ls += e;
          }
        lrow[nt] = lrow[nt] * alpha + ls;
#pragma unroll
        for (int a = 0; a < 4; ++a) o[a][nt] *= alpha;
        u32x4 w;
        w.x = cvt_pk_bf16(s[0][nt][0], s[0][nt][1]);
        w.y = cvt_pk_bf16(s[0][nt][2], s[0][nt][3]);
        w.z = cvt_pk_bf16(s[1][nt][0], s[1][nt][1]);
        w.w = cvt_pk_bf16(s[1][nt][2], s[1][nt][3]);
        pf[nt] = __builtin_bit_cast(bf16x8, w);
      }
#pragma unroll
      for (int mt = 0; mt < 4; ++mt) {
        const u32x2 lo = *(const u32x2*)(vb_ + (mt * 16 + l15) * NV_ROW + (4 * g) * 2);
        const u32x2 hi = *(const u32x2*)(vb_ + (mt * 16 + l15) * NV_ROW + (16 + 4 * g) * 2);
        u32x4 w;
        w.x = lo.x; w.y = lo.y; w.z = hi.x; w.w = hi.y;
        const bf16x8 vf = __builtin_bit_cast(bf16x8, w);
#pragma unroll
        for (int nt = 0; nt < 2; ++nt)
          o[mt][nt] = __builtin_amdgcn_mfma_f32_16x16x32_bf16(vf, pf[nt], o[mt][nt], 0, 0, 0);
      }
      if (t + 1 < 16) lstore((t + 1) & 1);
      __syncthreads();
    }
#pragma unroll
    for (int nt = 0; nt < 2; ++nt) {
      float lt = lrow[nt];
      lt += __shfl_xor(lt, 16);
      lt += __shfl_xor(lt, 32);
      const float inv = 1.0f / lt;
      const int tok = b * 4096 + r * 64 + cq[nt];
#pragma unroll
      for (int mt = 0; mt < 4; ++mt) {
        u32x2 w;
        w.x = cvt_pk_bf16(o[mt][nt][0] * inv, o[mt][nt][1] * inv);
        w.y = cvt_pk_bf16(o[mt][nt][2] * inv, o[mt][nt][3] * inv);
        *(u32x2*)(p.o_c + (size_t)tok * 256 + hw * 64 + mt * 16 + g * 4) = w;
      }
    }
  }
}


__device__ void attn_phase(const P& p, char* smem) {
  int tid_ = threadIdx.x;
  asm volatile("" : "+v"(tid_));
  const int tid = tid_, lane = tid & 63, wave = tid >> 6, l15 = lane & 15, g = lane >> 4;
  char* Ks = smem;
  char* Vs = smem + 2 * KBUF;
  for (int job = vblock(); job < 768; job += gridDim.x) {
    const int qblk = job & 15, bh = job >> 4;
    const int b = bh / 6, h = bh % 6;
    const bf16_t* Q = p.qb + (size_t)bh * 4096 * 96;
    const bf16_t* Kg = p.kb + (size_t)bh * 4096 * 96;
    const bf16_t* Vt = p.vT + (size_t)bh * 64 * 4096;
    const int q0 = qblk * 256 + wave * 32;
    bf16x8 qf[2][3];
#pragma unroll
    for (int nt = 0; nt < 2; ++nt)
#pragma unroll
      for (int ks = 0; ks < 3; ++ks)
        qf[nt][ks] = *(const bf16x8*)(Q + (size_t)(q0 + nt * 16 + l15) * 96 + ks * 32 + g * 8);
    f32x4 o[4][2];
#pragma unroll
    for (int a = 0; a < 4; ++a)
#pragma unroll
      for (int n = 0; n < 2; ++n) o[a][n] = (f32x4){0.f, 0.f, 0.f, 0.f};
    float mrow[2] = {-1e30f, -1e30f}, lrow[2] = {0.f, 0.f};

    u32x4 rk[2];
    u32x4 rv;
    const int kr1 = (tid + 512) / 12, kc1 = (tid + 512) - kr1 * 12;
    const int kr0 = tid / 12, kc0 = tid - kr0 * 12;
    auto gload = [&](int kt) {
      const u32x4* kp = (const u32x4*)(Kg + (size_t)kt * 64 * 96);
      rk[0] = kp[tid];
      if (tid < 256) rk[1] = kp[tid + 512];
      rv = *(const u32x4*)(Vt + (size_t)(tid >> 3) * 4096 + kt * 64 + (tid & 7) * 8);
    };
    auto lstore = [&](int buf) {
      char* kb_ = Ks + buf * KBUF;
      char* vb_ = Vs + buf * VBUF;
      *(u32x4*)(kb_ + kr0 * KROW + kc0 * 16) = rk[0];
      if (tid < 256) *(u32x4*)(kb_ + kr1 * KROW + kc1 * 16) = rk[1];
      u32x2 lo, hi;
      lo.x = rv.x; lo.y = rv.y; hi.x = rv.z; hi.y = rv.w;
      *(u32x2*)(vb_ + (tid >> 3) * VROW + (tid & 7) * 16) = lo;
      *(u32x2*)(vb_ + (tid >> 3) * VROW + (tid & 7) * 16 + 8) = hi;
    };
    const int NKT = 64;
    gload(0);
    __syncthreads();
    lstore(0);
    __syncthreads();
    for (int kt = 0; kt < NKT; ++kt) {
      if (kt + 1 < NKT) gload(kt + 1);
      __builtin_amdgcn_sched_barrier(0);
      const char* kb_ = Ks + (kt & 1) * KBUF;
      const char* vb_ = Vs + (kt & 1) * VBUF;
      f32x4 s[4][2];
#pragma unroll
      for (int a = 0; a < 4; ++a)
#pragma unroll
        for (int n = 0; n < 2; ++n) s[a][n] = (f32x4){0.f, 0.f, 0.f, 0.f};
#pragma unroll
      for (int mt = 0; mt < 4; ++mt)
#pragma unroll
        for (int ks = 0; ks < 3; ++ks) {
          const bf16x8 kf = *(const bf16x8*)(kb_ + (mt * 16 + l15) * KROW + (ks * 32 + g * 8) * 2);
#pragma unroll
          for (int nt = 0; nt < 2; ++nt)
            s[mt][nt] = __builtin_amdgcn_mfma_f32_16x16x32_bf16(kf, qf[nt][ks], s[mt][nt], 0, 0, 0);
        }
      bf16x8 pf[2][2];
#pragma unroll
      for (int nt = 0; nt < 2; ++nt) {
        float mx = s[0][nt][0];
#pragma unroll
        for (int mt = 0; mt < 4; ++mt)
#pragma unroll
          for (int j = 0; j < 4; ++j) mx = fmaxf(mx, s[mt][nt][j]);
        mx = fmaxf(mx, __shfl_xor(mx, 16));
        mx = fmaxf(mx, __shfl_xor(mx, 32));
        if (__any(mx > mrow[nt] + 8.0f)) {
          const float mnew = fmaxf(mrow[nt], mx);
          const float alpha = __builtin_amdgcn_exp2f(mrow[nt] - mnew);
          mrow[nt] = mnew;
          lrow[nt] *= alpha;
#pragma unroll
          for (int a = 0; a < 4; ++a) o[a][nt] *= alpha;
        }
        const float mref = mrow[nt];
        float ls = 0.f;
#pragma unroll
        for (int mt = 0; mt < 4; ++mt)
#pragma unroll
          for (int j = 0; j < 4; ++j) {
            const float e = __builtin_amdgcn_exp2f(s[mt][nt][j] - mref);
            s[mt][nt][j] = e;
            ls += e;
          }
        lrow[nt] += ls;
#pragma unroll
        for (int kk = 0; kk < 2; ++kk) {
          u32x4 w;
          w.x = cvt_pk_bf16(s[2 * kk][nt][0], s[2 * kk][nt][1]);
          w.y = cvt_pk_bf16(s[2 * kk][nt][2], s[2 * kk][nt][3]);
          w.z = cvt_pk_bf16(s[2 * kk + 1][nt][0], s[2 * kk + 1][nt][1]);
          w.w = cvt_pk_bf16(s[2 * kk + 1][nt][2], s[2 * kk + 1][nt][3]);
          pf[kk][nt] = __builtin_bit_cast(bf16x8, w);
        }
      }
#pragma unroll
      for (int kk = 0; kk < 2; ++kk)
#pragma unroll
        for (int mt = 0; mt < 4; ++mt) {
          const u32x2 lo = *(const u32x2*)(vb_ + (mt * 16 + l15) * VROW + (32 * kk + 4 * g) * 2);
          const u32x2 hi = *(const u32x2*)(vb_ + (mt * 16 + l15) * VROW + (32 * kk + 16 + 4 * g) * 2);
          u32x4 w;
          w.x = lo.x; w.y = lo.y; w.z = hi.x; w.w = hi.y;
          const bf16x8 vf = __builtin_bit_cast(bf16x8, w);
#pragma unroll
          for (int nt = 0; nt < 2; ++nt)
            o[mt][nt] = __builtin_amdgcn_mfma_f32_16x16x32_bf16(vf, pf[kk][nt], o[mt][nt], 0, 0, 0);
        }
      if (kt + 1 < NKT) lstore((kt + 1) & 1);
      __syncthreads();
    }
#pragma unroll
    for (int nt = 0; nt < 2; ++nt) {
      float lt = lrow[nt];
      lt += __shfl_xor(lt, 16);
      lt += __shfl_xor(lt, 32);
      const float inv = 1.0f / lt;
      const int tok = b * 4096 + q0 + nt * 16 + l15;
#pragma unroll
      for (int mt = 0; mt < 4; ++mt) {
        u32x2 w;
        w.x = cvt_pk_bf16(o[mt][nt][0] * inv, o[mt][nt][1] * inv);
        w.y = cvt_pk_bf16(o[mt][nt][2] * inv, o[mt][nt][3] * inv);
        *(u32x2*)(p.o_a + (size_t)tok * 384 + h * 64 + mt * 16 + g * 4) = w;
      }
    }
  }
}

__device__ void mixnorm_phase(const P& p, char* smem) {
  int tid_ = threadIdx.x;
  asm volatile("" : "+v"(tid_));
  const int tid = tid_;
  for (int job = blockIdx.x; job < NTOK / 32; job += gridDim.x) {
    const int tok0 = job * 32, b = tok0 >> 12, s0 = tok0 & 4095;
    __syncthreads();
#pragma unroll
    for (int i = 0; i < 3; ++i) {
      const int c = tid + 512 * i, row = c / 48, cc = c % 48;
      *(u32x4*)(smem + row * 2048 + cc * 16) = *(const u32x4*)(p.o_a + (size_t)(tok0 + row) * 384 + cc * 8);
    }
#pragma unroll
    for (int i = 0; i < 2; ++i) {
      const int c = tid + 512 * i, row = c >> 5, cc = c & 31;
      *(u32x4*)(smem + row * 2048 + 1536 + cc * 16) = *(const u32x4*)(p.o_c + (size_t)(tok0 + row) * 256 + cc * 8);
    }
#pragma unroll
    for (int i = 0; i < 3; ++i) {
      const int c = tid + 512 * i, ch = c >> 2, tc = c & 3;
      const u32x4 v = *(const u32x4*)(p.ybT + ((size_t)(b * 384 + ch)) * 4096 + s0 + tc * 8);
      bf16_t* dst = (bf16_t*)smem + (size_t)(tc * 8) * 1024 + 384 + ch;
      dst[0 * 1024] = (bf16_t)(v.x & 0xffff); dst[1 * 1024] = (bf16_t)(v.x >> 16);
      dst[2 * 1024] = (bf16_t)(v.y & 0xffff); dst[3 * 1024] = (bf16_t)(v.y >> 16);
      dst[4 * 1024] = (bf16_t)(v.z & 0xffff); dst[5 * 1024] = (bf16_t)(v.z >> 16);
      dst[6 * 1024] = (bf16_t)(v.w & 0xffff); dst[7 * 1024] = (bf16_t)(v.w >> 16);
    }
    __syncthreads();
    const int tok = tid >> 4, sub = tid & 15;
    float ss[3] = {0.f, 0.f, 0.f};
#pragma unroll
    for (int gi = 0; gi < 3; ++gi) {
      const int i0 = (gi == 0) ? 0 : (gi == 1 ? 3 : 6), i1 = (gi == 0) ? 3 : (gi == 1 ? 6 : 8);
      float acc = 0.f;
#pragma unroll 2
      for (int i = i0; i < i1; ++i) {
        const u32x4 v = *(const u32x4*)(smem + tok * 2048 + (sub + 16 * i) * 16);
        float a;
        a = bflo(v.x); acc += a * a; a = bfhi(v.x); acc += a * a;
        a = bflo(v.y); acc += a * a; a = bfhi(v.y); acc += a * a;
        a = bflo(v.z); acc += a * a; a = bfhi(v.z); acc += a * a;
        a = bflo(v.w); acc += a * a; a = bfhi(v.w); acc += a * a;
      }
      acc += __shfl_xor(acc, 1);
      acc += __shfl_xor(acc, 2);
      acc += __shfl_xor(acc, 4);
      acc += __shfl_xor(acc, 8);
      ss[gi] = acc;
    }
    float rs[3];
    rs[0] = rsqrtf(ss[0] * (1.0f / 384.0f) + 1e-6f);
    rs[1] = rsqrtf(ss[1] * (1.0f / 384.0f) + 1e-6f);
    rs[2] = rsqrtf(ss[2] * (1.0f / 256.0f) + 1e-6f);
#pragma unroll
    for (int gi = 0; gi < 3; ++gi) {
      const int i0 = (gi == 0) ? 0 : (gi == 1 ? 3 : 6), i1 = (gi == 0) ? 3 : (gi == 1 ? 6 : 8);
      const float r = rs[gi];
#pragma unroll 2
      for (int i = i0; i < i1; ++i) {
        const u32x4 v = *(const u32x4*)(smem + tok * 2048 + (sub + 16 * i) * 16);
        u32x4 w;
        w.x = cvt_pk_bf16(bflo(v.x) * r, bfhi(v.x) * r);
        w.y = cvt_pk_bf16(bflo(v.y) * r, bfhi(v.y) * r);
        w.z = cvt_pk_bf16(bflo(v.z) * r, bfhi(v.z) * r);
        w.w = cvt_pk_bf16(bflo(v.w) * r, bfhi(v.w) * r);
        *(u32x4*)(p.y + (size_t)(tok0 + tok) * 1024 + (sub + 16 * i) * 8) = w;
      }
    }
  }
}

enum { EPI_INPROJ = 0, EPI_QUP = 1, EPI_KVUP = 2, EPI_OUTPROJ = 3, EPI_SWIGLU = 4, EPI_DOWN = 5 };

template <int EPI>
__device__ void gemm_phase(const P& p, int l, const bf16_t* __restrict__ A, int lda, const bf16_t* __restrict__ Bt,
                           int K, int nN, char* smem) {
  int tid_ = threadIdx.x;
  asm volatile("" : "+v"(tid_));
  const int tid = tid_, lane = tid & 63, wave = tid >> 6, wm = wave >> 2, wn = wave & 3, l15 = lane & 15,
            g = lane >> 4;
  const int ntiles = 128 * nN;
  const int srow = tid >> 3, skc = tid & 7;
  const int sw_off = srow * 128 + ((skc ^ ((srow >> 1) & 7)) * 16);
  const int rsw = (l15 >> 1) & 7;
  for (int tile = vblock(); tile < ntiles; tile += gridDim.x) {
    const int gsz_ = 4 * nN, grp_ = tile / gsz_, w_ = tile - grp_ * gsz_;
    const int ni = w_ >> 2, mi = grp_ * 4 + (w_ & 3);
    const int m0 = mi * 256, n0 = ni * 256;
    f32x4 acc[8][4];
#pragma unroll
    for (int a = 0; a < 8; ++a)
#pragma unroll
      for (int b = 0; b < 4; ++b) acc[a][b] = (f32x4){0.f, 0.f, 0.f, 0.f};
    const bf16_t* Ag = A + (size_t)(m0 + srow) * lda + skc * 8;
    const bf16_t* Bg = Bt + (size_t)(n0 + srow) * K + skc * 8;
    u32x4 ra[4], rb[4];
    auto gl = [&](int kt) {
#pragma unroll
      for (int i = 0; i < 4; ++i) ra[i] = *(const u32x4*)(Ag + (size_t)i * 64 * lda + kt * 64);
#pragma unroll
      for (int i = 0; i < 4; ++i) rb[i] = *(const u32x4*)(Bg + (size_t)i * 64 * K + kt * 64);
    };
    auto st = [&](int buf) {
      char* nb = smem + buf * 65536;
#pragma unroll
      for (int i = 0; i < 4; ++i) *(u32x4*)(nb + sw_off + i * 8192) = ra[i];
#pragma unroll
      for (int i = 0; i < 4; ++i) *(u32x4*)(nb + 32768 + sw_off + i * 8192) = rb[i];
    };
    const int nk = K / 64;
    gl(0);
    __syncthreads();
    st(0);
    __syncthreads();
    for (int kt = 0; kt < nk; ++kt) {
      if (kt + 1 < nk) gl(kt + 1);
      __builtin_amdgcn_sched_barrier(0);
      const char* Ab = smem + (kt & 1) * 65536;
      const char* Bb = Ab + 32768;
#pragma unroll
      for (int ks = 0; ks < 2; ++ks) {
        bf16x8 bfr[4];
#pragma unroll
        for (int nt = 0; nt < 4; ++nt)
          bfr[nt] = *(const bf16x8*)(Bb + (wn * 64 + nt * 16 + l15) * 128 + (((ks * 4 + g) ^ rsw) * 16));
        bf16x8 af[2][2];
#pragma unroll
        for (int mt = 0; mt < 2; ++mt)
          af[0][mt] = *(const bf16x8*)(Ab + (wm * 128 + mt * 16 + l15) * 128 + (((ks * 4 + g) ^ rsw) * 16));
#pragma unroll
        for (int mh = 0; mh < 4; ++mh) {
          if (mh < 3) {
#pragma unroll
            for (int mt = 0; mt < 2; ++mt)
              af[(mh + 1) & 1][mt] = *(const bf16x8*)(Ab + (wm * 128 + ((mh + 1) * 2 + mt) * 16 + l15) * 128 + (((ks * 4 + g) ^ rsw) * 16));
          }
          __builtin_amdgcn_sched_barrier(0);
#pragma unroll
          for (int mt = 0; mt < 2; ++mt)
#pragma unroll
            for (int nt = 0; nt < 4; ++nt)
              acc[mh * 2 + mt][nt] = __builtin_amdgcn_mfma_f32_16x16x32_bf16(bfr[nt], af[mh & 1][mt], acc[mh * 2 + mt][nt], 0, 0, 0);
          __builtin_amdgcn_sched_barrier(0);
        }
      }
      if (kt + 1 < nk) st((kt + 1) & 1);
      __syncthreads();
    }
    int opq_ = 0;
    asm volatile("" : "+v"(opq_));
    const int rbase = m0 + wm * 128 + l15 + opq_;
    const int cbase = n0 + wn * 64 + g * 4 + opq_;
    if (EPI == EPI_INPROJ) {
      const int wc0 = n0 + wn * 64;
#pragma unroll
      for (int mt = 0; mt < 8; ++mt) {
        __builtin_amdgcn_sched_barrier(0);
        const int row = rbase + mt * 16;
        const f32x4* pp = (const f32x4*)(p.part_x + (size_t)row * 16);
        const f32x4 a0 = pp[0], a1 = pp[1], a2 = pp[2], a3 = pp[3];
        const float tot = (a0[0] + a0[1] + a0[2] + a0[3]) + (a1[0] + a1[1] + a1[2] + a1[3]) +
                          (a2[0] + a2[1] + a2[2] + a2[3]) + (a3[0] + a3[1] + a3[2] + a3[3]);
        const float rs = rsqrtf(tot * (1.0f / 1024.0f) + 1e-6f);
        const int bb = row >> 12, ss = row & 4095;
        float sq = 0.f;
#pragma unroll
        for (int nt = 0; nt < 4; ++nt) {
          const int ct = wc0 + nt * 16;
          const int col = cbase + nt * 16;
          f32x4 v = acc[mt][nt] * rs;
          if (ct < 384) {
            sq += v[0] * v[0] + v[1] * v[1] + v[2] * v[2] + v[3] * v[3];
            u32x2 w;
            w.x = cvt_pk_bf16(v[0], v[1]);
            w.y = cvt_pk_bf16(v[2], v[3]);
            *(u32x2*)(p.projA + (size_t)row * 416 + col) = w;
          } else if (ct == 384) {
            if (nt < 3) {
              const f32x4 v2 = acc[mt][(nt + 1) & 3] * rs;
              const int i0 = col - 384;
              const float2* cs = p.ropecs + ss * 16 + i0;
              float o1[4], o2[4];
#pragma unroll
              for (int j = 0; j < 4; ++j) {
                const float2 c_s = cs[j];
                o1[j] = v[j] * c_s.x - v2[j] * c_s.y;
                o2[j] = v[j] * c_s.y + v2[j] * c_s.x;
              }
              u32x2 w;
              w.x = cvt_pk_bf16(o1[0], o1[1]);
              w.y = cvt_pk_bf16(o1[2], o1[3]);
              *(u32x2*)(p.projA + (size_t)row * 416 + 384 + i0) = w;
              w.x = cvt_pk_bf16(o2[0], o2[1]);
              w.y = cvt_pk_bf16(o2[2], o2[3]);
              *(u32x2*)(p.projA + (size_t)row * 416 + 400 + i0) = w;
            }
          } else if (ct == 400) {
          } else if (ct < 1568) {
            const int hc = col - 416;
            bf16_t* dst = p.hyT + ((size_t)(bb * 1152 + hc)) * 4096 + ss;
            dst[0] = f2bf(v[0]);
            dst[4096] = f2bf(v[1]);
            dst[2 * 4096] = f2bf(v[2]);
            dst[3 * 4096] = f2bf(v[3]);
          } else if (ct < 2080) {
            u32x2 w;
            w.x = cvt_pk_bf16(v[0], v[1]);
            w.y = cvt_pk_bf16(v[2], v[3]);
            *(u32x2*)(p.na + (size_t)row * 768 + (col - 1568)) = w;
          } else if (ct < 2336) {
            const int vc = col - 2080;
            bf16_t* dst = p.naVT + ((size_t)(bb * 256 + vc)) * 4096 + ss;
            dst[0] = f2bf(v[0]);
            dst[4096] = f2bf(v[1]);
            dst[2 * 4096] = f2bf(v[2]);
            dst[3 * 4096] = f2bf(v[3]);
          }
        }
        if (wc0 < 384) {
          sq += __shfl_xor(sq, 16);
          sq += __shfl_xor(sq, 32);
          if (g == 0) {
            if (wc0 < 256) p.part_q[(size_t)row * 4 + (wc0 >> 6)] = sq;
            else p.part_kv[(size_t)row * 2 + ((wc0 - 256) >> 6)] = sq;
          }
        }
      }
    } else if (EPI == EPI_QUP) {
      const int wc0 = n0 + wn * 64;
      const float qscale = 0.10206207261596575f * 1.4426950408889634f;
#pragma unroll
      for (int mt = 0; mt < 8; ++mt) {
        __builtin_amdgcn_sched_barrier(0);
        const int row = rbase + mt * 16;
        const f32x4 a0 = *(const f32x4*)(p.part_q + (size_t)row * 4);
        const float rs = rsqrtf((a0[0] + a0[1] + a0[2] + a0[3]) * (1.0f / 256.0f) + 1e-6f) * qscale;
        const int bb = row >> 12, ss = row & 4095;
#pragma unroll
        for (int nt = 0; nt < 4; ++nt) {
          const int T = (wc0 >> 4) + nt;
          if (T < 36) {
            const int hh = T / 6, tt = T % 6;
            bf16_t* qrow = p.qb + ((size_t)((bb * 6 + hh) * 4096 + ss)) * 96;
            const f32x4 v = acc[mt][nt] * rs;
            if (tt < 4) {
              u32x2 w;
              w.x = cvt_pk_bf16(v[0], v[1]);
              w.y = cvt_pk_bf16(v[2], v[3]);
              *(u32x2*)(qrow + tt * 16 + g * 4) = w;
            } else if (tt == 4) {
              if (nt < 3) {
                const f32x4 v2 = acc[mt][(nt + 1) & 3] * rs;
                const float2* cs = p.ropecs + ss * 16 + g * 4;
                float o1[4], o2[4];
#pragma unroll
                for (int j = 0; j < 4; ++j) {
                  const float2 c_s = cs[j];
                  o1[j] = v[j] * c_s.x - v2[j] * c_s.y;
                  o2[j] = v[j] * c_s.y + v2[j] * c_s.x;
                }
                u32x2 w;
                w.x = cvt_pk_bf16(o1[0], o1[1]);
                w.y = cvt_pk_bf16(o1[2], o1[3]);
                *(u32x2*)(qrow + 64 + g * 4) = w;
                w.x = cvt_pk_bf16(o2[0], o2[1]);
                w.y = cvt_pk_bf16(o2[2], o2[3]);
                *(u32x2*)(qrow + 80 + g * 4) = w;
              }
            }
          }
        }
      }
    } else if (EPI == EPI_KVUP) {
      const int hh = ni * 2 + (wn >> 1);
#pragma unroll
      for (int mt = 0; mt < 8; ++mt) {
        __builtin_amdgcn_sched_barrier(0);
        const int row = rbase + mt * 16;
        const float2 a0 = *(const float2*)(p.part_kv + (size_t)row * 2);
        const float rs = rsqrtf((a0.x + a0.y) * (1.0f / 128.0f) + 1e-6f);
        const int bb = row >> 12, ss = row & 4095;
#pragma unroll
        for (int nt = 0; nt < 4; ++nt) {
          const f32x4 v = acc[mt][nt] * rs;
          if ((wn & 1) == 0) {
            u32x2 w;
            w.x = cvt_pk_bf16(v[0], v[1]);
            w.y = cvt_pk_bf16(v[2], v[3]);
            *(u32x2*)(p.kb + ((size_t)((bb * 6 + hh) * 4096 + ss)) * 96 + nt * 16 + g * 4) = w;
          } else {
            const int dv = nt * 16 + g * 4;
            bf16_t* dst = p.vT + ((size_t)((bb * 6 + hh) * 64 + dv)) * 4096 + ss;
            dst[0] = f2bf(v[0]);
            dst[4096] = f2bf(v[1]);
            dst[2 * 4096] = f2bf(v[2]);
            dst[3 * 4096] = f2bf(v[3]);
          }
        }
      }
#pragma unroll
      for (int i = 0; i < 2; ++i) {
        const int c = tid + 512 * i, rr = c >> 2, cc = c & 3;
        const int row = m0 + rr, bb = row >> 12, ss = row & 4095;
        const u32x4 v = *(const u32x4*)(p.projA + (size_t)row * 416 + 384 + cc * 8);
        *(u32x4*)(p.kb + ((size_t)((bb * 6 + ni * 2) * 4096 + ss)) * 96 + 64 + cc * 8) = v;
        *(u32x4*)(p.kb + ((size_t)((bb * 6 + ni * 2 + 1) * 4096 + ss)) * 96 + 64 + cc * 8) = v;
      }
    } else if (EPI == EPI_OUTPROJ || EPI == EPI_DOWN) {
      const bool last_upd = (EPI == EPI_DOWN && l == 1);
      const int slot = (n0 + wn * 64) >> 6;
#pragma unroll
      for (int mt = 0; mt < 8; ++mt) {
        __builtin_amdgcn_sched_barrier(0);
        const int row = rbase + mt * 16;
        float sq = 0.f;
#pragma unroll
        for (int nt = 0; nt < 4; ++nt) {
          const int col = cbase + nt * 16;
          const u32x2 xr = *(const u32x2*)(p.xb + (size_t)row * 1024 + col);
          const f32x4 xo = (f32x4){bflo(xr.x), bfhi(xr.x), bflo(xr.y), bfhi(xr.y)};
          const f32x4 v = acc[mt][nt] + xo;
          sq += v[0] * v[0] + v[1] * v[1] + v[2] * v[2] + v[3] * v[3];
          if (last_upd) {
            *(f32x4*)(p.out + (size_t)row * 1024 + col) = v;
          } else {
            u32x2 w;
            w.x = cvt_pk_bf16(v[0], v[1]);
            w.y = cvt_pk_bf16(v[2], v[3]);
            *(u32x2*)(p.xb + (size_t)row * 1024 + col) = w;
          }
        }
        sq += __shfl_xor(sq, 16);
        sq += __shfl_xor(sq, 32);
        if (g == 0) p.part_x[(size_t)row * 16 + slot] = sq;
      }
    } else if (EPI == EPI_SWIGLU) {
      const int fbase = ((n0 + wn * 64) >> 1) + g * 4;
#pragma unroll
      for (int mt = 0; mt < 8; ++mt) {
        __builtin_amdgcn_sched_barrier(0);
        const int row = rbase + mt * 16;
        const f32x4* pp = (const f32x4*)(p.part_x + (size_t)row * 16);
        const f32x4 a0 = pp[0], a1 = pp[1], a2 = pp[2], a3 = pp[3];
        const float tot = (a0[0] + a0[1] + a0[2] + a0[3]) + (a1[0] + a1[1] + a1[2] + a1[3]) +
                          (a2[0] + a2[1] + a2[2] + a2[3]) + (a3[0] + a3[1] + a3[2] + a3[3]);
        const float rs = rsqrtf(tot * (1.0f / 1024.0f) + 1e-6f);
#pragma unroll
        for (int i = 0; i < 2; ++i) {
          const f32x4 gt = acc[mt][2 * i] * rs, up = acc[mt][2 * i + 1] * rs;
          float hv[4];
#pragma unroll
          for (int j = 0; j < 4; ++j) hv[j] = gt[j] * __builtin_amdgcn_rcpf(1.0f + __expf(-gt[j])) * up[j];
          u32x2 w;
          w.x = cvt_pk_bf16(hv[0], hv[1]);
          w.y = cvt_pk_bf16(hv[2], hv[3]);
          *(u32x2*)(p.hidden + (size_t)row * 2816 + fbase + i * 16) = w;
        }
      }
    }
  }
}

__device__ void final_norm_phase(const P& p) {
  int tid_ = threadIdx.x;
  asm volatile("" : "+v"(tid_));
  const int tid = tid_, lane = tid & 63, wave = tid >> 6;
  for (int row = blockIdx.x * 8 + wave; row < NTOK; row += gridDim.x * 8) {
    const f32x4* pp = (const f32x4*)(p.part_x + (size_t)row * 16);
    const f32x4 a0 = pp[0], a1 = pp[1], a2 = pp[2], a3 = pp[3];
    const float tot = (a0[0] + a0[1] + a0[2] + a0[3]) + (a1[0] + a1[1] + a1[2] + a1[3]) +
                      (a2[0] + a2[1] + a2[2] + a2[3]) + (a3[0] + a3[1] + a3[2] + a3[3]);
    const float rs = rsqrtf(tot * (1.0f / 1024.0f) + 1e-6f);
    float* xr = p.out + (size_t)row * 1024;
#pragma unroll
    for (int i = 0; i < 4; ++i) {
      f32x4 v = *(const f32x4*)(xr + lane * 4 + 256 * i);
      const f32x4 gg = *(const f32x4*)(p.final_g + lane * 4 + 256 * i);
      v = v * rs * gg;
      *(f32x4*)(xr + lane * 4 + 256 * i) = v;
    }
  }
}


template <int S>
__device__ __forceinline__ void run_stage(const P& p, int l, char* smem) {
  if (S == 0) prep_phase(p, l, smem);
  if (S == 1) {
    filt_fft_phase(p, l, smem);
    gemm_phase<EPI_INPROJ>(p, l, p.xb, 1024, p.Win, 1024, 10, smem);
  }
  if (S == 2) {
    hyena_phase<0>(p, l, smem);
    gemm_phase<EPI_QUP>(p, l, p.projA, 416, p.Wuq, 256, 3, smem);
    gemm_phase<EPI_KVUP>(p, l, p.projA + 256, 416, p.Wukv, 128, 3, smem);
    natten_phase(p, l, smem);
  }
  if (S == 3) {
    hyena_phase<1>(p, l, smem);
    attn_phase(p, smem);
  }
  if (S == 4) mixnorm_phase(p, smem);
  if (S == 5) gemm_phase<EPI_OUTPROJ>(p, l, p.y, 1024, p.Wout, 1024, 4, smem);
  if (S == 6) gemm_phase<EPI_SWIGLU>(p, l, p.xb, 1024, p.Wgu, 1024, 22, smem);
  if (S == 7) gemm_phase<EPI_DOWN>(p, l, p.hidden, 2816, p.Wdown, 2816, 4, smem);
  if (S == 8) final_norm_phase(p);
}

__device__ __forceinline__ void grid_barrier(unsigned* bar, unsigned target) {
  asm volatile("s_waitcnt vmcnt(0)" ::: "memory");
  __syncthreads();
  if (threadIdx.x == 0) {
    __builtin_amdgcn_fence(__ATOMIC_RELEASE, "agent");
    asm volatile("s_waitcnt vmcnt(0)" ::: "memory");
    __hip_atomic_fetch_add(bar, 1u, __ATOMIC_RELAXED, __HIP_MEMORY_SCOPE_AGENT);
    unsigned spins = 0;
    while (__hip_atomic_load(bar, __ATOMIC_RELAXED, __HIP_MEMORY_SCOPE_AGENT) < target && spins < (1u << 22)) {
      __builtin_amdgcn_s_sleep(1);
      ++spins;
    }
    __builtin_amdgcn_fence(__ATOMIC_ACQUIRE, "agent");
    asm volatile("s_waitcnt vmcnt(0)" ::: "memory");
  }
  __syncthreads();
}

__global__ void __launch_bounds__(NTHREADS) k_main(P p) {
  extern __shared__ __attribute__((aligned(16))) char smem[];
  cg::grid_group grid = cg::this_grid();
  if (blockIdx.x == 0 && threadIdx.x == 0) __hip_atomic_store(p.bar, 0u, __ATOMIC_RELAXED, __HIP_MEMORY_SCOPE_AGENT);
  run_stage<0>(p, 0, smem); grid.sync();
  run_stage<1>(p, 0, smem); grid_barrier(p.bar, 1u * gridDim.x);
  run_stage<2>(p, 0, smem); grid_barrier(p.bar, 2u * gridDim.x);
  run_stage<3>(p, 0, smem); grid_barrier(p.bar, 3u * gridDim.x);
  run_stage<4>(p, 0, smem); grid_barrier(p.bar, 4u * gridDim.x);
  run_stage<5>(p, 0, smem); grid_barrier(p.bar, 5u * gridDim.x);
  run_stage<6>(p, 0, smem); grid_barrier(p.bar, 6u * gridDim.x);
  run_stage<7>(p, 0, smem); grid_barrier(p.bar, 7u * gridDim.x);
  run_stage<0>(p, 1, smem); grid_barrier(p.bar, 8u * gridDim.x);
  run_stage<1>(p, 1, smem); grid_barrier(p.bar, 9u * gridDim.x);
  run_stage<2>(p, 1, smem); grid_barrier(p.bar, 10u * gridDim.x);
  run_stage<3>(p, 1, smem); grid_barrier(p.bar, 11u * gridDim.x);
  run_stage<4>(p, 1, smem); grid_barrier(p.bar, 12u * gridDim.x);
  run_stage<5>(p, 1, smem); grid_barrier(p.bar, 13u * gridDim.x);
  run_stage<6>(p, 1, smem); grid_barrier(p.bar, 14u * gridDim.x);
  run_stage<7>(p, 1, smem); grid_barrier(p.bar, 15u * gridDim.x);
  run_stage<8>(p, 1, smem);
}


extern "C" void kernel_launch(void* const* d_in, const int* in_sizes, int n_in, void* d_out, int out_size, void* d_ws,
                              size_t ws_size, hipStream_t stream) {
  static int grid_blocks = 0;
  if (!grid_blocks) {
    int dev = 0, cus = 0;
    (void)hipGetDevice(&dev);
    (void)hipDeviceGetAttribute(&cus, hipDeviceAttributeMultiprocessorCount, dev);
    if (cus <= 0) cus = 256;
    int per_cu = 0;
    (void)hipFuncSetAttribute((const void*)k_main, hipFuncAttributeMaxDynamicSharedMemorySize, LDS_BYTES);
    (void)hipOccupancyMaxActiveBlocksPerMultiprocessor(&per_cu, k_main, NTHREADS, LDS_BYTES);
    if (per_cu > 1) per_cu = 1;
    if (per_cu < 1) per_cu = 1;
    grid_blocks = cus * per_cu;
  }
  P p;
  memset(&p, 0, sizeof(p));
  const float* const* in = (const float* const*)d_in;
  p.x = in[0]; p.norm1_g = in[1]; p.w_in = in[2]; p.q_norm_g = in[3]; p.w_uq = in[4]; p.kv_norm_g = in[5];
  p.w_ukv = in[6]; p.conv_w = in[7]; p.conv_b = in[8]; p.fw1 = in[9]; p.fb1 = in[10]; p.ff1 = in[11];
  p.fw2 = in[12]; p.fb2 = in[13]; p.ff2 = in[14]; p.fw3 = in[15]; p.skip = in[16]; p.rpb = in[17];
  p.mix_g = in[18]; p.w_out = in[19]; p.norm2_g = in[20]; p.w_gate = in[21]; p.w_up = in[22]; p.w_down = in[23];
  p.final_g = in[24];
  p.out = (float*)d_out;
  char* ws = (char*)d_ws;
  size_t off = 0;
  auto take = [&](size_t bytes) {
    char* r = ws + off;
    off += (bytes + 255) & ~(size_t)255;
    return r;
  };
  p.Win = (bf16_t*)take((size_t)2560 * 1024 * 2);
  p.Wuq = (bf16_t*)take((size_t)768 * 256 * 2);
  p.Wukv = (bf16_t*)take((size_t)768 * 128 * 2);
  p.Wout = (bf16_t*)take((size_t)1024 * 1024 * 2);
  p.Wgu = (bf16_t*)take((size_t)5632 * 1024 * 2);
  p.Wdown = (bf16_t*)take((size_t)1024 * 2816 * 2);
  p.ropecs = (float2*)take((size_t)65536 * 8);
  p.tw = (float2*)take((size_t)8192 * 8);
  p.bar = (unsigned*)take(256);
  p.part_x = (float*)take((size_t)NTOK * 16 * 4);
  p.part_q = (float*)take((size_t)NTOK * 4 * 4);
  p.part_kv = (float*)take((size_t)NTOK * 2 * 4);
  p.xb = (bf16_t*)take((size_t)NTOK * 1024 * 2);
  p.H2 = (float2*)take((size_t)768 * 8192 * 8);
  p.z1T = (bf16_t*)take((size_t)1536 * 4096 * 4);
  p.filtT = (float*)p.z1T;
  p.vT = (bf16_t*)take((size_t)8 * 6 * 64 * 4096 * 2);
  p.o_a = (bf16_t*)take((size_t)NTOK * 384 * 2);
  p.o_c = (bf16_t*)take((size_t)NTOK * 256 * 2);
  char* big = take(0);
  p.projA = (bf16_t*)take((size_t)NTOK * 416 * 2);
  p.hyT = (bf16_t*)take((size_t)8 * 1152 * 4096 * 2);
  p.na = (bf16_t*)take((size_t)NTOK * 768 * 2);
  p.qb = (bf16_t*)take((size_t)8 * 6 * 4096 * 96 * 2);
  p.kb = (bf16_t*)take((size_t)8 * 6 * 4096 * 96 * 2);
  p.hidden = (bf16_t*)big;
  p.ybT = (bf16_t*)take((size_t)8 * 384 * 4096 * 2);
  p.naVT = (bf16_t*)take((size_t)8 * 4 * 64 * 4096 * 2);
  p.y = p.qb;
  if (off > ws_size) {
    fprintf(stderr, "workspace too small: need %zu have %zu\n", off, ws_size);
    return;
  }
  void* args[] = {&p};
  hipError_t e = hipLaunchCooperativeKernel((void*)k_main, dim3(grid_blocks), dim3(NTHREADS), args, LDS_BYTES, stream);
  if (e != hipSuccess) fprintf(stderr, "cooperative launch failed: %s (grid %d)\n", hipGetErrorString(e), grid_blocks);
}
```

```cpp
#include <hip/hip_runtime.h>
#include <hip/hip_cooperative_groups.h>
#include <cstdio>
#include <cstring>
#include <cstdint>
#include <cmath>
#include <type_traits>
namespace cg = cooperative_groups;


typedef unsigned short bf16_t;
typedef short bf16x8 __attribute__((ext_vector_type(8)));
typedef float f32x4 __attribute__((ext_vector_type(4)));
typedef unsigned u32x4 __attribute__((ext_vector_type(4)));
typedef unsigned u32x2 __attribute__((ext_vector_type(2)));

constexpr int NTOK = 32768, SEQ = 4096;
constexpr int NTHREADS = 512;
constexpr int LDS_BYTES = 147456;
constexpr int TW_LDS_OFF = 69632;
#define PADI(i) ((i) + ((i) >> 4))

struct P {
  const float *x, *norm1_g, *w_in, *q_norm_g, *w_uq, *kv_norm_g, *w_ukv, *conv_w, *conv_b, *fw1, *fb1, *ff1, *fw2, *fb2,
      *ff2, *fw3, *skip, *rpb, *mix_g, *w_out, *norm2_g, *w_gate, *w_up, *w_down, *final_g;
  float* out;
  bf16_t *Win, *Wuq, *Wukv, *Wout, *Wgu, *Wdown;
  bf16_t *xb, *projA, *hyT, *na, *qb, *kb, *vT, *o_a, *o_c, *y, *hidden, *ybT, *naVT;
  float2* H2;
  float* filtT;
  bf16_t* z1T;
  float *part_x, *part_q, *part_kv;
  float2* ropecs;
  float2* tw;
  unsigned* bar;
  unsigned pad0_, pad1_;
};

typedef __bf16 bf16v2_t __attribute__((ext_vector_type(2)));
typedef float f32x2_t __attribute__((ext_vector_type(2)));
__device__ __forceinline__ unsigned cvt_pk_bf16(float lo, float hi) {
  const f32x2_t v = {lo, hi};
  const bf16v2_t r = __builtin_convertvector(v, bf16v2_t);
  return __builtin_bit_cast(unsigned, r);
}
__device__ __forceinline__ bf16_t f2bf(float f) { return (bf16_t)(cvt_pk_bf16(f, 0.f) & 0xffffu); }
__device__ __forceinline__ float bf2f(bf16_t h) { return __uint_as_float(((unsigned)h) << 16); }
__device__ __forceinline__ float bflo(unsigned u) { return __uint_as_float(u << 16); }
__device__ __forceinline__ float bfhi(unsigned u) { return __uint_as_float(u & 0xffff0000u); }

__device__ __forceinline__ void fast_sincos_rev(float rev, float* s, float* c) {
  const float fr = rev - rintf(rev);
  *s = __builtin_amdgcn_sinf(fr);
  *c = __builtin_amdgcn_cosf(fr);
}
__device__ __forceinline__ float fast_sin(float x) {
  const float rev = x * 0.15915494309189535f;
  const float fr = rev - rintf(rev);
  return __builtin_amdgcn_sinf(fr);
}

__device__ __forceinline__ int vblock() {
  const int G = gridDim.x, b = blockIdx.x;
  return ((G & 7) == 0) ? ((b & 7) * (G >> 3) + (b >> 3)) : b;
}

__device__ void conv_w(const float* __restrict__ W, int K, int N, int Npad, const float* __restrict__ g, bf16_t* Bt,
                       int mode, char* smem) {
  float* tile = (float*)smem;
  int tid_ = threadIdx.x;
  asm volatile("" : "+v"(tid_));
  const int tid = tid_;
  const int nkt = K / 64, nnt = Npad / 64;
  for (int job = blockIdx.x; job < nkt * nnt; job += gridDim.x) {
    const int kt = job % nkt, ntile = job / nkt;
    const int k0 = kt * 64, n0 = ntile * 64;
    __syncthreads();
#pragma unroll
    for (int i = 0; i < 2; ++i) {
      const int k = (tid >> 4) + 32 * i, nq = (tid & 15) * 4, n = n0 + nq;
      f32x4 v = {0.f, 0.f, 0.f, 0.f};
      if (n < N) {
        v = *(const f32x4*)(W + (size_t)(k0 + k) * N + n);
        if (g) v = v * g[k0 + k];
      }
      tile[k * 65 + nq + 0] = v[0];
      tile[k * 65 + nq + 1] = v[1];
      tile[k * 65 + nq + 2] = v[2];
      tile[k * 65 + nq + 3] = v[3];
    }
    __syncthreads();
    {
      const int c = tid, n = c >> 3, kc = c & 7;
      float e[8];
#pragma unroll
      for (int q = 0; q < 8; ++q) e[q] = tile[(kc * 8 + q) * 65 + n];
      u32x4 w;
      w.x = cvt_pk_bf16(e[0], e[1]);
      w.y = cvt_pk_bf16(e[2], e[3]);
      w.z = cvt_pk_bf16(e[4], e[5]);
      w.w = cvt_pk_bf16(e[6], e[7]);
      const int nn = n0 + n;
      int dest = nn;
      if (mode == 1) dest = 32 * (nn >> 4) + (nn & 15);
      if (mode == 2) dest = 32 * (nn >> 4) + 16 + (nn & 15);
      *(u32x4*)(Bt + (size_t)dest * K + k0 + kc * 8) = w;
    }
  }
}

__device__ void filt_mlp(const P& p, int l, char* smem) {
  float* zf = (float*)smem;
  float* h1 = zf + 16 * 17;
  float* h2 = h1 + 64 * 16;
  int tid_ = threadIdx.x;
  asm volatile("" : "+v"(tid_));
  const int tid = tid_, tl = tid & 15, kk = tid >> 4;
  const float* w1 = p.fw1 + l * 17 * 64;
  const float* b1 = p.fb1 + l * 64;
  const float* f1 = p.ff1 + l * 64;
  const float* w2 = p.fw2 + l * 64 * 64;
  const float* b2 = p.fb2 + l * 64;
  const float* f2 = p.ff2 + l * 64;
  const float* w3 = p.fw3 + (size_t)l * 64 * 1536;
  for (int job = blockIdx.x; job < 256; job += gridDim.x) {
    const int t0 = job * 16;
    __syncthreads();
    {
      const int t = t0 + tl;
      if (kk < 8) {
        const float band = 1e-4f + (float)kk * ((7.0f - 1e-4f) / 7.0f);
        const float ang = ((6.283185307179586f * (float)t) * band) / 4096.0f;
        float s, c;
        fast_sincos_rev(ang * 0.15915494309189535f, &s, &c);
        zf[tl * 17 + 1 + kk] = c;
        zf[tl * 17 + 9 + kk] = s;
      } else if (kk == 8) {
        zf[tl * 17] = (float)t / 4095.0f;
      }
    }
    __syncthreads();
#pragma unroll
    for (int m = 0; m < 2; ++m) {
      const int j = kk + 32 * m;
      float a = b1[j];
#pragma unroll 1
      for (int f = 0; f < 17; ++f) a += zf[tl * 17 + f] * w1[f * 64 + j];
      h1[j * 16 + tl] = fast_sin(f1[j] * a);
    }
    __syncthreads();
#pragma unroll
    for (int m = 0; m < 2; ++m) {
      const int j = kk + 32 * m;
      float a = b2[j];
#pragma unroll 16
      for (int i = 0; i < 64; ++i) a += h1[i * 16 + tl] * w2[i * 64 + j];
      h2[j * 16 + tl] = fast_sin(f2[j] * a);
    }
    __syncthreads();
#pragma unroll 1
    for (int mm = 0; mm < 3; ++mm) {
      const int col = tid + 512 * mm;
      float acc[16];
#pragma unroll
      for (int q = 0; q < 16; ++q) acc[q] = 0.f;
#pragma unroll 1
      for (int j0 = 0; j0 < 64; j0 += 8) {
        float wv[8];
#pragma unroll
        for (int q = 0; q < 8; ++q) wv[q] = w3[(size_t)(j0 + q) * 1536 + col];
#pragma unroll
        for (int q = 0; q < 8; ++q) {
          const float w = wv[q];
          const f32x4* hp = (const f32x4*)(h2 + (j0 + q) * 16);
          const f32x4 a0 = hp[0], a1 = hp[1], a2 = hp[2], a3 = hp[3];
          acc[0] += a0[0] * w; acc[1] += a0[1] * w; acc[2] += a0[2] * w; acc[3] += a0[3] * w;
          acc[4] += a1[0] * w; acc[5] += a1[1] * w; acc[6] += a1[2] * w; acc[7] += a1[3] * w;
          acc[8] += a2[0] * w; acc[9] += a2[1] * w; acc[10] += a2[2] * w; acc[11] += a2[3] * w;
          acc[12] += a3[0] * w; acc[13] += a3[1] * w; acc[14] += a3[2] * w; acc[15] += a3[3] * w;
        }
      }
      const int c = col % 384;
      const float lo = -3.0701134573253945f, hi = -15.350567286626972f;
      const float delta = fabsf(lo + (hi - lo) * ((float)c / 383.0f));
      float* dst = p.filtT + (size_t)col * 4096 + t0;
#pragma unroll
      for (int q = 0; q < 16; ++q) {
        const float tn = (float)(t0 + q) / 4095.0f;
        dst[q] = acc[q] * __expf(-tn * delta);
      }
    }
  }
}

__device__ void prep_phase(const P& p, int l, char* smem) {
  for (int w = 0; w < 7; ++w) {
    const float* W; const float* g; bf16_t* Bt; int K, N, Npad, mode = 0;
    switch (w) {
      case 0: W = p.w_in + (size_t)l * 1024 * 2336; K = 1024; N = 2336; Npad = 2560; g = p.norm1_g + l * 1024; Bt = p.Win; break;
      case 1: W = p.w_uq + (size_t)l * 256 * 576; K = 256; N = 576; Npad = 768; g = p.q_norm_g + l * 256; Bt = p.Wuq; break;
      case 2: W = p.w_ukv + (size_t)l * 128 * 768; K = 128; N = 768; Npad = 768; g = p.kv_norm_g + l * 128; Bt = p.Wukv; break;
      case 3: W = p.w_out + (size_t)l * 1024 * 1024; K = 1024; N = 1024; Npad = 1024; g = p.mix_g + l * 1024; Bt = p.Wout; break;
      case 4: W = p.w_gate + (size_t)l * 1024 * 2816; K = 1024; N = 2816; Npad = 2816; g = p.norm2_g + l * 1024; Bt = p.Wgu; mode = 1; break;
      case 5: W = p.w_up + (size_t)l * 1024 * 2816; K = 1024; N = 2816; Npad = 2816; g = p.norm2_g + l * 1024; Bt = p.Wgu; mode = 2; break;
      default: W = p.w_down + (size_t)l * 2816 * 1024; K = 2816; N = 1024; Npad = 1024; g = nullptr; Bt = p.Wdown; break;
    }
    conv_w(W, K, N, Npad, g, Bt, mode, smem);
  }
  filt_mlp(p, l, smem);
  if (l == 0) {
    int tid_ = threadIdx.x;
  asm volatile("" : "+v"(tid_));
  const int tid = tid_, lane = tid & 63, wave = tid >> 6;
    for (int row = blockIdx.x * 8 + wave; row < NTOK; row += gridDim.x * 8) {
      const float* xr = p.x + (size_t)row * 1024;
      bf16_t* xo = p.xb + (size_t)row * 1024;
      float s = 0.f;
#pragma unroll
      for (int i = 0; i < 4; ++i) {
        const f32x4 v = *(const f32x4*)(xr + lane * 4 + 256 * i);
        s += v[0] * v[0] + v[1] * v[1] + v[2] * v[2] + v[3] * v[3];
        u32x2 w;
        w.x = cvt_pk_bf16(v[0], v[1]);
        w.y = cvt_pk_bf16(v[2], v[3]);
        *(u32x2*)(xo + lane * 4 + 256 * i) = w;
      }
#pragma unroll
      for (int o = 1; o < 64; o <<= 1) s += __shfl_xor(s, o);
      if (lane < 16) p.part_x[(size_t)row * 16 + lane] = (lane == 0) ? s : 0.f;
    }
    for (int i = blockIdx.x * 512 + tid; i < 65536 + 8192; i += gridDim.x * 512) {
      if (i < 65536) {
        const int pos = i >> 4, k = i & 15;
        const float ang = (float)pos * __builtin_amdgcn_exp2f(-(float)k * 0.8304820237218405f);
        float s, c;
        fast_sincos_rev(ang * 0.15915494309189535f, &s, &c);
        p.ropecs[i] = make_float2(c, s);
      } else {
        const int k = i - 65536;
        const int ms = 1 << (31 - __clz(k + 1));
        const int pp = k + 1 - ms;
        float s, c;
        fast_sincos_rev((float)pp / (float)(2 * ms), &s, &c);
        p.tw[k] = make_float2(c, -s);
      }
    }
  }
}

template <int LOGR, int MTOP, bool INV, bool ZIN = false, bool HOUT = false>
__device__ __forceinline__ void fft_pass(float2* sm, const float2* tw) {
  constexpr int R = 1 << LOGR;
  constexpr int q = MTOP >> (LOGR - 1);
  constexpr int ntask = 8192 / R;
  for (int T = threadIdx.x; T < ntask; T += NTHREADS) {
    const int i = T & (q - 1);
    const int blk = T / q;
    const int base = blk * (2 * MTOP) + i;
    float2 v[R];
#pragma unroll
    for (int e = 0; e < R; ++e) {
      if (ZIN && e >= R / 2) v[e] = make_float2(0.f, 0.f);
      else v[e] = sm[PADI(base + e * q)];
    }
    if (!INV) {
#pragma unroll
      for (int s = 0; s < LOGR; ++s) {
        constexpr int dummy = 0;
        (void)dummy;
        const int hs = 1 << (LOGR - 1 - s);
        const int ms = MTOP >> s;
#pragma unroll
        for (int e = 0; e < R; ++e) {
          if ((e & hs) == 0) {
            const int pp = i + (e & (hs - 1)) * q;
            const float2 w = tw[(ms - 1) + pp];
            const float2 a = v[e], b = v[e + hs];
            v[e] = make_float2(a.x + b.x, a.y + b.y);
            const float dx = a.x - b.x, dy = a.y - b.y;
            v[e + hs] = make_float2(dx * w.x - dy * w.y, dx * w.y + dy * w.x);
          }
        }
      }
    } else {
#pragma unroll
      for (int s = LOGR - 1; s >= 0; --s) {
        const int hs = 1 << (LOGR - 1 - s);
        const int ms = MTOP >> s;
#pragma unroll
        for (int e = 0; e < R; ++e) {
          if ((e & hs) == 0) {
            const int pp = i + (e & (hs - 1)) * q;
            const float2 w = tw[(ms - 1) + pp];
            const float2 a = v[e], b = v[e + hs];
            const float tx = b.x * w.x + b.y * w.y, ty = b.y * w.x - b.x * w.y;
            v[e] = make_float2(a.x + tx, a.y + ty);
            v[e + hs] = make_float2(a.x - tx, a.y - ty);
          }
        }
      }
    }
#pragma unroll
    for (int e = 0; e < R; ++e) {
      if (HOUT && e >= R / 2) continue;
      sm[PADI(base + e * q)] = v[e];
    }
  }
  __syncthreads();
}

__device__ __forceinline__ void fft_fwd(float2* sm, const float2* tw) {
  fft_pass<4, 4096, false>(sm, tw);
  fft_pass<4, 256, false>(sm, tw);
  fft_pass<4, 16, false>(sm, tw);
  fft_pass<1, 1, false>(sm, tw);
}
__device__ __forceinline__ void fft_inv(float2* sm, const float2* tw) {
  fft_pass<1, 1, true>(sm, tw);
  fft_pass<3, 8, true>(sm, tw);
  fft_pass<3, 64, true>(sm, tw);
  fft_pass<3, 512, true>(sm, tw);
  fft_pass<3, 4096, true>(sm, tw);
}

__device__ void filt_fft_phase(const P& p, int l, char* smem) {
  float2* sm = (float2*)smem;
  float2* tws = (float2*)(smem + TW_LDS_OFF);
  int tid_ = threadIdx.x;
  asm volatile("" : "+v"(tid_));
  const int tid = tid_;
  for (int i = tid; i < 8192; i += NTHREADS) tws[i] = p.tw[i];
  for (int jj = blockIdx.x; jj < 384; jj += gridDim.x) {
    const int o = jj / 192, c = jj % 192;
    const int jobF = o * 384 + c, jobG = jobF + 192;
    const float* hf1 = p.filtT + ((size_t)((o * 2 + 0) * 384 + c)) * 4096;
    const float* hb1 = p.filtT + ((size_t)((o * 2 + 1) * 384 + c)) * 4096;
    const float* hf2 = hf1 + (size_t)192 * 4096;
    const float* hb2 = hb1 + (size_t)192 * 4096;
    const float sk1 = p.skip[(l * 2 + o) * 384 + c], sk2 = p.skip[(l * 2 + o) * 384 + c + 192];
    __syncthreads();
    for (int n = tid; n < 8192; n += NTHREADS) {
      float v1, v2;
      if (n == 0) { v1 = hf1[0] + hb1[0] + sk1; v2 = hf2[0] + hb2[0] + sk2; }
      else if (n < 4096) { v1 = hf1[n]; v2 = hf2[n]; }
      else if (n == 4096) { v1 = 0.f; v2 = 0.f; }
      else { v1 = hb1[8192 - n]; v2 = hb2[8192 - n]; }
      sm[PADI(n)] = make_float2(v1, v2);
    }
    __syncthreads();
    fft_fwd(sm, tws);
    float2* dF = p.H2 + (size_t)jobF * 8192;
    float2* dG = p.H2 + (size_t)jobG * 8192;
    const float sc = 0.5f / 8192.0f;
    for (int n = tid; n < 8192; n += NTHREADS) {
      const int k = (int)(__brev((unsigned)n) >> 19);
      const int np = (int)(__brev((unsigned)((8192 - k) & 8191)) >> 19);
      const float2 a = sm[PADI(n)], b = sm[PADI(np)];
      dF[n] = make_float2((a.x + b.x) * sc, (a.y - b.y) * sc);
      dG[n] = make_float2((a.y + b.y) * sc, (b.x - a.x) * sc);
    }
  }
}

__device__ __forceinline__ float short_conv(const bf16_t* row, int t, float w0, float w1, float w2, float bias) {
  const float xm = (t > 0) ? bf2f(row[t - 1]) : 0.f;
  const float x0 = bf2f(row[t]);
  const float xp = (t < SEQ - 1) ? bf2f(row[t + 1]) : 0.f;
  return w0 * xm + w1 * x0 + w2 * xp + bias;
}

__device__ __forceinline__ void conv8(const bf16_t* row, int t0, float w0, float w1, float w2, float bias, float (&out)[8]) {
  const u32x4 v = *(const u32x4*)(row + t0);
  float x[10];
  x[0] = (t0 > 0) ? bf2f(row[t0 - 1]) : 0.f;
  x[1] = bflo(v.x); x[2] = bfhi(v.x); x[3] = bflo(v.y); x[4] = bfhi(v.y);
  x[5] = bflo(v.z); x[6] = bfhi(v.z); x[7] = bflo(v.w); x[8] = bfhi(v.w);
  x[9] = (t0 + 8 < SEQ) ? bf2f(row[t0 + 8]) : 0.f;
#pragma unroll
  for (int k = 0; k < 8; ++k) out[k] = w0 * x[k] + w1 * x[k + 1] + w2 * x[k + 2] + bias;
}

struct RawRow { u32x4 v; float lo, hi; };
__device__ __forceinline__ RawRow load_raw(const bf16_t* row, int t0) {
  RawRow r;
  r.v = *(const u32x4*)(row + t0);
  r.lo = (t0 > 0) ? bf2f(row[t0 - 1]) : 0.f;
  r.hi = (t0 + 8 < SEQ) ? bf2f(row[t0 + 8]) : 0.f;
  return r;
}
__device__ __forceinline__ void conv8_raw(const RawRow& r, float w0, float w1, float w2, float bias, float (&out)[8]) {
  float x[10];
  x[0] = r.lo;
  x[1] = bflo(r.v.x); x[2] = bfhi(r.v.x); x[3] = bflo(r.v.y); x[4] = bfhi(r.v.y);
  x[5] = bflo(r.v.z); x[6] = bfhi(r.v.z); x[7] = bflo(r.v.w); x[8] = bfhi(r.v.w);
  x[9] = r.hi;
#pragma unroll
  for (int k = 0; k < 8; ++k) out[k] = w0 * x[k] + w1 * x[k + 1] + w2 * x[k + 2] + bias;
}

__device__ __forceinline__ void fft_mid(float2* sm, const f32x4 (&hpre)[8]) {
#pragma unroll
  for (int it = 0; it < 8; ++it) {
    const int T = threadIdx.x + it * NTHREADS;
    const float2 a = sm[PADI(2 * T)], b = sm[PADI(2 * T + 1)];
    const f32x4 h = hpre[it];
    const float sx = a.x + b.x, sy = a.y + b.y, dx = a.x - b.x, dy = a.y - b.y;
    const float Ax = sx * h[0] - sy * h[1], Ay = sx * h[1] + sy * h[0];
    const float Bx = dx * h[2] - dy * h[3], By = dx * h[3] + dy * h[2];
    sm[PADI(2 * T)] = make_float2(Ax + Bx, Ay + By);
    sm[PADI(2 * T + 1)] = make_float2(Ax - Bx, Ay - By);
  }
  __syncthreads();
}

template <int ORD>
__device__ void hyena_phase(const P& p, int l, char* smem) {
  float2* sm = (float2*)smem;
  float2* tws = (float2*)(smem + TW_LDS_OFF);
  int tid_ = threadIdx.x;
  asm volatile("" : "+v"(tid_));
  const int tid = tid_;
  for (int i = tid; i < 8192; i += NTHREADS) tws[i] = p.tw[i];
  const float* cw = p.conv_w + (size_t)l * 3 * 1152;
  const float* cb = p.conv_b + (size_t)l * 1152;
  const int t0 = tid * 8;
  for (int job = vblock(); job < 1536; job += gridDim.x) {
    const int pair = job & 3, c = job >> 2;
    const int b1 = pair * 2, b2 = b1 + 1;
    const int gc = (ORD == 0 ? 384 : 768) + c;
    const RawRow gr1 = load_raw(p.hyT + ((size_t)(b1 * 1152 + gc)) * 4096, t0);
    const RawRow gr2 = load_raw(p.hyT + ((size_t)(b2 * 1152 + gc)) * 4096, t0);
    __syncthreads();
    {
      float u1[8], u2[8];
      if (ORD == 0) {
        const bf16_t* r1 = p.hyT + ((size_t)(b1 * 1152 + c)) * 4096;
        const bf16_t* r2 = p.hyT + ((size_t)(b2 * 1152 + c)) * 4096;
        const float w0 = cw[c], w1 = cw[1152 + c], w2 = cw[2304 + c], bi = cb[c];
        conv8(r1, t0, w0, w1, w2, bi, u1);
        conv8(r2, t0, w0, w1, w2, bi, u2);
      } else {
        const u32x4 a0 = *(const u32x4*)(p.z1T + ((size_t)(b1 * 384 + c)) * 4096 + t0);
        const u32x4 c0_ = *(const u32x4*)(p.z1T + ((size_t)(b2 * 384 + c)) * 4096 + t0);
        u1[0] = bflo(a0.x); u1[1] = bfhi(a0.x); u1[2] = bflo(a0.y); u1[3] = bfhi(a0.y); u1[4] = bflo(a0.z); u1[5] = bfhi(a0.z); u1[6] = bflo(a0.w); u1[7] = bfhi(a0.w);
        u2[0] = bflo(c0_.x); u2[1] = bfhi(c0_.x); u2[2] = bflo(c0_.y); u2[3] = bfhi(c0_.y); u2[4] = bflo(c0_.z); u2[5] = bfhi(c0_.z); u2[6] = bflo(c0_.w); u2[7] = bfhi(c0_.w);
      }
#pragma unroll
      for (int k = 0; k < 8; ++k) {
        sm[PADI(t0 + k)] = make_float2(u1[k], u2[k]);
      }
    }
    __syncthreads();
    fft_pass<4, 4096, false, true, false>(sm, tws);
    fft_pass<4, 256, false>(sm, tws);
    f32x4 hpre[8];
    {
      const float2* H = p.H2 + ((size_t)(ORD * 384 + c)) * 8192;
#pragma unroll
      for (int it = 0; it < 8; ++it) hpre[it] = *(const f32x4*)(H + 2 * (tid + it * NTHREADS));
    }
    fft_pass<4, 16, false>(sm, tws);
    fft_mid(sm, hpre);
    fft_pass<4, 16, true>(sm, tws);
    fft_pass<4, 256, true>(sm, tws);
    fft_pass<4, 4096, true, false, true>(sm, tws);
    {
      const float w0 = cw[gc], w1 = cw[1152 + gc], w2 = cw[2304 + gc], bi = cb[gc];
      float q1[8], q2[8];
      conv8_raw(gr1, w0, w1, w2, bi, q1);
      conv8_raw(gr2, w0, w1, w2, bi, q2);
#pragma unroll
      for (int k = 0; k < 8; ++k) {
        const float2 yv = sm[PADI(t0 + k)];
        q1[k] *= yv.x;
        q2[k] *= yv.y;
      }
      {
        bf16_t* dbase = (ORD == 0) ? p.z1T : p.ybT;
        u32x4 w1_, w2_;
        w1_.x = cvt_pk_bf16(q1[0], q1[1]); w1_.y = cvt_pk_bf16(q1[2], q1[3]); w1_.z = cvt_pk_bf16(q1[4], q1[5]); w1_.w = cvt_pk_bf16(q1[6], q1[7]);
        w2_.x = cvt_pk_bf16(q2[0], q2[1]); w2_.y = cvt_pk_bf16(q2[2], q2[3]); w2_.z = cvt_pk_bf16(q2[4], q2[5]); w2_.w = cvt_pk_bf16(q2[6], q2[7]);
        *(u32x4*)(dbase + ((size_t)(b1 * 384 + c)) * 4096 + t0) = w1_;
        *(u32x4*)(dbase + ((size_t)(b2 * 384 + c)) * 4096 + t0) = w2_;
      }
    }
  }
}

constexpr int KROW = 208;
constexpr int VROW = 136;
constexpr int KBUF = 64 * KROW, VBUF = 64 * VROW;

constexpr int NK_ROW = 528;
constexpr int NK_BUF = 32 * NK_ROW;
constexpr int NV_ROW = 72;
constexpr int NV_BUF = 256 * NV_ROW;
constexpr int NRPB_OFF = 2 * NK_BUF + 2 * NV_BUF;

__device__ void natten_phase(const P& p, int l, char* smem) {
  int tid_ = threadIdx.x;
  asm volatile("" : "+v"(tid_));
  const int tid = tid_, lane = tid & 63, wave = tid >> 6, l15 = lane & 15, g = lane >> 4;
  const int hw = wave >> 1, qh = wave & 1;
  char* Ks = smem;
  char* Vs = smem + 2 * NK_BUF;
  float* rp = (float*)(smem + NRPB_OFF);
  __syncthreads();
  for (int i = tid; i < 4 * 15 * 31; i += NTHREADS) rp[i] = p.rpb[(size_t)l * 4 * 15 * 31 + i] * 1.4426950408889634f;
  const float qscale = 0.125f * 1.4426950408889634f;
  for (int job = blockIdx.x; job < 512; job += gridDim.x) {
    const int r = job & 63, b = job >> 6;
    const int r0 = min(max(r - 4, 0), 56);
    bf16x8 qf[2][2];
    int cq[2], c0[2];
#pragma unroll
    for (int nt = 0; nt < 2; ++nt) {
      cq[nt] = qh * 32 + nt * 16 + l15;
      c0[nt] = min(max(cq[nt] - 8, 0), 48);
      const bf16_t* qp = p.na + (size_t)(b * 4096 + r * 64 + cq[nt]) * 768 + hw * 64;
#pragma unroll
      for (int ks = 0; ks < 2; ++ks) qf[nt][ks] = *(const bf16x8*)(qp + ks * 32 + g * 8);
    }
    f32x4 o[4][2];
#pragma unroll
    for (int a = 0; a < 4; ++a)
#pragma unroll
      for (int n = 0; n < 2; ++n) o[a][n] = (f32x4){0.f, 0.f, 0.f, 0.f};
    float mrow[2] = {-1e30f, -1e30f}, lrow[2] = {0.f, 0.f};
    u32x4 rk[2], rv[2];
    auto gload = [&](int t) {
      const int kr = r0 + (t >> 1), kh = (t & 1) * 32;
      const bf16_t* kbase = p.na + (size_t)(b * 4096 + kr * 64 + kh) * 768 + 256;
#pragma unroll
      for (int i = 0; i < 2; ++i) {
        const int c = tid + 512 * i, key = c >> 5, cc = c & 31;
        rk[i] = *(const u32x4*)(kbase + (size_t)key * 768 + cc * 8);
      }
#pragma unroll
      for (int i = 0; i < 2; ++i) {
        const int c = tid + 512 * i, row = c >> 2, cc = c & 3;
        rv[i] = *(const u32x4*)(p.naVT + ((size_t)(b * 256 + row)) * 4096 + kr * 64 + kh + cc * 8);
      }
    };
    auto lstore = [&](int buf) {
      char* kb_ = Ks + buf * NK_BUF;
      char* vb_ = Vs + buf * NV_BUF;
#pragma unroll
      for (int i = 0; i < 2; ++i) {
        const int c = tid + 512 * i, key = c >> 5, cc = c & 31;
        *(u32x4*)(kb_ + key * NK_ROW + cc * 16) = rk[i];
      }
#pragma unroll
      for (int i = 0; i < 2; ++i) {
        const int c = tid + 512 * i, row = c >> 2, cc = c & 3;
        u32x2 lo, hi;
        lo.x = rv[i].x; lo.y = rv[i].y; hi.x = rv[i].z; hi.y = rv[i].w;
        *(u32x2*)(vb_ + row * NV_ROW + cc * 16) = lo;
        *(u32x2*)(vb_ + row * NV_ROW + cc * 16 + 8) = hi;
      }
    };
    gload(0);
    __syncthreads();
    lstore(0);
    __syncthreads();
    for (int t = 0; t < 16; ++t) {
      if (t + 1 < 16) gload(t + 1);
      __builtin_amdgcn_sched_barrier(0);
      const char* kb_ = Ks + (t & 1) * NK_BUF;
      const char* vb_ = Vs + (t & 1) * NV_BUF + hw * 64 * NV_ROW;
      const int kh = (t & 1) * 32;
      f32x4 s[2][2];
#pragma unroll
      for (int a = 0; a < 2; ++a)
#pragma unroll
        for (int n = 0; n < 2; ++n) s[a][n] = (f32x4){0.f, 0.f, 0.f, 0.f};
#pragma unroll
      for (int mt = 0; mt < 2; ++mt)
#pragma unroll
        for (int ks = 0; ks < 2; ++ks) {
          const bf16x8 kf = *(const bf16x8*)(kb_ + (mt * 16 + l15) * NK_ROW + hw * 128 + ks * 64 + g * 16);
#pragma unroll
          for (int nt = 0; nt < 2; ++nt)
            s[mt][nt] = __builtin_amdgcn_mfma_f32_16x16x32_bf16(kf, qf[nt][ks], s[mt][nt], 0, 0, 0);
        }
      const float* brow = rp + (hw * 15 + (r0 + (t >> 1) - r + 7)) * 31;
      bf16x8 pf[2];
#pragma unroll
      for (int nt = 0; nt < 2; ++nt) {
        float mx = -1e30f;
#pragma unroll
        for (int mt = 0; mt < 2; ++mt)
#pragma unroll
          for (int j = 0; j < 4; ++j) {
            const int kc = kh + mt * 16 + g * 4 + j;
            const bool valid = (unsigned)(kc - c0[nt]) < 16u;
            const int dc = min(max(kc - cq[nt] + 15, 0), 30);
            const float sc = valid ? (s[mt][nt][j] * qscale + brow[dc]) : -1e30f;
            s[mt][nt][j] = sc;
            mx = fmaxf(mx, sc);
          }
        mx = fmaxf(mx, __shfl_xor(mx, 16));
        mx = fmaxf(mx, __shfl_xor(mx, 32));
        const float mnew = fmaxf(mrow[nt], mx);
        const float alpha = __builtin_amdgcn_exp2f(mrow[nt] - mnew);
        mrow[nt] = mnew;
        float ls = 0.f;
#pragma unroll
        for (int mt = 0; mt < 2; ++mt)
#pragma unroll
          for (int j = 0; j < 4; ++j) {
            const float e = (s[mt][nt][j] > -1e29f) ? __builtin_amdgcn_exp2f(s[mt][nt][j] - mnew) : 0.f;
            s[mt][nt][j] = e;
            ls += e;
          }
        lrow[nt] = lrow[nt] * alpha + ls;
#pragma unroll
        for (int a = 0; a < 4; ++a) o[a][nt] *= alpha;
        u32x4 w;
        w.x = cvt_pk_bf16(s[0][nt][0], s[0][nt][1]);
        w.y = cvt_pk_bf16(s[0][nt][2], s[0][nt][3]);
        w.z = cvt_pk_bf16(s[1][nt][0], s[1][nt][1]);
        w.w = cvt_pk_bf16(s[1][nt][2], s[1][nt][3]);
        pf[nt] = __builtin_bit_cast(bf16x8, w);
      }
#pragma unroll
      for (int mt = 0; mt < 4; ++mt) {
        const u32x2 lo = *(const u32x2*)(vb_ + (mt * 16 + l15) * NV_ROW + (4 * g) * 2);
        const u32x2 hi = *(const u32x2*)(vb_ + (mt * 16 + l15) * NV_ROW + (16 + 4 * g) * 2);
        u32x4 w;
        w.x = lo.x; w.y = lo.y; w.z = hi.x; w.w = hi.y;
        const bf16x8 vf = __builtin_bit_cast(bf16x8, w);
#pragma unroll
        for (int nt = 0; nt < 2; ++nt)
          o[mt][nt] = __builtin_amdgcn_mfma_f32_16x16x32_bf16(vf, pf[nt], o[mt][nt], 0, 0, 0);
      }
      if (t + 1 < 16) lstore((t + 1) & 1);
      __syncthreads();
    }
#pragma unroll
    for (int nt = 0; nt < 2; ++nt) {
      float lt = lrow[nt];
      lt += __shfl_xor(lt, 16);
      lt += __shfl_xor(lt, 32);
      const float inv = 1.0f / lt;
      const int tok = b * 4096 + r * 64 + cq[nt];
#pragma unroll
      for (int mt = 0; mt < 4; ++mt) {
        u32x2 w;
        w.x = cvt_pk_bf16(o[mt][nt][0] * inv, o[mt][nt][1] * inv);
        w.y = cvt_pk_bf16(o[mt][nt][2] * inv, o[mt][nt][3] * inv);
        *(u32x2*)(p.o_c + (size_t)tok * 256 + hw * 64 + mt * 16 + g * 4) = w;
      }
    }
  }
}


__device__ void attn_phase(const P& p, char* smem) {
  int tid_ = threadIdx.x;
  asm volatile("" : "+v"(tid_));
  const int tid = tid_, lane = tid & 63, wave = tid >> 6, l15 = lane & 15, g = lane >> 4;
  char* Ks = smem;
  char* Vs = smem + 2 * KBUF;
  for (int job = vblock(); job < 768; job += gridDim.x) {
    const int qblk = job & 15, bh = job >> 4;
    const int b = bh / 6, h = bh % 6;
    const bf16_t* Q = p.qb + (size_t)bh * 4096 * 96;
    const bf16_t* Kg = p.kb + (size_t)bh * 4096 * 96;
    const bf16_t* Vt = p.vT + (size_t)bh * 64 * 4096;
    const int q0 = qblk * 256 + wave * 32;
    bf16x8 qf[2][3];
#pragma unroll
    for (int nt = 0; nt < 2; ++nt)
#pragma unroll
      for (int ks = 0; ks < 3; ++ks)
        qf[nt][ks] = *(const bf16x8*)(Q + (size_t)(q0 + nt * 16 + l15) * 96 + ks * 32 + g * 8);
    f32x4 o[4][2];
#pragma unroll
    for (int a = 0; a < 4; ++a)
#pragma unroll
      for (int n = 0; n < 2; ++n) o[a][n] = (f32x4){0.f, 0.f, 0.f, 0.f};
    float mrow[2] = {-1e30f, -1e30f}, lrow[2] = {0.f, 0.f};

    u32x4 rk[2];
    u32x4 rv;
    const int kr1 = (tid + 512) / 12, kc1 = (tid + 512) - kr1 * 12;
    const int kr0 = tid / 12, kc0 = tid - kr0 * 12;
    auto gload = [&](int kt) {
      const u32x4* kp = (const u32x4*)(Kg + (size_t)kt * 64 * 96);
      rk[0] = kp[tid];
      if (tid < 256) rk[1] = kp[tid + 512];
      rv = *(const u32x4*)(Vt + (size_t)(tid >> 3) * 4096 + kt * 64 + (tid & 7) * 8);
    };
    auto lstore = [&](int buf) {
      char* kb_ = Ks + buf * KBUF;
      char* vb_ = Vs + buf * VBUF;
      *(u32x4*)(kb_ + kr0 * KROW + kc0 * 16) = rk[0];
      if (tid < 256) *(u32x4*)(kb_ + kr1 * KROW + kc1 * 16) = rk[1];
      u32x2 lo, hi;
      lo.x = rv.x; lo.y = rv.y; hi.x = rv.z; hi.y = rv.w;
      *(u32x2*)(vb_ + (tid >> 3) * VROW + (tid & 7) * 16) = lo;
      *(u32x2*)(vb_ + (tid >> 3) * VROW + (tid & 7) * 16 + 8) = hi;
    };
    const int NKT = 64;
    gload(0);
    __syncthreads();
    lstore(0);
    __syncthreads();
    for (int kt = 0; kt < NKT; ++kt) {
      if (kt + 1 < NKT) gload(kt + 1);
      __builtin_amdgcn_sched_barrier(0);
      const char* kb_ = Ks + (kt & 1) * KBUF;
      const char* vb_ = Vs + (kt & 1) * VBUF;
      f32x4 s[4][2];
#pragma unroll
      for (int a = 0; a < 4; ++a)
#pragma unroll
        for (int n = 0; n < 2; ++n) s[a][n] = (f32x4){0.f, 0.f, 0.f, 0.f};
#pragma unroll
      for (int mt = 0; mt < 4; ++mt)
#pragma unroll
        for (int ks = 0; ks < 3; ++ks) {
          const bf16x8 kf = *(const bf16x8*)(kb_ + (mt * 16 + l15) * KROW + (ks * 32 + g * 8) * 2);
#pragma unroll
          for (int nt = 0; nt < 2; ++nt)
            s[mt][nt] = __builtin_amdgcn_mfma_f32_16x16x32_bf16(kf, qf[nt][ks], s[mt][nt], 0, 0, 0);
        }
      bf16x8 pf[2][2];
#pragma unroll
      for (int nt = 0; nt < 2; ++nt) {
        float mx = s[0][nt][0];
#pragma unroll
        for (int mt = 0; mt < 4; ++mt)
#pragma unroll
          for (int j = 0; j < 4; ++j) mx = fmaxf(mx, s[mt][nt][j]);
        mx = fmaxf(mx, __shfl_xor(mx, 16));
        mx = fmaxf(mx, __shfl_xor(mx, 32));
        if (__any(mx > mrow[nt] + 8.0f)) {
          const float mnew = fmaxf(mrow[nt], mx);
          const float alpha = __builtin_amdgcn_exp2f(mrow[nt] - mnew);
          mrow[nt] = mnew;
          lrow[nt] *= alpha;
#pragma unroll
          for (int a = 0; a < 4; ++a) o[a][nt] *= alpha;
        }
        const float mref = mrow[nt];
        float ls = 0.f;
#pragma unroll
        for (int mt = 0; mt < 4; ++mt)
#pragma unroll
          for (int j = 0; j < 4; ++j) {
            const float e = __builtin_amdgcn_exp2f(s[mt][nt][j] - mref);
            s[mt][nt][j] = e;
            ls += e;
          }
        lrow[nt] += ls;
#pragma unroll
        for (int kk = 0; kk < 2; ++kk) {
          u32x4 w;
          w.x = cvt_pk_bf16(s[2 * kk][nt][0], s[2 * kk][nt][1]);
          w.y = cvt_pk_bf16(s[2 * kk][nt][2], s[2 * kk][nt][3]);
          w.z = cvt_pk_bf16(s[2 * kk + 1][nt][0], s[2 * kk + 1][nt][1]);
          w.w = cvt_pk_bf16(s[2 * kk + 1][nt][2], s[2 * kk + 1][nt][3]);
          pf[kk][nt] = __builtin_bit_cast(bf16x8, w);
        }
      }
#pragma unroll
      for (int kk = 0; kk < 2; ++kk)
#pragma unroll
        for (int mt = 0; mt < 4; ++mt) {
          const u32x2 lo = *(const u32x2*)(vb_ + (mt * 16 + l15) * VROW + (32 * kk + 4 * g) * 2);
          const u32x2 hi = *(const u32x2*)(vb_ + (mt * 16 + l15) * VROW + (32 * kk + 16 + 4 * g) * 2);
          u32x4 w;
          w.x = lo.x; w.y = lo.y; w.z = hi.x; w.w = hi.y;
          const bf16x8 vf = __builtin_bit_cast(bf16x8, w);
#pragma unroll
          for (int nt = 0; nt < 2; ++nt)
            o[mt][nt] = __builtin_amdgcn_mfma_f32_16x16x32_bf16(vf, pf[kk][nt], o[mt][nt], 0, 0, 0);
        }
      if (kt + 1 < NKT) lstore((kt + 1) & 1);
      __syncthreads();
    }
#pragma unroll
    for (int nt = 0; nt < 2; ++nt) {
      float lt = lrow[nt];
      lt += __shfl_xor(lt, 16);
      lt += __shfl_xor(lt, 32);
      const float inv = 1.0f / lt;
      const int tok = b * 4096 + q0 + nt * 16 + l15;
#pragma unroll
      for (int mt = 0; mt < 4; ++mt) {
        u32x2 w;
        w.x = cvt_pk_bf16(o[mt][nt][0] * inv, o[mt][nt][1] * inv);
        w.y = cvt_pk_bf16(o[mt][nt][2] * inv, o[mt][nt][3] * inv);
        *(u32x2*)(p.o_a + (size_t)tok * 384 + h * 64 + mt * 16 + g * 4) = w;
      }
    }
  }
}

__device__ void mixnorm_phase(const P& p, char* smem) {
  int tid_ = threadIdx.x;
  asm volatile("" : "+v"(tid_));
  const int tid = tid_;
  for (int job = blockIdx.x; job < NTOK / 32; job += gridDim.x) {
    const int tok0 = job * 32, b = tok0 >> 12, s0 = tok0 & 4095;
    __syncthreads();
#pragma unroll
    for (int i = 0; i < 3; ++i) {
      const int c = tid + 512 * i, row = c / 48, cc = c % 48;
      *(u32x4*)(smem + row * 2048 + cc * 16) = *(const u32x4*)(p.o_a + (size_t)(tok0 + row) * 384 + cc * 8);
    }
#pragma unroll
    for (int i = 0; i < 2; ++i) {
      const int c = tid + 512 * i, row = c >> 5, cc = c & 31;
      *(u32x4*)(smem + row * 2048 + 1536 + cc * 16) = *(const u32x4*)(p.o_c + (size_t)(tok0 + row) * 256 + cc * 8);
    }
#pragma unroll
    for (int i = 0; i < 3; ++i) {
      const int c = tid + 512 * i, ch = c >> 2, tc = c & 3;
      const u32x4 v = *(const u32x4*)(p.ybT + ((size_t)(b * 384 + ch)) * 4096 + s0 + tc * 8);
      bf16_t* dst = (bf16_t*)smem + (size_t)(tc * 8) * 1024 + 384 + ch;
      dst[0 * 1024] = (bf16_t)(v.x & 0xffff); dst[1 * 1024] = (bf16_t)(v.x >> 16);
      dst[2 * 1024] = (bf16_t)(v.y & 0xffff); dst[3 * 1024] = (bf16_t)(v.y >> 16);
      dst[4 * 1024] = (bf16_t)(v.z & 0xffff); dst[5 * 1024] = (bf16_t)(v.z >> 16);
      dst[6 * 1024] = (bf16_t)(v.w & 0xffff); dst[7 * 1024] = (bf16_t)(v.w >> 16);
    }
    __syncthreads();
    const int tok = tid >> 4, sub = tid & 15;
    float ss[3] = {0.f, 0.f, 0.f};
#pragma unroll
    for (int gi = 0; gi < 3; ++gi) {
      const int i0 = (gi == 0) ? 0 : (gi == 1 ? 3 : 6), i1 = (gi == 0) ? 3 : (gi == 1 ? 6 : 8);
      float acc = 0.f;
#pragma unroll 2
      for (int i = i0; i < i1; ++i) {
        const u32x4 v = *(const u32x4*)(smem + tok * 2048 + (sub + 16 * i) * 16);
        float a;
        a = bflo(v.x); acc += a * a; a = bfhi(v.x); acc += a * a;
        a = bflo(v.y); acc += a * a; a = bfhi(v.y); acc += a * a;
        a = bflo(v.z); acc += a * a; a = bfhi(v.z); acc += a * a;
        a = bflo(v.w); acc += a * a; a = bfhi(v.w); acc += a * a;
      }
      acc += __shfl_xor(acc, 1);
      acc += __shfl_xor(acc, 2);
      acc += __shfl_xor(acc, 4);
      acc += __shfl_xor(acc, 8);
      ss[gi] = acc;
    }
    float rs[3];
    rs[0] = rsqrtf(ss[0] * (1.0f / 384.0f) + 1e-6f);
    rs[1] = rsqrtf(ss[1] * (1.0f / 384.0f) + 1e-6f);
    rs[2] = rsqrtf(ss[2] * (1.0f / 256.0f) + 1e-6f);
#pragma unroll
    for (int gi = 0; gi < 3; ++gi) {
      const int i0 = (gi == 0) ? 0 : (gi == 1 ? 3 : 6), i1 = (gi == 0) ? 3 : (gi == 1 ? 6 : 8);
      const float r = rs[gi];
#pragma unroll 2
      for (int i = i0; i < i1; ++i) {
        const u32x4 v = *(const u32x4*)(smem + tok * 2048 + (sub + 16 * i) * 16);
        u32x4 w;
        w.x = cvt_pk_bf16(bflo(v.x) * r, bfhi(v.x) * r);
        w.y = cvt_pk_bf16(bflo(v.y) * r, bfhi(v.y) * r);
        w.z = cvt_pk_bf16(bflo(v.z) * r, bfhi(v.z) * r);
        w.w = cvt_pk_bf16(bflo(v.w) * r, bfhi(v.w) * r);
        *(u32x4*)(p.y + (size_t)(tok0 + tok) * 1024 + (sub + 16 * i) * 8) = w;
      }
    }
  }
}

enum { EPI_INPROJ = 0, EPI_QUP = 1, EPI_KVUP = 2, EPI_OUTPROJ = 3, EPI_SWIGLU = 4, EPI_DOWN = 5 };

template <int EPI>
__device__ void gemm_phase(const P& p, int l, const bf16_t* __restrict__ A, int lda, const bf16_t* __restrict__ Bt,
                           int K, int nN, char* smem) {
  int tid_ = threadIdx.x;
  asm volatile("" : "+v"(tid_));
  const int tid = tid_, lane = tid & 63, wave = tid >> 6, wm = wave >> 2, wn = wave & 3, l15 = lane & 15,
            g = lane >> 4;
  const int ntiles = 128 * nN;
  const int srow = tid >> 3, skc = tid & 7;
  const int sw_off = srow * 128 + ((skc ^ ((srow >> 1) & 7)) * 16);
  const int rsw = (l15 >> 1) & 7;
  for (int tile = vblock(); tile < ntiles; tile += gridDim.x) {
    const int gsz_ = 4 * nN, grp_ = tile / gsz_, w_ = tile - grp_ * gsz_;
    const int ni = w_ >> 2, mi = grp_ * 4 + (w_ & 3);
    const int m0 = mi * 256, n0 = ni * 256;
    f32x4 acc[8][4];
#pragma unroll
    for (int a = 0; a < 8; ++a)
#pragma unroll
      for (int b = 0; b < 4; ++b) acc[a][b] = (f32x4){0.f, 0.f, 0.f, 0.f};
    const bf16_t* Ag = A + (size_t)(m0 + srow) * lda + skc * 8;
    const bf16_t* Bg = Bt + (size_t)(n0 + srow) * K + skc * 8;
    u32x4 ra[4], rb[4];
    auto gl = [&](int kt) {
#pragma unroll
      for (int i = 0; i < 4; ++i) ra[i] = *(const u32x4*)(Ag + (size_t)i * 64 * lda + kt * 64);
#pragma unroll
      for (int i = 0; i < 4; ++i) rb[i] = *(const u32x4*)(Bg + (size_t)i * 64 * K + kt * 64);
    };
    auto st = [&](int buf) {
      char* nb = smem + buf * 65536;
#pragma unroll
      for (int i = 0; i < 4; ++i) *(u32x4*)(nb + sw_off + i * 8192) = ra[i];
#pragma unroll
      for (int i = 0; i < 4; ++i) *(u32x4*)(nb + 32768 + sw_off + i * 8192) = rb[i];
    };
    const int nk = K / 64;
    gl(0);
    __syncthreads();
    st(0);
    __syncthreads();
    for (int kt = 0; kt < nk; ++kt) {
      if (kt + 1 < nk) gl(kt + 1);
      __builtin_amdgcn_sched_barrier(0);
      const char* Ab = smem + (kt & 1) * 65536;
      const char* Bb = Ab + 32768;
#pragma unroll
      for (int ks = 0; ks < 2; ++ks) {
        bf16x8 bfr[4];
#pragma unroll
        for (int nt = 0; nt < 4; ++nt)
          bfr[nt] = *(const bf16x8*)(Bb + (wn * 64 + nt * 16 + l15) * 128 + (((ks * 4 + g) ^ rsw) * 16));
        bf16x8 af[2][2];
#pragma unroll
        for (int mt = 0; mt < 2; ++mt)
          af[0][mt] = *(const bf16x8*)(Ab + (wm * 128 + mt * 16 + l15) * 128 + (((ks * 4 + g) ^ rsw) * 16));
#pragma unroll
        for (int mh = 0; mh < 4; ++mh) {
          if (mh < 3) {
#pragma unroll
            for (int mt = 0; mt < 2; ++mt)
              af[(mh + 1) & 1][mt] = *(const bf16x8*)(Ab + (wm * 128 + ((mh + 1) * 2 + mt) * 16 + l15) * 128 + (((ks * 4 + g) ^ rsw) * 16));
          }
          __builtin_amdgcn_sched_barrier(0);
#pragma unroll
          for (int mt = 0; mt < 2; ++mt)
#pragma unroll
            for (int nt = 0; nt < 4; ++nt)
              acc[mh * 2 + mt][nt] = __builtin_amdgcn_mfma_f32_16x16x32_bf16(bfr[nt], af[mh & 1][mt], acc[mh * 2 + mt][nt], 0, 0, 0);
          __builtin_amdgcn_sched_barrier(0);
        }
      }
      if (kt + 1 < nk) st((kt + 1) & 1);
      __syncthreads();
    }
    int opq_ = 0;
    asm volatile("" : "+v"(opq_));
    const int rbase = m0 + wm * 128 + l15 + opq_;
    const int cbase = n0 + wn * 64 + g * 4 + opq_;
    if (EPI == EPI_INPROJ) {
      const int wc0 = n0 + wn * 64;
#pragma unroll
      for (int mt = 0; mt < 8; ++mt) {
        __builtin_amdgcn_sched_barrier(0);
        const int row = rbase + mt * 16;
        const f32x4* pp = (const f32x4*)(p.part_x + (size_t)row * 16);
        const f32x4 a0 = pp[0], a1 = pp[1], a2 = pp[2], a3 = pp[3];
        const float tot = (a0[0] + a0[1] + a0[2] + a0[3]) + (a1[0] + a1[1] + a1[2] + a1[3]) +
                          (a2[0] + a2[1] + a2[2] + a2[3]) + (a3[0] + a3[1] + a3[2] + a3[3]);
        const float rs = rsqrtf(tot * (1.0f / 1024.0f) + 1e-6f);
        const int bb = row >> 12, ss = row & 4095;
        float sq = 0.f;
#pragma unroll
        for (int nt = 0; nt < 4; ++nt) {
          const int ct = wc0 + nt * 16;
          const int col = cbase + nt * 16;
          f32x4 v = acc[mt][nt] * rs;
          if (ct < 384) {
            sq += v[0] * v[0] + v[1] * v[1] + v[2] * v[2] + v[3] * v[3];
            u32x2 w;
            w.x = cvt_pk_bf16(v[0], v[1]);
            w.y = cvt_pk_bf16(v[2], v[3]);
            *(u32x2*)(p.projA + (size_t)row * 416 + col) = w;
          } else if (ct == 384) {
            if (nt < 3) {
              const f32x4 v2 = acc[mt][(nt + 1) & 3] * rs;
              const int i0 = col - 384;
              const float2* cs = p.ropecs + ss * 16 + i0;
              float o1[4], o2[4];
#pragma unroll
              for (int j = 0; j < 4; ++j) {
                const float2 c_s = cs[j];
                o1[j] = v[j] * c_s.x - v2[j] * c_s.y;
                o2[j] = v[j] * c_s.y + v2[j] * c_s.x;
              }
              u32x2 w;
              w.x = cvt_pk_bf16(o1[0], o1[1]);
              w.y = cvt_pk_bf16(o1[2], o1[3]);
              *(u32x2*)(p.projA + (size_t)row * 416 + 384 + i0) = w;
              w.x = cvt_pk_bf16(o2[0], o2[1]);
              w.y = cvt_pk_bf16(o2[2], o2[3]);
              *(u32x2*)(p.projA + (size_t)row * 416 + 400 + i0) = w;
            }
          } else if (ct == 400) {
          } else if (ct < 1568) {
            const int hc = col - 416;
            bf16_t* dst = p.hyT + ((size_t)(bb * 1152 + hc)) * 4096 + ss;
            dst[0] = f2bf(v[0]);
            dst[4096] = f2bf(v[1]);
            dst[2 * 4096] = f2bf(v[2]);
            dst[3 * 4096] = f2bf(v[3]);
          } else if (ct < 2080) {
            u32x2 w;
            w.x = cvt_pk_bf16(v[0], v[1]);
            w.y = cvt_pk_bf16(v[2], v[3]);
            *(u32x2*)(p.na + (size_t)row * 768 + (col - 1568)) = w;
          } else if (ct < 2336) {
            const int vc = col - 2080;
            bf16_t* dst = p.naVT + ((size_t)(bb * 256 + vc)) * 4096 + ss;
            dst[0] = f2bf(v[0]);
            dst[4096] = f2bf(v[1]);
            dst[2 * 4096] = f2bf(v[2]);
            dst[3 * 4096] = f2bf(v[3]);
          }
        }
        if (wc0 < 384) {
          sq += __shfl_xor(sq, 16);
          sq += __shfl_xor(sq, 32);
          if (g == 0) {
            if (wc0 < 256) p.part_q[(size_t)row * 4 + (wc0 >> 6)] = sq;
            else p.part_kv[(size_t)row * 2 + ((wc0 - 256) >> 6)] = sq;
          }
        }
      }
    } else if (EPI == EPI_QUP) {
      const int wc0 = n0 + wn * 64;
      const float qscale = 0.10206207261596575f * 1.4426950408889634f;
#pragma unroll
      for (int mt = 0; mt < 8; ++mt) {
        __builtin_amdgcn_sched_barrier(0);
        const int row = rbase + mt * 16;
        const f32x4 a0 = *(const f32x4*)(p.part_q + (size_t)row * 4);
        const float rs = rsqrtf((a0[0] + a0[1] + a0[2] + a0[3]) * (1.0f / 256.0f) + 1e-6f) * qscale;
        const int bb = row >> 12, ss = row & 4095;
#pragma unroll
        for (int nt = 0; nt < 4; ++nt) {
          const int T = (wc0 >> 4) + nt;
          if (T < 36) {
            const int hh = T / 6, tt = T % 6;
            bf16_t* qrow = p.qb + ((size_t)((bb * 6 + hh) * 4096 + ss)) * 96;
            const f32x4 v = acc[mt][nt] * rs;
            if (tt < 4) {
              u32x2 w;
              w.x = cvt_pk_bf16(v[0], v[1]);
              w.y = cvt_pk_bf16(v[2], v[3]);
              *(u32x2*)(qrow + tt * 16 + g * 4) = w;
            } else if (tt == 4) {
              if (nt < 3) {
                const f32x4 v2 = acc[mt][(nt + 1) & 3] * rs;
                const float2* cs = p.ropecs + ss * 16 + g * 4;
                float o1[4], o2[4];
#pragma unroll
                for (int j = 0; j < 4; ++j) {
                  const float2 c_s = cs[j];
                  o1[j] = v[j] * c_s.x - v2[j] * c_s.y;
                  o2[j] = v[j] * c_s.y + v2[j] * c_s.x;
                }
                u32x2 w;
                w.x = cvt_pk_bf16(o1[0], o1[1]);
                w.y = cvt_pk_bf16(o1[2], o1[3]);
                *(u32x2*)(qrow + 64 + g * 4) = w;
                w.x = cvt_pk_bf16(o2[0], o2[1]);
                w.y = cvt_pk_bf16(o2[2], o2[3]);
                *(u32x2*)(qrow + 80 + g * 4) = w;
              }
            }
          }
        }
      }
    } else if (EPI == EPI_KVUP) {
      const int hh = ni * 2 + (wn >> 1);
#pragma unroll
      for (int mt = 0; mt < 8; ++mt) {
        __builtin_amdgcn_sched_barrier(0);
        const int row = rbase + mt * 16;
        const float2 a0 = *(const float2*)(p.part_kv + (size_t)row * 2);
        const float rs = rsqrtf((a0.x + a0.y) * (1.0f / 128.0f) + 1e-6f);
        const int bb = row >> 12, ss = row & 4095;
#pragma unroll
        for (int nt = 0; nt < 4; ++nt) {
          const f32x4 v = acc[mt][nt] * rs;
          if ((wn & 1) == 0) {
            u32x2 w;
            w.x = cvt_pk_bf16(v[0], v[1]);
            w.y = cvt_pk_bf16(v[2], v[3]);
            *(u32x2*)(p.kb + ((size_t)((bb * 6 + hh) * 4096 + ss)) * 96 + nt * 16 + g * 4) = w;
          } else {
            const int dv = nt * 16 + g * 4;
            bf16_t* dst = p.vT + ((size_t)((bb * 6 + hh) * 64 + dv)) * 4096 + ss;
            dst[0] = f2bf(v[0]);
            dst[4096] = f2bf(v[1]);
            dst[2 * 4096] = f2bf(v[2]);
            dst[3 * 4096] = f2bf(v[3]);
          }
        }
      }
#pragma unroll
      for (int i = 0; i < 2; ++i) {
        const int c = tid + 512 * i, rr = c >> 2, cc = c & 3;
        const int row = m0 + rr, bb = row >> 12, ss = row & 4095;
        const u32x4 v = *(const u32x4*)(p.projA + (size_t)row * 416 + 384 + cc * 8);
        *(u32x4*)(p.kb + ((size_t)((bb * 6 + ni * 2) * 4096 + ss)) * 96 + 64 + cc * 8) = v;
        *(u32x4*)(p.kb + ((size_t)((bb * 6 + ni * 2 + 1) * 4096 + ss)) * 96 + 64 + cc * 8) = v;
      }
    } else if (EPI == EPI_OUTPROJ || EPI == EPI_DOWN) {
      const bool last_upd = (EPI == EPI_DOWN && l == 1);
      const int slot = (n0 + wn * 64) >> 6;
#pragma unroll
      for (int mt = 0; mt < 8; ++mt) {
        __builtin_amdgcn_sched_barrier(0);
        const int row = rbase + mt * 16;
        float sq = 0.f;
#pragma unroll
        for (int nt = 0; nt < 4; ++nt) {
          const int col = cbase + nt * 16;
          const u32x2 xr = *(const u32x2*)(p.xb + (size_t)row * 1024 + col);
          const f32x4 xo = (f32x4){bflo(xr.x), bfhi(xr.x), bflo(xr.y), bfhi(xr.y)};
          const f32x4 v = acc[mt][nt] + xo;
          sq += v[0] * v[0] + v[1] * v[1] + v[2] * v[2] + v[3] * v[3];
          if (last_upd) {
            *(f32x4*)(p.out + (size_t)row * 1024 + col) = v;
          } else {
            u32x2 w;
            w.x = cvt_pk_bf16(v[0], v[1]);
            w.y = cvt_pk_bf16(v[2], v[3]);
            *(u32x2*)(p.xb + (size_t)row * 1024 + col) = w;
          }
        }
        sq += __shfl_xor(sq, 16);
        sq += __shfl_xor(sq, 32);
        if (g == 0) p.part_x[(size_t)row * 16 + slot] = sq;
      }
    } else if (EPI == EPI_SWIGLU) {
      const int fbase = ((n0 + wn * 64) >> 1) + g * 4;
#pragma unroll
      for (int mt = 0; mt < 8; ++mt) {
        __builtin_amdgcn_sched_barrier(0);
        const int row = rbase + mt * 16;
        const f32x4* pp = (const f32x4*)(p.part_x + (size_t)row * 16);
        const f32x4 a0 = pp[0], a1 = pp[1], a2 = pp[2], a3 = pp[3];
        const float tot = (a0[0] + a0[1] + a0[2] + a0[3]) + (a1[0] + a1[1] + a1[2] + a1[3]) +
                          (a2[0] + a2[1] + a2[2] + a2[3]) + (a3[0] + a3[1] + a3[2] + a3[3]);
        const float rs = rsqrtf(tot * (1.0f / 1024.0f) + 1e-6f);
#pragma unroll
        for (int i = 0; i < 2; ++i) {
          const f32x4 gt = acc[mt][2 * i] * rs, up = acc[mt][2 * i + 1] * rs;
          float hv[4];
#pragma unroll
          for (int j = 0; j < 4; ++j) hv[j] = gt[j] * __builtin_amdgcn_rcpf(1.0f + __expf(-gt[j])) * up[j];
          u32x2 w;
          w.x = cvt_pk_bf16(hv[0], hv[1]);
          w.y = cvt_pk_bf16(hv[2], hv[3]);
          *(u32x2*)(p.hidden + (size_t)row * 2816 + fbase + i * 16) = w;
        }
      }
    }
  }
}

__device__ void final_norm_phase(const P& p) {
  int tid_ = threadIdx.x;
  asm volatile("" : "+v"(tid_));
  const int tid = tid_, lane = tid & 63, wave = tid >> 6;
  for (int row = blockIdx.x * 8 + wave; row < NTOK; row += gridDim.x * 8) {
    const f32x4* pp = (const f32x4*)(p.part_x + (size_t)row * 16);
    const f32x4 a0 = pp[0], a1 = pp[1], a2 = pp[2], a3 = pp[3];
    const float tot = (a0[0] + a0[1] + a0[2] + a0[3]) + (a1[0] + a1[1] + a1[2] + a1[3]) +
                      (a2[0] + a2[1] + a2[2] + a2[3]) + (a3[0] + a3[1] + a3[2] + a3[3]);
    const float rs = rsqrtf(tot * (1.0f / 1024.0f) + 1e-6f);
    float* xr = p.out + (size_t)row * 1024;
#pragma unroll
    for (int i = 0; i < 4; ++i) {
      f32x4 v = *(const f32x4*)(xr + lane * 4 + 256 * i);
      const f32x4 gg = *(const f32x4*)(p.final_g + lane * 4 + 256 * i);
      v = v * rs * gg;
      *(f32x4*)(xr + lane * 4 + 256 * i) = v;
    }
  }
}


template <int S>
__device__ __forceinline__ void run_stage(const P& p, int l, char* smem) {
  if (S == 0) prep_phase(p, l, smem);
  if (S == 1) {
    filt_fft_phase(p, l, smem);
    gemm_phase<EPI_INPROJ>(p, l, p.xb, 1024, p.Win, 1024, 10, smem);
  }
  if (S == 2) {
    hyena_phase<0>(p, l, smem);
    gemm_phase<EPI_QUP>(p, l, p.projA, 416, p.Wuq, 256, 3, smem);
    gemm_phase<EPI_KVUP>(p, l, p.projA + 256, 416, p.Wukv, 128, 3, smem);
    natten_phase(p, l, smem);
  }
  if (S == 3) {
    hyena_phase<1>(p, l, smem);
    attn_phase(p, smem);
  }
  if (S == 4) mixnorm_phase(p, smem);
  if (S == 5) gemm_phase<EPI_OUTPROJ>(p, l, p.y, 1024, p.Wout, 1024, 4, smem);
  if (S == 6) gemm_phase<EPI_SWIGLU>(p, l, p.xb, 1024, p.Wgu, 1024, 22, smem);
  if (S == 7) gemm_phase<EPI_DOWN>(p, l, p.hidden, 2816, p.Wdown, 2816, 4, smem);
  if (S == 8) final_norm_phase(p);
}

__device__ __forceinline__ void grid_barrier(unsigned* bar, unsigned target) {
  asm volatile("s_waitcnt vmcnt(0)" ::: "memory");
  __syncthreads();
  if (threadIdx.x == 0) {
    __builtin_amdgcn_fence(__ATOMIC_RELEASE, "agent");
    asm volatile("s_waitcnt vmcnt(0)" ::: "memory");
    __hip_atomic_fetch_add(bar, 1u, __ATOMIC_RELAXED, __HIP_MEMORY_SCOPE_AGENT);
    unsigned spins = 0;
    while (__hip_atomic_load(bar, __ATOMIC_RELAXED, __HIP_MEMORY_SCOPE_AGENT) < target && spins < (1u << 22)) {
      __builtin_amdgcn_s_sleep(1);
      ++spins;
    }
    __builtin_amdgcn_fence(__ATOMIC_ACQUIRE, "agent");
    asm volatile("s_waitcnt vmcnt(0)" ::: "memory");
  }
  __syncthreads();
}

__global__ void __launch_bounds__(NTHREADS) k_main(P p) {
  extern __shared__ __attribute__((aligned(16))) char smem[];
  cg::grid_group grid = cg::this_grid();
  if (blockIdx.x == 0 && threadIdx.x == 0) __hip_atomic_store(p.bar, 0u, __ATOMIC_RELAXED, __HIP_MEMORY_SCOPE_AGENT);
  run_stage<0>(p, 0, smem); grid.sync();
  run_stage<1>(p, 0, smem); grid_barrier(p.bar, 1u * gridDim.x);
  run_stage<2>(p, 0, smem); grid_barrier(p.bar, 2u * gridDim.x);
  run_stage<3>(p, 0, smem); grid_barrier(p.bar, 3u * gridDim.x);
  run_stage<4>(p, 0, smem); grid_barrier(p.bar, 4u * gridDim.x);
  run_stage<5>(p, 0, smem); grid_barrier(p.bar, 5u * gridDim.x);
  run_stage<6>(p, 0, smem); grid_barrier(p.bar, 6u * gridDim.x);
  run_stage<7>(p, 0, smem); grid_barrier(p.bar, 7u * gridDim.x);
  run_stage<0>(p, 1, smem); grid_barrier(p.bar, 8u * gridDim.x);
  run_stage<1>(p, 1, smem); grid_barrier(p.bar, 9u * gridDim.x);
  run_stage<2>(p, 1, smem); grid_barrier(p.bar, 10u * gridDim.x);
  run_stage<3>(p, 1, smem); grid_barrier(p.bar, 11u * gridDim.x);
  run_stage<4>(p, 1, smem); grid_barrier(p.bar, 12u * gridDim.x);
  run_stage<5>(p, 1, smem); grid_barrier(p.bar, 13u * gridDim.x);
  run_stage<6>(p, 1, smem); grid_barrier(p.bar, 14u * gridDim.x);
  run_stage<7>(p, 1, smem); grid_barrier(p.bar, 15u * gridDim.x);
  run_stage<8>(p, 1, smem);
}


extern "C" void kernel_launch(void* const* d_in, const int* in_sizes, int n_in, void* d_out, int out_size, void* d_ws,
                              size_t ws_size, hipStream_t stream) {
  static int grid_blocks = 0;
  if (!grid_blocks) {
    int dev = 0, cus = 0;
    (void)hipGetDevice(&dev);
    (void)hipDeviceGetAttribute(&cus, hipDeviceAttributeMultiprocessorCount, dev);
    if (cus <= 0) cus = 256;
    int per_cu = 0;
    (void)hipFuncSetAttribute((const void*)k_main, hipFuncAttributeMaxDynamicSharedMemorySize, LDS_BYTES);
    (void)hipOccupancyMaxActiveBlocksPerMultiprocessor(&per_cu, k_main, NTHREADS, LDS_BYTES);
    if (per_cu > 1) per_cu = 1;
    if (per_cu < 1) per_cu = 1;
    grid_blocks = cus * per_cu;
  }
  P p;
  memset(&p, 0, sizeof(p));
  const float* const* in = (const float* const*)d_in;
  p.x = in[0]; p.norm1_g = in[1]; p.w_in = in[2]; p.q_norm_g = in[3]; p.w_uq = in[4]; p.kv_norm_g = in[5];
  p.w_ukv = in[6]; p.conv_w = in[7]; p.conv_b = in[8]; p.fw1 = in[9]; p.fb1 = in[10]; p.ff1 = in[11];
  p.fw2 = in[12]; p.fb2 = in[13]; p.ff2 = in[14]; p.fw3 = in[15]; p.skip = in[16]; p.rpb = in[17];
  p.mix_g = in[18]; p.w_out = in[19]; p.norm2_g = in[20]; p.w_gate = in[21]; p.w_up = in[22]; p.w_down = in[23];
  p.final_g = in[24];
  p.out = (float*)d_out;
  char* ws = (char*)d_ws;
  size_t off = 0;
  auto take = [&](size_t bytes) {
    char* r = ws + off;
    off += (bytes + 255) & ~(size_t)255;
    return r;
  };
  p.Win = (bf16_t*)take((size_t)2560 * 1024 * 2);
  p.Wuq = (bf16_t*)take((size_t)768 * 256 * 2);
  p.Wukv = (bf16_t*)take((size_t)768 * 128 * 2);
  p.Wout = (bf16_t*)take((size_t)1024 * 1024 * 2);
  p.Wgu = (bf16_t*)take((size_t)5632 * 1024 * 2);
  p.Wdown = (bf16_t*)take((size_t)1024 * 2816 * 2);
  p.ropecs = (float2*)take((size_t)65536 * 8);
  p.tw = (float2*)take((size_t)8192 * 8);
  p.bar = (unsigned*)take(256);
  p.part_x = (float*)take((size_t)NTOK * 16 * 4);
  p.part_q = (float*)take((size_t)NTOK * 4 * 4);
  p.part_kv = (float*)take((size_t)NTOK * 2 * 4);
  p.xb = (bf16_t*)take((size_t)NTOK * 1024 * 2);
  p.H2 = (float2*)take((size_t)768 * 8192 * 8);
  p.z1T = (bf16_t*)take((size_t)1536 * 4096 * 4);
  p.filtT = (float*)p.z1T;
  p.vT = (bf16_t*)take((size_t)8 * 6 * 64 * 4096 * 2);
  p.o_a = (bf16_t*)take((size_t)NTOK * 384 * 2);
  p.o_c = (bf16_t*)take((size_t)NTOK * 256 * 2);
  char* big = take(0);
  p.projA = (bf16_t*)take((size_t)NTOK * 416 * 2);
  p.hyT = (bf16_t*)take((size_t)8 * 1152 * 4096 * 2);
  p.na = (bf16_t*)take((size_t)NTOK * 768 * 2);
  p.qb = (bf16_t*)take((size_t)8 * 6 * 4096 * 96 * 2);
  p.kb = (bf16_t*)take((size_t)8 * 6 * 4096 * 96 * 2);
  p.hidden = (bf16_t*)big;
  p.ybT = (bf16_t*)take((size_t)8 * 384 * 4096 * 2);
  p.naVT = (bf16_t*)take((size_t)8 * 4 * 64 * 4096 * 2);
  p.y = p.qb;
  if (off > ws_size) {
    fprintf(stderr, "workspace too small: need %zu have %zu\n", off, ws_size);
    return;
  }
  void* args[] = {&p};
  hipError_t e = hipLaunchCooperativeKernel((void*)k_main, dim3(grid_blocks), dim3(NTHREADS), args, LDS_BYTES, stream);
  if (e != hipSuccess) fprintf(stderr, "cooperative launch failed: %s (grid %d)\n", hipGetErrorString(e), grid_blocks);
}
```

```cpp
#include <hip/hip_runtime.h>
#include <hip/hip_cooperative_groups.h>
#include <cstdio>
#include <cstring>
#include <cstdint>
#include <cmath>
#include <type_traits>
namespace cg = cooperative_groups;


typedef unsigned short bf16_t;
typedef short bf16x8 __attribute__((ext_vector_type(8)));
typedef float f32x4 __attribute__((ext_vector_type(4)));
typedef unsigned u32x4 __attribute__((ext_vector_type(4)));
typedef unsigned u32x2 __attribute__((ext_vector_type(2)));

constexpr int NTOK = 32768, SEQ = 4096;
constexpr int NTHREADS = 512;
constexpr int LDS_BYTES = 147456;
constexpr int TW_LDS_OFF = 69632;
#define PADI(i) ((i) + ((i) >> 4))

struct P {
  const float *x, *norm1_g, *w_in, *q_norm_g, *w_uq, *kv_norm_g, *w_ukv, *conv_w, *conv_b, *fw1, *fb1, *ff1, *fw2, *fb2,
      *ff2, *fw3, *skip, *rpb, *mix_g, *w_out, *norm2_g, *w_gate, *w_up, *w_down, *final_g;
  float* out;
  bf16_t *Win, *Wuq, *Wukv, *Wout, *Wgu, *Wdown;
  bf16_t *xb, *projA, *hyT, *na, *qb, *kb, *vT, *o_a, *o_c, *y, *hidden, *ybT, *naVT;
  float2* H2;
  float* filtT;
  bf16_t* z1T;
  float *part_x, *part_q, *part_kv;
  float2* ropecs;
  float2* tw;
  unsigned* bar;
  unsigned pad0_, pad1_;
};

typedef __bf16 bf16v2_t __attribute__((ext_vector_type(2)));
typedef float f32x2_t __attribute__((ext_vector_type(2)));
__device__ __forceinline__ unsigned cvt_pk_bf16(float lo, float hi) {
  const f32x2_t v = {lo, hi};
  const bf16v2_t r = __builtin_convertvector(v, bf16v2_t);
  return __builtin_bit_cast(unsigned, r);
}
__device__ __forceinline__ bf16_t f2bf(float f) { return (bf16_t)(cvt_pk_bf16(f, 0.f) & 0xffffu); }
__device__ __forceinline__ float bf2f(bf16_t h) { return __uint_as_float(((unsigned)h) << 16); }
__device__ __forceinline__ float bflo(unsigned u) { return __uint_as_float(u << 16); }
__device__ __forceinline__ float bfhi(unsigned u) { return __uint_as_float(u & 0xffff0000u); }

__device__ __forceinline__ void fast_sincos_rev(float rev, float* s, float* c) {
  const float fr = rev - rintf(rev);
  *s = __builtin_amdgcn_sinf(fr);
  *c = __builtin_amdgcn_cosf(fr);
}
__device__ __forceinline__ float fast_sin(float x) {
  const float rev = x * 0.15915494309189535f;
  const float fr = rev - rintf(rev);
  return __builtin_amdgcn_sinf(fr);
}

__device__ __forceinline__ int vblock() {
  const int G = gridDim.x, b = blockIdx.x;
  return ((G & 7) == 0) ? ((b & 7) * (G >> 3) + (b >> 3)) : b;
}

__device__ void conv_w(const float* __restrict__ W, int K, int N, int Npad, const float* __restrict__ g, bf16_t* Bt,
                       int mode, char* smem) {
  float* tile = (float*)smem;
  int tid_ = threadIdx.x;
  asm volatile("" : "+v"(tid_));
  const int tid = tid_;
  const int nkt = K / 64, nnt = Npad / 64;
  for (int job = blockIdx.x; job < nkt * nnt; job += gridDim.x) {
    const int kt = job % nkt, ntile = job / nkt;
    const int k0 = kt * 64, n0 = ntile * 64;
    __syncthreads();
#pragma unroll
    for (int i = 0; i < 2; ++i) {
      const int k = (tid >> 4) + 32 * i, nq = (tid & 15) * 4, n = n0 + nq;
      f32x4 v = {0.f, 0.f, 0.f, 0.f};
      if (n < N) {
        v = *(const f32x4*)(W + (size_t)(k0 + k) * N + n);
        if (g) v = v * g[k0 + k];
      }
      tile[k * 65 + nq + 0] = v[0];
      tile[k * 65 + nq + 1] = v[1];
      tile[k * 65 + nq + 2] = v[2];
      tile[k * 65 + nq + 3] = v[3];
    }
    __syncthreads();
    {
      const int c = tid, n = c >> 3, kc = c & 7;
      float e[8];
#pragma unroll
      for (int q = 0; q < 8; ++q) e[q] = tile[(kc * 8 + q) * 65 + n];
      u32x4 w;
      w.x = cvt_pk_bf16(e[0], e[1]);
      w.y = cvt_pk_bf16(e[2], e[3]);
      w.z = cvt_pk_bf16(e[4], e[5]);
      w.w = cvt_pk_bf16(e[6], e[7]);
      const int nn = n0 + n;
      int dest = nn;
      if (mode == 1) dest = 32 * (nn >> 4) + (nn & 15);
      if (mode == 2) dest = 32 * (nn >> 4) + 16 + (nn & 15);
      *(u32x4*)(Bt + (size_t)dest * K + k0 + kc * 8) = w;
    }
  }
}

__device__ void filt_mlp(const P& p, int l, char* smem) {
  float* zf = (float*)smem;
  float* h1 = zf + 16 * 17;
  float* h2 = h1 + 64 * 16;
  int tid_ = threadIdx.x;
  asm volatile("" : "+v"(tid_));
  const int tid = tid_, tl = tid & 15, kk = tid >> 4;
  const float* w1 = p.fw1 + l * 17 * 64;
  const float* b1 = p.fb1 + l * 64;
  const float* f1 = p.ff1 + l * 64;
  const float* w2 = p.fw2 + l * 64 * 64;
  const float* b2 = p.fb2 + l * 64;
  const float* f2 = p.ff2 + l * 64;
  const float* w3 = p.fw3 + (size_t)l * 64 * 1536;
  for (int job = blockIdx.x; job < 256; job += gridDim.x) {
    const int t0 = job * 16;
    __syncthreads();
    {
      const int t = t0 + tl;
      if (kk < 8) {
        const float band = 1e-4f + (float)kk * ((7.0f - 1e-4f) / 7.0f);
        const float ang = ((6.283185307179586f * (float)t) * band) / 4096.0f;
        float s, c;
        fast_sincos_rev(ang * 0.15915494309189535f, &s, &c);
        zf[tl * 17 + 1 + kk] = c;
        zf[tl * 17 + 9 + kk] = s;
      } else if (kk == 8) {
        zf[tl * 17] = (float)t / 4095.0f;
      }
    }
    __syncthreads();
#pragma unroll
    for (int m = 0; m < 2; ++m) {
      const int j = kk + 32 * m;
      float a = b1[j];
#pragma unroll 1
      for (int f = 0; f < 17; ++f) a += zf[tl * 17 + f] * w1[f * 64 + j];
      h1[j * 16 + tl] = fast_sin(f1[j] * a);
    }
    __syncthreads();
#pragma unroll
    for (int m = 0; m < 2; ++m) {
      const int j = kk + 32 * m;
      float a = b2[j];
#pragma unroll 16
      for (int i = 0; i < 64; ++i) a += h1[i * 16 + tl] * w2[i * 64 + j];
      h2[j * 16 + tl] = fast_sin(f2[j] * a);
    }
    __syncthreads();
#pragma unroll 1
    for (int mm = 0; mm < 3; ++mm) {
      const int col = tid + 512 * mm;
      float acc[16];
#pragma unroll
      for (int q = 0; q < 16; ++q) acc[q] = 0.f;
#pragma unroll 1
      for (int j0 = 0; j0 < 64; j0 += 8) {
        float wv[8];
#pragma unroll
        for (int q = 0; q < 8; ++q) wv[q] = w3[(size_t)(j0 + q) * 1536 + col];
#pragma unroll
        for (int q = 0; q < 8; ++q) {
          const float w = wv[q];
          const f32x4* hp = (const f32x4*)(h2 + (j0 + q) * 16);
          const f32x4 a0 = hp[0], a1 = hp[1], a2 = hp[2], a3 = hp[3];
          acc[0] += a0[0] * w; acc[1] += a0[1] * w; acc[2] += a0[2] * w; acc[3] += a0[3] * w;
          acc[4] += a1[0] * w; acc[5] += a1[1] * w; acc[6] += a1[2] * w; acc[7] += a1[3] * w;
          acc[8] += a2[0] * w; acc[9] += a2[1] * w; acc[10] += a2[2] * w; acc[11] += a2[3] * w;
          acc[12] += a3[0] * w; acc[13] += a3[1] * w; acc[14] += a3[2] * w; acc[15] += a3[3] * w;
        }
      }
      const int c = col % 384;
      const float lo = -3.0701134573253945f, hi = -15.350567286626972f;
      const float delta = fabsf(lo + (hi - lo) * ((float)c / 383.0f));
      float* dst = p.filtT + (size_t)col * 4096 + t0;
#pragma unroll
      for (int q = 0; q < 16; ++q) {
        const float tn = (float)(t0 + q) / 4095.0f;
        dst[q] = acc[q] * __expf(-tn * delta);
      }
    }
  }
}

__device__ void prep_phase(const P& p, int l, char* smem) {
  for (int w = 0; w < 7; ++w) {
    const float* W; const float* g; bf16_t* Bt; int K, N, Npad, mode = 0;
    switch (w) {
      case 0: W = p.w_in + (size_t)l * 1024 * 2336; K = 1024; N = 2336; Npad = 2560; g = p.norm1_g + l * 1024; Bt = p.Win; break;
      case 1: W = p.w_uq + (size_t)l * 256 * 576; K = 256; N = 576; Npad = 768; g = p.q_norm_g + l * 256; Bt = p.Wuq; break;
      case 2: W = p.w_ukv + (size_t)l * 128 * 768; K = 128; N = 768; Npad = 768; g = p.kv_norm_g + l * 128; Bt = p.Wukv; break;
      case 3: W = p.w_out + (size_t)l * 1024 * 1024; K = 1024; N = 1024; Npad = 1024; g = p.mix_g + l * 1024; Bt = p.Wout; break;
      case 4: W = p.w_gate + (size_t)l * 1024 * 2816; K = 1024; N = 2816; Npad = 2816; g = p.norm2_g + l * 1024; Bt = p.Wgu; mode = 1; break;
      case 5: W = p.w_up + (size_t)l * 1024 * 2816; K = 1024; N = 2816; Npad = 2816; g = p.norm2_g + l * 1024; Bt = p.Wgu; mode = 2; break;
      default: W = p.w_down + (size_t)l * 2816 * 1024; K = 2816; N = 1024; Npad = 1024; g = nullptr; Bt = p.Wdown; break;
    }
    conv_w(W, K, N, Npad, g, Bt, mode, smem);
  }
  filt_mlp(p, l, smem);
  if (l == 0) {
    int tid_ = threadIdx.x;
  asm volatile("" : "+v"(tid_));
  const int tid = tid_, lane = tid & 63, wave = tid >> 6;
    for (int row = blockIdx.x * 8 + wave; row < NTOK; row += gridDim.x * 8) {
      const float* xr = p.x + (size_t)row * 1024;
      bf16_t* xo = p.xb + (size_t)row * 1024;
      float s = 0.f;
#pragma unroll
      for (int i = 0; i < 4; ++i) {
        const f32x4 v = *(const f32x4*)(xr + lane * 4 + 256 * i);
        s += v[0] * v[0] + v[1] * v[1] + v[2] * v[2] + v[3] * v[3];
        u32x2 w;
        w.x = cvt_pk_bf16(v[0], v[1]);
        w.y = cvt_pk_bf16(v[2], v[3]);
        *(u32x2*)(xo + lane * 4 + 256 * i) = w;
      }
#pragma unroll
      for (int o = 1; o < 64; o <<= 1) s += __shfl_xor(s, o);
      if (lane < 16) p.part_x[(size_t)row * 16 + lane] = (lane == 0) ? s : 0.f;
    }
    for (int i = blockIdx.x * 512 + tid; i < 65536 + 8192; i += gridDim.x * 512) {
      if (i < 65536) {
        const int pos = i >> 4, k = i & 15;
        const float ang = (float)pos * __builtin_amdgcn_exp2f(-(float)k * 0.8304820237218405f);
        float s, c;
        fast_sincos_rev(ang * 0.15915494309189535f, &s, &c);
        p.ropecs[i] = make_float2(c, s);
      } else {
        const int k = i - 65536;
        const int ms = 1 << (31 - __clz(k + 1));
        const int pp = k + 1 - ms;
        float s, c;
        fast_sincos_rev((float)pp / (float)(2 * ms), &s, &c);
        p.tw[k] = make_float2(c, -s);
      }
    }
  }
}

template <int LOGR, int MTOP, bool INV, bool ZIN = false, bool HOUT = false>
__device__ __forceinline__ void fft_pass(float2* sm, const float2* tw) {
  constexpr int R = 1 << LOGR;
  constexpr int q = MTOP >> (LOGR - 1);
  constexpr int ntask = 8192 / R;
  for (int T = threadIdx.x; T < ntask; T += NTHREADS) {
    const int i = T & (q - 1);
    const int blk = T / q;
    const int base = blk * (2 * MTOP) + i;
    float2 v[R];
#pragma unroll
    for (int e = 0; e < R; ++e) {
      if (ZIN && e >= R / 2) v[e] = make_float2(0.f, 0.f);
      else v[e] = sm[PADI(base + e * q)];
    }
    if (!INV) {
#pragma unroll
      for (int s = 0; s < LOGR; ++s) {
        constexpr int dummy = 0;
        (void)dummy;
        const int hs = 1 << (LOGR - 1 - s);
        const int ms = MTOP >> s;
#pragma unroll
        for (int e = 0; e < R; ++e) {
          if ((e & hs) == 0) {
            const int pp = i + (e & (hs - 1)) * q;
            const float2 w = tw[(ms - 1) + pp];
            const float2 a = v[e], b = v[e + hs];
            v[e] = make_float2(a.x + b.x, a.y + b.y);
            const float dx = a.x - b.x, dy = a.y - b.y;
            v[e + hs] = make_float2(dx * w.x - dy * w.y, dx * w.y + dy * w.x);
          }
        }
      }
    } else {
#pragma unroll
      for (int s = LOGR - 1; s >= 0; --s) {
        const int hs = 1 << (LOGR - 1 - s);
        const int ms = MTOP >> s;
#pragma unroll
        for (int e = 0; e < R; ++e) {
          if ((e & hs) == 0) {
            const int pp = i + (e & (hs - 1)) * q;
            const float2 w = tw[(ms - 1) + pp];
            const float2 a = v[e], b = v[e + hs];
            const float tx = b.x * w.x + b.y * w.y, ty = b.y * w.x - b.x * w.y;
            v[e] = make_float2(a.x + tx, a.y + ty);
            v[e + hs] = make_float2(a.x - tx, a.y - ty);
          }
        }
      }
    }
#pragma unroll
    for (int e = 0; e < R; ++e) {
      if (HOUT && e >= R / 2) continue;
      sm[PADI(base + e * q)] = v[e];
    }
  }
  __syncthreads();
}

__device__ __forceinline__ void fft_fwd(float2* sm, const float2* tw) {
  fft_pass<4, 4096, false>(sm, tw);
  fft_pass<4, 256, false>(sm, tw);
  fft_pass<4, 16, false>(sm, tw);
  fft_pass<1, 1, false>(sm, tw);
}
__device__ __forceinline__ void fft_inv(float2* sm, const float2* tw) {
  fft_pass<1, 1, true>(sm, tw);
  fft_pass<3, 8, true>(sm, tw);
  fft_pass<3, 64, true>(sm, tw);
  fft_pass<3, 512, true>(sm, tw);
  fft_pass<3, 4096, true>(sm, tw);
}

__device__ void filt_fft_phase(const P& p, int l, char* smem) {
  float2* sm = (float2*)smem;
  float2* tws = (float2*)(smem + TW_LDS_OFF);
  int tid_ = threadIdx.x;
  asm volatile("" : "+v"(tid_));
  const int tid = tid_;
  for (int i = tid; i < 8192; i += NTHREADS) tws[i] = p.tw[i];
  for (int jj = blockIdx.x; jj < 384; jj += gridDim.x) {
    const int o = jj / 192, c = jj % 192;
    const int jobF = o * 384 + c, jobG = jobF + 192;
    const float* hf1 = p.filtT + ((size_t)((o * 2 + 0) * 384 + c)) * 4096;
    const float* hb1 = p.filtT + ((size_t)((o * 2 + 1) * 384 + c)) * 4096;
    const float* hf2 = hf1 + (size_t)192 * 4096;
    const float* hb2 = hb1 + (size_t)192 * 4096;
    const float sk1 = p.skip[(l * 2 + o) * 384 + c], sk2 = p.skip[(l * 2 + o) * 384 + c + 192];
    __syncthreads();
    for (int n = tid; n < 8192; n += NTHREADS) {
      float v1, v2;
      if (n == 0) { v1 = hf1[0] + hb1[0] + sk1; v2 = hf2[0] + hb2[0] + sk2; }
      else if (n < 4096) { v1 = hf1[n]; v2 = hf2[n]; }
      else if (n == 4096) { v1 = 0.f; v2 = 0.f; }
      else { v1 = hb1[8192 - n]; v2 = hb2[8192 - n]; }
      sm[PADI(n)] = make_float2(v1, v2);
    }
    __syncthreads();
    fft_fwd(sm, tws);
    float2* dF = p.H2 + (size_t)jobF * 8192;
    float2* dG = p.H2 + (size_t)jobG * 8192;
    const float sc = 0.5f / 8192.0f;
    for (int n = tid; n < 8192; n += NTHREADS) {
      const int k = (int)(__brev((unsigned)n) >> 19);
      const int np = (int)(__brev((unsigned)((8192 - k) & 8191)) >> 19);
      const float2 a = sm[PADI(n)], b = sm[PADI(np)];
      dF[n] = make_float2((a.x + b.x) * sc, (a.y - b.y) * sc);
      dG[n] = make_float2((a.y + b.y) * sc, (b.x - a.x) * sc);
    }
  }
}

__device__ __forceinline__ float short_conv(const bf16_t* row, int t, float w0, float w1, float w2, float bias) {
  const float xm = (t > 0) ? bf2f(row[t - 1]) : 0.f;
  const float x0 = bf2f(row[t]);
  const float xp = (t < SEQ - 1) ? bf2f(row[t + 1]) : 0.f;
  return w0 * xm + w1 * x0 + w2 * xp + bias;
}

__device__ __forceinline__ void conv8(const bf16_t* row, int t0, float w0, float w1, float w2, float bias, float (&out)[8]) {
  const u32x4 v = *(const u32x4*)(row + t0);
  float x[10];
  x[0] = (t0 > 0) ? bf2f(row[t0 - 1]) : 0.f;
  x[1] = bflo(v.x); x[2] = bfhi(v.x); x[3] = bflo(v.y); x[4] = bfhi(v.y);
  x[5] = bflo(v.z); x[6] = bfhi(v.z); x[7] = bflo(v.w); x[8] = bfhi(v.w);
  x[9] = (t0 + 8 < SEQ) ? bf2f(row[t0 + 8]) : 0.f;
#pragma unroll
  for (int k = 0; k < 8; ++k) out[k] = w0 * x[k] + w1 * x[k + 1] + w2 * x[k + 2] + bias;
}

struct RawRow { u32x4 v; float lo, hi; };
__device__ __forceinline__ RawRow load_raw(const bf16_t* row, int t0) {
  RawRow r;
  r.v = *(const u32x4*)(row + t0);
  r.lo = (t0 > 0) ? bf2f(row[t0 - 1]) : 0.f;
  r.hi = (t0 + 8 < SEQ) ? bf2f(row[t0 + 8]) : 0.f;
  return r;
}
__device__ __forceinline__ void conv8_raw(const RawRow& r, float w0, float w1, float w2, float bias, float (&out)[8]) {
  float x[10];
  x[0] = r.lo;
  x[1] = bflo(r.v.x); x[2] = bfhi(r.v.x); x[3] = bflo(r.v.y); x[4] = bfhi(r.v.y);
  x[5] = bflo(r.v.z); x[6] = bfhi(r.v.z); x[7] = bflo(r.v.w); x[8] = bfhi(r.v.w);
  x[9] = r.hi;
#pragma unroll
  for (int k = 0; k < 8; ++k) out[k] = w0 * x[k] + w1 * x[k + 1] + w2 * x[k + 2] + bias;
}

__device__ __forceinline__ void fft_mid(float2* sm, const f32x4 (&hpre)[8]) {
#pragma unroll
  for (int it = 0; it < 8; ++it) {
    const int T = threadIdx.x + it * NTHREADS;
    const float2 a = sm[PADI(2 * T)], b = sm[PADI(2 * T + 1)];
    const f32x4 h = hpre[it];
    const float sx = a.x + b.x, sy = a.y + b.y, dx = a.x - b.x, dy = a.y - b.y;
    const float Ax = sx * h[0] - sy * h[1], Ay = sx * h[1] + sy * h[0];
    const float Bx = dx * h[2] - dy * h[3], By = dx * h[3] + dy * h[2];
    sm[PADI(2 * T)] = make_float2(Ax + Bx, Ay + By);
    sm[PADI(2 * T + 1)] = make_float2(Ax - Bx, Ay - By);
  }
  __syncthreads();
}

template <int ORD>
__device__ void hyena_phase(const P& p, int l, char* smem) {
  float2* sm = (float2*)smem;
  float2* tws = (float2*)(smem + TW_LDS_OFF);
  int tid_ = threadIdx.x;
  asm volatile("" : "+v"(tid_));
  const int tid = tid_;
  for (int i = tid; i < 8192; i += NTHREADS) tws[i] = p.tw[i];
  const float* cw = p.conv_w + (size_t)l * 3 * 1152;
  const float* cb = p.conv_b + (size_t)l * 1152;
  const int t0 = tid * 8;
  for (int job = vblock(); job < 1536; job += gridDim.x) {
    const int pair = job & 3, c = job >> 2;
    const int b1 = pair * 2, b2 = b1 + 1;
    const int gc = (ORD == 0 ? 384 : 768) + c;
    const RawRow gr1 = load_raw(p.hyT + ((size_t)(b1 * 1152 + gc)) * 4096, t0);
    const RawRow gr2 = load_raw(p.hyT + ((size_t)(b2 * 1152 + gc)) * 4096, t0);
    __syncthreads();
    {
      float u1[8], u2[8];
      if (ORD == 0) {
        const bf16_t* r1 = p.hyT + ((size_t)(b1 * 1152 + c)) * 4096;
        const bf16_t* r2 = p.hyT + ((size_t)(b2 * 1152 + c)) * 4096;
        const float w0 = cw[c], w1 = cw[1152 + c], w2 = cw[2304 + c], bi = cb[c];
        conv8(r1, t0, w0, w1, w2, bi, u1);
        conv8(r2, t0, w0, w1, w2, bi, u2);
      } else {
        const u32x4 a0 = *(const u32x4*)(p.z1T + ((size_t)(b1 * 384 + c)) * 4096 + t0);
        const u32x4 c0_ = *(const u32x4*)(p.z1T + ((size_t)(b2 * 384 + c)) * 4096 + t0);
        u1[0] = bflo(a0.x); u1[1] = bfhi(a0.x); u1[2] = bflo(a0.y); u1[3] = bfhi(a0.y); u1[4] = bflo(a0.z); u1[5] = bfhi(a0.z); u1[6] = bflo(a0.w); u1[7] = bfhi(a0.w);
        u2[0] = bflo(c0_.x); u2[1] = bfhi(c0_.x); u2[2] = bflo(c0_.y); u2[3] = bfhi(c0_.y); u2[4] = bflo(c0_.z); u2[5] = bfhi(c0_.z); u2[6] = bflo(c0_.w); u2[7] = bfhi(c0_.w);
      }
#pragma unroll
      for (int k = 0; k < 8; ++k) {
        sm[PADI(t0 + k)] = make_float2(u1[k], u2[k]);
      }
    }
    __syncthreads();
    fft_pass<4, 4096, false, true, false>(sm, tws);
    fft_pass<4, 256, false>(sm, tws);
    f32x4 hpre[8];
    {
      const float2* H = p.H2 + ((size_t)(ORD * 384 + c)) * 8192;
#pragma unroll
      for (int it = 0; it < 8; ++it) hpre[it] = *(const f32x4*)(H + 2 * (tid + it * NTHREADS));
    }
    fft_pass<4, 16, false>(sm, tws);
    fft_mid(sm, hpre);
    fft_pass<4, 16, true>(sm, tws);
    fft_pass<4, 256, true>(sm, tws);
    fft_pass<4, 4096, true, false, true>(sm, tws);
    {
      const float w0 = cw[gc], w1 = cw[1152 + gc], w2 = cw[2304 + gc], bi = cb[gc];
      float q1[8], q2[8];
      conv8_raw(gr1, w0, w1, w2, bi, q1);
      conv8_raw(gr2, w0, w1, w2, bi, q2);
#pragma unroll
      for (int k = 0; k < 8; ++k) {
        const float2 yv = sm[PADI(t0 + k)];
        q1[k] *= yv.x;
        q2[k] *= yv.y;
      }
      {
        bf16_t* dbase = (ORD == 0) ? p.z1T : p.ybT;
        u32x4 w1_, w2_;
        w1_.x = cvt_pk_bf16(q1[0], q1[1]); w1_.y = cvt_pk_bf16(q1[2], q1[3]); w1_.z = cvt_pk_bf16(q1[4], q1[5]); w1_.w = cvt_pk_bf16(q1[6], q1[7]);
        w2_.x = cvt_pk_bf16(q2[0], q2[1]); w2_.y = cvt_pk_bf16(q2[2], q2[3]); w2_.z = cvt_pk_bf16(q2[4], q2[5]); w2_.w = cvt_pk_bf16(q2[6], q2[7]);
        *(u32x4*)(dbase + ((size_t)(b1 * 384 + c)) * 4096 + t0) = w1_;
        *(u32x4*)(dbase + ((size_t)(b2 * 384 + c)) * 4096 + t0) = w2_;
      }
    }
  }
}

constexpr int KROW = 208;
constexpr int VROW = 136;
constexpr int KBUF = 64 * KROW, VBUF = 64 * VROW;

constexpr int NK_ROW = 528;
constexpr int NK_BUF = 32 * NK_ROW;
constexpr int NV_ROW = 72;
constexpr int NV_BUF = 256 * NV_ROW;
constexpr int NRPB_OFF = 2 * NK_BUF + 2 * NV_BUF;

__device__ void natten_phase(const P& p, int l, char* smem) {
  int tid_ = threadIdx.x;
  asm volatile("" : "+v"(tid_));
  const int tid = tid_, lane = tid & 63, wave = tid >> 6, l15 = lane & 15, g = lane >> 4;
  const int hw = wave >> 1, qh = wave & 1;
  char* Ks = smem;
  char* Vs = smem + 2 * NK_BUF;
  float* rp = (float*)(smem + NRPB_OFF);
  __syncthreads();
  for (int i = tid; i < 4 * 15 * 31; i += NTHREADS) rp[i] = p.rpb[(size_t)l * 4 * 15 * 31 + i] * 1.4426950408889634f;
  const float qscale = 0.125f * 1.4426950408889634f;
  for (int job = blockIdx.x; job < 512; job += gridDim.x) {
    const int r = job & 63, b = job >> 6;
    const int r0 = min(max(r - 4, 0), 56);
    bf16x8 qf[2][2];
    int cq[2], c0[2];
#pragma unroll
    for (int nt = 0; nt < 2; ++nt) {
      cq[nt] = qh * 32 + nt * 16 + l15;
      c0[nt] = min(max(cq[nt] - 8, 0), 48);
      const bf16_t* qp = p.na + (size_t)(b * 4096 + r * 64 + cq[nt]) * 768 + hw * 64;
#pragma unroll
      for (int ks = 0; ks < 2; ++ks) qf[nt][ks] = *(const bf16x8*)(qp + ks * 32 + g * 8);
    }
    f32x4 o[4][2];
#pragma unroll
    for (int a = 0; a < 4; ++a)
#pragma unroll
      for (int n = 0; n < 2; ++n) o[a][n] = (f32x4){0.f, 0.f, 0.f, 0.f};
    float mrow[2] = {-1e30f, -1e30f}, lrow[2] = {0.f, 0.f};
    u32x4 rk[2], rv[2];
    auto gload = [&](int t) {
      const int kr = r0 + (t >> 1), kh = (t & 1) * 32;
      const bf16_t* kbase = p.na + (size_t)(b * 4096 + kr * 64 + kh) * 768 + 256;
#pragma unroll
      for (int i = 0; i < 2; ++i) {
        const int c = tid + 512 * i, key = c >> 5, cc = c & 31;
        rk[i] = *(const u32x4*)(kbase + (size_t)key * 768 + cc * 8);
      }
#pragma unroll
      for (int i = 0; i < 2; ++i) {
        const int c = tid + 512 * i, row = c >> 2, cc = c & 3;
        rv[i] = *(const u32x4*)(p.naVT + ((size_t)(b * 256 + row)) * 4096 + kr * 64 + kh + cc * 8);
      }
    };
    auto lstore = [&](int buf) {
      char* kb_ = Ks + buf * NK_BUF;
      char* vb_ = Vs + buf * NV_BUF;
#pragma unroll
      for (int i = 0; i < 2; ++i) {
        const int c = tid + 512 * i, key = c >> 5, cc = c & 31;
        *(u32x4*)(kb_ + key * NK_ROW + cc * 16) = rk[i];
      }
#pragma unroll
      for (int i = 0; i < 2; ++i) {
        const int c = tid + 512 * i, row = c >> 2, cc = c & 3;
        u32x2 lo, hi;
        lo.x = rv[i].x; lo.y = rv[i].y; hi.x = rv[i].z; hi.y = rv[i].w;
        *(u32x2*)(vb_ + row * NV_ROW + cc * 16) = lo;
        *(u32x2*)(vb_ + row * NV_ROW + cc * 16 + 8) = hi;
      }
    };
    gload(0);
    __syncthreads();
    lstore(0);
    __syncthreads();
    for (int t = 0; t < 16; ++t) {
      if (t + 1 < 16) gload(t + 1);
      __builtin_amdgcn_sched_barrier(0);
      const char* kb_ = Ks + (t & 1) * NK_BUF;
      const char* vb_ = Vs + (t & 1) * NV_BUF + hw * 64 * NV_ROW;
      const int kh = (t & 1) * 32;
      f32x4 s[2][2];
#pragma unroll
      for (int a = 0; a < 2; ++a)
#pragma unroll
        for (int n = 0; n < 2; ++n) s[a][n] = (f32x4){0.f, 0.f, 0.f, 0.f};
#pragma unroll
      for (int mt = 0; mt < 2; ++mt)
#pragma unroll
        for (int ks = 0; ks < 2; ++ks) {
          const bf16x8 kf = *(const bf16x8*)(kb_ + (mt * 16 + l15) * NK_ROW + hw * 128 + ks * 64 + g * 16);
#pragma unroll
          for (int nt = 0; nt < 2; ++nt)
            s[mt][nt] = __builtin_amdgcn_mfma_f32_16x16x32_bf16(kf, qf[nt][ks], s[mt][nt], 0, 0, 0);
        }
      const float* brow = rp + (hw * 15 + (r0 + (t >> 1) - r + 7)) * 31;
      bf16x8 pf[2];
#pragma unroll
      for (int nt = 0; nt < 2; ++nt) {
        float mx = -1e30f;
#pragma unroll
        for (int mt = 0; mt < 2; ++mt)
#pragma unroll
          for (int j = 0; j < 4; ++j) {
            const int kc = kh + mt * 16 + g * 4 + j;
            const bool valid = (unsigned)(kc - c0[nt]) < 16u;
            const int dc = min(max(kc - cq[nt] + 15, 0), 30);
            const float sc = valid ? (s[mt][nt][j] * qscale + brow[dc]) : -1e30f;
            s[mt][nt][j] = sc;
            mx = fmaxf(mx, sc);
          }
        mx = fmaxf(mx, __shfl_xor(mx, 16));
        mx = fmaxf(mx, __shfl_xor(mx, 32));
        const float mnew = fmaxf(mrow[nt], mx);
        const float alpha = __builtin_amdgcn_exp2f(mrow[nt] - mnew);
        mrow[nt] = mnew;
        float ls = 0.f;
#pragma unroll
        for (int mt = 0; mt < 2; ++mt)
#pragma unroll
          for (int j = 0; j < 4; ++j) {
            const float e = (s[mt][nt][j] > -1e29f) ? __builtin_amdgcn_exp2f(s[mt][nt][j] - mnew) : 0.f;
            s[mt][nt][j] = e;
            ls += e;
          }
        lrow[nt] = lrow[nt] * alpha + ls;
#pragma unroll
        for (int a = 0; a < 4; ++a) o[a][nt] *= alpha;
        u32x4 w;
        w.x = cvt_pk_bf16(s[0][nt][0], s[0][nt][1]);
        w.y = cvt_pk_bf16(s[0][nt][2], s[0][nt][3]);
        w.z = cvt_pk_bf16(s[1][nt][0], s[1][nt][1]);
        w.w = cvt_pk_bf16(s[1][nt][2], s[1][nt][3]);
        pf[nt] = __builtin_bit_cast(bf16x8, w);
      }
#pragma unroll
      for (int mt = 0; mt < 4; ++mt) {
        const u32x2 lo = *(const u32x2*)(vb_ + (mt * 16 + l15) * NV_ROW + (4 * g) * 2);
        const u32x2 hi = *(const u32x2*)(vb_ + (mt * 16 + l15) * NV_ROW + (16 + 4 * g) * 2);
        u32x4 w;
        w.x = lo.x; w.y = lo.y; w.z = hi.x; w.w = hi.y;
        const bf16x8 vf = __builtin_bit_cast(bf16x8, w);
#pragma unroll
        for (int nt = 0; nt < 2; ++nt)
          o[mt][nt] = __builtin_amdgcn_mfma_f32_16x16x32_bf16(vf, pf[nt], o[mt][nt], 0, 0, 0);
      }
      if (t + 1 < 16) lstore((t + 1) & 1);
      __syncthreads();
    }
#pragma unroll
    for (int nt = 0; nt < 2; ++nt) {
      float lt = lrow[nt];
      lt += __shfl_xor(lt, 16);
      lt += __shfl_xor(lt, 32);
      const float inv = 1.0f / lt;
      const int tok = b * 4096 + r * 64 + cq[nt];
#pragma unroll
      for (int mt = 0; mt < 4; ++mt) {
        u32x2 w;
        w.x = cvt_pk_bf16(o[mt][nt][0] * inv, o[mt][nt][1] * inv);
        w.y = cvt_pk_bf16(o[mt][nt][2] * inv, o[mt][nt][3] * inv);
        *(u32x2*)(p.o_c + (size_t)tok * 256 + hw * 64 + mt * 16 + g * 4) = w;
      }
    }
  }
}


__device__ void attn_phase(const P& p, char* smem) {
  int tid_ = threadIdx.x;
  asm volatile("" : "+v"(tid_));
  const int tid = tid_, lane = tid & 63, wave = tid >> 6, l15 = lane & 15, g = lane >> 4;
  char* Ks = smem;
  char* Vs = smem + 2 * KBUF;
  for (int job = vblock(); job < 768; job += gridDim.x) {
    const int qblk = job & 15, bh = job >> 4;
    const int b = bh / 6, h = bh % 6;
    const bf16_t* Q = p.qb + (size_t)bh * 4096 * 96;
    const bf16_t* Kg = p.kb + (size_t)bh * 4096 * 96;
    const bf16_t* Vt = p.vT + (size_t)bh * 64 * 4096;
    const int q0 = qblk * 256 + wave * 32;
    bf16x8 qf[2][3];
#pragma unroll
    for (int nt = 0; nt < 2; ++nt)
#pragma unroll
      for (int ks = 0; ks < 3; ++ks)
        qf[nt][ks] = *(const bf16x8*)(Q + (size_t)(q0 + nt * 16 + l15) * 96 + ks * 32 + g * 8);
    f32x4 o[4][2];
#pragma unroll
    for (int a = 0; a < 4; ++a)
#pragma unroll
      for (int n = 0; n < 2; ++n) o[a][n] = (f32x4){0.f, 0.f, 0.f, 0.f};
    float mrow[2] = {-1e30f, -1e30f}, lrow[2] = {0.f, 0.f};

    u32x4 rk[2];
    u32x4 rv;
    const int kr1 = (tid + 512) / 12, kc1 = (tid + 512) - kr1 * 12;
    const int kr0 = tid / 12, kc0 = tid - kr0 * 12;
    auto gload = [&](int kt) {
      const u32x4* kp = (const u32x4*)(Kg + (size_t)kt * 64 * 96);
      rk[0] = kp[tid];
      if (tid < 256) rk[1] = kp[tid + 512];
      rv = *(const u32x4*)(Vt + (size_t)(tid >> 3) * 4096 + kt * 64 + (tid & 7) * 8);
    };
    auto lstore = [&](int buf) {
      char* kb_ = Ks + buf * KBUF;
      char* vb_ = Vs + buf * VBUF;
      *(u32x4*)(kb_ + kr0 * KROW + kc0 * 16) = rk[0];
      if (tid < 256) *(u32x4*)(kb_ + kr1 * KROW + kc1 * 16) = rk[1];
      u32x2 lo, hi;
      lo.x = rv.x; lo.y = rv.y; hi.x = rv.z; hi.y = rv.w;
      *(u32x2*)(vb_ + (tid >> 3) * VROW + (tid & 7) * 16) = lo;
      *(u32x2*)(vb_ + (tid >> 3) * VROW + (tid & 7) * 16 + 8) = hi;
    };
    const int NKT = 64;
    gload(0);
    __syncthreads();
    lstore(0);
    __syncthreads();
    for (int kt = 0; kt < NKT; ++kt) {
      if (kt + 1 < NKT) gload(kt + 1);
      __builtin_amdgcn_sched_barrier(0);
      const char* kb_ = Ks + (kt & 1) * KBUF;
      const char* vb_ = Vs + (kt & 1) * VBUF;
      f32x4 s[4][2];
#pragma unroll
      for (int a = 0; a < 4; ++a)
#pragma unroll
        for (int n = 0; n < 2; ++n) s[a][n] = (f32x4){0.f, 0.f, 0.f, 0.f};
#pragma unroll
      for (int mt = 0; mt < 4; ++mt)
#pragma unroll
        for (int ks = 0; ks < 3; ++ks) {
          const bf16x8 kf = *(const bf16x8*)(kb_ + (mt * 16 + l15) * KROW + (ks * 32 + g * 8) * 2);
#pragma unroll
          for (int nt = 0; nt < 2; ++nt)
            s[mt][nt] = __builtin_amdgcn_mfma_f32_16x16x32_bf16(kf, qf[nt][ks], s[mt][nt], 0, 0, 0);
        }
      bf16x8 pf[2][2];
#pragma unroll
      for (int nt = 0; nt < 2; ++nt) {
        float mx = s[0][nt][0];
#pragma unroll
        for (int mt = 0; mt < 4; ++mt)
#pragma unroll
          for (int j = 0; j < 4; ++j) mx = fmaxf(mx, s[mt][nt][j]);
        mx = fmaxf(mx, __shfl_xor(mx, 16));
        mx = fmaxf(mx, __shfl_xor(mx, 32));
        if (__any(mx > mrow[nt] + 8.0f)) {
          const float mnew = fmaxf(mrow[nt], mx);
          const float alpha = __builtin_amdgcn_exp2f(mrow[nt] - mnew);
          mrow[nt] = mnew;
          lrow[nt] *= alpha;
#pragma unroll
          for (int a = 0; a < 4; ++a) o[a][nt] *= alpha;
        }
        const float mref = mrow[nt];
        float ls = 0.f;
#pragma unroll
        for (int mt = 0; mt < 4; ++mt)
#pragma unroll
          for (int j = 0; j < 4; ++j) {
            const float e = __builtin_amdgcn_exp2f(s[mt][nt][j] - mref);
            s[mt][nt][j] = e;
            ls += e;
          }
        lrow[nt] += ls;
#pragma unroll
        for (int kk = 0; kk < 2; ++kk) {
          u32x4 w;
          w.x = cvt_pk_bf16(s[2 * kk][nt][0], s[2 * kk][nt][1]);
          w.y = cvt_pk_bf16(s[2 * kk][nt][2], s[2 * kk][nt][3]);
          w.z = cvt_pk_bf16(s[2 * kk + 1][nt][0], s[2 * kk + 1][nt][1]);
          w.w = cvt_pk_bf16(s[2 * kk + 1][nt][2], s[2 * kk + 1][nt][3]);
          pf[kk][nt] = __builtin_bit_cast(bf16x8, w);
        }
      }
#pragma unroll
      for (int kk = 0; kk < 2; ++kk)
#pragma unroll
        for (int mt = 0; mt < 4; ++mt) {
          const u32x2 lo = *(const u32x2*)(vb_ + (mt * 16 + l15) * VROW + (32 * kk + 4 * g) * 2);
          const u32x2 hi = *(const u32x2*)(vb_ + (mt * 16 + l15) * VROW + (32 * kk + 16 + 4 * g) * 2);
          u32x4 w;
          w.x = lo.x; w.y = lo.y; w.z = hi.x; w.w = hi.y;
          const bf16x8 vf = __builtin_bit_cast(bf16x8, w);
#pragma unroll
          for (int nt = 0; nt < 2; ++nt)
            o[mt][nt] = __builtin_amdgcn_mfma_f32_16x16x32_bf16(vf, pf[kk][nt], o[mt][nt], 0, 0, 0);
        }
      if (kt + 1 < NKT) lstore((kt + 1) & 1);
      __syncthreads();
    }
#pragma unroll
    for (int nt = 0; nt < 2; ++nt) {
      float lt = lrow[nt];
      lt += __shfl_xor(lt, 16);
      lt += __shfl_xor(lt, 32);
      const float inv = 1.0f / lt;
      const int tok = b * 4096 + q0 + nt * 16 + l15;
#pragma unroll
      for (int mt = 0; mt < 4; ++mt) {
        u32x2 w;
        w.x = cvt_pk_bf16(o[mt][nt][0] * inv, o[mt][nt][1] * inv);
        w.y = cvt_pk_bf16(o[mt][nt][2] * inv, o[mt][nt][3] * inv);
        *(u32x2*)(p.o_a + (size_t)tok * 384 + h * 64 + mt * 16 + g * 4) = w;
      }
    }
  }
}

__device__ void mixnorm_phase(const P& p, char* smem) {
  int tid_ = threadIdx.x;
  asm volatile("" : "+v"(tid_));
  const int tid = tid_;
  for (int job = blockIdx.x; job < NTOK / 32; job += gridDim.x) {
    const int tok0 = job * 32, b = tok0 >> 12, s0 = tok0 & 4095;
    __syncthreads();
#pragma unroll
    for (int i = 0; i < 3; ++i) {
      const int c = tid + 512 * i, row = c / 48, cc = c % 48;
      *(u32x4*)(smem + row * 2048 + cc * 16) = *(const u32x4*)(p.o_a + (size_t)(tok0 + row) * 384 + cc * 8);
    }
#pragma unroll
    for (int i = 0; i < 2; ++i) {
      const int c = tid + 512 * i, row = c >> 5, cc = c & 31;
      *(u32x4*)(smem + row * 2048 + 1536 + cc * 16) = *(const u32x4*)(p.o_c + (size_t)(tok0 + row) * 256 + cc * 8);
    }
#pragma unroll
    for (int i = 0; i < 3; ++i) {
      const int c = tid + 512 * i, ch = c >> 2, tc = c & 3;
      const u32x4 v = *(const u32x4*)(p.ybT + ((size_t)(b * 384 + ch)) * 4096 + s0 + tc * 8);
      bf16_t* dst = (bf16_t*)smem + (size_t)(tc * 8) * 1024 + 384 + ch;
      dst[0 * 1024] = (bf16_t)(v.x & 0xffff); dst[1 * 1024] = (bf16_t)(v.x >> 16);
      dst[2 * 1024] = (bf16_t)(v.y & 0xffff); dst[3 * 1024] = (bf16_t)(v.y >> 16);
      dst[4 * 1024] = (bf16_t)(v.z & 0xffff); dst[5 * 1024] = (bf16_t)(v.z >> 16);
      dst[6 * 1024] = (bf16_t)(v.w & 0xffff); dst[7 * 1024] = (bf16_t)(v.w >> 16);
    }
    __syncthreads();
    const int tok = tid >> 4, sub = tid & 15;
    float ss[3] = {0.f, 0.f, 0.f};
#pragma unroll
    for (int gi = 0; gi < 3; ++gi) {
      const int i0 = (gi == 0) ? 0 : (gi == 1 ? 3 : 6), i1 = (gi == 0) ? 3 : (gi == 1 ? 6 : 8);
      float acc = 0.f;
#pragma unroll 2
      for (int i = i0; i < i1; ++i) {
        const u32x4 v = *(const u32x4*)(smem + tok * 2048 + (sub + 16 * i) * 16);
        float a;
        a = bflo(v.x); acc += a * a; a = bfhi(v.x); acc += a * a;
        a = bflo(v.y); acc += a * a; a = bfhi(v.y); acc += a * a;
        a = bflo(v.z); acc += a * a; a = bfhi(v.z); acc += a * a;
        a = bflo(v.w); acc += a * a; a = bfhi(v.w); acc += a * a;
      }
      acc += __shfl_xor(acc, 1);
      acc += __shfl_xor(acc, 2);
      acc += __shfl_xor(acc, 4);
      acc += __shfl_xor(acc, 8);
      ss[gi] = acc;
    }
    float rs[3];
    rs[0] = rsqrtf(ss[0] * (1.0f / 384.0f) + 1e-6f);
    rs[1] = rsqrtf(ss[1] * (1.0f / 384.0f) + 1e-6f);
    rs[2] = rsqrtf(ss[2] * (1.0f / 256.0f) + 1e-6f);
#pragma unroll
    for (int gi = 0; gi < 3; ++gi) {
      const int i0 = (gi == 0) ? 0 : (gi == 1 ? 3 : 6), i1 = (gi == 0) ? 3 : (gi == 1 ? 6 : 8);
      const float r = rs[gi];
#pragma unroll 2
      for (int i = i0; i < i1; ++i) {
        const u32x4 v = *(const u32x4*)(smem + tok * 2048 + (sub + 16 * i) * 16);
        u32x4 w;
        w.x = cvt_pk_bf16(bflo(v.x) * r, bfhi(v.x) * r);
        w.y = cvt_pk_bf16(bflo(v.y) * r, bfhi(v.y) * r);
        w.z = cvt_pk_bf16(bflo(v.z) * r, bfhi(v.z) * r);
        w.w = cvt_pk_bf16(bflo(v.w) * r, bfhi(v.w) * r);
        *(u32x4*)(p.y + (size_t)(tok0 + tok) * 1024 + (sub + 16 * i) * 8) = w;
      }
    }
  }
}

enum { EPI_INPROJ = 0, EPI_QUP = 1, EPI_KVUP = 2, EPI_OUTPROJ = 3, EPI_SWIGLU = 4, EPI_DOWN = 5 };

template <int EPI>
__device__ void gemm_phase(const P& p, int l, const bf16_t* __restrict__ A, int lda, const bf16_t* __restrict__ Bt,
                           int K, int nN, char* smem) {
  int tid_ = threadIdx.x;
  asm volatile("" : "+v"(tid_));
  const int tid = tid_, lane = tid & 63, wave = tid >> 6, wm = wave >> 2, wn = wave & 3, l15 = lane & 15,
            g = lane >> 4;
  const int ntiles = 128 * nN;
  const int srow = tid >> 3, skc = tid & 7;
  const int sw_off = srow * 128 + ((skc ^ ((srow >> 1) & 7)) * 16);
  const int rsw = (l15 >> 1) & 7;
  for (int tile = vblock(); tile < ntiles; tile += gridDim.x) {
    const int gsz_ = 4 * nN, grp_ = tile / gsz_, w_ = tile - grp_ * gsz_;
    const int ni = w_ >> 2, mi = grp_ * 4 + (w_ & 3);
    const int m0 = mi * 256, n0 = ni * 256;
    f32x4 acc[8][4];
#pragma unroll
    for (int a = 0; a < 8; ++a)
#pragma unroll
      for (int b = 0; b < 4; ++b) acc[a][b] = (f32x4){0.f, 0.f, 0.f, 0.f};
    const bf16_t* Ag = A + (size_t)(m0 + srow) * lda + skc * 8;
    const bf16_t* Bg = Bt + (size_t)(n0 + srow) * K + skc * 8;
    u32x4 ra[4], rb[4];
    auto gl = [&](int kt) {
#pragma unroll
      for (int i = 0; i < 4; ++i) ra[i] = *(const u32x4*)(Ag + (size_t)i * 64 * lda + kt * 64);
#pragma unroll
      for (int i = 0; i < 4; ++i) rb[i] = *(const u32x4*)(Bg + (size_t)i * 64 * K + kt * 64);
    };
    auto st = [&](int buf) {
      char* nb = smem + buf * 65536;
#pragma unroll
      for (int i = 0; i < 4; ++i) *(u32x4*)(nb + sw_off + i * 8192) = ra[i];
#pragma unroll
      for (int i = 0; i < 4; ++i) *(u32x4*)(nb + 32768 + sw_off + i * 8192) = rb[i];
    };
    const int nk = K / 64;
    gl(0);
    float rs_row = 1.f;
    if (EPI == EPI_INPROJ || EPI == EPI_SWIGLU) {
      if (tid < 256) {
        const f32x4* pp = (const f32x4*)(p.part_x + (size_t)(m0 + tid) * 16);
        const f32x4 a0 = pp[0], a1 = pp[1], a2 = pp[2], a3 = pp[3];
        const float tot = (a0[0] + a0[1] + a0[2] + a0[3]) + (a1[0] + a1[1] + a1[2] + a1[3]) +
                          (a2[0] + a2[1] + a2[2] + a2[3]) + (a3[0] + a3[1] + a3[2] + a3[3]);
        rs_row = rsqrtf(tot * (1.0f / 1024.0f) + 1e-6f);
      }
    } else if (EPI == EPI_QUP) {
      if (tid < 256) {
        const f32x4 a0 = *(const f32x4*)(p.part_q + (size_t)(m0 + tid) * 4);
        rs_row = rsqrtf((a0[0] + a0[1] + a0[2] + a0[3]) * (1.0f / 256.0f) + 1e-6f);
      }
    } else if (EPI == EPI_KVUP) {
      if (tid < 256) {
        const float2 a0 = *(const float2*)(p.part_kv + (size_t)(m0 + tid) * 2);
        rs_row = rsqrtf((a0.x + a0.y) * (1.0f / 128.0f) + 1e-6f);
      }
    }
    float* s_rs = (float*)(smem + 131072);
    __syncthreads();
    st(0);
    if (EPI != EPI_OUTPROJ && EPI != EPI_DOWN && true) {
      if (tid < 256) s_rs[tid] = rs_row;
    }
    __syncthreads();
    for (int kt = 0; kt < nk; ++kt) {
      if (kt + 1 < nk) gl(kt + 1);
      __builtin_amdgcn_sched_barrier(0);
      const char* Ab = smem + (kt & 1) * 65536;
      const char* Bb = Ab + 32768;
#pragma unroll
      for (int ks = 0; ks < 2; ++ks) {
        bf16x8 bfr[4];
#pragma unroll
        for (int nt = 0; nt < 4; ++nt)
          bfr[nt] = *(const bf16x8*)(Bb + (wn * 64 + nt * 16 + l15) * 128 + (((ks * 4 + g) ^ rsw) * 16));
        bf16x8 af[2][2];
#pragma unroll
        for (int mt = 0; mt < 2; ++mt)
          af[0][mt] = *(const bf16x8*)(Ab + (wm * 128 + mt * 16 + l15) * 128 + (((ks * 4 + g) ^ rsw) * 16));
#pragma unroll
        for (int mh = 0; mh < 4; ++mh) {
          if (mh < 3) {
#pragma unroll
            for (int mt = 0; mt < 2; ++mt)
              af[(mh + 1) & 1][mt] = *(const bf16x8*)(Ab + (wm * 128 + ((mh + 1) * 2 + mt) * 16 + l15) * 128 + (((ks * 4 + g) ^ rsw) * 16));
          }
          __builtin_amdgcn_sched_barrier(0);
#pragma unroll
          for (int mt = 0; mt < 2; ++mt)
#pragma unroll
            for (int nt = 0; nt < 4; ++nt)
              acc[mh * 2 + mt][nt] = __builtin_amdgcn_mfma_f32_16x16x32_bf16(bfr[nt], af[mh & 1][mt], acc[mh * 2 + mt][nt], 0, 0, 0);
          __builtin_amdgcn_sched_barrier(0);
        }
      }
      if (kt + 1 < nk) st((kt + 1) & 1);
      __syncthreads();
    }
    int opq_ = 0;
    asm volatile("" : "+v"(opq_));
    const int rbase = m0 + wm * 128 + l15 + opq_;
    const int cbase = n0 + wn * 64 + g * 4 + opq_;
    if (EPI == EPI_INPROJ) {
      const int wc0 = n0 + wn * 64;
#pragma unroll
      for (int mt = 0; mt < 8; ++mt) {
        const int row = rbase + mt * 16;
        const float rs = s_rs[row - m0];
        const int bb = row >> 12, ss = row & 4095;
        float sq = 0.f;
#pragma unroll
        for (int nt = 0; nt < 4; ++nt) {
          const int ct = wc0 + nt * 16;
          const int col = cbase + nt * 16;
          f32x4 v = acc[mt][nt] * rs;
          if (ct < 384) {
            sq += v[0] * v[0] + v[1] * v[1] + v[2] * v[2] + v[3] * v[3];
            u32x2 w;
            w.x = cvt_pk_bf16(v[0], v[1]);
            w.y = cvt_pk_bf16(v[2], v[3]);
            *(u32x2*)(p.projA + (size_t)row * 416 + col) = w;
          } else if (ct == 384) {
            if (nt < 3) {
              const f32x4 v2 = acc[mt][(nt + 1) & 3] * rs;
              const int i0 = col - 384;
              const float2* cs = p.ropecs + ss * 16 + i0;
              float o1[4], o2[4];
#pragma unroll
              for (int j = 0; j < 4; ++j) {
                const float2 c_s = cs[j];
                o1[j] = v[j] * c_s.x - v2[j] * c_s.y;
                o2[j] = v[j] * c_s.y + v2[j] * c_s.x;
              }
              u32x2 w;
              w.x = cvt_pk_bf16(o1[0], o1[1]);
              w.y = cvt_pk_bf16(o1[2], o1[3]);
              *(u32x2*)(p.projA + (size_t)row * 416 + 384 + i0) = w;
              w.x = cvt_pk_bf16(o2[0], o2[1]);
              w.y = cvt_pk_bf16(o2[2], o2[3]);
              *(u32x2*)(p.projA + (size_t)row * 416 + 400 + i0) = w;
            }
          } else if (ct == 400) {
          } else if (ct < 1568) {
            const int hc = col - 416;
            bf16_t* dst = p.hyT + ((size_t)(bb * 1152 + hc)) * 4096 + ss;
            dst[0] = f2bf(v[0]);
            dst[4096] = f2bf(v[1]);
            dst[2 * 4096] = f2bf(v[2]);
            dst[3 * 4096] = f2bf(v[3]);
          } else if (ct < 2080) {
            u32x2 w;
            w.x = cvt_pk_bf16(v[0], v[1]);
            w.y = cvt_pk_bf16(v[2], v[3]);
            *(u32x2*)(p.na + (size_t)row * 768 + (col - 1568)) = w;
          } else if (ct < 2336) {
            const int vc = col - 2080;
            bf16_t* dst = p.naVT + ((size_t)(bb * 256 + vc)) * 4096 + ss;
            dst[0] = f2bf(v[0]);
            dst[4096] = f2bf(v[1]);
            dst[2 * 4096] = f2bf(v[2]);
            dst[3 * 4096] = f2bf(v[3]);
          }
        }
        if (wc0 < 384) {
          sq += __shfl_xor(sq, 16);
          sq += __shfl_xor(sq, 32);
          if (g == 0) {
            if (wc0 < 256) p.part_q[(size_t)row * 4 + (wc0 >> 6)] = sq;
            else p.part_kv[(size_t)row * 2 + ((wc0 - 256) >> 6)] = sq;
          }
        }
      }
    } else if (EPI == EPI_QUP) {
      const int wc0 = n0 + wn * 64;
      const float qscale = 0.10206207261596575f * 1.4426950408889634f;
#pragma unroll
      for (int mt = 0; mt < 8; ++mt) {
        const int row = rbase + mt * 16;
        const float rs = s_rs[row - m0] * qscale;
        const int bb = row >> 12, ss = row & 4095;
#pragma unroll
        for (int nt = 0; nt < 4; ++nt) {
          const int T = (wc0 >> 4) + nt;
          if (T < 36) {
            const int hh = T / 6, tt = T % 6;
            bf16_t* qrow = p.qb + ((size_t)((bb * 6 + hh) * 4096 + ss)) * 96;
            const f32x4 v = acc[mt][nt] * rs;
            if (tt < 4) {
              u32x2 w;
              w.x = cvt_pk_bf16(v[0], v[1]);
              w.y = cvt_pk_bf16(v[2], v[3]);
              *(u32x2*)(qrow + tt * 16 + g * 4) = w;
            } else if (tt == 4) {
              if (nt < 3) {
                const f32x4 v2 = acc[mt][(nt + 1) & 3] * rs;
                const float2* cs = p.ropecs + ss * 16 + g * 4;
                float o1[4], o2[4];
#pragma unroll
                for (int j = 0; j < 4; ++j) {
                  const float2 c_s = cs[j];
                  o1[j] = v[j] * c_s.x - v2[j] * c_s.y;
                  o2[j] = v[j] * c_s.y + v2[j] * c_s.x;
                }
                u32x2 w;
                w.x = cvt_pk_bf16(o1[0], o1[1]);
                w.y = cvt_pk_bf16(o1[2], o1[3]);
                *(u32x2*)(qrow + 64 + g * 4) = w;
                w.x = cvt_pk_bf16(o2[0], o2[1]);
                w.y = cvt_pk_bf16(o2[2], o2[3]);
                *(u32x2*)(qrow + 80 + g * 4) = w;
              }
            }
          }
        }
      }
    } else if (EPI == EPI_KVUP) {
      const int hh = ni * 2 + (wn >> 1);
#pragma unroll
      for (int mt = 0; mt < 8; ++mt) {
        const int row = rbase + mt * 16;
        const float rs = s_rs[row - m0];
        const int bb = row >> 12, ss = row & 4095;
#pragma unroll
        for (int nt = 0; nt < 4; ++nt) {
          const f32x4 v = acc[mt][nt] * rs;
          if ((wn & 1) == 0) {
            u32x2 w;
            w.x = cvt_pk_bf16(v[0], v[1]);
            w.y = cvt_pk_bf16(v[2], v[3]);
            *(u32x2*)(p.kb + ((size_t)((bb * 6 + hh) * 4096 + ss)) * 96 + nt * 16 + g * 4) = w;
          } else {
            const int dv = nt * 16 + g * 4;
            bf16_t* dst = p.vT + ((size_t)((bb * 6 + hh) * 64 + dv)) * 4096 + ss;
            dst[0] = f2bf(v[0]);
            dst[4096] = f2bf(v[1]);
            dst[2 * 4096] = f2bf(v[2]);
            dst[3 * 4096] = f2bf(v[3]);
          }
        }
      }
#pragma unroll
      for (int i = 0; i < 2; ++i) {
        const int c = tid + 512 * i, rr = c >> 2, cc = c & 3;
        const int row = m0 + rr, bb = row >> 12, ss = row & 4095;
        const u32x4 v = *(const u32x4*)(p.projA + (size_t)row * 416 + 384 + cc * 8);
        *(u32x4*)(p.kb + ((size_t)((bb * 6 + ni * 2) * 4096 + ss)) * 96 + 64 + cc * 8) = v;
        *(u32x4*)(p.kb + ((size_t)((bb * 6 + ni * 2 + 1) * 4096 + ss)) * 96 + 64 + cc * 8) = v;
      }
    } else if (EPI == EPI_OUTPROJ || EPI == EPI_DOWN) {
      const bool last_upd = (EPI == EPI_DOWN && l == 1);
      const int slot = (n0 + wn * 64) >> 6;
#pragma unroll
      for (int mt = 0; mt < 8; ++mt) {
        const int row = rbase + mt * 16;
        float sq = 0.f;
#pragma unroll
        for (int nt = 0; nt < 4; ++nt) {
          const int col = cbase + nt * 16;
          const u32x2 xr = *(const u32x2*)(p.xb + (size_t)row * 1024 + col);
          const f32x4 xo = (f32x4){bflo(xr.x), bfhi(xr.x), bflo(xr.y), bfhi(xr.y)};
          const f32x4 v = acc[mt][nt] + xo;
          sq += v[0] * v[0] + v[1] * v[1] + v[2] * v[2] + v[3] * v[3];
          if (last_upd) {
            *(f32x4*)(p.out + (size_t)row * 1024 + col) = v;
          } else {
            u32x2 w;
            w.x = cvt_pk_bf16(v[0], v[1]);
            w.y = cvt_pk_bf16(v[2], v[3]);
            *(u32x2*)(p.xb + (size_t)row * 1024 + col) = w;
          }
        }
        sq += __shfl_xor(sq, 16);
        sq += __shfl_xor(sq, 32);
        if (g == 0) p.part_x[(size_t)row * 16 + slot] = sq;
      }
    } else if (EPI == EPI_SWIGLU) {
      const int fbase = ((n0 + wn * 64) >> 1) + g * 4;
#pragma unroll
      for (int mt = 0; mt < 8; ++mt) {
        const int row = rbase + mt * 16;
        const float rs = s_rs[row - m0];
#pragma unroll
        for (int i = 0; i < 2; ++i) {
          const f32x4 gt = acc[mt][2 * i] * rs, up = acc[mt][2 * i + 1] * rs;
          float hv[4];
#pragma unroll
          for (int j = 0; j < 4; ++j) hv[j] = gt[j] * __builtin_amdgcn_rcpf(1.0f + __expf(-gt[j])) * up[j];
          u32x2 w;
          w.x = cvt_pk_bf16(hv[0], hv[1]);
          w.y = cvt_pk_bf16(hv[2], hv[3]);
          *(u32x2*)(p.hidden + (size_t)row * 2816 + fbase + i * 16) = w;
        }
      }
    }
  }
}

__device__ void final_norm_phase(const P& p) {
  int tid_ = threadIdx.x;
  asm volatile("" : "+v"(tid_));
  const int tid = tid_, lane = tid & 63, wave = tid >> 6;
  for (int row = blockIdx.x * 8 + wave; row < NTOK; row += gridDim.x * 8) {
    const f32x4* pp = (const f32x4*)(p.part_x + (size_t)row * 16);
    const f32x4 a0 = pp[0], a1 = pp[1], a2 = pp[2], a3 = pp[3];
    const float tot = (a0[0] + a0[1] + a0[2] + a0[3]) + (a1[0] + a1[1] + a1[2] + a1[3]) +
                      (a2[0] + a2[1] + a2[2] + a2[3]) + (a3[0] + a3[1] + a3[2] + a3[3]);
    const float rs = rsqrtf(tot * (1.0f / 1024.0f) + 1e-6f);
    float* xr = p.out + (size_t)row * 1024;
#pragma unroll
    for (int i = 0; i < 4; ++i) {
      f32x4 v = *(const f32x4*)(xr + lane * 4 + 256 * i);
      const f32x4 gg = *(const f32x4*)(p.final_g + lane * 4 + 256 * i);
      v = v * rs * gg;
      *(f32x4*)(xr + lane * 4 + 256 * i) = v;
    }
  }
}


template <int S>
__device__ __forceinline__ void run_stage(const P& p, int l, char* smem) {
  if (S == 0) prep_phase(p, l, smem);
  if (S == 1) {
    filt_fft_phase(p, l, smem);
    gemm_phase<EPI_INPROJ>(p, l, p.xb, 1024, p.Win, 1024, 10, smem);
  }
  if (S == 2) {
    hyena_phase<0>(p, l, smem);
    gemm_phase<EPI_QUP>(p, l, p.projA, 416, p.Wuq, 256, 3, smem);
    gemm_phase<EPI_KVUP>(p, l, p.projA + 256, 416, p.Wukv, 128, 3, smem);
    natten_phase(p, l, smem);
  }
  if (S == 3) {
    hyena_phase<1>(p, l, smem);
    attn_phase(p, smem);
  }
  if (S == 4) mixnorm_phase(p, smem);
  if (S == 5) gemm_phase<EPI_OUTPROJ>(p, l, p.y, 1024, p.Wout, 1024, 4, smem);
  if (S == 6) gemm_phase<EPI_SWIGLU>(p, l, p.xb, 1024, p.Wgu, 1024, 22, smem);
  if (S == 7) gemm_phase<EPI_DOWN>(p, l, p.hidden, 2816, p.Wdown, 2816, 4, smem);
  if (S == 8) final_norm_phase(p);
}

__device__ __forceinline__ void grid_barrier(unsigned* bar, unsigned target) {
  asm volatile("s_waitcnt vmcnt(0)" ::: "memory");
  __syncthreads();
  if (threadIdx.x == 0) {
    __builtin_amdgcn_fence(__ATOMIC_RELEASE, "agent");
    asm volatile("s_waitcnt vmcnt(0)" ::: "memory");
    __hip_atomic_fetch_add(bar, 1u, __ATOMIC_RELAXED, __HIP_MEMORY_SCOPE_AGENT);
    unsigned spins = 0;
    while (__hip_atomic_load(bar, __ATOMIC_RELAXED, __HIP_MEMORY_SCOPE_AGENT) < target && spins < (1u << 22)) {
      __builtin_amdgcn_s_sleep(1);
      ++spins;
    }
    __builtin_amdgcn_fence(__ATOMIC_ACQUIRE, "agent");
    asm volatile("s_waitcnt vmcnt(0)" ::: "memory");
  }
  __syncthreads();
}

__global__ void __launch_bounds__(NTHREADS) k_main(P p) {
  extern __shared__ __attribute__((aligned(16))) char smem[];
  cg::grid_group grid = cg::this_grid();
  if (blockIdx.x == 0 && threadIdx.x == 0) __hip_atomic_store(p.bar, 0u, __ATOMIC_RELAXED, __HIP_MEMORY_SCOPE_AGENT);
  run_stage<0>(p, 0, smem); grid.sync();
  run_stage<1>(p, 0, smem); grid_barrier(p.bar, 1u * gridDim.x);
  run_stage<2>(p, 0, smem); grid_barrier(p.bar, 2u * gridDim.x);
  run_stage<3>(p, 0, smem); grid_barrier(p.bar, 3u * gridDim.x);
  run_stage<4>(p, 0, smem); grid_barrier(p.bar, 4u * gridDim.x);
  run_stage<5>(p, 0, smem); grid_barrier(p.bar, 5u * gridDim.x);
  run_stage<6>(p, 0, smem); grid_barrier(p.bar, 6u * gridDim.x);
  run_stage<7>(p, 0, smem); grid_barrier(p.bar, 7u * gridDim.x);
  run_stage<0>(p, 1, smem); grid_barrier(p.bar, 8u * gridDim.x);
  run_stage<1>(p, 1, smem); grid_barrier(p.bar, 9u * gridDim.x);
  run_stage<2>(p, 1, smem); grid_barrier(p.bar, 10u * gridDim.x);
  run_stage<3>(p, 1, smem); grid_barrier(p.bar, 11u * gridDim.x);
  run_stage<4>(p, 1, smem); grid_barrier(p.bar, 12u * gridDim.x);
  run_stage<5>(p, 1, smem); grid_barrier(p.bar, 13u * gridDim.x);
  run_stage<6>(p, 1, smem); grid_barrier(p.bar, 14u * gridDim.x);
  run_stage<7>(p, 1, smem); grid_barrier(p.bar, 15u * gridDim.x);
  run_stage<8>(p, 1, smem);
}


extern "C" void kernel_launch(void* const* d_in, const int* in_sizes, int n_in, void* d_out, int out_size, void* d_ws,
                              size_t ws_size, hipStream_t stream) {
  static int grid_blocks = 0;
  if (!grid_blocks) {
    int dev = 0, cus = 0;
    (void)hipGetDevice(&dev);
    (void)hipDeviceGetAttribute(&cus, hipDeviceAttributeMultiprocessorCount, dev);
    if (cus <= 0) cus = 256;
    int per_cu = 0;
    (void)hipFuncSetAttribute((const void*)k_main, hipFuncAttributeMaxDynamicSharedMemorySize, LDS_BYTES);
    (void)hipOccupancyMaxActiveBlocksPerMultiprocessor(&per_cu, k_main, NTHREADS, LDS_BYTES);
    if (per_cu > 1) per_cu = 1;
    if (per_cu < 1) per_cu = 1;
    grid_blocks = cus * per_cu;
  }
  P p;
  memset(&p, 0, sizeof(p));
  const float* const* in = (const float* const*)d_in;
  p.x = in[0]; p.norm1_g = in[1]; p.w_in = in[2]; p.q_norm_g = in[3]; p.w_uq = in[4]; p.kv_norm_g = in[5];
  p.w_ukv = in[6]; p.conv_w = in[7]; p.conv_b = in[8]; p.fw1 = in[9]; p.fb1 = in[10]; p.ff1 = in[11];
  p.fw2 = in[12]; p.fb2 = in[13]; p.ff2 = in[14]; p.fw3 = in[15]; p.skip = in[16]; p.rpb = in[17];
  p.mix_g = in[18]; p.w_out = in[19]; p.norm2_g = in[20]; p.w_gate = in[21]; p.w_up = in[22]; p.w_down = in[23];
  p.final_g = in[24];
  p.out = (float*)d_out;
  char* ws = (char*)d_ws;
  size_t off = 0;
  auto take = [&](size_t bytes) {
    char* r = ws + off;
    off += (bytes + 255) & ~(size_t)255;
    return r;
  };
  p.Win = (bf16_t*)take((size_t)2560 * 1024 * 2);
  p.Wuq = (bf16_t*)take((size_t)768 * 256 * 2);
  p.Wukv = (bf16_t*)take((size_t)768 * 128 * 2);
  p.Wout = (bf16_t*)take((size_t)1024 * 1024 * 2);
  p.Wgu = (bf16_t*)take((size_t)5632 * 1024 * 2);
  p.Wdown = (bf16_t*)take((size_t)1024 * 2816 * 2);
  p.ropecs = (float2*)take((size_t)65536 * 8);
  p.tw = (float2*)take((size_t)8192 * 8);
  p.bar = (unsigned*)take(256);
  p.part_x = (float*)take((size_t)NTOK * 16 * 4);
  p.part_q = (float*)take((size_t)NTOK * 4 * 4);
  p.part_kv = (float*)take((size_t)NTOK * 2 * 4);
  p.xb = (bf16_t*)take((size_t)NTOK * 1024 * 2);
  p.H2 = (float2*)take((size_t)768 * 8192 * 8);
  p.z1T = (bf16_t*)take((size_t)1536 * 4096 * 4);
  p.filtT = (float*)p.z1T;
  p.vT = (bf16_t*)take((size_t)8 * 6 * 64 * 4096 * 2);
  p.o_a = (bf16_t*)take((size_t)NTOK * 384 * 2);
  p.o_c = (bf16_t*)take((size_t)NTOK * 256 * 2);
  char* big = take(0);
  p.projA = (bf16_t*)take((size_t)NTOK * 416 * 2);
  p.hyT = (bf16_t*)take((size_t)8 * 1152 * 4096 * 2);
  p.na = (bf16_t*)take((size_t)NTOK * 768 * 2);
  p.qb = (bf16_t*)take((size_t)8 * 6 * 4096 * 96 * 2);
  p.kb = (bf16_t*)take((size_t)8 * 6 * 4096 * 96 * 2);
  p.hidden = (bf16_t*)big;
  p.ybT = (bf16_t*)take((size_t)8 * 384 * 4096 * 2);
  p.naVT = (bf16_t*)take((size_t)8 * 4 * 64 * 4096 * 2);
  p.y = p.qb;
  if (off > ws_size) {
    fprintf(stderr, "workspace too small: need %zu have %zu\n", off, ws_size);
    return;
  }
  void* args[] = {&p};
  hipError_t e = hipLaunchCooperativeKernel((void*)k_main, dim3(grid_blocks), dim3(NTHREADS), args, LDS_BYTES, stream);
  if (e != hipSuccess) fprintf(stderr, "cooperative launch failed: %s (grid %d)\n", hipGetErrorString(e), grid_blocks);
}
```

```cpp
#include <hip/hip_runtime.h>
#include <hip/hip_cooperative_groups.h>
#include <cstdio>
#include <cstring>
#include <cstdint>
#include <cmath>
#include <type_traits>
namespace cg = cooperative_groups;


typedef unsigned short bf16_t;
typedef short bf16x8 __attribute__((ext_vector_type(8)));
typedef float f32x4 __attribute__((ext_vector_type(4)));
typedef unsigned u32x4 __attribute__((ext_vector_type(4)));
typedef unsigned u32x2 __attribute__((ext_vector_type(2)));

constexpr int NTOK = 32768, SEQ = 4096;
constexpr int NTHREADS = 512;
constexpr int LDS_BYTES = 147456;
constexpr int TW_LDS_OFF = 69632;
#define PADI(i) ((i) + ((i) >> 4))

struct P {
  const float *x, *norm1_g, *w_in, *q_norm_g, *w_uq, *kv_norm_g, *w_ukv, *conv_w, *conv_b, *fw1, *fb1, *ff1, *fw2, *fb2,
      *ff2, *fw3, *skip, *rpb, *mix_g, *w_out, *norm2_g, *w_gate, *w_up, *w_down, *final_g;
  float* out;
  bf16_t *Win, *Wuq, *Wukv, *Wout, *Wgu, *Wdown;
  bf16_t *xb, *projA, *hyT, *na, *qb, *kb, *vT, *o_a, *o_c, *y, *hidden, *ybT, *naVT;
  float2* H2;
  float* filtT;
  bf16_t* z1T;
  float *part_x, *part_q, *part_kv;
  float2* ropecs;
  float2* tw;
  unsigned* bar;
  unsigned pad0_, pad1_;
};

typedef __bf16 bf16v2_t __attribute__((ext_vector_type(2)));
typedef float f32x2_t __attribute__((ext_vector_type(2)));
__device__ __forceinline__ unsigned cvt_pk_bf16(float lo, float hi) {
  const f32x2_t v = {lo, hi};
  const bf16v2_t r = __builtin_convertvector(v, bf16v2_t);
  return __builtin_bit_cast(unsigned, r);
}
__device__ __forceinline__ bf16_t f2bf(float f) { return (bf16_t)(cvt_pk_bf16(f, 0.f) & 0xffffu); }
__device__ __forceinline__ float bf2f(bf16_t h) { return __uint_as_float(((unsigned)h) << 16); }
__device__ __forceinline__ float bflo(unsigned u) { return __uint_as_float(u << 16); }
__device__ __forceinline__ float bfhi(unsigned u) { return __uint_as_float(u & 0xffff0000u); }

__device__ __forceinline__ void fast_sincos_rev(float rev, float* s, float* c) {
  const float fr = rev - rintf(rev);
  *s = __builtin_amdgcn_sinf(fr);
  *c = __builtin_amdgcn_cosf(fr);
}
__device__ __forceinline__ float fast_sin(float x) {
  const float rev = x * 0.15915494309189535f;
  const float fr = rev - rintf(rev);
  return __builtin_amdgcn_sinf(fr);
}

__device__ __forceinline__ int vblock() {
  const int G = gridDim.x, b = blockIdx.x;
  return ((G & 7) == 0) ? ((b & 7) * (G >> 3) + (b >> 3)) : b;
}

__device__ void conv_w(const float* __restrict__ W, int K, int N, int Npad, const float* __restrict__ g, bf16_t* Bt,
                       int mode, char* smem) {
  float* tile = (float*)smem;
  int tid_ = threadIdx.x;
  asm volatile("" : "+v"(tid_));
  const int tid = tid_;
  const int nkt = K / 64, nnt = Npad / 64;
  for (int job = blockIdx.x; job < nkt * nnt; job += gridDim.x) {
    const int kt = job % nkt, ntile = job / nkt;
    const int k0 = kt * 64, n0 = ntile * 64;
    __syncthreads();
#pragma unroll
    for (int i = 0; i < 2; ++i) {
      const int k = (tid >> 4) + 32 * i, nq = (tid & 15) * 4, n = n0 + nq;
      f32x4 v = {0.f, 0.f, 0.f, 0.f};
      if (n < N) {
        v = *(const f32x4*)(W + (size_t)(k0 + k) * N + n);
        if (g) v = v * g[k0 + k];
      }
      tile[k * 65 + nq + 0] = v[0];
      tile[k * 65 + nq + 1] = v[1];
      tile[k * 65 + nq + 2] = v[2];
      tile[k * 65 + nq + 3] = v[3];
    }
    __syncthreads();
    {
      const int c = tid, n = c >> 3, kc = c & 7;
      float e[8];
#pragma unroll
      for (int q = 0; q < 8; ++q) e[q] = tile[(kc * 8 + q) * 65 + n];
      u32x4 w;
      w.x = cvt_pk_bf16(e[0], e[1]);
      w.y = cvt_pk_bf16(e[2], e[3]);
      w.z = cvt_pk_bf16(e[4], e[5]);
      w.w = cvt_pk_bf16(e[6], e[7]);
      const int nn = n0 + n;
      int dest = nn;
      if (mode == 1) dest = 32 * (nn >> 4) + (nn & 15);
      if (mode == 2) dest = 32 * (nn >> 4) + 16 + (nn & 15);
      *(u32x4*)(Bt + (size_t)dest * K + k0 + kc * 8) = w;
    }
  }
}

__device__ void filt_mlp(const P& p, int l, char* smem) {
  float* zf = (float*)smem;
  float* h1 = zf + 16 * 17;
  float* h2 = h1 + 64 * 16;
  int tid_ = threadIdx.x;
  asm volatile("" : "+v"(tid_));
  const int tid = tid_, tl = tid & 15, kk = tid >> 4;
  const float* w1 = p.fw1 + l * 17 * 64;
  const float* b1 = p.fb1 + l * 64;
  const float* f1 = p.ff1 + l * 64;
  const float* w2 = p.fw2 + l * 64 * 64;
  const float* b2 = p.fb2 + l * 64;
  const float* f2 = p.ff2 + l * 64;
  const float* w3 = p.fw3 + (size_t)l * 64 * 1536;
  for (int job = blockIdx.x; job < 256; job += gridDim.x) {
    const int t0 = job * 16;
    __syncthreads();
    {
      const int t = t0 + tl;
      if (kk < 8) {
        const float band = 1e-4f + (float)kk * ((7.0f - 1e-4f) / 7.0f);
        const float ang = ((6.283185307179586f * (float)t) * band) / 4096.0f;
        float s, c;
        fast_sincos_rev(ang * 0.15915494309189535f, &s, &c);
        zf[tl * 17 + 1 + kk] = c;
        zf[tl * 17 + 9 + kk] = s;
      } else if (kk == 8) {
        zf[tl * 17] = (float)t / 4095.0f;
      }
    }
    __syncthreads();
#pragma unroll
    for (int m = 0; m < 2; ++m) {
      const int j = kk + 32 * m;
      float a = b1[j];
#pragma unroll 1
      for (int f = 0; f < 17; ++f) a += zf[tl * 17 + f] * w1[f * 64 + j];
      h1[j * 16 + tl] = fast_sin(f1[j] * a);
    }
    __syncthreads();
#pragma unroll
    for (int m = 0; m < 2; ++m) {
      const int j = kk + 32 * m;
      float a = b2[j];
#pragma unroll 16
      for (int i = 0; i < 64; ++i) a += h1[i * 16 + tl] * w2[i * 64 + j];
      h2[j * 16 + tl] = fast_sin(f2[j] * a);
    }
    __syncthreads();
#pragma unroll 1
    for (int mm = 0; mm < 3; ++mm) {
      const int col = tid + 512 * mm;
      float acc[16];
#pragma unroll
      for (int q = 0; q < 16; ++q) acc[q] = 0.f;
#pragma unroll 1
      for (int j0 = 0; j0 < 64; j0 += 8) {
        float wv[8];
#pragma unroll
        for (int q = 0; q < 8; ++q) wv[q] = w3[(size_t)(j0 + q) * 1536 + col];
#pragma unroll
        for (int q = 0; q < 8; ++q) {
          const float w = wv[q];
          const f32x4* hp = (const f32x4*)(h2 + (j0 + q) * 16);
          const f32x4 a0 = hp[0], a1 = hp[1], a2 = hp[2], a3 = hp[3];
          acc[0] += a0[0] * w; acc[1] += a0[1] * w; acc[2] += a0[2] * w; acc[3] += a0[3] * w;
          acc[4] += a1[0] * w; acc[5] += a1[1] * w; acc[6] += a1[2] * w; acc[7] += a1[3] * w;
          acc[8] += a2[0] * w; acc[9] += a2[1] * w; acc[10] += a2[2] * w; acc[11] += a2[3] * w;
          acc[12] += a3[0] * w; acc[13] += a3[1] * w; acc[14] += a3[2] * w; acc[15] += a3[3] * w;
        }
      }
      const int c = col % 384;
      const float lo = -3.0701134573253945f, hi = -15.350567286626972f;
      const float delta = fabsf(lo + (hi - lo) * ((float)c / 383.0f));
      float* dst = p.filtT + (size_t)col * 4096 + t0;
#pragma unroll
      for (int q = 0; q < 16; ++q) {
        const float tn = (float)(t0 + q) / 4095.0f;
        dst[q] = acc[q] * __expf(-tn * delta);
      }
    }
  }
}

__device__ void prep_phase(const P& p, int l, char* smem) {
  for (int w = 0; w < 7; ++w) {
    const float* W; const float* g; bf16_t* Bt; int K, N, Npad, mode = 0;
    switch (w) {
      case 0: W = p.w_in + (size_t)l * 1024 * 2336; K = 1024; N = 2336; Npad = 2560; g = p.norm1_g + l * 1024; Bt = p.Win; break;
      case 1: W = p.w_uq + (size_t)l * 256 * 576; K = 256; N = 576; Npad = 768; g = p.q_norm_g + l * 256; Bt = p.Wuq; break;
      case 2: W = p.w_ukv + (size_t)l * 128 * 768; K = 128; N = 768; Npad = 768; g = p.kv_norm_g + l * 128; Bt = p.Wukv; break;
      case 3: W = p.w_out + (size_t)l * 1024 * 1024; K = 1024; N = 1024; Npad = 1024; g = p.mix_g + l * 1024; Bt = p.Wout; break;
      case 4: W = p.w_gate + (size_t)l * 1024 * 2816; K = 1024; N = 2816; Npad = 2816; g = p.norm2_g + l * 1024; Bt = p.Wgu; mode = 1; break;
      case 5: W = p.w_up + (size_t)l * 1024 * 2816; K = 1024; N = 2816; Npad = 2816; g = p.norm2_g + l * 1024; Bt = p.Wgu; mode = 2; break;
      default: W = p.w_down + (size_t)l * 2816 * 1024; K = 2816; N = 1024; Npad = 1024; g = nullptr; Bt = p.Wdown; break;
    }
    conv_w(W, K, N, Npad, g, Bt, mode, smem);
  }
  filt_mlp(p, l, smem);
  if (l == 0) {
    int tid_ = threadIdx.x;
  asm volatile("" : "+v"(tid_));
  const int tid = tid_, lane = tid & 63, wave = tid >> 6;
    for (int row = blockIdx.x * 8 + wave; row < NTOK; row += gridDim.x * 8) {
      const float* xr = p.x + (size_t)row * 1024;
      bf16_t* xo = p.xb + (size_t)row * 1024;
      float s = 0.f;
#pragma unroll
      for (int i = 0; i < 4; ++i) {
        const f32x4 v = *(const f32x4*)(xr + lane * 4 + 256 * i);
        s += v[0] * v[0] + v[1] * v[1] + v[2] * v[2] + v[3] * v[3];
        u32x2 w;
        w.x = cvt_pk_bf16(v[0], v[1]);
        w.y = cvt_pk_bf16(v[2], v[3]);
        *(u32x2*)(xo + lane * 4 + 256 * i) = w;
      }
#pragma unroll
      for (int o = 1; o < 64; o <<= 1) s += __shfl_xor(s, o);
      if (lane < 16) p.part_x[(size_t)row * 16 + lane] = (lane == 0) ? s : 0.f;
    }
    for (int i = blockIdx.x * 512 + tid; i < 65536 + 8192; i += gridDim.x * 512) {
      if (i < 65536) {
        const int pos = i >> 4, k = i & 15;
        const float ang = (float)pos * __builtin_amdgcn_exp2f(-(float)k * 0.8304820237218405f);
        float s, c;
        fast_sincos_rev(ang * 0.15915494309189535f, &s, &c);
        p.ropecs[i] = make_float2(c, s);
      } else {
        const int k = i - 65536;
        const int ms = 1 << (31 - __clz(k + 1));
        const int pp = k + 1 - ms;
        float s, c;
        fast_sincos_rev((float)pp / (float)(2 * ms), &s, &c);
        p.tw[k] = make_float2(c, -s);
      }
    }
  }
}

template <int LOGR, int MTOP, bool INV, bool ZIN = false, bool HOUT = false>
__device__ __forceinline__ void fft_pass(float2* sm, const float2* tw) {
  constexpr int R = 1 << LOGR;
  constexpr int q = MTOP >> (LOGR - 1);
  constexpr int ntask = 8192 / R;
  for (int T = threadIdx.x; T < ntask; T += NTHREADS) {
    const int i = T & (q - 1);
    const int blk = T / q;
    const int base = blk * (2 * MTOP) + i;
    float2 v[R];
#pragma unroll
    for (int e = 0; e < R; ++e) {
      if (ZIN && e >= R / 2) v[e] = make_float2(0.f, 0.f);
      else v[e] = sm[PADI(base + e * q)];
    }
    if (!INV) {
#pragma unroll
      for (int s = 0; s < LOGR; ++s) {
        constexpr int dummy = 0;
        (void)dummy;
        const int hs = 1 << (LOGR - 1 - s);
        const int ms = MTOP >> s;
#pragma unroll
        for (int e = 0; e < R; ++e) {
          if ((e & hs) == 0) {
            const int pp = i + (e & (hs - 1)) * q;
            const float2 w = tw[(ms - 1) + pp];
            const float2 a = v[e], b = v[e + hs];
            v[e] = make_float2(a.x + b.x, a.y + b.y);
            const float dx = a.x - b.x, dy = a.y - b.y;
            v[e + hs] = make_float2(dx * w.x - dy * w.y, dx * w.y + dy * w.x);
          }
        }
      }
    } else {
#pragma unroll
      for (int s = LOGR - 1; s >= 0; --s) {
        const int hs = 1 << (LOGR - 1 - s);
        const int ms = MTOP >> s;
#pragma unroll
        for (int e = 0; e < R; ++e) {
          if ((e & hs) == 0) {
            const int pp = i + (e & (hs - 1)) * q;
            const float2 w = tw[(ms - 1) + pp];
            const float2 a = v[e], b = v[e + hs];
            const float tx = b.x * w.x + b.y * w.y, ty = b.y * w.x - b.x * w.y;
            v[e] = make_float2(a.x + tx, a.y + ty);
            v[e + hs] = make_float2(a.x - tx, a.y - ty);
          }
        }
      }
    }
#pragma unroll
    for (int e = 0; e < R; ++e) {
      if (HOUT && e >= R / 2) continue;
      sm[PADI(base + e * q)] = v[e];
    }
  }
  __syncthreads();
}

__device__ __forceinline__ void fft_fwd(float2* sm, const float2* tw) {
  fft_pass<4, 4096, false>(sm, tw);
  fft_pass<4, 256, false>(sm, tw);
  fft_pass<4, 16, false>(sm, tw);
  fft_pass<1, 1, false>(sm, tw);
}
__device__ __forceinline__ void fft_inv(float2* sm, const float2* tw) {
  fft_pass<1, 1, true>(sm, tw);
  fft_pass<3, 8, true>(sm, tw);
  fft_pass<3, 64, true>(sm, tw);
  fft_pass<3, 512, true>(sm, tw);
  fft_pass<3, 4096, true>(sm, tw);
}

__device__ void filt_fft_phase(const P& p, int l, char* smem) {
  float2* sm = (float2*)smem;
  float2* tws = (float2*)(smem + TW_LDS_OFF);
  int tid_ = threadIdx.x;
  asm volatile("" : "+v"(tid_));
  const int tid = tid_;
  for (int i = tid; i < 8192; i += NTHREADS) tws[i] = p.tw[i];
  for (int jj = blockIdx.x; jj < 384; jj += gridDim.x) {
    const int o = jj / 192, c = jj % 192;
    const int jobF = o * 384 + c, jobG = jobF + 192;
    const float* hf1 = p.filtT + ((size_t)((o * 2 + 0) * 384 + c)) * 4096;
    const float* hb1 = p.filtT + ((size_t)((o * 2 + 1) * 384 + c)) * 4096;
    const float* hf2 = hf1 + (size_t)192 * 4096;
    const float* hb2 = hb1 + (size_t)192 * 4096;
    const float sk1 = p.skip[(l * 2 + o) * 384 + c], sk2 = p.skip[(l * 2 + o) * 384 + c + 192];
    __syncthreads();
    for (int n = tid; n < 8192; n += NTHREADS) {
      float v1, v2;
      if (n == 0) { v1 = hf1[0] + hb1[0] + sk1; v2 = hf2[0] + hb2[0] + sk2; }
      else if (n < 4096) { v1 = hf1[n]; v2 = hf2[n]; }
      else if (n == 4096) { v1 = 0.f; v2 = 0.f; }
      else { v1 = hb1[8192 - n]; v2 = hb2[8192 - n]; }
      sm[PADI(n)] = make_float2(v1, v2);
    }
    __syncthreads();
    fft_fwd(sm, tws);
    float2* dF = p.H2 + (size_t)jobF * 8192;
    float2* dG = p.H2 + (size_t)jobG * 8192;
    const float sc = 0.5f / 8192.0f;
    for (int n = tid; n < 8192; n += NTHREADS) {
      const int k = (int)(__brev((unsigned)n) >> 19);
      const int np = (int)(__brev((unsigned)((8192 - k) & 8191)) >> 19);
      const float2 a = sm[PADI(n)], b = sm[PADI(np)];
      dF[n] = make_float2((a.x + b.x) * sc, (a.y - b.y) * sc);
      dG[n] = make_float2((a.y + b.y) * sc, (b.x - a.x) * sc);
    }
  }
}

__device__ __forceinline__ float short_conv(const bf16_t* row, int t, float w0, float w1, float w2, float bias) {
  const float xm = (t > 0) ? bf2f(row[t - 1]) : 0.f;
  const float x0 = bf2f(row[t]);
  const float xp = (t < SEQ - 1) ? bf2f(row[t + 1]) : 0.f;
  return w0 * xm + w1 * x0 + w2 * xp + bias;
}

__device__ __forceinline__ void conv8(const bf16_t* row, int t0, float w0, float w1, float w2, float bias, float (&out)[8]) {
  const u32x4 v = *(const u32x4*)(row + t0);
  float x[10];
  x[0] = (t0 > 0) ? bf2f(row[t0 - 1]) : 0.f;
  x[1] = bflo(v.x); x[2] = bfhi(v.x); x[3] = bflo(v.y); x[4] = bfhi(v.y);
  x[5] = bflo(v.z); x[6] = bfhi(v.z); x[7] = bflo(v.w); x[8] = bfhi(v.w);
  x[9] = (t0 + 8 < SEQ) ? bf2f(row[t0 + 8]) : 0.f;
#pragma unroll
  for (int k = 0; k < 8; ++k) out[k] = w0 * x[k] + w1 * x[k + 1] + w2 * x[k + 2] + bias;
}

struct RawRow { u32x4 v; float lo, hi; };
__device__ __forceinline__ RawRow load_raw(const bf16_t* row, int t0) {
  RawRow r;
  r.v = *(const u32x4*)(row + t0);
  r.lo = (t0 > 0) ? bf2f(row[t0 - 1]) : 0.f;
  r.hi = (t0 + 8 < SEQ) ? bf2f(row[t0 + 8]) : 0.f;
  return r;
}
__device__ __forceinline__ void conv8_raw(const RawRow& r, float w0, float w1, float w2, float bias, float (&out)[8]) {
  float x[10];
  x[0] = r.lo;
  x[1] = bflo(r.v.x); x[2] = bfhi(r.v.x); x[3] = bflo(r.v.y); x[4] = bfhi(r.v.y);
  x[5] = bflo(r.v.z); x[6] = bfhi(r.v.z); x[7] = bflo(r.v.w); x[8] = bfhi(r.v.w);
  x[9] = r.hi;
#pragma unroll
  for (int k = 0; k < 8; ++k) out[k] = w0 * x[k] + w1 * x[k + 1] + w2 * x[k + 2] + bias;
}

__device__ __forceinline__ void fft_mid(float2* sm, const f32x4 (&hpre)[8]) {
#pragma unroll
  for (int it = 0; it < 8; ++it) {
    const int T = threadIdx.x + it * NTHREADS;
    const float2 a = sm[PADI(2 * T)], b = sm[PADI(2 * T + 1)];
    const f32x4 h = hpre[it];
    const float sx = a.x + b.x, sy = a.y + b.y, dx = a.x - b.x, dy = a.y - b.y;
    const float Ax = sx * h[0] - sy * h[1], Ay = sx * h[1] + sy * h[0];
    const float Bx = dx * h[2] - dy * h[3], By = dx * h[3] + dy * h[2];
    sm[PADI(2 * T)] = make_float2(Ax + Bx, Ay + By);
    sm[PADI(2 * T + 1)] = make_float2(Ax - Bx, Ay - By);
  }
  __syncthreads();
}

template <int ORD>
__device__ void hyena_phase(const P& p, int l, char* smem) {
  float2* sm = (float2*)smem;
  float2* tws = (float2*)(smem + TW_LDS_OFF);
  int tid_ = threadIdx.x;
  asm volatile("" : "+v"(tid_));
  const int tid = tid_;
  for (int i = tid; i < 8192; i += NTHREADS) tws[i] = p.tw[i];
  const float* cw = p.conv_w + (size_t)l * 3 * 1152;
  const float* cb = p.conv_b + (size_t)l * 1152;
  const int t0 = tid * 8;
  for (int job = vblock(); job < 1536; job += gridDim.x) {
    const int pair = job & 3, c = job >> 2;
    const int b1 = pair * 2, b2 = b1 + 1;
    const int gc = (ORD == 0 ? 384 : 768) + c;
    const RawRow gr1 = load_raw(p.hyT + ((size_t)(b1 * 1152 + gc)) * 4096, t0);
    const RawRow gr2 = load_raw(p.hyT + ((size_t)(b2 * 1152 + gc)) * 4096, t0);
    __syncthreads();
    {
      float u1[8], u2[8];
      if (ORD == 0) {
        const bf16_t* r1 = p.hyT + ((size_t)(b1 * 1152 + c)) * 4096;
        const bf16_t* r2 = p.hyT + ((size_t)(b2 * 1152 + c)) * 4096;
        const float w0 = cw[c], w1 = cw[1152 + c], w2 = cw[2304 + c], bi = cb[c];
        conv8(r1, t0, w0, w1, w2, bi, u1);
        conv8(r2, t0, w0, w1, w2, bi, u2);
      } else {
        const u32x4 a0 = *(const u32x4*)(p.z1T + ((size_t)(b1 * 384 + c)) * 4096 + t0);
        const u32x4 c0_ = *(const u32x4*)(p.z1T + ((size_t)(b2 * 384 + c)) * 4096 + t0);
        u1[0] = bflo(a0.x); u1[1] = bfhi(a0.x); u1[2] = bflo(a0.y); u1[3] = bfhi(a0.y); u1[4] = bflo(a0.z); u1[5] = bfhi(a0.z); u1[6] = bflo(a0.w); u1[7] = bfhi(a0.w);
        u2[0] = bflo(c0_.x); u2[1] = bfhi(c0_.x); u2[2] = bflo(c0_.y); u2[3] = bfhi(c0_.y); u2[4] = bflo(c0_.z); u2[5] = bfhi(c0_.z); u2[6] = bflo(c0_.w); u2[7] = bfhi(c0_.w);
      }
#pragma unroll
      for (int k = 0; k < 8; ++k) {
        sm[PADI(t0 + k)] = make_float2(u1[k], u2[k]);
      }
    }
    __syncthreads();
    fft_pass<4, 4096, false, true, false>(sm, tws);
    fft_pass<4, 256, false>(sm, tws);
    f32x4 hpre[8];
    {
      const float2* H = p.H2 + ((size_t)(ORD * 384 + c)) * 8192;
#pragma unroll
      for (int it = 0; it < 8; ++it) hpre[it] = *(const f32x4*)(H + 2 * (tid + it * NTHREADS));
    }
    fft_pass<4, 16, false>(sm, tws);
    fft_mid(sm, hpre);
    fft_pass<4, 16, true>(sm, tws);
    fft_pass<4, 256, true>(sm, tws);
    fft_pass<4, 4096, true, false, true>(sm, tws);
    {
      const float w0 = cw[gc], w1 = cw[1152 + gc], w2 = cw[2304 + gc], bi = cb[gc];
      float q1[8], q2[8];
      conv8_raw(gr1, w0, w1, w2, bi, q1);
      conv8_raw(gr2, w0, w1, w2, bi, q2);
#pragma unroll
      for (int k = 0; k < 8; ++k) {
        const float2 yv = sm[PADI(t0 + k)];
        q1[k] *= yv.x;
        q2[k] *= yv.y;
      }
      {
        bf16_t* dbase = (ORD == 0) ? p.z1T : p.ybT;
        u32x4 w1_, w2_;
        w1_.x = cvt_pk_bf16(q1[0], q1[1]); w1_.y = cvt_pk_bf16(q1[2], q1[3]); w1_.z = cvt_pk_bf16(q1[4], q1[5]); w1_.w = cvt_pk_bf16(q1[6], q1[7]);
        w2_.x = cvt_pk_bf16(q2[0], q2[1]); w2_.y = cvt_pk_bf16(q2[2], q2[3]); w2_.z = cvt_pk_bf16(q2[4], q2[5]); w2_.w = cvt_pk_bf16(q2[6], q2[7]);
        *(u32x4*)(dbase + ((size_t)(b1 * 384 + c)) * 4096 + t0) = w1_;
        *(u32x4*)(dbase + ((size_t)(b2 * 384 + c)) * 4096 + t0) = w2_;
      }
    }
  }
}

constexpr int KROW = 208;
constexpr int VROW = 136;
constexpr int KBUF = 64 * KROW, VBUF = 64 * VROW;

constexpr int NK_ROW = 528;
constexpr int NK_BUF = 32 * NK_ROW;
constexpr int NV_ROW = 72;
constexpr int NV_BUF = 256 * NV_ROW;
constexpr int NRPB_OFF = 2 * NK_BUF + 2 * NV_BUF;

__device__ void natten_phase(const P& p, int l, char* smem) {
  int tid_ = threadIdx.x;
  asm volatile("" : "+v"(tid_));
  const int tid = tid_, lane = tid & 63, wave = tid >> 6, l15 = lane & 15, g = lane >> 4;
  const int hw = wave >> 1, qh = wave & 1;
  char* Ks = smem;
  char* Vs = smem + 2 * NK_BUF;
  float* rp = (float*)(smem + NRPB_OFF);
  __syncthreads();
  for (int i = tid; i < 4 * 15 * 31; i += NTHREADS) rp[i] = p.rpb[(size_t)l * 4 * 15 * 31 + i] * 1.4426950408889634f;
  const float qscale = 0.125f * 1.4426950408889634f;
  for (int job = blockIdx.x; job < 512; job += gridDim.x) {
    const int r = job & 63, b = job >> 6;
    const int r0 = min(max(r - 4, 0), 56);
    bf16x8 qf[2][2];
    int cq[2], c0[2];
#pragma unroll
    for (int nt = 0; nt < 2; ++nt) {
      cq[nt] = qh * 32 + nt * 16 + l15;
      c0[nt] = min(max(cq[nt] - 8, 0), 48);
      const bf16_t* qp = p.na + (size_t)(b * 4096 + r * 64 + cq[nt]) * 768 + hw * 64;
#pragma unroll
      for (int ks = 0; ks < 2; ++ks) qf[nt][ks] = *(const bf16x8*)(qp + ks * 32 + g * 8);
    }
    f32x4 o[4][2];
#pragma unroll
    for (int a = 0; a < 4; ++a)
#pragma unroll
      for (int n = 0; n < 2; ++n) o[a][n] = (f32x4){0.f, 0.f, 0.f, 0.f};
    float mrow[2] = {-1e30f, -1e30f}, lrow[2] = {0.f, 0.f};
    u32x4 rk[2], rv[2];
    auto gload = [&](int t) {
      const int kr = r0 + (t >> 1), kh = (t & 1) * 32;
      const bf16_t* kbase = p.na + (size_t)(b * 4096 + kr * 64 + kh) * 768 + 256;
#pragma unroll
      for (int i = 0; i < 2; ++i) {
        const int c = tid + 512 * i, key = c >> 5, cc = c & 31;
        rk[i] = *(const u32x4*)(kbase + (size_t)key * 768 + cc * 8);
      }
#pragma unroll
      for (int i = 0; i < 2; ++i) {
        const int c = tid + 512 * i, row = c >> 2, cc = c & 3;
        rv[i] = *(const u32x4*)(p.naVT + ((size_t)(b * 256 + row)) * 4096 + kr * 64 + kh + cc * 8);
      }
    };
    auto lstore = [&](int buf) {
      char* kb_ = Ks + buf * NK_BUF;
      char* vb_ = Vs + buf * NV_BUF;
#pragma unroll
      for (int i = 0; i < 2; ++i) {
        const int c = tid + 512 * i, key = c >> 5, cc = c & 31;
        *(u32x4*)(kb_ + key * NK_ROW + cc * 16) = rk[i];
      }
#pragma unroll
      for (int i = 0; i < 2; ++i) {
        const int c = tid + 512 * i, row = c >> 2, cc = c & 3;
        u32x2 lo, hi;
        lo.x = rv[i].x; lo.y = rv[i].y; hi.x = rv[i].z; hi.y = rv[i].w;
        *(u32x2*)(vb_ + row * NV_ROW + cc * 16) = lo;
        *(u32x2*)(vb_ + row * NV_ROW + cc * 16 + 8) = hi;
      }
    };
    gload(0);
    __syncthreads();
    lstore(0);
    __syncthreads();
    for (int t = 0; t < 16; ++t) {
      if (t + 1 < 16) gload(t + 1);
      __builtin_amdgcn_sched_barrier(0);
      const char* kb_ = Ks + (t & 1) * NK_BUF;
      const char* vb_ = Vs + (t & 1) * NV_BUF + hw * 64 * NV_ROW;
      const int kh = (t & 1) * 32;
      f32x4 s[2][2];
#pragma unroll
      for (int a = 0; a < 2; ++a)
#pragma unroll
        for (int n = 0; n < 2; ++n) s[a][n] = (f32x4){0.f, 0.f, 0.f, 0.f};
#pragma unroll
      for (int mt = 0; mt < 2; ++mt)
#pragma unroll
        for (int ks = 0; ks < 2; ++ks) {
          const bf16x8 kf = *(const bf16x8*)(kb_ + (mt * 16 + l15) * NK_ROW + hw * 128 + ks * 64 + g * 16);
#pragma unroll
          for (int nt = 0; nt < 2; ++nt)
            s[mt][nt] = __builtin_amdgcn_mfma_f32_16x16x32_bf16(kf, qf[nt][ks], s[mt][nt], 0, 0, 0);
        }
      const float* brow = rp + (hw * 15 + (r0 + (t >> 1) - r + 7)) * 31;
      bf16x8 pf[2];
#pragma unroll
      for (int nt = 0; nt < 2; ++nt) {
        float mx = -1e30f;
#pragma unroll
        for (int mt = 0; mt < 2; ++mt)
#pragma unroll
          for (int j = 0; j < 4; ++j) {
            const int kc = kh + mt * 16 + g * 4 + j;
            const bool valid = (unsigned)(kc - c0[nt]) < 16u;
            const int dc = min(max(kc - cq[nt] + 15, 0), 30);
            const float sc = valid ? (s[mt][nt][j] * qscale + brow[dc]) : -1e30f;
            s[mt][nt][j] = sc;
            mx = fmaxf(mx, sc);
          }
        mx = fmaxf(mx, __shfl_xor(mx, 16));
        mx = fmaxf(mx, __shfl_xor(mx, 32));
        const float mnew = fmaxf(mrow[nt], mx);
        const float alpha = __builtin_amdgcn_exp2f(mrow[nt] - mnew);
        mrow[nt] = mnew;
        float ls = 0.f;
#pragma unroll
        for (int mt = 0; mt < 2; ++mt)
#pragma unroll
          for (int j = 0; j < 4; ++j) {
            const float e = (s[mt][nt][j] > -1e29f) ? __builtin_amdgcn_exp2f(s[mt][nt][j] - mnew) : 0.f;
            s[mt][nt][j] = e;
            ls += e;
          }
        lrow[nt] = lrow[nt] * alpha + ls;
#pragma unroll
        for (int a = 0; a < 4; ++a) o[a][nt] *= alpha;
        u32x4 w;
        w.x = cvt_pk_bf16(s[0][nt][0], s[0][nt][1]);
        w.y = cvt_pk_bf16(s[0][nt][2], s[0][nt][3]);
        w.z = cvt_pk_bf16(s[1][nt][0], s[1][nt][1]);
        w.w = cvt_pk_bf16(s[1][nt][2], s[1][nt][3]);
        pf[nt] = __builtin_bit_cast(bf16x8, w);
      }
#pragma unroll
      for (int mt = 0; mt < 4; ++mt) {
        const u32x2 lo = *(const u32x2*)(vb_ + (mt * 16 + l15) * NV_ROW + (4 * g) * 2);
        const u32x2 hi = *(const u32x2*)(vb_ + (mt * 16 + l15) * NV_ROW + (16 + 4 * g) * 2);
        u32x4 w;
        w.x = lo.x; w.y = lo.y; w.z = hi.x; w.w = hi.y;
        const bf16x8 vf = __builtin_bit_cast(bf16x8, w);
#pragma unroll
        for (int nt = 0; nt < 2; ++nt)
          o[mt][nt] = __builtin_amdgcn_mfma_f32_16x16x32_bf16(vf, pf[nt], o[mt][nt], 0, 0, 0);
      }
      if (t + 1 < 16) lstore((t + 1) & 1);
      __syncthreads();
    }
#pragma unroll
    for (int nt = 0; nt < 2; ++nt) {
      float lt = lrow[nt];
      lt += __shfl_xor(lt, 16);
      lt += __shfl_xor(lt, 32);
      const float inv = 1.0f / lt;
      const int tok = b * 4096 + r * 64 + cq[nt];
#pragma unroll
      for (int mt = 0; mt < 4; ++mt) {
        u32x2 w;
        w.x = cvt_pk_bf16(o[mt][nt][0] * inv, o[mt][nt][1] * inv);
        w.y = cvt_pk_bf16(o[mt][nt][2] * inv, o[mt][nt][3] * inv);
        *(u32x2*)(p.o_c + (size_t)tok * 256 + hw * 64 + mt * 16 + g * 4) = w;
      }
    }
  }
}


__device__ void attn_phase(const P& p, char* smem) {
  int tid_ = threadIdx.x;
  asm volatile("" : "+v"(tid_));
  const int tid = tid_, lane = tid & 63, wave = tid >> 6, l15 = lane & 15, g = lane >> 4;
  char* Ks = smem;
  char* Vs = smem + 2 * KBUF;
  for (int job = vblock(); job < 768; job += gridDim.x) {
    const int qblk = job & 15, bh = job >> 4;
    const int b = bh / 6, h = bh % 6;
    const bf16_t* Q = p.qb + (size_t)bh * 4096 * 96;
    const bf16_t* Kg = p.kb + (size_t)bh * 4096 * 96;
    const bf16_t* Vt = p.vT + (size_t)bh * 64 * 4096;
    const int q0 = qblk * 256 + wave * 32;
    bf16x8 qf[2][3];
#pragma unroll
    for (int nt = 0; nt < 2; ++nt)
#pragma unroll
      for (int ks = 0; ks < 3; ++ks)
        qf[nt][ks] = *(const bf16x8*)(Q + (size_t)(q0 + nt * 16 + l15) * 96 + ks * 32 + g * 8);
    f32x4 o[4][2];
#pragma unroll
    for (int a = 0; a < 4; ++a)
#pragma unroll
      for (int n = 0; n < 2; ++n) o[a][n] = (f32x4){0.f, 0.f, 0.f, 0.f};
    float mrow[2] = {-1e30f, -1e30f}, lrow[2] = {0.f, 0.f};

    u32x4 rk[2];
    u32x4 rv;
    const int kr1 = (tid + 512) / 12, kc1 = (tid + 512) - kr1 * 12;
    const int kr0 = tid / 12, kc0 = tid - kr0 * 12;
    auto gload = [&](int kt) {
      const u32x4* kp = (const u32x4*)(Kg + (size_t)kt * 64 * 96);
      rk[0] = kp[tid];
      if (tid < 256) rk[1] = kp[tid + 512];
      rv = *(const u32x4*)(Vt + (size_t)(tid >> 3) * 4096 + kt * 64 + (tid & 7) * 8);
    };
    auto lstore = [&](int buf) {
      char* kb_ = Ks + buf * KBUF;
      char* vb_ = Vs + buf * VBUF;
      *(u32x4*)(kb_ + kr0 * KROW + kc0 * 16) = rk[0];
      if (tid < 256) *(u32x4*)(kb_ + kr1 * KROW + kc1 * 16) = rk[1];
      u32x2 lo, hi;
      lo.x = rv.x; lo.y = rv.y; hi.x = rv.z; hi.y = rv.w;
      *(u32x2*)(vb_ + (tid >> 3) * VROW + (tid & 7) * 16) = lo;
      *(u32x2*)(vb_ + (tid >> 3) * VROW + (tid & 7) * 16 + 8) = hi;
    };
    const int NKT = 64;
    gload(0);
    __syncthreads();
    lstore(0);
    gload(1);
    for (int kt = 0; kt < NKT; ++kt) {
      __syncthreads();
      if (kt + 1 < NKT) {
        lstore((kt + 1) & 1);
        if (kt + 2 < NKT) gload(kt + 2);
      }
      __builtin_amdgcn_sched_barrier(0);
      const char* kb_ = Ks + (kt & 1) * KBUF;
      const char* vb_ = Vs + (kt & 1) * VBUF;
      f32x4 s[4][2];
#pragma unroll
      for (int a = 0; a < 4; ++a)
#pragma unroll
        for (int n = 0; n < 2; ++n) s[a][n] = (f32x4){0.f, 0.f, 0.f, 0.f};
#pragma unroll
      for (int mt = 0; mt < 4; ++mt)
#pragma unroll
        for (int ks = 0; ks < 3; ++ks) {
          const bf16x8 kf = *(const bf16x8*)(kb_ + (mt * 16 + l15) * KROW + (ks * 32 + g * 8) * 2);
#pragma unroll
          for (int nt = 0; nt < 2; ++nt)
            s[mt][nt] = __builtin_amdgcn_mfma_f32_16x16x32_bf16(kf, qf[nt][ks], s[mt][nt], 0, 0, 0);
        }
      bf16x8 pf[2][2];
#pragma unroll
      for (int nt = 0; nt < 2; ++nt) {
        float mx = s[0][nt][0];
#pragma unroll
        for (int mt = 0; mt < 4; ++mt)
#pragma unroll
          for (int j = 0; j < 4; ++j) mx = fmaxf(mx, s[mt][nt][j]);
        mx = fmaxf(mx, __shfl_xor(mx, 16));
        mx = fmaxf(mx, __shfl_xor(mx, 32));
        if (__any(mx > mrow[nt] + 8.0f)) {
          const float mnew = fmaxf(mrow[nt], mx);
          const float alpha = __builtin_amdgcn_exp2f(mrow[nt] - mnew);
          mrow[nt] = mnew;
          lrow[nt] *= alpha;
#pragma unroll
          for (int a = 0; a < 4; ++a) o[a][nt] *= alpha;
        }
        const float mref = mrow[nt];
        float ls = 0.f;
#pragma unroll
        for (int mt = 0; mt < 4; ++mt)
#pragma unroll
          for (int j = 0; j < 4; ++j) {
            const float e = __builtin_amdgcn_exp2f(s[mt][nt][j] - mref);
            s[mt][nt][j] = e;
            ls += e;
          }
        lrow[nt] += ls;
#pragma unroll
        for (int kk = 0; kk < 2; ++kk) {
          u32x4 w;
          w.x = cvt_pk_bf16(s[2 * kk][nt][0], s[2 * kk][nt][1]);
          w.y = cvt_pk_bf16(s[2 * kk][nt][2], s[2 * kk][nt][3]);
          w.z = cvt_pk_bf16(s[2 * kk + 1][nt][0], s[2 * kk + 1][nt][1]);
          w.w = cvt_pk_bf16(s[2 * kk + 1][nt][2], s[2 * kk + 1][nt][3]);
          pf[kk][nt] = __builtin_bit_cast(bf16x8, w);
        }
      }
#pragma unroll
      for (int kk = 0; kk < 2; ++kk)
#pragma unroll
        for (int mt = 0; mt < 4; ++mt) {
          const u32x2 lo = *(const u32x2*)(vb_ + (mt * 16 + l15) * VROW + (32 * kk + 4 * g) * 2);
          const u32x2 hi = *(const u32x2*)(vb_ + (mt * 16 + l15) * VROW + (32 * kk + 16 + 4 * g) * 2);
          u32x4 w;
          w.x = lo.x; w.y = lo.y; w.z = hi.x; w.w = hi.y;
          const bf16x8 vf = __builtin_bit_cast(bf16x8, w);
#pragma unroll
          for (int nt = 0; nt < 2; ++nt)
            o[mt][nt] = __builtin_amdgcn_mfma_f32_16x16x32_bf16(vf, pf[kk][nt], o[mt][nt], 0, 0, 0);
        }
    }
#pragma unroll
    for (int nt = 0; nt < 2; ++nt) {
      float lt = lrow[nt];
      lt += __shfl_xor(lt, 16);
      lt += __shfl_xor(lt, 32);
      const float inv = 1.0f / lt;
      const int tok = b * 4096 + q0 + nt * 16 + l15;
#pragma unroll
      for (int mt = 0; mt < 4; ++mt) {
        u32x2 w;
        w.x = cvt_pk_bf16(o[mt][nt][0] * inv, o[mt][nt][1] * inv);
        w.y = cvt_pk_bf16(o[mt][nt][2] * inv, o[mt][nt][3] * inv);
        *(u32x2*)(p.o_a + (size_t)tok * 384 + h * 64 + mt * 16 + g * 4) = w;
      }
    }
  }
}

__device__ void mixnorm_phase(const P& p, char* smem) {
  int tid_ = threadIdx.x;
  asm volatile("" : "+v"(tid_));
  const int tid = tid_;
  for (int job = blockIdx.x; job < NTOK / 32; job += gridDim.x) {
    const int tok0 = job * 32, b = tok0 >> 12, s0 = tok0 & 4095;
    __syncthreads();
#pragma unroll
    for (int i = 0; i < 3; ++i) {
      const int c = tid + 512 * i, row = c / 48, cc = c % 48;
      *(u32x4*)(smem + row * 2048 + cc * 16) = *(const u32x4*)(p.o_a + (size_t)(tok0 + row) * 384 + cc * 8);
    }
#pragma unroll
    for (int i = 0; i < 2; ++i) {
      const int c = tid + 512 * i, row = c >> 5, cc = c & 31;
      *(u32x4*)(smem + row * 2048 + 1536 + cc * 16) = *(const u32x4*)(p.o_c + (size_t)(tok0 + row) * 256 + cc * 8);
    }
#pragma unroll
    for (int i = 0; i < 3; ++i) {
      const int c = tid + 512 * i, ch = c >> 2, tc = c & 3;
      const u32x4 v = *(const u32x4*)(p.ybT + ((size_t)(b * 384 + ch)) * 4096 + s0 + tc * 8);
      bf16_t* dst = (bf16_t*)smem + (size_t)(tc * 8) * 1024 + 384 + ch;
      dst[0 * 1024] = (bf16_t)(v.x & 0xffff); dst[1 * 1024] = (bf16_t)(v.x >> 16);
      dst[2 * 1024] = (bf16_t)(v.y & 0xffff); dst[3 * 1024] = (bf16_t)(v.y >> 16);
      dst[4 * 1024] = (bf16_t)(v.z & 0xffff); dst[5 * 1024] = (bf16_t)(v.z >> 16);
      dst[6 * 1024] = (bf16_t)(v.w & 0xffff); dst[7 * 1024] = (bf16_t)(v.w >> 16);
    }
    __syncthreads();
    const int tok = tid >> 4, sub = tid & 15;
    float ss[3] = {0.f, 0.f, 0.f};
#pragma unroll
    for (int gi = 0; gi < 3; ++gi) {
      const int i0 = (gi == 0) ? 0 : (gi == 1 ? 3 : 6), i1 = (gi == 0) ? 3 : (gi == 1 ? 6 : 8);
      float acc = 0.f;
#pragma unroll 2
      for (int i = i0; i < i1; ++i) {
        const u32x4 v = *(const u32x4*)(smem + tok * 2048 + (sub + 16 * i) * 16);
        float a;
        a = bflo(v.x); acc += a * a; a = bfhi(v.x); acc += a * a;
        a = bflo(v.y); acc += a * a; a = bfhi(v.y); acc += a * a;
        a = bflo(v.z); acc += a * a; a = bfhi(v.z); acc += a * a;
        a = bflo(v.w); acc += a * a; a = bfhi(v.w); acc += a * a;
      }
      acc += __shfl_xor(acc, 1);
      acc += __shfl_xor(acc, 2);
      acc += __shfl_xor(acc, 4);
      acc += __shfl_xor(acc, 8);
      ss[gi] = acc;
    }
    float rs[3];
    rs[0] = rsqrtf(ss[0] * (1.0f / 384.0f) + 1e-6f);
    rs[1] = rsqrtf(ss[1] * (1.0f / 384.0f) + 1e-6f);
    rs[2] = rsqrtf(ss[2] * (1.0f / 256.0f) + 1e-6f);
#pragma unroll
    for (int gi = 0; gi < 3; ++gi) {
      const int i0 = (gi == 0) ? 0 : (gi == 1 ? 3 : 6), i1 = (gi == 0) ? 3 : (gi == 1 ? 6 : 8);
      const float r = rs[gi];
#pragma unroll 2
      for (int i = i0; i < i1; ++i) {
        const u32x4 v = *(const u32x4*)(smem + tok * 2048 + (sub + 16 * i) * 16);
        u32x4 w;
        w.x = cvt_pk_bf16(bflo(v.x) * r, bfhi(v.x) * r);
        w.y = cvt_pk_bf16(bflo(v.y) * r, bfhi(v.y) * r);
        w.z = cvt_pk_bf16(bflo(v.z) * r, bfhi(v.z) * r);
        w.w = cvt_pk_bf16(bflo(v.w) * r, bfhi(v.w) * r);
        *(u32x4*)(p.y + (size_t)(tok0 + tok) * 1024 + (sub + 16 * i) * 8) = w;
      }
    }
  }
}

enum { EPI_INPROJ = 0, EPI_QUP = 1, EPI_KVUP = 2, EPI_OUTPROJ = 3, EPI_SWIGLU = 4, EPI_DOWN = 5 };

template <int EPI>
__device__ void gemm_phase(const P& p, int l, const bf16_t* __restrict__ A, int lda, const bf16_t* __restrict__ Bt,
                           int K, int nN, char* smem) {
  int tid_ = threadIdx.x;
  asm volatile("" : "+v"(tid_));
  const int tid = tid_, lane = tid & 63, wave = tid >> 6, wm = wave >> 2, wn = wave & 3, l15 = lane & 15,
            g = lane >> 4;
  const int ntiles = 128 * nN;
  const int srow = tid >> 3, skc = tid & 7;
  const int sw_off = srow * 128 + ((skc ^ ((srow >> 1) & 7)) * 16);
  const int rsw = (l15 >> 1) & 7;
  for (int tile = vblock(); tile < ntiles; tile += gridDim.x) {
    const int gsz_ = 4 * nN, grp_ = tile / gsz_, w_ = tile - grp_ * gsz_;
    const int ni = w_ >> 2, mi = grp_ * 4 + (w_ & 3);
    const int m0 = mi * 256, n0 = ni * 256;
    f32x4 acc[8][4];
#pragma unroll
    for (int a = 0; a < 8; ++a)
#pragma unroll
      for (int b = 0; b < 4; ++b) acc[a][b] = (f32x4){0.f, 0.f, 0.f, 0.f};
    const bf16_t* Ag = A + (size_t)(m0 + srow) * lda + skc * 8;
    const bf16_t* Bg = Bt + (size_t)(n0 + srow) * K + skc * 8;
    u32x4 ra[4], rb[4];
    auto gl = [&](int kt) {
#pragma unroll
      for (int i = 0; i < 4; ++i) ra[i] = *(const u32x4*)(Ag + (size_t)i * 64 * lda + kt * 64);
#pragma unroll
      for (int i = 0; i < 4; ++i) rb[i] = *(const u32x4*)(Bg + (size_t)i * 64 * K + kt * 64);
    };
    auto st = [&](int buf) {
      char* nb = smem + buf * 65536;
#pragma unroll
      for (int i = 0; i < 4; ++i) *(u32x4*)(nb + sw_off + i * 8192) = ra[i];
#pragma unroll
      for (int i = 0; i < 4; ++i) *(u32x4*)(nb + 32768 + sw_off + i * 8192) = rb[i];
    };
    const int nk = K / 64;
    gl(0);
    float rs_row = 1.f;
    if (EPI == EPI_INPROJ || EPI == EPI_SWIGLU) {
      if (tid < 256) {
        const f32x4* pp = (const f32x4*)(p.part_x + (size_t)(m0 + tid) * 16);
        const f32x4 a0 = pp[0], a1 = pp[1], a2 = pp[2], a3 = pp[3];
        const float tot = (a0[0] + a0[1] + a0[2] + a0[3]) + (a1[0] + a1[1] + a1[2] + a1[3]) +
                          (a2[0] + a2[1] + a2[2] + a2[3]) + (a3[0] + a3[1] + a3[2] + a3[3]);
        rs_row = rsqrtf(tot * (1.0f / 1024.0f) + 1e-6f);
      }
    } else if (EPI == EPI_QUP) {
      if (tid < 256) {
        const f32x4 a0 = *(const f32x4*)(p.part_q + (size_t)(m0 + tid) * 4);
        rs_row = rsqrtf((a0[0] + a0[1] + a0[2] + a0[3]) * (1.0f / 256.0f) + 1e-6f);
      }
    } else if (EPI == EPI_KVUP) {
      if (tid < 256) {
        const float2 a0 = *(const float2*)(p.part_kv + (size_t)(m0 + tid) * 2);
        rs_row = rsqrtf((a0.x + a0.y) * (1.0f / 128.0f) + 1e-6f);
      }
    }
    float* s_rs = (float*)(smem + 131072);
    __syncthreads();
    st(0);
    if (EPI != EPI_OUTPROJ && EPI != EPI_DOWN && true) {
      if (tid < 256) s_rs[tid] = rs_row;
    }
    __syncthreads();
    for (int kt = 0; kt < nk; ++kt) {
      if (kt + 1 < nk) gl(kt + 1);
      __builtin_amdgcn_sched_barrier(0);
      const char* Ab = smem + (kt & 1) * 65536;
      const char* Bb = Ab + 32768;
#pragma unroll
      for (int ks = 0; ks < 2; ++ks) {
        bf16x8 bfr[4];
#pragma unroll
        for (int nt = 0; nt < 4; ++nt)
          bfr[nt] = *(const bf16x8*)(Bb + (wn * 64 + nt * 16 + l15) * 128 + (((ks * 4 + g) ^ rsw) * 16));
        bf16x8 af[2][2];
#pragma unroll
        for (int mt = 0; mt < 2; ++mt)
          af[0][mt] = *(const bf16x8*)(Ab + (wm * 128 + mt * 16 + l15) * 128 + (((ks * 4 + g) ^ rsw) * 16));
#pragma unroll
        for (int mh = 0; mh < 4; ++mh) {
          if (mh < 3) {
#pragma unroll
            for (int mt = 0; mt < 2; ++mt)
              af[(mh + 1) & 1][mt] = *(const bf16x8*)(Ab + (wm * 128 + ((mh + 1) * 2 + mt) * 16 + l15) * 128 + (((ks * 4 + g) ^ rsw) * 16));
          }
          __builtin_amdgcn_sched_barrier(0);
#pragma unroll
          for (int mt = 0; mt < 2; ++mt)
#pragma unroll
            for (int nt = 0; nt < 4; ++nt)
              acc[mh * 2 + mt][nt] = __builtin_amdgcn_mfma_f32_16x16x32_bf16(bfr[nt], af[mh & 1][mt], acc[mh * 2 + mt][nt], 0, 0, 0);
          __builtin_amdgcn_sched_barrier(0);
        }
      }
      if (kt + 1 < nk) st((kt + 1) & 1);
      __syncthreads();
    }
    int opq_ = 0;
    asm volatile("" : "+v"(opq_));
    const int rbase = m0 + wm * 128 + l15 + opq_;
    const int cbase = n0 + wn * 64 + g * 4 + opq_;
    if (EPI == EPI_INPROJ) {
      const int wc0 = n0 + wn * 64;
#pragma unroll
      for (int mt = 0; mt < 8; ++mt) {
        const int row = rbase + mt * 16;
        const float rs = s_rs[row - m0];
        const int bb = row >> 12, ss = row & 4095;
        float sq = 0.f;
#pragma unroll
        for (int nt = 0; nt < 4; ++nt) {
          const int ct = wc0 + nt * 16;
          const int col = cbase + nt * 16;
          f32x4 v = acc[mt][nt] * rs;
          if (ct < 384) {
            sq += v[0] * v[0] + v[1] * v[1] + v[2] * v[2] + v[3] * v[3];
            u32x2 w;
            w.x = cvt_pk_bf16(v[0], v[1]);
            w.y = cvt_pk_bf16(v[2], v[3]);
            *(u32x2*)(p.projA + (size_t)row * 416 + col) = w;
          } else if (ct == 384) {
            if (nt < 3) {
              const f32x4 v2 = acc[mt][(nt + 1) & 3] * rs;
              const int i0 = col - 384;
              const float2* cs = p.ropecs + ss * 16 + i0;
              float o1[4], o2[4];
#pragma unroll
              for (int j = 0; j < 4; ++j) {
                const float2 c_s = cs[j];
                o1[j] = v[j] * c_s.x - v2[j] * c_s.y;
                o2[j] = v[j] * c_s.y + v2[j] * c_s.x;
              }
              u32x2 w;
              w.x = cvt_pk_bf16(o1[0], o1[1]);
              w.y = cvt_pk_bf16(o1[2], o1[3]);
              *(u32x2*)(p.projA + (size_t)row * 416 + 384 + i0) = w;
              w.x = cvt_pk_bf16(o2[0], o2[1]);
              w.y = cvt_pk_bf16(o2[2], o2[3]);
              *(u32x2*)(p.projA + (size_t)row * 416 + 400 + i0) = w;
            }
          } else if (ct == 400) {
          } else if (ct < 1568) {
            const int hc = col - 416;
            bf16_t* dst = p.hyT + ((size_t)(bb * 1152 + hc)) * 4096 + ss;
            dst[0] = f2bf(v[0]);
            dst[4096] = f2bf(v[1]);
            dst[2 * 4096] = f2bf(v[2]);
            dst[3 * 4096] = f2bf(v[3]);
          } else if (ct < 2080) {
            u32x2 w;
            w.x = cvt_pk_bf16(v[0], v[1]);
            w.y = cvt_pk_bf16(v[2], v[3]);
            *(u32x2*)(p.na + (size_t)row * 768 + (col - 1568)) = w;
          } else if (ct < 2336) {
            const int vc = col - 2080;
            bf16_t* dst = p.naVT + ((size_t)(bb * 256 + vc)) * 4096 + ss;
            dst[0] = f2bf(v[0]);
            dst[4096] = f2bf(v[1]);
            dst[2 * 4096] = f2bf(v[2]);
            dst[3 * 4096] = f2bf(v[3]);
          }
        }
        if (wc0 < 384) {
          sq += __shfl_xor(sq, 16);
          sq += __shfl_xor(sq, 32);
          if (g == 0) {
            if (wc0 < 256) p.part_q[(size_t)row * 4 + (wc0 >> 6)] = sq;
            else p.part_kv[(size_t)row * 2 + ((wc0 - 256) >> 6)] = sq;
          }
        }
      }
    } else if (EPI == EPI_QUP) {
      const int wc0 = n0 + wn * 64;
      const float qscale = 0.10206207261596575f * 1.4426950408889634f;
#pragma unroll
      for (int mt = 0; mt < 8; ++mt) {
        const int row = rbase + mt * 16;
        const float rs = s_rs[row - m0] * qscale;
        const int bb = row >> 12, ss = row & 4095;
#pragma unroll
        for (int nt = 0; nt < 4; ++nt) {
          const int T = (wc0 >> 4) + nt;
          if (T < 36) {
            const int hh = T / 6, tt = T % 6;
            bf16_t* qrow = p.qb + ((size_t)((bb * 6 + hh) * 4096 + ss)) * 96;
            const f32x4 v = acc[mt][nt] * rs;
            if (tt < 4) {
              u32x2 w;
              w.x = cvt_pk_bf16(v[0], v[1]);
              w.y = cvt_pk_bf16(v[2], v[3]);
              *(u32x2*)(qrow + tt * 16 + g * 4) = w;
            } else if (tt == 4) {
              if (nt < 3) {
                const f32x4 v2 = acc[mt][(nt + 1) & 3] * rs;
                const float2* cs = p.ropecs + ss * 16 + g * 4;
                float o1[4], o2[4];
#pragma unroll
                for (int j = 0; j < 4; ++j) {
                  const float2 c_s = cs[j];
                  o1[j] = v[j] * c_s.x - v2[j] * c_s.y;
                  o2[j] = v[j] * c_s.y + v2[j] * c_s.x;
                }
                u32x2 w;
                w.x = cvt_pk_bf16(o1[0], o1[1]);
                w.y = cvt_pk_bf16(o1[2], o1[3]);
                *(u32x2*)(qrow + 64 + g * 4) = w;
                w.x = cvt_pk_bf16(o2[0], o2[1]);
                w.y = cvt_pk_bf16(o2[2], o2[3]);
                *(u32x2*)(qrow + 80 + g * 4) = w;
              }
            }
          }
        }
      }
    } else if (EPI == EPI_KVUP) {
      const int hh = ni * 2 + (wn >> 1);
#pragma unroll
      for (int mt = 0; mt < 8; ++mt) {
        const int row = rbase + mt * 16;
        const float rs = s_rs[row - m0];
        const int bb = row >> 12, ss = row & 4095;
#pragma unroll
        for (int nt = 0; nt < 4; ++nt) {
          const f32x4 v = acc[mt][nt] * rs;
          if ((wn & 1) == 0) {
            u32x2 w;
            w.x = cvt_pk_bf16(v[0], v[1]);
            w.y = cvt_pk_bf16(v[2], v[3]);
            *(u32x2*)(p.kb + ((size_t)((bb * 6 + hh) * 4096 + ss)) * 96 + nt * 16 + g * 4) = w;
          } else {
            const int dv = nt * 16 + g * 4;
            bf16_t* dst = p.vT + ((size_t)((bb * 6 + hh) * 64 + dv)) * 4096 + ss;
            dst[0] = f2bf(v[0]);
            dst[4096] = f2bf(v[1]);
            dst[2 * 4096] = f2bf(v[2]);
            dst[3 * 4096] = f2bf(v[3]);
          }
        }
      }
#pragma unroll
      for (int i = 0; i < 2; ++i) {
        const int c = tid + 512 * i, rr = c >> 2, cc = c & 3;
        const int row = m0 + rr, bb = row >> 12, ss = row & 4095;
        const u32x4 v = *(const u32x4*)(p.projA + (size_t)row * 416 + 384 + cc * 8);
        *(u32x4*)(p.kb + ((size_t)((bb * 6 + ni * 2) * 4096 + ss)) * 96 + 64 + cc * 8) = v;
        *(u32x4*)(p.kb + ((size_t)((bb * 6 + ni * 2 + 1) * 4096 + ss)) * 96 + 64 + cc * 8) = v;
      }
    } else if (EPI == EPI_OUTPROJ || EPI == EPI_DOWN) {
      const bool last_upd = (EPI == EPI_DOWN && l == 1);
      const int slot = (n0 + wn * 64) >> 6;
#pragma unroll
      for (int mt = 0; mt < 8; ++mt) {
        const int row = rbase + mt * 16;
        float sq = 0.f;
#pragma unroll
        for (int nt = 0; nt < 4; ++nt) {
          const int col = cbase + nt * 16;
          const u32x2 xr = *(const u32x2*)(p.xb + (size_t)row * 1024 + col);
          const f32x4 xo = (f32x4){bflo(xr.x), bfhi(xr.x), bflo(xr.y), bfhi(xr.y)};
          const f32x4 v = acc[mt][nt] + xo;
          sq += v[0] * v[0] + v[1] * v[1] + v[2] * v[2] + v[3] * v[3];
          if (last_upd) {
            *(f32x4*)(p.out + (size_t)row * 1024 + col) = v;
          } else {
            u32x2 w;
            w.x = cvt_pk_bf16(v[0], v[1]);
            w.y = cvt_pk_bf16(v[2], v[3]);
            *(u32x2*)(p.xb + (size_t)row * 1024 + col) = w;
          }
        }
        sq += __shfl_xor(sq, 16);
        sq += __shfl_xor(sq, 32);
        if (g == 0) p.part_x[(size_t)row * 16 + slot] = sq;
      }
    } else if (EPI == EPI_SWIGLU) {
      const int fbase = ((n0 + wn * 64) >> 1) + g * 4;
#pragma unroll
      for (int mt = 0; mt < 8; ++mt) {
        const int row = rbase + mt * 16;
        const float rs = s_rs[row - m0];
#pragma unroll
        for (int i = 0; i < 2; ++i) {
          const f32x4 gt = acc[mt][2 * i] * rs, up = acc[mt][2 * i + 1] * rs;
          float hv[4];
#pragma unroll
          for (int j = 0; j < 4; ++j) hv[j] = gt[j] * __builtin_amdgcn_rcpf(1.0f + __expf(-gt[j])) * up[j];
          u32x2 w;
          w.x = cvt_pk_bf16(hv[0], hv[1]);
          w.y = cvt_pk_bf16(hv[2], hv[3]);
          *(u32x2*)(p.hidden + (size_t)row * 2816 + fbase + i * 16) = w;
        }
      }
    }
  }
}

__device__ void final_norm_phase(const P& p) {
  int tid_ = threadIdx.x;
  asm volatile("" : "+v"(tid_));
  const int tid = tid_, lane = tid & 63, wave = tid >> 6;
  for (int row = blockIdx.x * 8 + wave; row < NTOK; row += gridDim.x * 8) {
    const f32x4* pp = (const f32x4*)(p.part_x + (size_t)row * 16);
    const f32x4 a0 = pp[0], a1 = pp[1], a2 = pp[2], a3 = pp[3];
    const float tot = (a0[0] + a0[1] + a0[2] + a0[3]) + (a1[0] + a1[1] + a1[2] + a1[3]) +
                      (a2[0] + a2[1] + a2[2] + a2[3]) + (a3[0] + a3[1] + a3[2] + a3[3]);
    const float rs = rsqrtf(tot * (1.0f / 1024.0f) + 1e-6f);
    float* xr = p.out + (size_t)row * 1024;
#pragma unroll
    for (int i = 0; i < 4; ++i) {
      f32x4 v = *(const f32x4*)(xr + lane * 4 + 256 * i);
      const f32x4 gg = *(const f32x4*)(p.final_g + lane * 4 + 256 * i);
      v = v * rs * gg;
      *(f32x4*)(xr + lane * 4 + 256 * i) = v;
    }
  }
}


template <int S>
__device__ __forceinline__ void run_stage(const P& p, int l, char* smem) {
  if (S == 0) prep_phase(p, l, smem);
  if (S == 1) {
    filt_fft_phase(p, l, smem);
    gemm_phase<EPI_INPROJ>(p, l, p.xb, 1024, p.Win, 1024, 10, smem);
  }
  if (S == 2) {
    hyena_phase<0>(p, l, smem);
    gemm_phase<EPI_QUP>(p, l, p.projA, 416, p.Wuq, 256, 3, smem);
    gemm_phase<EPI_KVUP>(p, l, p.projA + 256, 416, p.Wukv, 128, 3, smem);
    natten_phase(p, l, smem);
  }
  if (S == 3) {
    hyena_phase<1>(p, l, smem);
    attn_phase(p, smem);
  }
  if (S == 4) mixnorm_phase(p, smem);
  if (S == 5) gemm_phase<EPI_OUTPROJ>(p, l, p.y, 1024, p.Wout, 1024, 4, smem);
  if (S == 6) gemm_phase<EPI_SWIGLU>(p, l, p.xb, 1024, p.Wgu, 1024, 22, smem);
  if (S == 7) gemm_phase<EPI_DOWN>(p, l, p.hidden, 2816, p.Wdown, 2816, 4, smem);
  if (S == 8) final_norm_phase(p);
}

__device__ __forceinline__ void grid_barrier(unsigned* bar, unsigned target) {
  asm volatile("s_waitcnt vmcnt(0)" ::: "memory");
  __syncthreads();
  if (threadIdx.x == 0) {
    __builtin_amdgcn_fence(__ATOMIC_RELEASE, "agent");
    asm volatile("s_waitcnt vmcnt(0)" ::: "memory");
    __hip_atomic_fetch_add(bar, 1u, __ATOMIC_RELAXED, __HIP_MEMORY_SCOPE_AGENT);
    unsigned spins = 0;
    while (__hip_atomic_load(bar, __ATOMIC_RELAXED, __HIP_MEMORY_SCOPE_AGENT) < target && spins < (1u << 22)) {
      __builtin_amdgcn_s_sleep(1);
      ++spins;
    }
    __builtin_amdgcn_fence(__ATOMIC_ACQUIRE, "agent");
    asm volatile("s_waitcnt vmcnt(0)" ::: "memory");
  }
  __syncthreads();
}

__global__ void __launch_bounds__(NTHREADS) k_main(P p) {
  extern __shared__ __attribute__((aligned(16))) char smem[];
  cg::grid_group grid = cg::this_grid();
  if (blockIdx.x == 0 && threadIdx.x == 0) __hip_atomic_store(p.bar, 0u, __ATOMIC_RELAXED, __HIP_MEMORY_SCOPE_AGENT);
  run_stage<0>(p, 0, smem); grid.sync();
  run_stage<1>(p, 0, smem); grid_barrier(p.bar, 1u * gridDim.x);
  run_stage<2>(p, 0, smem); grid_barrier(p.bar, 2u * gridDim.x);
  run_stage<3>(p, 0, smem); grid_barrier(p.bar, 3u * gridDim.x);
  run_stage<4>(p, 0, smem); grid_barrier(p.bar, 4u * gridDim.x);
  run_stage<5>(p, 0, smem); grid_barrier(p.bar, 5u * gridDim.x);
  run_stage<6>(p, 0, smem); grid_barrier(p.bar, 6u * gridDim.x);
  run_stage<7>(p, 0, smem); grid_barrier(p.bar, 7u * gridDim.x);
  run_stage<0>(p, 1, smem); grid_barrier(p.bar, 8u * gridDim.x);
  run_stage<1>(p, 1, smem); grid_barrier(p.bar, 9u * gridDim.x);
  run_stage<2>(p, 1, smem); grid_barrier(p.bar, 10u * gridDim.x);
  run_stage<3>(p, 1, smem); grid_barrier(p.bar, 11u * gridDim.x);
  run_stage<4>(p, 1, smem); grid_barrier(p.bar, 12u * gridDim.x);
  run_stage<5>(p, 1, smem); grid_barrier(p.bar, 13u * gridDim.x);
  run_stage<6>(p, 1, smem); grid_barrier(p.bar, 14u * gridDim.x);
  run_stage<7>(p, 1, smem); grid_barrier(p.bar, 15u * gridDim.x);
  run_stage<8>(p, 1, smem);
}


extern "C" void kernel_launch(void* const* d_in, const int* in_sizes, int n_in, void* d_out, int out_size, void* d_ws,
                              size_t ws_size, hipStream_t stream) {
  static int grid_blocks = 0;
  if (!grid_blocks) {
    int dev = 0, cus = 0;
    (void)hipGetDevice(&dev);
    (void)hipDeviceGetAttribute(&cus, hipDeviceAttributeMultiprocessorCount, dev);
    if (cus <= 0) cus = 256;
    int per_cu = 0;
    (void)hipFuncSetAttribute((const void*)k_main, hipFuncAttributeMaxDynamicSharedMemorySize, LDS_BYTES);
    (void)hipOccupancyMaxActiveBlocksPerMultiprocessor(&per_cu, k_main, NTHREADS, LDS_BYTES);
    if (per_cu > 1) per_cu = 1;
    if (per_cu < 1) per_cu = 1;
    grid_blocks = cus * per_cu;
  }
  P p;
  memset(&p, 0, sizeof(p));
  const float* const* in = (const float* const*)d_in;
  p.x = in[0]; p.norm1_g = in[1]; p.w_in = in[2]; p.q_norm_g = in[3]; p.w_uq = in[4]; p.kv_norm_g = in[5];
  p.w_ukv = in[6]; p.conv_w = in[7]; p.conv_b = in[8]; p.fw1 = in[9]; p.fb1 = in[10]; p.ff1 = in[11];
  p.fw2 = in[12]; p.fb2 = in[13]; p.ff2 = in[14]; p.fw3 = in[15]; p.skip = in[16]; p.rpb = in[17];
  p.mix_g = in[18]; p.w_out = in[19]; p.norm2_g = in[20]; p.w_gate = in[21]; p.w_up = in[22]; p.w_down = in[23];
  p.final_g = in[24];
  p.out = (float*)d_out;
  char* ws = (char*)d_ws;
  size_t off = 0;
  auto take = [&](size_t bytes) {
    char* r = ws + off;
    off += (bytes + 255) & ~(size_t)255;
    return r;
  };
  p.Win = (bf16_t*)take((size_t)2560 * 1024 * 2);
  p.Wuq = (bf16_t*)take((size_t)768 * 256 * 2);
  p.Wukv = (bf16_t*)take((size_t)768 * 128 * 2);
  p.Wout = (bf16_t*)take((size_t)1024 * 1024 * 2);
  p.Wgu = (bf16_t*)take((size_t)5632 * 1024 * 2);
  p.Wdown = (bf16_t*)take((size_t)1024 * 2816 * 2);
  p.ropecs = (float2*)take((size_t)65536 * 8);
  p.tw = (float2*)take((size_t)8192 * 8);
  p.bar = (unsigned*)take(256);
  p.part_x = (float*)take((size_t)NTOK * 16 * 4);
  p.part_q = (float*)take((size_t)NTOK * 4 * 4);
  p.part_kv = (float*)take((size_t)NTOK * 2 * 4);
  p.xb = (bf16_t*)take((size_t)NTOK * 1024 * 2);
  p.H2 = (float2*)take((size_t)768 * 8192 * 8);
  p.z1T = (bf16_t*)take((size_t)1536 * 4096 * 4);
  p.filtT = (float*)p.z1T;
  p.vT = (bf16_t*)take((size_t)8 * 6 * 64 * 4096 * 2);
  p.o_a = (bf16_t*)take((size_t)NTOK * 384 * 2);
  p.o_c = (bf16_t*)take((size_t)NTOK * 256 * 2);
  char* big = take(0);
  p.projA = (bf16_t*)take((size_t)NTOK * 416 * 2);
  p.hyT = (bf16_t*)take((size_t)8 * 1152 * 4096 * 2);
  p.na = (bf16_t*)take((size_t)NTOK * 768 * 2);
  p.qb = (bf16_t*)take((size_t)8 * 6 * 4096 * 96 * 2);
  p.kb = (bf16_t*)take((size_t)8 * 6 * 4096 * 96 * 2);
  p.hidden = (bf16_t*)big;
  p.ybT = (bf16_t*)take((size_t)8 * 384 * 4096 * 2);
  p.naVT = (bf16_t*)take((size_t)8 * 4 * 64 * 4096 * 2);
  p.y = p.qb;
  if (off > ws_size) {
    fprintf(stderr, "workspace too small: need %zu have %zu\n", off, ws_size);
    return;
  }
  void* args[] = {&p};
  hipError_t e = hipLaunchCooperativeKernel((void*)k_main, dim3(grid_blocks), dim3(NTHREADS), args, LDS_BYTES, stream);
  if (e != hipSuccess) fprintf(stderr, "cooperative launch failed: %s (grid %d)\n", hipGetErrorString(e), grid_blocks);
}
```

```cpp
#include <hip/hip_runtime.h>
#include <hip/hip_cooperative_groups.h>
#include <cstdio>
#include <cstring>
#include <cstdint>
#include <cmath>
#include <type_traits>
namespace cg = cooperative_groups;


typedef unsigned short bf16_t;
typedef short bf16x8 __attribute__((ext_vector_type(8)));
typedef float f32x4 __attribute__((ext_vector_type(4)));
typedef unsigned u32x4 __attribute__((ext_vector_type(4)));
typedef unsigned u32x2 __attribute__((ext_vector_type(2)));

constexpr int NTOK = 32768, SEQ = 4096;
constexpr int NTHREADS = 512;
constexpr int LDS_BYTES = 147456;
constexpr int TW_LDS_OFF = 69632;
#define PADI(i) ((i) + ((i) >> 4))

struct P {
  const float *x, *norm1_g, *w_in, *q_norm_g, *w_uq, *kv_norm_g, *w_ukv, *conv_w, *conv_b, *fw1, *fb1, *ff1, *fw2, *fb2,
      *ff2, *fw3, *skip, *rpb, *mix_g, *w_out, *norm2_g, *w_gate, *w_up, *w_down, *final_g;
  float* out;
  bf16_t *Win, *Wuq, *Wukv, *Wout, *Wgu, *Wdown;
  bf16_t *xb, *projA, *hyT, *na, *qb, *kb, *vT, *o_a, *o_c, *y, *hidden, *ybT, *naVT;
  float2* H2;
  float* filtT;
  bf16_t* z1T;
  float *part_x, *part_q, *part_kv;
  float2* ropecs;
  float2* tw;
  unsigned* bar;
  unsigned pad0_, pad1_;
};

typedef __bf16 bf16v2_t __attribute__((ext_vector_type(2)));
typedef float f32x2_t __attribute__((ext_vector_type(2)));
__device__ __forceinline__ unsigned cvt_pk_bf16(float lo, float hi) {
  const f32x2_t v = {lo, hi};
  const bf16v2_t r = __builtin_convertvector(v, bf16v2_t);
  return __builtin_bit_cast(unsigned, r);
}
__device__ __forceinline__ bf16_t f2bf(float f) { return (bf16_t)(cvt_pk_bf16(f, 0.f) & 0xffffu); }
__device__ __forceinline__ float bf2f(bf16_t h) { return __uint_as_float(((unsigned)h) << 16); }
__device__ __forceinline__ float bflo(unsigned u) { return __uint_as_float(u << 16); }
__device__ __forceinline__ float bfhi(unsigned u) { return __uint_as_float(u & 0xffff0000u); }

__device__ __forceinline__ void fast_sincos_rev(float rev, float* s, float* c) {
  const float fr = rev - rintf(rev);
  *s = __builtin_amdgcn_sinf(fr);
  *c = __builtin_amdgcn_cosf(fr);
}
__device__ __forceinline__ float fast_sin(float x) {
  const float rev = x * 0.15915494309189535f;
  const float fr = rev - rintf(rev);
  return __builtin_amdgcn_sinf(fr);
}

__device__ __forceinline__ int vblock() {
  const int G = gridDim.x, b = blockIdx.x;
  return ((G & 7) == 0) ? ((b & 7) * (G >> 3) + (b >> 3)) : b;
}

__device__ void conv_w(const float* __restrict__ W, int K, int N, int Npad, const float* __restrict__ g, bf16_t* Bt,
                       int mode, char* smem) {
  float* tile = (float*)smem;
  int tid_ = threadIdx.x;
  asm volatile("" : "+v"(tid_));
  const int tid = tid_;
  const int nkt = K / 64, nnt = Npad / 64;
  for (int job = blockIdx.x; job < nkt * nnt; job += gridDim.x) {
    const int kt = job % nkt, ntile = job / nkt;
    const int k0 = kt * 64, n0 = ntile * 64;
    __syncthreads();
#pragma unroll
    for (int i = 0; i < 2; ++i) {
      const int k = (tid >> 4) + 32 * i, nq = (tid & 15) * 4, n = n0 + nq;
      f32x4 v = {0.f, 0.f, 0.f, 0.f};
      if (n < N) {
        v = *(const f32x4*)(W + (size_t)(k0 + k) * N + n);
        if (g) v = v * g[k0 + k];
      }
      tile[k * 65 + nq + 0] = v[0];
      tile[k * 65 + nq + 1] = v[1];
      tile[k * 65 + nq + 2] = v[2];
      tile[k * 65 + nq + 3] = v[3];
    }
    __syncthreads();
    {
      const int c = tid, n = c >> 3, kc = c & 7;
      float e[8];
#pragma unroll
      for (int q = 0; q < 8; ++q) e[q] = tile[(kc * 8 + q) * 65 + n];
      u32x4 w;
      w.x = cvt_pk_bf16(e[0], e[1]);
      w.y = cvt_pk_bf16(e[2], e[3]);
      w.z = cvt_pk_bf16(e[4], e[5]);
      w.w = cvt_pk_bf16(e[6], e[7]);
      const int nn = n0 + n;
      int dest = nn;
      if (mode == 1) dest = 32 * (nn >> 4) + (nn & 15);
      if (mode == 2) dest = 32 * (nn >> 4) + 16 + (nn & 15);
      *(u32x4*)(Bt + (size_t)dest * K + k0 + kc * 8) = w;
    }
  }
}

__device__ void filt_mlp(const P& p, int l, char* smem) {
  float* zf = (float*)smem;
  float* h1 = zf + 16 * 17;
  float* h2 = h1 + 64 * 16;
  int tid_ = threadIdx.x;
  asm volatile("" : "+v"(tid_));
  const int tid = tid_, tl = tid & 15, kk = tid >> 4;
  const float* w1 = p.fw1 + l * 17 * 64;
  const float* b1 = p.fb1 + l * 64;
  const float* f1 = p.ff1 + l * 64;
  const float* w2 = p.fw2 + l * 64 * 64;
  const float* b2 = p.fb2 + l * 64;
  const float* f2 = p.ff2 + l * 64;
  const float* w3 = p.fw3 + (size_t)l * 64 * 1536;
  for (int job = blockIdx.x; job < 256; job += gridDim.x) {
    const int t0 = job * 16;
    __syncthreads();
    {
      const int t = t0 + tl;
      if (kk < 8) {
        const float band = 1e-4f + (float)kk * ((7.0f - 1e-4f) / 7.0f);
        const float ang = ((6.283185307179586f * (float)t) * band) / 4096.0f;
        float s, c;
        fast_sincos_rev(ang * 0.15915494309189535f, &s, &c);
        zf[tl * 17 + 1 + kk] = c;
        zf[tl * 17 + 9 + kk] = s;
      } else if (kk == 8) {
        zf[tl * 17] = (float)t / 4095.0f;
      }
    }
    __syncthreads();
#pragma unroll
    for (int m = 0; m < 2; ++m) {
      const int j = kk + 32 * m;
      float a = b1[j];
#pragma unroll 1
      for (int f = 0; f < 17; ++f) a += zf[tl * 17 + f] * w1[f * 64 + j];
      h1[j * 16 + tl] = fast_sin(f1[j] * a);
    }
    __syncthreads();
#pragma unroll
    for (int m = 0; m < 2; ++m) {
      const int j = kk + 32 * m;
      float a = b2[j];
#pragma unroll 16
      for (int i = 0; i < 64; ++i) a += h1[i * 16 + tl] * w2[i * 64 + j];
      h2[j * 16 + tl] = fast_sin(f2[j] * a);
    }
    __syncthreads();
#pragma unroll 1
    for (int mm = 0; mm < 3; ++mm) {
      const int col = tid + 512 * mm;
      float acc[16];
#pragma unroll
      for (int q = 0; q < 16; ++q) acc[q] = 0.f;
#pragma unroll 1
      for (int j0 = 0; j0 < 64; j0 += 8) {
        float wv[8];
#pragma unroll
        for (int q = 0; q < 8; ++q) wv[q] = w3[(size_t)(j0 + q) * 1536 + col];
#pragma unroll
        for (int q = 0; q < 8; ++q) {
          const float w = wv[q];
          const f32x4* hp = (const f32x4*)(h2 + (j0 + q) * 16);
          const f32x4 a0 = hp[0], a1 = hp[1], a2 = hp[2], a3 = hp[3];
          acc[0] += a0[0] * w; acc[1] += a0[1] * w; acc[2] += a0[2] * w; acc[3] += a0[3] * w;
          acc[4] += a1[0] * w; acc[5] += a1[1] * w; acc[6] += a1[2] * w; acc[7] += a1[3] * w;
          acc[8] += a2[0] * w; acc[9] += a2[1] * w; acc[10] += a2[2] * w; acc[11] += a2[3] * w;
          acc[12] += a3[0] * w; acc[13] += a3[1] * w; acc[14] += a3[2] * w; acc[15] += a3[3] * w;
        }
      }
      const int c = col % 384;
      const float lo = -3.0701134573253945f, hi = -15.350567286626972f;
      const float delta = fabsf(lo + (hi - lo) * ((float)c / 383.0f));
      float* dst = p.filtT + (size_t)col * 4096 + t0;
#pragma unroll
      for (int q = 0; q < 16; ++q) {
        const float tn = (float)(t0 + q) / 4095.0f;
        dst[q] = acc[q] * __expf(-tn * delta);
      }
    }
  }
}

__device__ void prep_phase(const P& p, int l, char* smem) {
  for (int w = 0; w < 7; ++w) {
    const float* W; const float* g; bf16_t* Bt; int K, N, Npad, mode = 0;
    switch (w) {
      case 0: W = p.w_in + (size_t)l * 1024 * 2336; K = 1024; N = 2336; Npad = 2560; g = p.norm1_g + l * 1024; Bt = p.Win; break;
      case 1: W = p.w_uq + (size_t)l * 256 * 576; K = 256; N = 576; Npad = 768; g = p.q_norm_g + l * 256; Bt = p.Wuq; break;
      case 2: W = p.w_ukv + (size_t)l * 128 * 768; K = 128; N = 768; Npad = 768; g = p.kv_norm_g + l * 128; Bt = p.Wukv; break;
      case 3: W = p.w_out + (size_t)l * 1024 * 1024; K = 1024; N = 1024; Npad = 1024; g = p.mix_g + l * 1024; Bt = p.Wout; break;
      case 4: W = p.w_gate + (size_t)l * 1024 * 2816; K = 1024; N = 2816; Npad = 2816; g = p.norm2_g + l * 1024; Bt = p.Wgu; mode = 1; break;
      case 5: W = p.w_up + (size_t)l * 1024 * 2816; K = 1024; N = 2816; Npad = 2816; g = p.norm2_g + l * 1024; Bt = p.Wgu; mode = 2; break;
      default: W = p.w_down + (size_t)l * 2816 * 1024; K = 2816; N = 1024; Npad = 1024; g = nullptr; Bt = p.Wdown; break;
    }
    conv_w(W, K, N, Npad, g, Bt, mode, smem);
  }
  filt_mlp(p, l, smem);
  if (l == 0) {
    int tid_ = threadIdx.x;
  asm volatile("" : "+v"(tid_));
  const int tid = tid_, lane = tid & 63, wave = tid >> 6;
    for (int row = blockIdx.x * 8 + wave; row < NTOK; row += gridDim.x * 8) {
      const float* xr = p.x + (size_t)row * 1024;
      bf16_t* xo = p.xb + (size_t)row * 1024;
      float s = 0.f;
#pragma unroll
      for (int i = 0; i < 4; ++i) {
        const f32x4 v = *(const f32x4*)(xr + lane * 4 + 256 * i);
        s += v[0] * v[0] + v[1] * v[1] + v[2] * v[2] + v[3] * v[3];
        u32x2 w;
        w.x = cvt_pk_bf16(v[0], v[1]);
        w.y = cvt_pk_bf16(v[2], v[3]);
        *(u32x2*)(xo + lane * 4 + 256 * i) = w;
      }
#pragma unroll
      for (int o = 1; o < 64; o <<= 1) s += __shfl_xor(s, o);
      if (lane < 16) p.part_x[(size_t)row * 16 + lane] = (lane == 0) ? s : 0.f;
    }
    for (int i = blockIdx.x * 512 + tid; i < 65536 + 8192; i += gridDim.x * 512) {
      if (i < 65536) {
        const int pos = i >> 4, k = i & 15;
        const float ang = (float)pos * __builtin_amdgcn_exp2f(-(float)k * 0.8304820237218405f);
        float s, c;
        fast_sincos_rev(ang * 0.15915494309189535f, &s, &c);
        p.ropecs[i] = make_float2(c, s);
      } else {
        const int k = i - 65536;
        const int ms = 1 << (31 - __clz(k + 1));
        const int pp = k + 1 - ms;
        float s, c;
        fast_sincos_rev((float)pp / (float)(2 * ms), &s, &c);
        p.tw[k] = make_float2(c, -s);
      }
    }
  }
}

template <int LOGR, int MTOP, bool INV, bool ZIN = false, bool HOUT = false>
__device__ __forceinline__ void fft_pass(float2* sm, const float2* tw) {
  constexpr int R = 1 << LOGR;
  constexpr int q = MTOP >> (LOGR - 1);
  constexpr int ntask = 8192 / R;
  for (int T = threadIdx.x; T < ntask; T += NTHREADS) {
    const int i = T & (q - 1);
    const int blk = T / q;
    const int base = blk * (2 * MTOP) + i;
    float2 v[R];
#pragma unroll
    for (int e = 0; e < R; ++e) {
      if (ZIN && e >= R / 2) v[e] = make_float2(0.f, 0.f);
      else v[e] = sm[PADI(base + e * q)];
    }
    if (!INV) {
#pragma unroll
      for (int s = 0; s < LOGR; ++s) {
        constexpr int dummy = 0;
        (void)dummy;
        const int hs = 1 << (LOGR - 1 - s);
        const int ms = MTOP >> s;
#pragma unroll
        for (int e = 0; e < R; ++e) {
          if ((e & hs) == 0) {
            const int pp = i + (e & (hs - 1)) * q;
            const float2 w = tw[(ms - 1) + pp];
            const float2 a = v[e], b = v[e + hs];
            v[e] = make_float2(a.x + b.x, a.y + b.y);
            const float dx = a.x - b.x, dy = a.y - b.y;
            v[e + hs] = make_float2(dx * w.x - dy * w.y, dx * w.y + dy * w.x);
          }
        }
      }
    } else {
#pragma unroll
      for (int s = LOGR - 1; s >= 0; --s) {
        const int hs = 1 << (LOGR - 1 - s);
        const int ms = MTOP >> s;
#pragma unroll
        for (int e = 0; e < R; ++e) {
          if ((e & hs) == 0) {
            const int pp = i + (e & (hs - 1)) * q;
            const float2 w = tw[(ms - 1) + pp];
            const float2 a = v[e], b = v[e + hs];
            const float tx = b.x * w.x + b.y * w.y, ty = b.y * w.x - b.x * w.y;
            v[e] = make_float2(a.x + tx, a.y + ty);
            v[e + hs] = make_float2(a.x - tx, a.y - ty);
          }
        }
      }
    }
#pragma unroll
    for (int e = 0; e < R; ++e) {
      if (HOUT && e >= R / 2) continue;
      sm[PADI(base + e * q)] = v[e];
    }
  }
  __syncthreads();
}

__device__ __forceinline__ void fft_fwd(float2* sm, const float2* tw) {
  fft_pass<4, 4096, false>(sm, tw);
  fft_pass<4, 256, false>(sm, tw);
  fft_pass<4, 16, false>(sm, tw);
  fft_pass<1, 1, false>(sm, tw);
}
__device__ __forceinline__ void fft_inv(float2* sm, const float2* tw) {
  fft_pass<1, 1, true>(sm, tw);
  fft_pass<3, 8, true>(sm, tw);
  fft_pass<3, 64, true>(sm, tw);
  fft_pass<3, 512, true>(sm, tw);
  fft_pass<3, 4096, true>(sm, tw);
}

__device__ void filt_fft_phase(const P& p, int l, char* smem) {
  float2* sm = (float2*)smem;
  float2* tws = (float2*)(smem + TW_LDS_OFF);
  int tid_ = threadIdx.x;
  asm volatile("" : "+v"(tid_));
  const int tid = tid_;
  for (int i = tid; i < 8192; i += NTHREADS) tws[i] = p.tw[i];
  for (int jj = blockIdx.x; jj < 384; jj += gridDim.x) {
    const int o = jj / 192, c = jj % 192;
    const int jobF = o * 384 + c, jobG = jobF + 192;
    const float* hf1 = p.filtT + ((size_t)((o * 2 + 0) * 384 + c)) * 4096;
    const float* hb1 = p.filtT + ((size_t)((o * 2 + 1) * 384 + c)) * 4096;
    const float* hf2 = hf1 + (size_t)192 * 4096;
    const float* hb2 = hb1 + (size_t)192 * 4096;
    const float sk1 = p.skip[(l * 2 + o) * 384 + c], sk2 = p.skip[(l * 2 + o) * 384 + c + 192];
    __syncthreads();
    for (int n = tid; n < 8192; n += NTHREADS) {
      float v1, v2;
      if (n == 0) { v1 = hf1[0] + hb1[0] + sk1; v2 = hf2[0] + hb2[0] + sk2; }
      else if (n < 4096) { v1 = hf1[n]; v2 = hf2[n]; }
      else if (n == 4096) { v1 = 0.f; v2 = 0.f; }
      else { v1 = hb1[8192 - n]; v2 = hb2[8192 - n]; }
      sm[PADI(n)] = make_float2(v1, v2);
    }
    __syncthreads();
    fft_fwd(sm, tws);
    float2* dF = p.H2 + (size_t)jobF * 8192;
    float2* dG = p.H2 + (size_t)jobG * 8192;
    const float sc = 0.5f / 8192.0f;
    for (int n = tid; n < 8192; n += NTHREADS) {
      const int k = (int)(__brev((unsigned)n) >> 19);
      const int np = (int)(__brev((unsigned)((8192 - k) & 8191)) >> 19);
      const float2 a = sm[PADI(n)], b = sm[PADI(np)];
      dF[n] = make_float2((a.x + b.x) * sc, (a.y - b.y) * sc);
      dG[n] = make_float2((a.y + b.y) * sc, (b.x - a.x) * sc);
    }
  }
}

__device__ __forceinline__ float short_conv(const bf16_t* row, int t, float w0, float w1, float w2, float bias) {
  const float xm = (t > 0) ? bf2f(row[t - 1]) : 0.f;
  const float x0 = bf2f(row[t]);
  const float xp = (t < SEQ - 1) ? bf2f(row[t + 1]) : 0.f;
  return w0 * xm + w1 * x0 + w2 * xp + bias;
}

__device__ __forceinline__ void conv8(const bf16_t* row, int t0, float w0, float w1, float w2, float bias, float (&out)[8]) {
  const u32x4 v = *(const u32x4*)(row + t0);
  float x[10];
  x[0] = (t0 > 0) ? bf2f(row[t0 - 1]) : 0.f;
  x[1] = bflo(v.x); x[2] = bfhi(v.x); x[3] = bflo(v.y); x[4] = bfhi(v.y);
  x[5] = bflo(v.z); x[6] = bfhi(v.z); x[7] = bflo(v.w); x[8] = bfhi(v.w);
  x[9] = (t0 + 8 < SEQ) ? bf2f(row[t0 + 8]) : 0.f;
#pragma unroll
  for (int k = 0; k < 8; ++k) out[k] = w0 * x[k] + w1 * x[k + 1] + w2 * x[k + 2] + bias;
}

struct RawRow { u32x4 v; float lo, hi; };
__device__ __forceinline__ RawRow load_raw(const bf16_t* row, int t0) {
  RawRow r;
  r.v = *(const u32x4*)(row + t0);
  r.lo = (t0 > 0) ? bf2f(row[t0 - 1]) : 0.f;
  r.hi = (t0 + 8 < SEQ) ? bf2f(row[t0 + 8]) : 0.f;
  return r;
}
__device__ __forceinline__ void conv8_raw(const RawRow& r, float w0, float w1, float w2, float bias, float (&out)[8]) {
  float x[10];
  x[0] = r.lo;
  x[1] = bflo(r.v.x); x[2] = bfhi(r.v.x); x[3] = bflo(r.v.y); x[4] = bfhi(r.v.y);
  x[5] = bflo(r.v.z); x[6] = bfhi(r.v.z); x[7] = bflo(r.v.w); x[8] = bfhi(r.v.w);
  x[9] = r.hi;
#pragma unroll
  for (int k = 0; k < 8; ++k) out[k] = w0 * x[k] + w1 * x[k + 1] + w2 * x[k + 2] + bias;
}

__device__ __forceinline__ void fft_mid(float2* sm, const f32x4 (&hpre)[8]) {
#pragma unroll
  for (int it = 0; it < 8; ++it) {
    const int T = threadIdx.x + it * NTHREADS;
    const float2 a = sm[PADI(2 * T)], b = sm[PADI(2 * T + 1)];
    const f32x4 h = hpre[it];
    const float sx = a.x + b.x, sy = a.y + b.y, dx = a.x - b.x, dy = a.y - b.y;
    const float Ax = sx * h[0] - sy * h[1], Ay = sx * h[1] + sy * h[0];
    const float Bx = dx * h[2] - dy * h[3], By = dx * h[3] + dy * h[2];
    sm[PADI(2 * T)] = make_float2(Ax + Bx, Ay + By);
    sm[PADI(2 * T + 1)] = make_float2(Ax - Bx, Ay - By);
  }
  __syncthreads();
}

template <int ORD>
__device__ void hyena_phase(const P& p, int l, char* smem) {
  float2* sm = (float2*)smem;
  float2* tws = (float2*)(smem + TW_LDS_OFF);
  int tid_ = threadIdx.x;
  asm volatile("" : "+v"(tid_));
  const int tid = tid_;
  for (int i = tid; i < 8192; i += NTHREADS) tws[i] = p.tw[i];
  const float* cw = p.conv_w + (size_t)l * 3 * 1152;
  const float* cb = p.conv_b + (size_t)l * 1152;
  const int t0 = tid * 8;
  for (int job = vblock(); job < 1536; job += gridDim.x) {
    const int pair = job & 3, c = job >> 2;
    const int b1 = pair * 2, b2 = b1 + 1;
    const int gc = (ORD == 0 ? 384 : 768) + c;
    const RawRow gr1 = load_raw(p.hyT + ((size_t)(b1 * 1152 + gc)) * 4096, t0);
    const RawRow gr2 = load_raw(p.hyT + ((size_t)(b2 * 1152 + gc)) * 4096, t0);
    __syncthreads();
    {
      float u1[8], u2[8];
      if (ORD == 0) {
        const bf16_t* r1 = p.hyT + ((size_t)(b1 * 1152 + c)) * 4096;
        const bf16_t* r2 = p.hyT + ((size_t)(b2 * 1152 + c)) * 4096;
        const float w0 = cw[c], w1 = cw[1152 + c], w2 = cw[2304 + c], bi = cb[c];
        conv8(r1, t0, w0, w1, w2, bi, u1);
        conv8(r2, t0, w0, w1, w2, bi, u2);
      } else {
        const u32x4 a0 = *(const u32x4*)(p.z1T + ((size_t)(b1 * 384 + c)) * 4096 + t0);
        const u32x4 c0_ = *(const u32x4*)(p.z1T + ((size_t)(b2 * 384 + c)) * 4096 + t0);
        u1[0] = bflo(a0.x); u1[1] = bfhi(a0.x); u1[2] = bflo(a0.y); u1[3] = bfhi(a0.y); u1[4] = bflo(a0.z); u1[5] = bfhi(a0.z); u1[6] = bflo(a0.w); u1[7] = bfhi(a0.w);
        u2[0] = bflo(c0_.x); u2[1] = bfhi(c0_.x); u2[2] = bflo(c0_.y); u2[3] = bfhi(c0_.y); u2[4] = bflo(c0_.z); u2[5] = bfhi(c0_.z); u2[6] = bflo(c0_.w); u2[7] = bfhi(c0_.w);
      }
#pragma unroll
      for (int k = 0; k < 8; ++k) {
        sm[PADI(t0 + k)] = make_float2(u1[k], u2[k]);
      }
    }
    __syncthreads();
    fft_pass<4, 4096, false, true, false>(sm, tws);
    fft_pass<4, 256, false>(sm, tws);
    f32x4 hpre[8];
    {
      const float2* H = p.H2 + ((size_t)(ORD * 384 + c)) * 8192;
#pragma unroll
      for (int it = 0; it < 8; ++it) hpre[it] = *(const f32x4*)(H + 2 * (tid + it * NTHREADS));
    }
    fft_pass<4, 16, false>(sm, tws);
    fft_mid(sm, hpre);
    fft_pass<4, 16, true>(sm, tws);
    fft_pass<4, 256, true>(sm, tws);
    fft_pass<4, 4096, true, false, true>(sm, tws);
    {
      const float w0 = cw[gc], w1 = cw[1152 + gc], w2 = cw[2304 + gc], bi = cb[gc];
      float q1[8], q2[8];
      conv8_raw(gr1, w0, w1, w2, bi, q1);
      conv8_raw(gr2, w0, w1, w2, bi, q2);
#pragma unroll
      for (int k = 0; k < 8; ++k) {
        const float2 yv = sm[PADI(t0 + k)];
        q1[k] *= yv.x;
        q2[k] *= yv.y;
      }
      {
        bf16_t* dbase = (ORD == 0) ? p.z1T : p.ybT;
        u32x4 w1_, w2_;
        w1_.x = cvt_pk_bf16(q1[0], q1[1]); w1_.y = cvt_pk_bf16(q1[2], q1[3]); w1_.z = cvt_pk_bf16(q1[4], q1[5]); w1_.w = cvt_pk_bf16(q1[6], q1[7]);
        w2_.x = cvt_pk_bf16(q2[0], q2[1]); w2_.y = cvt_pk_bf16(q2[2], q2[3]); w2_.z = cvt_pk_bf16(q2[4], q2[5]); w2_.w = cvt_pk_bf16(q2[6], q2[7]);
        *(u32x4*)(dbase + ((size_t)(b1 * 384 + c)) * 4096 + t0) = w1_;
        *(u32x4*)(dbase + ((size_t)(b2 * 384 + c)) * 4096 + t0) = w2_;
      }
    }
  }
}

constexpr int KROW = 208;
constexpr int VROW = 136;
constexpr int KBUF = 64 * KROW, VBUF = 64 * VROW;

constexpr int NK_ROW = 528;
constexpr int NK_BUF = 32 * NK_ROW;
constexpr int NV_ROW = 72;
constexpr int NV_BUF = 256 * NV_ROW;
constexpr int NRPB_OFF = 2 * NK_BUF + 2 * NV_BUF;

__device__ void natten_phase(const P& p, int l, char* smem) {
  int tid_ = threadIdx.x;
  asm volatile("" : "+v"(tid_));
  const int tid = tid_, lane = tid & 63, wave = tid >> 6, l15 = lane & 15, g = lane >> 4;
  const int hw = wave >> 1, qh = wave & 1;
  char* Ks = smem;
  char* Vs = smem + 2 * NK_BUF;
  float* rp = (float*)(smem + NRPB_OFF);
  __syncthreads();
  for (int i = tid; i < 4 * 15 * 31; i += NTHREADS) rp[i] = p.rpb[(size_t)l * 4 * 15 * 31 + i] * 1.4426950408889634f;
  const float qscale = 0.125f * 1.4426950408889634f;
  for (int job = blockIdx.x; job < 512; job += gridDim.x) {
    const int r = job & 63, b = job >> 6;
    const int r0 = min(max(r - 4, 0), 56);
    bf16x8 qf[2][2];
    int cq[2], c0[2];
#pragma unroll
    for (int nt = 0; nt < 2; ++nt) {
      cq[nt] = qh * 32 + nt * 16 + l15;
      c0[nt] = min(max(cq[nt] - 8, 0), 48);
      const bf16_t* qp = p.na + (size_t)(b * 4096 + r * 64 + cq[nt]) * 768 + hw * 64;
#pragma unroll
      for (int ks = 0; ks < 2; ++ks) qf[nt][ks] = *(const bf16x8*)(qp + ks * 32 + g * 8);
    }
    f32x4 o[4][2];
#pragma unroll
    for (int a = 0; a < 4; ++a)
#pragma unroll
      for (int n = 0; n < 2; ++n) o[a][n] = (f32x4){0.f, 0.f, 0.f, 0.f};
    float mrow[2] = {-1e30f, -1e30f}, lrow[2] = {0.f, 0.f};
    u32x4 rk[2], rv[2];
    auto gload = [&](int t) {
      const int kr = r0 + (t >> 1), kh = (t & 1) * 32;
      const bf16_t* kbase = p.na + (size_t)(b * 4096 + kr * 64 + kh) * 768 + 256;
#pragma unroll
      for (int i = 0; i < 2; ++i) {
        const int c = tid + 512 * i, key = c >> 5, cc = c & 31;
        rk[i] = *(const u32x4*)(kbase + (size_t)key * 768 + cc * 8);
      }
#pragma unroll
      for (int i = 0; i < 2; ++i) {
        const int c = tid + 512 * i, row = c >> 2, cc = c & 3;
        rv[i] = *(const u32x4*)(p.naVT + ((size_t)(b * 256 + row)) * 4096 + kr * 64 + kh + cc * 8);
      }
    };
    auto lstore = [&](int buf) {
      char* kb_ = Ks + buf * NK_BUF;
      char* vb_ = Vs + buf * NV_BUF;
#pragma unroll
      for (int i = 0; i < 2; ++i) {
        const int c = tid + 512 * i, key = c >> 5, cc = c & 31;
        *(u32x4*)(kb_ + key * NK_ROW + cc * 16) = rk[i];
      }
#pragma unroll
      for (int i = 0; i < 2; ++i) {
        const int c = tid + 512 * i, row = c >> 2, cc = c & 3;
        u32x2 lo, hi;
        lo.x = rv[i].x; lo.y = rv[i].y; hi.x = rv[i].z; hi.y = rv[i].w;
        *(u32x2*)(vb_ + row * NV_ROW + cc * 16) = lo;
        *(u32x2*)(vb_ + row * NV_ROW + cc * 16 + 8) = hi;
      }
    };
    gload(0);
    __syncthreads();
    lstore(0);
    gload(1);
    for (int t = 0; t < 16; ++t) {
      __syncthreads();
      if (t + 1 < 16) {
        lstore((t + 1) & 1);
        if (t + 2 < 16) gload(t + 2);
      }
      __builtin_amdgcn_sched_barrier(0);
      const char* kb_ = Ks + (t & 1) * NK_BUF;
      const char* vb_ = Vs + (t & 1) * NV_BUF + hw * 64 * NV_ROW;
      const int kh = (t & 1) * 32;
      f32x4 s[2][2];
#pragma unroll
      for (int a = 0; a < 2; ++a)
#pragma unroll
        for (int n = 0; n < 2; ++n) s[a][n] = (f32x4){0.f, 0.f, 0.f, 0.f};
#pragma unroll
      for (int mt = 0; mt < 2; ++mt)
#pragma unroll
        for (int ks = 0; ks < 2; ++ks) {
          const bf16x8 kf = *(const bf16x8*)(kb_ + (mt * 16 + l15) * NK_ROW + hw * 128 + ks * 64 + g * 16);
#pragma unroll
          for (int nt = 0; nt < 2; ++nt)
            s[mt][nt] = __builtin_amdgcn_mfma_f32_16x16x32_bf16(kf, qf[nt][ks], s[mt][nt], 0, 0, 0);
        }
      const float* brow = rp + (hw * 15 + (r0 + (t >> 1) - r + 7)) * 31;
      bf16x8 pf[2];
#pragma unroll
      for (int nt = 0; nt < 2; ++nt) {
        float mx = -1e30f;
#pragma unroll
        for (int mt = 0; mt < 2; ++mt)
#pragma unroll
          for (int j = 0; j < 4; ++j) {
            const int kc = kh + mt * 16 + g * 4 + j;
            const bool valid = (unsigned)(kc - c0[nt]) < 16u;
            const int dc = min(max(kc - cq[nt] + 15, 0), 30);
            const float sc = valid ? (s[mt][nt][j] * qscale + brow[dc]) : -1e30f;
            s[mt][nt][j] = sc;
            mx = fmaxf(mx, sc);
          }
        mx = fmaxf(mx, __shfl_xor(mx, 16));
        mx = fmaxf(mx, __shfl_xor(mx, 32));
        const float mnew = fmaxf(mrow[nt], mx);
        const float alpha = __builtin_amdgcn_exp2f(mrow[nt] - mnew);
        mrow[nt] = mnew;
        float ls = 0.f;
#pragma unroll
        for (int mt = 0; mt < 2; ++mt)
#pragma unroll
          for (int j = 0; j < 4; ++j) {
            const float e = (s[mt][nt][j] > -1e29f) ? __builtin_amdgcn_exp2f(s[mt][nt][j] - mnew) : 0.f;
            s[mt][nt][j] = e;
            ls += e;
          }
        lrow[nt] = lrow[nt] * alpha + ls;
#pragma unroll
        for (int a = 0; a < 4; ++a) o[a][nt] *= alpha;
        u32x4 w;
        w.x = cvt_pk_bf16(s[0][nt][0], s[0][nt][1]);
        w.y = cvt_pk_bf16(s[0][nt][2], s[0][nt][3]);
        w.z = cvt_pk_bf16(s[1][nt][0], s[1][nt][1]);
        w.w = cvt_pk_bf16(s[1][nt][2], s[1][nt][3]);
        pf[nt] = __builtin_bit_cast(bf16x8, w);
      }
#pragma unroll
      for (int mt = 0; mt < 4; ++mt) {
        const u32x2 lo = *(const u32x2*)(vb_ + (mt * 16 + l15) * NV_ROW + (4 * g) * 2);
        const u32x2 hi = *(const u32x2*)(vb_ + (mt * 16 + l15) * NV_ROW + (16 + 4 * g) * 2);
        u32x4 w;
        w.x = lo.x; w.y = lo.y; w.z = hi.x; w.w = hi.y;
        const bf16x8 vf = __builtin_bit_cast(bf16x8, w);
#pragma unroll
        for (int nt = 0; nt < 2; ++nt)
          o[mt][nt] = __builtin_amdgcn_mfma_f32_16x16x32_bf16(vf, pf[nt], o[mt][nt], 0, 0, 0);
      }
    }
#pragma unroll
    for (int nt = 0; nt < 2; ++nt) {
      float lt = lrow[nt];
      lt += __shfl_xor(lt, 16);
      lt += __shfl_xor(lt, 32);
      const float inv = 1.0f / lt;
      const int tok = b * 4096 + r * 64 + cq[nt];
#pragma unroll
      for (int mt = 0; mt < 4; ++mt) {
        u32x2 w;
        w.x = cvt_pk_bf16(o[mt][nt][0] * inv, o[mt][nt][1] * inv);
        w.y = cvt_pk_bf16(o[mt][nt][2] * inv, o[mt][nt][3] * inv);
        *(u32x2*)(p.o_c + (size_t)tok * 256 + hw * 64 + mt * 16 + g * 4) = w;
      }
    }
  }
}


__device__ void attn_phase(const P& p, char* smem) {
  int tid_ = threadIdx.x;
  asm volatile("" : "+v"(tid_));
  const int tid = tid_, lane = tid & 63, wave = tid >> 6, l15 = lane & 15, g = lane >> 4;
  char* Ks = smem;
  char* Vs = smem + 2 * KBUF;
  for (int job = vblock(); job < 768; job += gridDim.x) {
    const int qblk = job & 15, bh = job >> 4;
    const int b = bh / 6, h = bh % 6;
    const bf16_t* Q = p.qb + (size_t)bh * 4096 * 96;
    const bf16_t* Kg = p.kb + (size_t)bh * 4096 * 96;
    const bf16_t* Vt = p.vT + (size_t)bh * 64 * 4096;
    const int q0 = qblk * 256 + wave * 32;
    bf16x8 qf[2][3];
#pragma unroll
    for (int nt = 0; nt < 2; ++nt)
#pragma unroll
      for (int ks = 0; ks < 3; ++ks)
        qf[nt][ks] = *(const bf16x8*)(Q + (size_t)(q0 + nt * 16 + l15) * 96 + ks * 32 + g * 8);
    f32x4 o[4][2];
#pragma unroll
    for (int a = 0; a < 4; ++a)
#pragma unroll
      for (int n = 0; n < 2; ++n) o[a][n] = (f32x4){0.f, 0.f, 0.f, 0.f};
    float mrow[2] = {-1e30f, -1e30f}, lrow[2] = {0.f, 0.f};

    u32x4 rk[2];
    u32x4 rv;
    const int kr1 = (tid + 512) / 12, kc1 = (tid + 512) - kr1 * 12;
    const int kr0 = tid / 12, kc0 = tid - kr0 * 12;
    auto gload = [&](int kt) {
      const u32x4* kp = (const u32x4*)(Kg + (size_t)kt * 64 * 96);
      rk[0] = kp[tid];
      if (tid < 256) rk[1] = kp[tid + 512];
      rv = *(const u32x4*)(Vt + (size_t)(tid >> 3) * 4096 + kt * 64 + (tid & 7) * 8);
    };
    auto lstore = [&](int buf) {
      char* kb_ = Ks + buf * KBUF;
      char* vb_ = Vs + buf * VBUF;
      *(u32x4*)(kb_ + kr0 * KROW + kc0 * 16) = rk[0];
      if (tid < 256) *(u32x4*)(kb_ + kr1 * KROW + kc1 * 16) = rk[1];
      u32x2 lo, hi;
      lo.x = rv.x; lo.y = rv.y; hi.x = rv.z; hi.y = rv.w;
      *(u32x2*)(vb_ + (tid >> 3) * VROW + (tid & 7) * 16) = lo;
      *(u32x2*)(vb_ + (tid >> 3) * VROW + (tid & 7) * 16 + 8) = hi;
    };
    const int NKT = 64;
    gload(0);
    __syncthreads();
    lstore(0);
    gload(1);
    for (int kt = 0; kt < NKT; ++kt) {
      __syncthreads();
      if (kt + 1 < NKT) {
        lstore((kt + 1) & 1);
        if (kt + 2 < NKT) gload(kt + 2);
      }
      __builtin_amdgcn_sched_barrier(0);
      const char* kb_ = Ks + (kt & 1) * KBUF;
      const char* vb_ = Vs + (kt & 1) * VBUF;
      f32x4 s[4][2];
#pragma unroll
      for (int a = 0; a < 4; ++a)
#pragma unroll
        for (int n = 0; n < 2; ++n) s[a][n] = (f32x4){0.f, 0.f, 0.f, 0.f};
#pragma unroll
      for (int mt = 0; mt < 4; ++mt)
#pragma unroll
        for (int ks = 0; ks < 3; ++ks) {
          const bf16x8 kf = *(const bf16x8*)(kb_ + (mt * 16 + l15) * KROW + (ks * 32 + g * 8) * 2);
#pragma unroll
          for (int nt = 0; nt < 2; ++nt)
            s[mt][nt] = __builtin_amdgcn_mfma_f32_16x16x32_bf16(kf, qf[nt][ks], s[mt][nt], 0, 0, 0);
        }
      bf16x8 pf[2][2];
#pragma unroll
      for (int nt = 0; nt < 2; ++nt) {
        float mx = s[0][nt][0];
#pragma unroll
        for (int mt = 0; mt < 4; ++mt)
#pragma unroll
          for (int j = 0; j < 4; ++j) mx = fmaxf(mx, s[mt][nt][j]);
        mx = fmaxf(mx, __shfl_xor(mx, 16));
        mx = fmaxf(mx, __shfl_xor(mx, 32));
        if (__any(mx > mrow[nt] + 8.0f)) {
          const float mnew = fmaxf(mrow[nt], mx);
          const float alpha = __builtin_amdgcn_exp2f(mrow[nt] - mnew);
          mrow[nt] = mnew;
          lrow[nt] *= alpha;
#pragma unroll
          for (int a = 0; a < 4; ++a) o[a][nt] *= alpha;
        }
        const float mref = mrow[nt];
        float ls = 0.f;
#pragma unroll
        for (int mt = 0; mt < 4; ++mt)
#pragma unroll
          for (int j = 0; j < 4; ++j) {
            const float e = __builtin_amdgcn_exp2f(s[mt][nt][j] - mref);
            s[mt][nt][j] = e;
            ls += e;
          }
        lrow[nt] += ls;
#pragma unroll
        for (int kk = 0; kk < 2; ++kk) {
          u32x4 w;
          w.x = cvt_pk_bf16(s[2 * kk][nt][0], s[2 * kk][nt][1]);
          w.y = cvt_pk_bf16(s[2 * kk][nt][2], s[2 * kk][nt][3]);
          w.z = cvt_pk_bf16(s[2 * kk + 1][nt][0], s[2 * kk + 1][nt][1]);
          w.w = cvt_pk_bf16(s[2 * kk + 1][nt][2], s[2 * kk + 1][nt][3]);
          pf[kk][nt] = __builtin_bit_cast(bf16x8, w);
        }
      }
#pragma unroll
      for (int kk = 0; kk < 2; ++kk)
#pragma unroll
        for (int mt = 0; mt < 4; ++mt) {
          const u32x2 lo = *(const u32x2*)(vb_ + (mt * 16 + l15) * VROW + (32 * kk + 4 * g) * 2);
          const u32x2 hi = *(const u32x2*)(vb_ + (mt * 16 + l15) * VROW + (32 * kk + 16 + 4 * g) * 2);
          u32x4 w;
          w.x = lo.x; w.y = lo.y; w.z = hi.x; w.w = hi.y;
          const bf16x8 vf = __builtin_bit_cast(bf16x8, w);
#pragma unroll
          for (int nt = 0; nt < 2; ++nt)
            o[mt][nt] = __builtin_amdgcn_mfma_f32_16x16x32_bf16(vf, pf[kk][nt], o[mt][nt], 0, 0, 0);
        }
    }
#pragma unroll
    for (int nt = 0; nt < 2; ++nt) {
      float lt = lrow[nt];
      lt += __shfl_xor(lt, 16);
      lt += __shfl_xor(lt, 32);
      const float inv = 1.0f / lt;
      const int tok = b * 4096 + q0 + nt * 16 + l15;
#pragma unroll
      for (int mt = 0; mt < 4; ++mt) {
        u32x2 w;
        w.x = cvt_pk_bf16(o[mt][nt][0] * inv, o[mt][nt][1] * inv);
        w.y = cvt_pk_bf16(o[mt][nt][2] * inv, o[mt][nt][3] * inv);
        *(u32x2*)(p.o_a + (size_t)tok * 384 + h * 64 + mt * 16 + g * 4) = w;
      }
    }
  }
}

__device__ void mixnorm_phase(const P& p, char* smem) {
  int tid_ = threadIdx.x;
  asm volatile("" : "+v"(tid_));
  const int tid = tid_;
  for (int job = blockIdx.x; job < NTOK / 32; job += gridDim.x) {
    const int tok0 = job * 32, b = tok0 >> 12, s0 = tok0 & 4095;
    __syncthreads();
#pragma unroll
    for (int i = 0; i < 3; ++i) {
      const int c = tid + 512 * i, row = c / 48, cc = c % 48;
      *(u32x4*)(smem + row * 2048 + cc * 16) = *(const u32x4*)(p.o_a + (size_t)(tok0 + row) * 384 + cc * 8);
    }
#pragma unroll
    for (int i = 0; i < 2; ++i) {
      const int c = tid + 512 * i, row = c >> 5, cc = c & 31;
      *(u32x4*)(smem + row * 2048 + 1536 + cc * 16) = *(const u32x4*)(p.o_c + (size_t)(tok0 + row) * 256 + cc * 8);
    }
#pragma unroll
    for (int i = 0; i < 3; ++i) {
      const int c = tid + 512 * i, ch = c >> 2, tc = c & 3;
      const u32x4 v = *(const u32x4*)(p.ybT + ((size_t)(b * 384 + ch)) * 4096 + s0 + tc * 8);
      bf16_t* dst = (bf16_t*)smem + (size_t)(tc * 8) * 1024 + 384 + ch;
      dst[0 * 1024] = (bf16_t)(v.x & 0xffff); dst[1 * 1024] = (bf16_t)(v.x >> 16);
      dst[2 * 1024] = (bf16_t)(v.y & 0xffff); dst[3 * 1024] = (bf16_t)(v.y >> 16);
      dst[4 * 1024] = (bf16_t)(v.z & 0xffff); dst[5 * 1024] = (bf16_t)(v.z >> 16);
      dst[6 * 1024] = (bf16_t)(v.w & 0xffff); dst[7 * 1024] = (bf16_t)(v.w >> 16);
    }
    __syncthreads();
    const int tok = tid >> 4, sub = tid & 15;
    float ss[3] = {0.f, 0.f, 0.f};
#pragma unroll
    for (int gi = 0; gi < 3; ++gi) {
      const int i0 = (gi == 0) ? 0 : (gi == 1 ? 3 : 6), i1 = (gi == 0) ? 3 : (gi == 1 ? 6 : 8);
      float acc = 0.f;
#pragma unroll 2
      for (int i = i0; i < i1; ++i) {
        const u32x4 v = *(const u32x4*)(smem + tok * 2048 + (sub + 16 * i) * 16);
        float a;
        a = bflo(v.x); acc += a * a; a = bfhi(v.x); acc += a * a;
        a = bflo(v.y); acc += a * a; a = bfhi(v.y); acc += a * a;
        a = bflo(v.z); acc += a * a; a = bfhi(v.z); acc += a * a;
        a = bflo(v.w); acc += a * a; a = bfhi(v.w); acc += a * a;
      }
      acc += __shfl_xor(acc, 1);
      acc += __shfl_xor(acc, 2);
      acc += __shfl_xor(acc, 4);
      acc += __shfl_xor(acc, 8);
      ss[gi] = acc;
    }
    float rs[3];
    rs[0] = rsqrtf(ss[0] * (1.0f / 384.0f) + 1e-6f);
    rs[1] = rsqrtf(ss[1] * (1.0f / 384.0f) + 1e-6f);
    rs[2] = rsqrtf(ss[2] * (1.0f / 256.0f) + 1e-6f);
#pragma unroll
    for (int gi = 0; gi < 3; ++gi) {
      const int i0 = (gi == 0) ? 0 : (gi == 1 ? 3 : 6), i1 = (gi == 0) ? 3 : (gi == 1 ? 6 : 8);
      const float r = rs[gi];
#pragma unroll 2
      for (int i = i0; i < i1; ++i) {
        const u32x4 v = *(const u32x4*)(smem + tok * 2048 + (sub + 16 * i) * 16);
        u32x4 w;
        w.x = cvt_pk_bf16(bflo(v.x) * r, bfhi(v.x) * r);
        w.y = cvt_pk_bf16(bflo(v.y) * r, bfhi(v.y) * r);
        w.z = cvt_pk_bf16(bflo(v.z) * r, bfhi(v.z) * r);
        w.w = cvt_pk_bf16(bflo(v.w) * r, bfhi(v.w) * r);
        *(u32x4*)(p.y + (size_t)(tok0 + tok) * 1024 + (sub + 16 * i) * 8) = w;
      }
    }
  }
}

enum { EPI_INPROJ = 0, EPI_QUP = 1, EPI_KVUP = 2, EPI_OUTPROJ = 3, EPI_SWIGLU = 4, EPI_DOWN = 5 };

template <int EPI>
__device__ void gemm_phase(const P& p, int l, const bf16_t* __restrict__ A, int lda, const bf16_t* __restrict__ Bt,
                           int K, int nN, char* smem) {
  int tid_ = threadIdx.x;
  asm volatile("" : "+v"(tid_));
  const int tid = tid_, lane = tid & 63, wave = tid >> 6, wm = wave >> 2, wn = wave & 3, l15 = lane & 15,
            g = lane >> 4;
  const int ntiles = 128 * nN;
  const int srow = tid >> 3, skc = tid & 7;
  const int sw_off = srow * 128 + ((skc ^ ((srow >> 1) & 7)) * 16);
  const int rsw = (l15 >> 1) & 7;
  for (int tile = vblock(); tile < ntiles; tile += gridDim.x) {
    const int gsz_ = 4 * nN, grp_ = tile / gsz_, w_ = tile - grp_ * gsz_;
    const int ni = w_ >> 2, mi = grp_ * 4 + (w_ & 3);
    const int m0 = mi * 256, n0 = ni * 256;
    f32x4 acc[8][4];
#pragma unroll
    for (int a = 0; a < 8; ++a)
#pragma unroll
      for (int b = 0; b < 4; ++b) acc[a][b] = (f32x4){0.f, 0.f, 0.f, 0.f};
    const bf16_t* Ag = A + (size_t)(m0 + srow) * lda + skc * 8;
    const bf16_t* Bg = Bt + (size_t)(n0 + srow) * K + skc * 8;
    u32x4 ra[4], rb[4];
    auto gl = [&](int kt) {
#pragma unroll
      for (int i = 0; i < 4; ++i) ra[i] = *(const u32x4*)(Ag + (size_t)i * 64 * lda + kt * 64);
#pragma unroll
      for (int i = 0; i < 4; ++i) rb[i] = *(const u32x4*)(Bg + (size_t)i * 64 * K + kt * 64);
    };
    auto st = [&](int buf) {
      char* nb = smem + buf * 65536;
#pragma unroll
      for (int i = 0; i < 4; ++i) *(u32x4*)(nb + sw_off + i * 8192) = ra[i];
#pragma unroll
      for (int i = 0; i < 4; ++i) *(u32x4*)(nb + 32768 + sw_off + i * 8192) = rb[i];
    };
    const int nk = K / 64;
    gl(0);
    float rs_row = 1.f;
    if (EPI == EPI_INPROJ || EPI == EPI_SWIGLU) {
      if (tid < 256) {
        const f32x4* pp = (const f32x4*)(p.part_x + (size_t)(m0 + tid) * 16);
        const f32x4 a0 = pp[0], a1 = pp[1], a2 = pp[2], a3 = pp[3];
        const float tot = (a0[0] + a0[1] + a0[2] + a0[3]) + (a1[0] + a1[1] + a1[2] + a1[3]) +
                          (a2[0] + a2[1] + a2[2] + a2[3]) + (a3[0] + a3[1] + a3[2] + a3[3]);
        rs_row = rsqrtf(tot * (1.0f / 1024.0f) + 1e-6f);
      }
    } else if (EPI == EPI_QUP) {
      if (tid < 256) {
        const f32x4 a0 = *(const f32x4*)(p.part_q + (size_t)(m0 + tid) * 4);
        rs_row = rsqrtf((a0[0] + a0[1] + a0[2] + a0[3]) * (1.0f / 256.0f) + 1e-6f);
      }
    } else if (EPI == EPI_KVUP) {
      if (tid < 256) {
        const float2 a0 = *(const float2*)(p.part_kv + (size_t)(m0 + tid) * 2);
        rs_row = rsqrtf((a0.x + a0.y) * (1.0f / 128.0f) + 1e-6f);
      }
    }
    float* s_rs = (float*)(smem + 131072);
    __syncthreads();
    st(0);
    if (EPI != EPI_OUTPROJ && EPI != EPI_DOWN && true) {
      if (tid < 256) s_rs[tid] = rs_row;
    }
    __syncthreads();
    for (int kt = 0; kt < nk; ++kt) {
      if (kt + 1 < nk) gl(kt + 1);
      __builtin_amdgcn_sched_barrier(0);
      const char* Ab = smem + (kt & 1) * 65536;
      const char* Bb = Ab + 32768;
#pragma unroll
      for (int ks = 0; ks < 2; ++ks) {
        bf16x8 bfr[4];
#pragma unroll
        for (int nt = 0; nt < 4; ++nt)
          bfr[nt] = *(const bf16x8*)(Bb + (wn * 64 + nt * 16 + l15) * 128 + (((ks * 4 + g) ^ rsw) * 16));
        bf16x8 af[2][2];
#pragma unroll
        for (int mt = 0; mt < 2; ++mt)
          af[0][mt] = *(const bf16x8*)(Ab + (wm * 128 + mt * 16 + l15) * 128 + (((ks * 4 + g) ^ rsw) * 16));
#pragma unroll
        for (int mh = 0; mh < 4; ++mh) {
          if (mh < 3) {
#pragma unroll
            for (int mt = 0; mt < 2; ++mt)
              af[(mh + 1) & 1][mt] = *(const bf16x8*)(Ab + (wm * 128 + ((mh + 1) * 2 + mt) * 16 + l15) * 128 + (((ks * 4 + g) ^ rsw) * 16));
          }
          __builtin_amdgcn_sched_barrier(0);
#pragma unroll
          for (int mt = 0; mt < 2; ++mt)
#pragma unroll
            for (int nt = 0; nt < 4; ++nt)
              acc[mh * 2 + mt][nt] = __builtin_amdgcn_mfma_f32_16x16x32_bf16(bfr[nt], af[mh & 1][mt], acc[mh * 2 + mt][nt], 0, 0, 0);
          __builtin_amdgcn_sched_barrier(0);
        }
      }
      if (kt + 1 < nk) st((kt + 1) & 1);
      __syncthreads();
    }
    int opq_ = 0;
    asm volatile("" : "+v"(opq_));
    const int rbase = m0 + wm * 128 + l15 + opq_;
    const int cbase = n0 + wn * 64 + g * 4 + opq_;
    if (EPI == EPI_INPROJ) {
      const int wc0 = n0 + wn * 64;
#pragma unroll
      for (int mt = 0; mt < 8; ++mt) {
        const int row = rbase + mt * 16;
        const float rs = s_rs[row - m0];
        const int bb = row >> 12, ss = row & 4095;
        float sq = 0.f;
#pragma unroll
        for (int nt = 0; nt < 4; ++nt) {
          const int ct = wc0 + nt * 16;
          const int col = cbase + nt * 16;
          f32x4 v = acc[mt][nt] * rs;
          if (ct < 384) {
            sq += v[0] * v[0] + v[1] * v[1] + v[2] * v[2] + v[3] * v[3];
            u32x2 w;
            w.x = cvt_pk_bf16(v[0], v[1]);
            w.y = cvt_pk_bf16(v[2], v[3]);
            *(u32x2*)(p.projA + (size_t)row * 416 + col) = w;
          } else if (ct == 384) {
            if (nt < 3) {
              const f32x4 v2 = acc[mt][(nt + 1) & 3] * rs;
              const int i0 = col - 384;
              const float2* cs = p.ropecs + ss * 16 + i0;
              float o1[4], o2[4];
#pragma unroll
              for (int j = 0; j < 4; ++j) {
                const float2 c_s = cs[j];
                o1[j] = v[j] * c_s.x - v2[j] * c_s.y;
                o2[j] = v[j] * c_s.y + v2[j] * c_s.x;
              }
              u32x2 w;
              w.x = cvt_pk_bf16(o1[0], o1[1]);
              w.y = cvt_pk_bf16(o1[2], o1[3]);
              *(u32x2*)(p.projA + (size_t)row * 416 + 384 + i0) = w;
              w.x = cvt_pk_bf16(o2[0], o2[1]);
              w.y = cvt_pk_bf16(o2[2], o2[3]);
              *(u32x2*)(p.projA + (size_t)row * 416 + 400 + i0) = w;
            }
          } else if (ct == 400) {
          } else if (ct < 1568) {
            const int hc = col - 416;
            bf16_t* dst = p.hyT + ((size_t)(bb * 1152 + hc)) * 4096 + ss;
            dst[0] = f2bf(v[0]);
            dst[4096] = f2bf(v[1]);
            dst[2 * 4096] = f2bf(v[2]);
            dst[3 * 4096] = f2bf(v[3]);
          } else if (ct < 2080) {
            u32x2 w;
            w.x = cvt_pk_bf16(v[0], v[1]);
            w.y = cvt_pk_bf16(v[2], v[3]);
            *(u32x2*)(p.na + (size_t)row * 768 + (col - 1568)) = w;
          } else if (ct < 2336) {
            const int vc = col - 2080;
            bf16_t* dst = p.naVT + ((size_t)(bb * 256 + vc)) * 4096 + ss;
            dst[0] = f2bf(v[0]);
            dst[4096] = f2bf(v[1]);
            dst[2 * 4096] = f2bf(v[2]);
            dst[3 * 4096] = f2bf(v[3]);
          }
        }
        if (wc0 < 384) {
          sq += __shfl_xor(sq, 16);
          sq += __shfl_xor(sq, 32);
          if (g == 0) {
            if (wc0 < 256) p.part_q[(size_t)row * 4 + (wc0 >> 6)] = sq;
            else p.part_kv[(size_t)row * 2 + ((wc0 - 256) >> 6)] = sq;
          }
        }
      }
    } else if (EPI == EPI_QUP) {
      const int wc0 = n0 + wn * 64;
      const float qscale = 0.10206207261596575f * 1.4426950408889634f;
#pragma unroll
      for (int mt = 0; mt < 8; ++mt) {
        const int row = rbase + mt * 16;
        const float rs = s_rs[row - m0] * qscale;
        const int bb = row >> 12, ss = row & 4095;
#pragma unroll
        for (int nt = 0; nt < 4; ++nt) {
          const int T = (wc0 >> 4) + nt;
          if (T < 36) {
            const int hh = T / 6, tt = T % 6;
            bf16_t* qrow = p.qb + ((size_t)((bb * 6 + hh) * 4096 + ss)) * 96;
            const f32x4 v = acc[mt][nt] * rs;
            if (tt < 4) {
              u32x2 w;
              w.x = cvt_pk_bf16(v[0], v[1]);
              w.y = cvt_pk_bf16(v[2], v[3]);
              *(u32x2*)(qrow + tt * 16 + g * 4) = w;
            } else if (tt == 4) {
              if (nt < 3) {
                const f32x4 v2 = acc[mt][(nt + 1) & 3] * rs;
                const float2* cs = p.ropecs + ss * 16 + g * 4;
                float o1[4], o2[4];
#pragma unroll
                for (int j = 0; j < 4; ++j) {
                  const float2 c_s = cs[j];
                  o1[j] = v[j] * c_s.x - v2[j] * c_s.y;
                  o2[j] = v[j] * c_s.y + v2[j] * c_s.x;
                }
                u32x2 w;
                w.x = cvt_pk_bf16(o1[0], o1[1]);
                w.y = cvt_pk_bf16(o1[2], o1[3]);
                *(u32x2*)(qrow + 64 + g * 4) = w;
                w.x = cvt_pk_bf16(o2[0], o2[1]);
                w.y = cvt_pk_bf16(o2[2], o2[3]);
                *(u32x2*)(qrow + 80 + g * 4) = w;
              }
            }
          }
        }
      }
    } else if (EPI == EPI_KVUP) {
      const int hh = ni * 2 + (wn >> 1);
#pragma unroll
      for (int mt = 0; mt < 8; ++mt) {
        const int row = rbase + mt * 16;
        const float rs = s_rs[row - m0];
        const int bb = row >> 12, ss = row & 4095;
#pragma unroll
        for (int nt = 0; nt < 4; ++nt) {
          const f32x4 v = acc[mt][nt] * rs;
          if ((wn & 1) == 0) {
            u32x2 w;
            w.x = cvt_pk_bf16(v[0], v[1]);
            w.y = cvt_pk_bf16(v[2], v[3]);
            *(u32x2*)(p.kb + ((size_t)((bb * 6 + hh) * 4096 + ss)) * 96 + nt * 16 + g * 4) = w;
          } else {
            const int dv = nt * 16 + g * 4;
            bf16_t* dst = p.vT + ((size_t)((bb * 6 + hh) * 64 + dv)) * 4096 + ss;
            dst[0] = f2bf(v[0]);
            dst[4096] = f2bf(v[1]);
            dst[2 * 4096] = f2bf(v[2]);
            dst[3 * 4096] = f2bf(v[3]);
          }
        }
      }
#pragma unroll
      for (int i = 0; i < 2; ++i) {
        const int c = tid + 512 * i, rr = c >> 2, cc = c & 3;
        const int row = m0 + rr, bb = row >> 12, ss = row & 4095;
        const u32x4 v = *(const u32x4*)(p.projA + (size_t)row * 416 + 384 + cc * 8);
        *(u32x4*)(p.kb + ((size_t)((bb * 6 + ni * 2) * 4096 + ss)) * 96 + 64 + cc * 8) = v;
        *(u32x4*)(p.kb + ((size_t)((bb * 6 + ni * 2 + 1) * 4096 + ss)) * 96 + 64 + cc * 8) = v;
      }
    } else if (EPI == EPI_OUTPROJ || EPI == EPI_DOWN) {
      const bool last_upd = (EPI == EPI_DOWN && l == 1);
      const int slot = (n0 + wn * 64) >> 6;
#pragma unroll
      for (int mt = 0; mt < 8; ++mt) {
        const int row = rbase + mt * 16;
        float sq = 0.f;
#pragma unroll
        for (int nt = 0; nt < 4; ++nt) {
          const int col = cbase + nt * 16;
          const u32x2 xr = *(const u32x2*)(p.xb + (size_t)row * 1024 + col);
          const f32x4 xo = (f32x4){bflo(xr.x), bfhi(xr.x), bflo(xr.y), bfhi(xr.y)};
          const f32x4 v = acc[mt][nt] + xo;
          sq += v[0] * v[0] + v[1] * v[1] + v[2] * v[2] + v[3] * v[3];
          if (last_upd) {
            *(f32x4*)(p.out + (size_t)row * 1024 + col) = v;
          } else {
            u32x2 w;
            w.x = cvt_pk_bf16(v[0], v[1]);
            w.y = cvt_pk_bf16(v[2], v[3]);
            *(u32x2*)(p.xb + (size_t)row * 1024 + col) = w;
          }
        }
        sq += __shfl_xor(sq, 16);
        sq += __shfl_xor(sq, 32);
        if (g == 0) p.part_x[(size_t)row * 16 + slot] = sq;
      }
    } else if (EPI == EPI_SWIGLU) {
      const int fbase = ((n0 + wn * 64) >> 1) + g * 4;
#pragma unroll
      for (int mt = 0; mt < 8; ++mt) {
        const int row = rbase + mt * 16;
        const float rs = s_rs[row - m0];
#pragma unroll
        for (int i = 0; i < 2; ++i) {
          const f32x4 gt = acc[mt][2 * i] * rs, up = acc[mt][2 * i + 1] * rs;
          float hv[4];
#pragma unroll
          for (int j = 0; j < 4; ++j) hv[j] = gt[j] * __builtin_amdgcn_rcpf(1.0f + __expf(-gt[j])) * up[j];
          u32x2 w;
          w.x = cvt_pk_bf16(hv[0], hv[1]);
          w.y = cvt_pk_bf16(hv[2], hv[3]);
          *(u32x2*)(p.hidden + (size_t)row * 2816 + fbase + i * 16) = w;
        }
      }
    }
  }
}

__device__ void final_norm_phase(const P& p) {
  int tid_ = threadIdx.x;
  asm volatile("" : "+v"(tid_));
  const int tid = tid_, lane = tid & 63, wave = tid >> 6;
  for (int row = blockIdx.x * 8 + wave; row < NTOK; row += gridDim.x * 8) {
    const f32x4* pp = (const f32x4*)(p.part_x + (size_t)row * 16);
    const f32x4 a0 = pp[0], a1 = pp[1], a2 = pp[2], a3 = pp[3];
    const float tot = (a0[0] + a0[1] + a0[2] + a0[3]) + (a1[0] + a1[1] + a1[2] + a1[3]) +
                      (a2[0] + a2[1] + a2[2] + a2[3]) + (a3[0] + a3[1] + a3[2] + a3[3]);
    const float rs = rsqrtf(tot * (1.0f / 1024.0f) + 1e-6f);
    float* xr = p.out + (size_t)row * 1024;
#pragma unroll
    for (int i = 0; i < 4; ++i) {
      f32x4 v = *(const f32x4*)(xr + lane * 4 + 256 * i);
      const f32x4 gg = *(const f32x4*)(p.final_g + lane * 4 + 256 * i);
      v = v * rs * gg;
      *(f32x4*)(xr + lane * 4 + 256 * i) = v;
    }
  }
}


template <int S>
__device__ __forceinline__ void run_stage(const P& p, int l, char* smem) {
  if (S == 0) prep_phase(p, l, smem);
  if (S == 1) {
    filt_fft_phase(p, l, smem);
    gemm_phase<EPI_INPROJ>(p, l, p.xb, 1024, p.Win, 1024, 10, smem);
  }
  if (S == 2) {
    hyena_phase<0>(p, l, smem);
    gemm_phase<EPI_QUP>(p, l, p.projA, 416, p.Wuq, 256, 3, smem);
    gemm_phase<EPI_KVUP>(p, l, p.projA + 256, 416, p.Wukv, 128, 3, smem);
    natten_phase(p, l, smem);
  }
  if (S == 3) {
    hyena_phase<1>(p, l, smem);
    attn_phase(p, smem);
  }
  if (S == 4) mixnorm_phase(p, smem);
  if (S == 5) gemm_phase<EPI_OUTPROJ>(p, l, p.y, 1024, p.Wout, 1024, 4, smem);
  if (S == 6) gemm_phase<EPI_SWIGLU>(p, l, p.xb, 1024, p.Wgu, 1024, 22, smem);
  if (S == 7) gemm_phase<EPI_DOWN>(p, l, p.hidden, 2816, p.Wdown, 2816, 4, smem);
  if (S == 8) final_norm_phase(p);
}

__device__ __forceinline__ void grid_barrier(unsigned* bar, unsigned target) {
  asm volatile("s_waitcnt vmcnt(0)" ::: "memory");
  __syncthreads();
  if (threadIdx.x == 0) {
    __builtin_amdgcn_fence(__ATOMIC_RELEASE, "agent");
    asm volatile("s_waitcnt vmcnt(0)" ::: "memory");
    __hip_atomic_fetch_add(bar, 1u, __ATOMIC_RELAXED, __HIP_MEMORY_SCOPE_AGENT);
    unsigned spins = 0;
    while (__hip_atomic_load(bar, __ATOMIC_RELAXED, __HIP_MEMORY_SCOPE_AGENT) < target && spins < (1u << 22)) {
      __builtin_amdgcn_s_sleep(1);
      ++spins;
    }
    __builtin_amdgcn_fence(__ATOMIC_ACQUIRE, "agent");
    asm volatile("s_waitcnt vmcnt(0)" ::: "memory");
  }
  __syncthreads();
}

__global__ void __launch_bounds__(NTHREADS) k_main(P p) {
  extern __shared__ __attribute__((aligned(16))) char smem[];
  cg::grid_group grid = cg::this_grid();
  if (blockIdx.x == 0 && threadIdx.x == 0) __hip_atomic_store(p.bar, 0u, __ATOMIC_RELAXED, __HIP_MEMORY_SCOPE_AGENT);
  run_stage<0>(p, 0, smem); grid.sync();
  run_stage<1>(p, 0, smem); grid_barrier(p.bar, 1u * gridDim.x);
  run_stage<2>(p, 0, smem); grid_barrier(p.bar, 2u * gridDim.x);
  run_stage<3>(p, 0, smem); grid_barrier(p.bar, 3u * gridDim.x);
  run_stage<4>(p, 0, smem); grid_barrier(p.bar, 4u * gridDim.x);
  run_stage<5>(p, 0, smem); grid_barrier(p.bar, 5u * gridDim.x);
  run_stage<6>(p, 0, smem); grid_barrier(p.bar, 6u * gridDim.x);
  run_stage<7>(p, 0, smem); grid_barrier(p.bar, 7u * gridDim.x);
  run_stage<0>(p, 1, smem); grid_barrier(p.bar, 8u * gridDim.x);
  run_stage<1>(p, 1, smem); grid_barrier(p.bar, 9u * gridDim.x);
  run_stage<2>(p, 1, smem); grid_barrier(p.bar, 10u * gridDim.x);
  run_stage<3>(p, 1, smem); grid_barrier(p.bar, 11u * gridDim.x);
  run_stage<4>(p, 1, smem); grid_barrier(p.bar, 12u * gridDim.x);
  run_stage<5>(p, 1, smem); grid_barrier(p.bar, 13u * gridDim.x);
  run_stage<6>(p, 1, smem); grid_barrier(p.bar, 14u * gridDim.x);
  run_stage<7>(p, 1, smem); grid_barrier(p.bar, 15u * gridDim.x);
  run_stage<8>(p, 1, smem);
}


extern "C" void kernel_launch(void* const* d_in, const int* in_sizes, int n_in, void* d_out, int out_size, void* d_ws,
                              size_t ws_size, hipStream_t stream) {
  static int grid_blocks = 0;
  if (!grid_blocks) {
    int dev = 0, cus = 0;
    (void)hipGetDevice(&dev);
    (void)hipDeviceGetAttribute(&cus, hipDeviceAttributeMultiprocessorCount, dev);
    if (cus <= 0) cus = 256;
    int per_cu = 0;
    (void)hipFuncSetAttribute((const void*)k_main, hipFuncAttributeMaxDynamicSharedMemorySize, LDS_BYTES);
    (void)hipOccupancyMaxActiveBlocksPerMultiprocessor(&per_cu, k_main, NTHREADS, LDS_BYTES);
    if (per_cu > 1) per_cu = 1;
    if (per_cu < 1) per_cu = 1;
    grid_blocks = cus * per_cu;
  }
  P p;
  memset(&p, 0, sizeof(p));
  const float* const* in = (const float* const*)d_in;
  p.x = in[0]; p.norm1_g = in[1]; p.w_in = in[2]; p.q_norm_g = in[3]; p.w_uq = in[4]; p.kv_norm_g = in[5];
  p.w_ukv = in[6]; p.conv_w = in[7]; p.conv_b = in[8]; p.fw1 = in[9]; p.fb1 = in[10]; p.ff1 = in[11];
  p.fw2 = in[12]; p.fb2 = in[13]; p.ff2 = in[14]; p.fw3 = in[15]; p.skip = in[16]; p.rpb = in[17];
  p.mix_g = in[18]; p.w_out = in[19]; p.norm2_g = in[20]; p.w_gate = in[21]; p.w_up = in[22]; p.w_down = in[23];
  p.final_g = in[24];
  p.out = (float*)d_out;
  char* ws = (char*)d_ws;
  size_t off = 0;
  auto take = [&](size_t bytes) {
    char* r = ws + off;
    off += (bytes + 255) & ~(size_t)255;
    return r;
  };
  p.Win = (bf16_t*)take((size_t)2560 * 1024 * 2);
  p.Wuq = (bf16_t*)take((size_t)768 * 256 * 2);
  p.Wukv = (bf16_t*)take((size_t)768 * 128 * 2);
  p.Wout = (bf16_t*)take((size_t)1024 * 1024 * 2);
  p.Wgu = (bf16_t*)take((size_t)5632 * 1024 * 2);
  p.Wdown = (bf16_t*)take((size_t)1024 * 2816 * 2);
  p.ropecs = (float2*)take((size_t)65536 * 8);
  p.tw = (float2*)take((size_t)8192 * 8);
  p.bar = (unsigned*)take(256);
  p.part_x = (float*)take((size_t)NTOK * 16 * 4);
  p.part_q = (float*)take((size_t)NTOK * 4 * 4);
  p.part_kv = (float*)take((size_t)NTOK * 2 * 4);
  p.xb = (bf16_t*)take((size_t)NTOK * 1024 * 2);
  p.H2 = (float2*)take((size_t)768 * 8192 * 8);
  p.z1T = (bf16_t*)take((size_t)1536 * 4096 * 4);
  p.filtT = (float*)p.z1T;
  p.vT = (bf16_t*)take((size_t)8 * 6 * 64 * 4096 * 2);
  p.o_a = (bf16_t*)take((size_t)NTOK * 384 * 2);
  p.o_c = (bf16_t*)take((size_t)NTOK * 256 * 2);
  char* big = take(0);
  p.projA = (bf16_t*)take((size_t)NTOK * 416 * 2);
  p.hyT = (bf16_t*)take((size_t)8 * 1152 * 4096 * 2);
  p.na = (bf16_t*)take((size_t)NTOK * 768 * 2);
  p.qb = (bf16_t*)take((size_t)8 * 6 * 4096 * 96 * 2);
  p.kb = (bf16_t*)take((size_t)8 * 6 * 4096 * 96 * 2);
  p.hidden = (bf16_t*)big;
  p.ybT = (bf16_t*)take((size_t)8 * 384 * 4096 * 2);
  p.naVT = (bf16_t*)take((size_t)8 * 4 * 64 * 4096 * 2);
  p.y = p.qb;
  if (off > ws_size) {
    fprintf(stderr, "workspace too small: need %zu have %zu\n", off, ws_size);
    return;
  }
  void* args[] = {&p};
  hipError_t e = hipLaunchCooperativeKernel((void*)k_main, dim3(grid_blocks), dim3(NTHREADS), args, LDS_BYTES, stream);
  if (e != hipSuccess) fprintf(stderr, "cooperative launch failed: %s (grid %d)\n", hipGetErrorString(e), grid_blocks);
}
```

```cpp
#include <hip/hip_runtime.h>
#include <hip/hip_cooperative_groups.h>
#include <cstdio>
#include <cstring>
#include <cstdint>
#include <cmath>
#include <type_traits>
namespace cg = cooperative_groups;


typedef unsigned short bf16_t;
typedef short bf16x8 __attribute__((ext_vector_type(8)));
typedef float f32x4 __attribute__((ext_vector_type(4)));
typedef unsigned u32x4 __attribute__((ext_vector_type(4)));
typedef unsigned u32x2 __attribute__((ext_vector_type(2)));

constexpr int NTOK = 32768, SEQ = 4096;
constexpr int NTHREADS = 512;
constexpr int LDS_BYTES = 147456;
constexpr int TW_LDS_OFF = 69632;
#define PADI(i) ((i) + ((i) >> 4))

struct P {
  const float *x, *norm1_g, *w_in, *q_norm_g, *w_uq, *kv_norm_g, *w_ukv, *conv_w, *conv_b, *fw1, *fb1, *ff1, *fw2, *fb2,
      *ff2, *fw3, *skip, *rpb, *mix_g, *w_out, *norm2_g, *w_gate, *w_up, *w_down, *final_g;
  float* out;
  bf16_t *Win, *Wuq, *Wukv, *Wout, *Wgu, *Wdown;
  bf16_t *xb, *projA, *hyT, *na, *qb, *kb, *vT, *o_a, *o_c, *y, *hidden, *ybT, *naVT;
  float2* H2;
  float* filtT;
  bf16_t* z1T;
  float *part_x, *part_q, *part_kv;
  float2* ropecs;
  float2* tw;
  unsigned* bar;
  unsigned pad0_, pad1_;
};

typedef __bf16 bf16v2_t __attribute__((ext_vector_type(2)));
typedef float f32x2_t __attribute__((ext_vector_type(2)));
__device__ __forceinline__ unsigned cvt_pk_bf16(float lo, float hi) {
  const f32x2_t v = {lo, hi};
  const bf16v2_t r = __builtin_convertvector(v, bf16v2_t);
  return __builtin_bit_cast(unsigned, r);
}
__device__ __forceinline__ bf16_t f2bf(float f) { return (bf16_t)(cvt_pk_bf16(f, 0.f) & 0xffffu); }
__device__ __forceinline__ float bf2f(bf16_t h) { return __uint_as_float(((unsigned)h) << 16); }
__device__ __forceinline__ float bflo(unsigned u) { return __uint_as_float(u << 16); }
__device__ __forceinline__ float bfhi(unsigned u) { return __uint_as_float(u & 0xffff0000u); }

__device__ __forceinline__ void fast_sincos_rev(float rev, float* s, float* c) {
  const float fr = rev - rintf(rev);
  *s = __builtin_amdgcn_sinf(fr);
  *c = __builtin_amdgcn_cosf(fr);
}
__device__ __forceinline__ float fast_sin(float x) {
  const float rev = x * 0.15915494309189535f;
  const float fr = rev - rintf(rev);
  return __builtin_amdgcn_sinf(fr);
}

__device__ __forceinline__ int vblock() {
  const int G = gridDim.x, b = blockIdx.x;
  return ((G & 7) == 0) ? ((b & 7) * (G >> 3) + (b >> 3)) : b;
}

__device__ void conv_w(const float* __restrict__ W, int K, int N, int Npad, const float* __restrict__ g, bf16_t* Bt,
                       int mode, char* smem) {
  float* tile = (float*)smem;
  int tid_ = threadIdx.x;
  asm volatile("" : "+v"(tid_));
  const int tid = tid_;
  const int nkt = K / 64, nnt = Npad / 64;
  for (int job = blockIdx.x; job < nkt * nnt; job += gridDim.x) {
    const int kt = job % nkt, ntile = job / nkt;
    const int k0 = kt * 64, n0 = ntile * 64;
    __syncthreads();
#pragma unroll
    for (int i = 0; i < 2; ++i) {
      const int k = (tid >> 4) + 32 * i, nq = (tid & 15) * 4, n = n0 + nq;
      f32x4 v = {0.f, 0.f, 0.f, 0.f};
      if (n < N) {
        v = *(const f32x4*)(W + (size_t)(k0 + k) * N + n);
        if (g) v = v * g[k0 + k];
      }
      tile[k * 65 + nq + 0] = v[0];
      tile[k * 65 + nq + 1] = v[1];
      tile[k * 65 + nq + 2] = v[2];
      tile[k * 65 + nq + 3] = v[3];
    }
    __syncthreads();
    {
      const int c = tid, n = c >> 3, kc = c & 7;
      float e[8];
#pragma unroll
      for (int q = 0; q < 8; ++q) e[q] = tile[(kc * 8 + q) * 65 + n];
      u32x4 w;
      w.x = cvt_pk_bf16(e[0], e[1]);
      w.y = cvt_pk_bf16(e[2], e[3]);
      w.z = cvt_pk_bf16(e[4], e[5]);
      w.w = cvt_pk_bf16(e[6], e[7]);
      const int nn = n0 + n;
      int dest = nn;
      if (mode == 1) dest = 32 * (nn >> 4) + (nn & 15);
      if (mode == 2) dest = 32 * (nn >> 4) + 16 + (nn & 15);
      *(u32x4*)(Bt + (size_t)dest * K + k0 + kc * 8) = w;
    }
  }
}

__device__ void filt_mlp(const P& p, int l, char* smem) {
  float* zf = (float*)smem;
  float* h1 = zf + 16 * 17;
  float* h2 = h1 + 64 * 16;
  int tid_ = threadIdx.x;
  asm volatile("" : "+v"(tid_));
  const int tid = tid_, tl = tid & 15, kk = tid >> 4;
  const float* w1 = p.fw1 + l * 17 * 64;
  const float* b1 = p.fb1 + l * 64;
  const float* f1 = p.ff1 + l * 64;
  const float* w2 = p.fw2 + l * 64 * 64;
  const float* b2 = p.fb2 + l * 64;
  const float* f2 = p.ff2 + l * 64;
  const float* w3 = p.fw3 + (size_t)l * 64 * 1536;
  for (int job = blockIdx.x; job < 256; job += gridDim.x) {
    const int t0 = job * 16;
    __syncthreads();
    {
      const int t = t0 + tl;
      if (kk < 8) {
        const float band = 1e-4f + (float)kk * ((7.0f - 1e-4f) / 7.0f);
        const float ang = ((6.283185307179586f * (float)t) * band) / 4096.0f;
        float s, c;
        fast_sincos_rev(ang * 0.15915494309189535f, &s, &c);
        zf[tl * 17 + 1 + kk] = c;
        zf[tl * 17 + 9 + kk] = s;
      } else if (kk == 8) {
        zf[tl * 17] = (float)t / 4095.0f;
      }
    }
    __syncthreads();
#pragma unroll
    for (int m = 0; m < 2; ++m) {
      const int j = kk + 32 * m;
      float a = b1[j];
#pragma unroll 1
      for (int f = 0; f < 17; ++f) a += zf[tl * 17 + f] * w1[f * 64 + j];
      h1[j * 16 + tl] = fast_sin(f1[j] * a);
    }
    __syncthreads();
#pragma unroll
    for (int m = 0; m < 2; ++m) {
      const int j = kk + 32 * m;
      float a = b2[j];
#pragma unroll 16
      for (int i = 0; i < 64; ++i) a += h1[i * 16 + tl] * w2[i * 64 + j];
      h2[j * 16 + tl] = fast_sin(f2[j] * a);
    }
    __syncthreads();
#pragma unroll 1
    for (int mm = 0; mm < 3; ++mm) {
      const int col = tid + 512 * mm;
      float acc[16];
#pragma unroll
      for (int q = 0; q < 16; ++q) acc[q] = 0.f;
#pragma unroll 1
      for (int j0 = 0; j0 < 64; j0 += 8) {
        float wv[8];
#pragma unroll
        for (int q = 0; q < 8; ++q) wv[q] = w3[(size_t)(j0 + q) * 1536 + col];
#pragma unroll
        for (int q = 0; q < 8; ++q) {
          const float w = wv[q];
          const f32x4* hp = (const f32x4*)(h2 + (j0 + q) * 16);
          const f32x4 a0 = hp[0], a1 = hp[1], a2 = hp[2], a3 = hp[3];
          acc[0] += a0[0] * w; acc[1] += a0[1] * w; acc[2] += a0[2] * w; acc[3] += a0[3] * w;
          acc[4] += a1[0] * w; acc[5] += a1[1] * w; acc[6] += a1[2] * w; acc[7] += a1[3] * w;
          acc[8] += a2[0] * w; acc[9] += a2[1] * w; acc[10] += a2[2] * w; acc[11] += a2[3] * w;
          acc[12] += a3[0] * w; acc[13] += a3[1] * w; acc[14] += a3[2] * w; acc[15] += a3[3] * w;
        }
      }
      const int c = col % 384;
      const float lo = -3.0701134573253945f, hi = -15.350567286626972f;
      const float delta = fabsf(lo + (hi - lo) * ((float)c / 383.0f));
      float* dst = p.filtT + (size_t)col * 4096 + t0;
#pragma unroll
      for (int q = 0; q < 16; ++q) {
        const float tn = (float)(t0 + q) / 4095.0f;
        dst[q] = acc[q] * __expf(-tn * delta);
      }
    }
  }
}

__device__ void prep_phase(const P& p, int l, char* smem) {
  for (int w = 0; w < 7; ++w) {
    const float* W; const float* g; bf16_t* Bt; int K, N, Npad, mode = 0;
    switch (w) {
      case 0: W = p.w_in + (size_t)l * 1024 * 2336; K = 1024; N = 2336; Npad = 2560; g = p.norm1_g + l * 1024; Bt = p.Win; break;
      case 1: W = p.w_uq + (size_t)l * 256 * 576; K = 256; N = 576; Npad = 768; g = p.q_norm_g + l * 256; Bt = p.Wuq; break;
      case 2: W = p.w_ukv + (size_t)l * 128 * 768; K = 128; N = 768; Npad = 768; g = p.kv_norm_g + l * 128; Bt = p.Wukv; break;
      case 3: W = p.w_out + (size_t)l * 1024 * 1024; K = 1024; N = 1024; Npad = 1024; g = p.mix_g + l * 1024; Bt = p.Wout; break;
      case 4: W = p.w_gate + (size_t)l * 1024 * 2816; K = 1024; N = 2816; Npad = 2816; g = p.norm2_g + l * 1024; Bt = p.Wgu; mode = 1; break;
      case 5: W = p.w_up + (size_t)l * 1024 * 2816; K = 1024; N = 2816; Npad = 2816; g = p.norm2_g + l * 1024; Bt = p.Wgu; mode = 2; break;
      default: W = p.w_down + (size_t)l * 2816 * 1024; K = 2816; N = 1024; Npad = 1024; g = nullptr; Bt = p.Wdown; break;
    }
    conv_w(W, K, N, Npad, g, Bt, mode, smem);
  }
  filt_mlp(p, l, smem);
  if (l == 0) {
    int tid_ = threadIdx.x;
  asm volatile("" : "+v"(tid_));
  const int tid = tid_, lane = tid & 63, wave = tid >> 6;
    for (int row = blockIdx.x * 8 + wave; row < NTOK; row += gridDim.x * 8) {
      const float* xr = p.x + (size_t)row * 1024;
      bf16_t* xo = p.xb + (size_t)row * 1024;
      float s = 0.f;
#pragma unroll
      for (int i = 0; i < 4; ++i) {
        const f32x4 v = *(const f32x4*)(xr + lane * 4 + 256 * i);
        s += v[0] * v[0] + v[1] * v[1] + v[2] * v[2] + v[3] * v[3];
        u32x2 w;
        w.x = cvt_pk_bf16(v[0], v[1]);
        w.y = cvt_pk_bf16(v[2], v[3]);
        *(u32x2*)(xo + lane * 4 + 256 * i) = w;
      }
#pragma unroll
      for (int o = 1; o < 64; o <<= 1) s += __shfl_xor(s, o);
      if (lane < 16) p.part_x[(size_t)row * 16 + lane] = (lane == 0) ? s : 0.f;
    }
    for (int i = blockIdx.x * 512 + tid; i < 65536 + 8192; i += gridDim.x * 512) {
      if (i < 65536) {
        const int pos = i >> 4, k = i & 15;
        const float ang = (float)pos * __builtin_amdgcn_exp2f(-(float)k * 0.8304820237218405f);
        float s, c;
        fast_sincos_rev(ang * 0.15915494309189535f, &s, &c);
        p.ropecs[i] = make_float2(c, s);
      } else {
        const int k = i - 65536;
        const int ms = 1 << (31 - __clz(k + 1));
        const int pp = k + 1 - ms;
        float s, c;
        fast_sincos_rev((float)pp / (float)(2 * ms), &s, &c);
        p.tw[k] = make_float2(c, -s);
      }
    }
  }
}

template <int LOGR, int MTOP, bool INV, bool ZIN = false, bool HOUT = false>
__device__ __forceinline__ void fft_pass(float2* sm, const float2* tw) {
  constexpr int R = 1 << LOGR;
  constexpr int q = MTOP >> (LOGR - 1);
  constexpr int ntask = 8192 / R;
  for (int T = threadIdx.x; T < ntask; T += NTHREADS) {
    const int i = T & (q - 1);
    const int blk = T / q;
    const int base = blk * (2 * MTOP) + i;
    float2 v[R];
#pragma unroll
    for (int e = 0; e < R; ++e) {
      if (ZIN && e >= R / 2) v[e] = make_float2(0.f, 0.f);
      else v[e] = sm[PADI(base + e * q)];
    }
    if (!INV) {
#pragma unroll
      for (int s = 0; s < LOGR; ++s) {
        constexpr int dummy = 0;
        (void)dummy;
        const int hs = 1 << (LOGR - 1 - s);
        const int ms = MTOP >> s;
#pragma unroll
        for (int e = 0; e < R; ++e) {
          if ((e & hs) == 0) {
            const int pp = i + (e & (hs - 1)) * q;
            const float2 w = tw[(ms - 1) + pp];
            const float2 a = v[e], b = v[e + hs];
            v[e] = make_float2(a.x + b.x, a.y + b.y);
            const float dx = a.x - b.x, dy = a.y - b.y;
            v[e + hs] = make_float2(dx * w.x - dy * w.y, dx * w.y + dy * w.x);
          }
        }
      }
    } else {
#pragma unroll
      for (int s = LOGR - 1; s >= 0; --s) {
        const int hs = 1 << (LOGR - 1 - s);
        const int ms = MTOP >> s;
#pragma unroll
        for (int e = 0; e < R; ++e) {
          if ((e & hs) == 0) {
            const int pp = i + (e & (hs - 1)) * q;
            const float2 w = tw[(ms - 1) + pp];
            const float2 a = v[e], b = v[e + hs];
            const float tx = b.x * w.x + b.y * w.y, ty = b.y * w.x - b.x * w.y;
            v[e] = make_float2(a.x + tx, a.y + ty);
            v[e + hs] = make_float2(a.x - tx, a.y - ty);
          }
        }
      }
    }
#pragma unroll
    for (int e = 0; e < R; ++e) {
      if (HOUT && e >= R / 2) continue;
      sm[PADI(base + e * q)] = v[e];
    }
  }
  __syncthreads();
}

__device__ __forceinline__ void fft_fwd(float2* sm, const float2* tw) {
  fft_pass<4, 4096, false>(sm, tw);
  fft_pass<4, 256, false>(sm, tw);
  fft_pass<4, 16, false>(sm, tw);
  fft_pass<1, 1, false>(sm, tw);
}
__device__ __forceinline__ void fft_inv(float2* sm, const float2* tw) {
  fft_pass<1, 1, true>(sm, tw);
  fft_pass<3, 8, true>(sm, tw);
  fft_pass<3, 64, true>(sm, tw);
  fft_pass<3, 512, true>(sm, tw);
  fft_pass<3, 4096, true>(sm, tw);
}

__device__ void filt_fft_phase(const P& p, int l, char* smem) {
  float2* sm = (float2*)smem;
  float2* tws = (float2*)(smem + TW_LDS_OFF);
  int tid_ = threadIdx.x;
  asm volatile("" : "+v"(tid_));
  const int tid = tid_;
  for (int i = tid; i < 8192; i += NTHREADS) tws[i] = p.tw[i];
  for (int jj = blockIdx.x; jj < 384; jj += gridDim.x) {
    const int o = jj / 192, c = jj % 192;
    const int jobF = o * 384 + c, jobG = jobF + 192;
    const float* hf1 = p.filtT + ((size_t)((o * 2 + 0) * 384 + c)) * 4096;
    const float* hb1 = p.filtT + ((size_t)((o * 2 + 1) * 384 + c)) * 4096;
    const float* hf2 = hf1 + (size_t)192 * 4096;
    const float* hb2 = hb1 + (size_t)192 * 4096;
    const float sk1 = p.skip[(l * 2 + o) * 384 + c], sk2 = p.skip[(l * 2 + o) * 384 + c + 192];
    __syncthreads();
    for (int n = tid; n < 8192; n += NTHREADS) {
      float v1, v2;
      if (n == 0) { v1 = hf1[0] + hb1[0] + sk1; v2 = hf2[0] + hb2[0] + sk2; }
      else if (n < 4096) { v1 = hf1[n]; v2 = hf2[n]; }
      else if (n == 4096) { v1 = 0.f; v2 = 0.f; }
      else { v1 = hb1[8192 - n]; v2 = hb2[8192 - n]; }
      sm[PADI(n)] = make_float2(v1, v2);
    }
    __syncthreads();
    fft_fwd(sm, tws);
    float2* dF = p.H2 + (size_t)jobF * 8192;
    float2* dG = p.H2 + (size_t)jobG * 8192;
    const float sc = 0.5f / 8192.0f;
    for (int n = tid; n < 8192; n += NTHREADS) {
      const int k = (int)(__brev((unsigned)n) >> 19);
      const int np = (int)(__brev((unsigned)((8192 - k) & 8191)) >> 19);
      const float2 a = sm[PADI(n)], b = sm[PADI(np)];
      dF[n] = make_float2((a.x + b.x) * sc, (a.y - b.y) * sc);
      dG[n] = make_float2((a.y + b.y) * sc, (b.x - a.x) * sc);
    }
  }
}

__device__ __forceinline__ float short_conv(const bf16_t* row, int t, float w0, float w1, float w2, float bias) {
  const float xm = (t > 0) ? bf2f(row[t - 1]) : 0.f;
  const float x0 = bf2f(row[t]);
  const float xp = (t < SEQ - 1) ? bf2f(row[t + 1]) : 0.f;
  return w0 * xm + w1 * x0 + w2 * xp + bias;
}

__device__ __forceinline__ void conv8(const bf16_t* row, int t0, float w0, float w1, float w2, float bias, float (&out)[8]) {
  const u32x4 v = *(const u32x4*)(row + t0);
  float x[10];
  x[0] = (t0 > 0) ? bf2f(row[t0 - 1]) : 0.f;
  x[1] = bflo(v.x); x[2] = bfhi(v.x); x[3] = bflo(v.y); x[4] = bfhi(v.y);
  x[5] = bflo(v.z); x[6] = bfhi(v.z); x[7] = bflo(v.w); x[8] = bfhi(v.w);
  x[9] = (t0 + 8 < SEQ) ? bf2f(row[t0 + 8]) : 0.f;
#pragma unroll
  for (int k = 0; k < 8; ++k) out[k] = w0 * x[k] + w1 * x[k + 1] + w2 * x[k + 2] + bias;
}

struct RawRow { u32x4 v; float lo, hi; };
__device__ __forceinline__ RawRow load_raw(const bf16_t* row, int t0) {
  RawRow r;
  r.v = *(const u32x4*)(row + t0);
  r.lo = (t0 > 0) ? bf2f(row[t0 - 1]) : 0.f;
  r.hi = (t0 + 8 < SEQ) ? bf2f(row[t0 + 8]) : 0.f;
  return r;
}
__device__ __forceinline__ void conv8_raw(const RawRow& r, float w0, float w1, float w2, float bias, float (&out)[8]) {
  float x[10];
  x[0] = r.lo;
  x[1] = bflo(r.v.x); x[2] = bfhi(r.v.x); x[3] = bflo(r.v.y); x[4] = bfhi(r.v.y);
  x[5] = bflo(r.v.z); x[6] = bfhi(r.v.z); x[7] = bflo(r.v.w); x[8] = bfhi(r.v.w);
  x[9] = r.hi;
#pragma unroll
  for (int k = 0; k < 8; ++k) out[k] = w0 * x[k] + w1 * x[k + 1] + w2 * x[k + 2] + bias;
}

__device__ __forceinline__ void fft_mid(float2* sm, const f32x4 (&hpre)[8]) {
#pragma unroll
  for (int it = 0; it < 8; ++it) {
    const int T = threadIdx.x + it * NTHREADS;
    const float2 a = sm[PADI(2 * T)], b = sm[PADI(2 * T + 1)];
    const f32x4 h = hpre[it];
    const float sx = a.x + b.x, sy = a.y + b.y, dx = a.x - b.x, dy = a.y - b.y;
    const float Ax = sx * h[0] - sy * h[1], Ay = sx * h[1] + sy * h[0];
    const float Bx = dx * h[2] - dy * h[3], By = dx * h[3] + dy * h[2];
    sm[PADI(2 * T)] = make_float2(Ax + Bx, Ay + By);
    sm[PADI(2 * T + 1)] = make_float2(Ax - Bx, Ay - By);
  }
  __syncthreads();
}

template <int ORD>
__device__ void hyena_phase(const P& p, int l, char* smem) {
  float2* sm = (float2*)smem;
  float2* tws = (float2*)(smem + TW_LDS_OFF);
  int tid_ = threadIdx.x;
  asm volatile("" : "+v"(tid_));
  const int tid = tid_;
  for (int i = tid; i < 8192; i += NTHREADS) tws[i] = p.tw[i];
  const float* cw = p.conv_w + (size_t)l * 3 * 1152;
  const float* cb = p.conv_b + (size_t)l * 1152;
  const int t0 = tid * 8;
  for (int job = vblock(); job < 1536; job += gridDim.x) {
    const int pair = job & 3, c = job >> 2;
    const int b1 = pair * 2, b2 = b1 + 1;
    const int gc = (ORD == 0 ? 384 : 768) + c;
    const RawRow gr1 = load_raw(p.hyT + ((size_t)(b1 * 1152 + gc)) * 4096, t0);
    const RawRow gr2 = load_raw(p.hyT + ((size_t)(b2 * 1152 + gc)) * 4096, t0);
    __syncthreads();
    {
      float u1[8], u2[8];
      if (ORD == 0) {
        const bf16_t* r1 = p.hyT + ((size_t)(b1 * 1152 + c)) * 4096;
        const bf16_t* r2 = p.hyT + ((size_t)(b2 * 1152 + c)) * 4096;
        const float w0 = cw[c], w1 = cw[1152 + c], w2 = cw[2304 + c], bi = cb[c];
        conv8(r1, t0, w0, w1, w2, bi, u1);
        conv8(r2, t0, w0, w1, w2, bi, u2);
      } else {
        const u32x4 a0 = *(const u32x4*)(p.z1T + ((size_t)(b1 * 384 + c)) * 4096 + t0);
        const u32x4 c0_ = *(const u32x4*)(p.z1T + ((size_t)(b2 * 384 + c)) * 4096 + t0);
        u1[0] = bflo(a0.x); u1[1] = bfhi(a0.x); u1[2] = bflo(a0.y); u1[3] = bfhi(a0.y); u1[4] = bflo(a0.z); u1[5] = bfhi(a0.z); u1[6] = bflo(a0.w); u1[7] = bfhi(a0.w);
        u2[0] = bflo(c0_.x); u2[1] = bfhi(c0_.x); u2[2] = bflo(c0_.y); u2[3] = bfhi(c0_.y); u2[4] = bflo(c0_.z); u2[5] = bfhi(c0_.z); u2[6] = bflo(c0_.w); u2[7] = bfhi(c0_.w);
      }
#pragma unroll
      for (int k = 0; k < 8; ++k) {
        sm[PADI(t0 + k)] = make_float2(u1[k], u2[k]);
      }
    }
    __syncthreads();
    fft_pass<4, 4096, false, true, false>(sm, tws);
    fft_pass<4, 256, false>(sm, tws);
    f32x4 hpre[8];
    {
      const float2* H = p.H2 + ((size_t)(ORD * 384 + c)) * 8192;
#pragma unroll
      for (int it = 0; it < 8; ++it) hpre[it] = *(const f32x4*)(H + 2 * (tid + it * NTHREADS));
    }
    fft_pass<4, 16, false>(sm, tws);
    fft_mid(sm, hpre);
    fft_pass<4, 16, true>(sm, tws);
    fft_pass<4, 256, true>(sm, tws);
    fft_pass<4, 4096, true, false, true>(sm, tws);
    {
      const float w0 = cw[gc], w1 = cw[1152 + gc], w2 = cw[2304 + gc], bi = cb[gc];
      float q1[8], q2[8];
      conv8_raw(gr1, w0, w1, w2, bi, q1);
      conv8_raw(gr2, w0, w1, w2, bi, q2);
#pragma unroll
      for (int k = 0; k < 8; ++k) {
        const float2 yv = sm[PADI(t0 + k)];
        q1[k] *= yv.x;
        q2[k] *= yv.y;
      }
      {
        bf16_t* dbase = (ORD == 0) ? p.z1T : p.ybT;
        u32x4 w1_, w2_;
        w1_.x = cvt_pk_bf16(q1[0], q1[1]); w1_.y = cvt_pk_bf16(q1[2], q1[3]); w1_.z = cvt_pk_bf16(q1[4], q1[5]); w1_.w = cvt_pk_bf16(q1[6], q1[7]);
        w2_.x = cvt_pk_bf16(q2[0], q2[1]); w2_.y = cvt_pk_bf16(q2[2], q2[3]); w2_.z = cvt_pk_bf16(q2[4], q2[5]); w2_.w = cvt_pk_bf16(q2[6], q2[7]);
        *(u32x4*)(dbase + ((size_t)(b1 * 384 + c)) * 4096 + t0) = w1_;
        *(u32x4*)(dbase + ((size_t)(b2 * 384 + c)) * 4096 + t0) = w2_;
      }
    }
  }
}

constexpr int KROW = 208;
constexpr int VROW = 136;
constexpr int KBUF = 64 * KROW, VBUF = 64 * VROW;

constexpr int NK_ROW = 528;
constexpr int NK_BUF = 32 * NK_ROW;
constexpr int NV_ROW = 72;
constexpr int NV_BUF = 256 * NV_ROW;
constexpr int NRPB_OFF = 2 * NK_BUF + 2 * NV_BUF;

__device__ void natten_phase(const P& p, int l, char* smem) {
  int tid_ = threadIdx.x;
  asm volatile("" : "+v"(tid_));
  const int tid = tid_, lane = tid & 63, wave = tid >> 6, l15 = lane & 15, g = lane >> 4;
  const int hw = wave >> 1, qh = wave & 1;
  char* Ks = smem;
  char* Vs = smem + 2 * NK_BUF;
  float* rp = (float*)(smem + NRPB_OFF);
  __syncthreads();
  for (int i = tid; i < 4 * 15 * 31; i += NTHREADS) rp[i] = p.rpb[(size_t)l * 4 * 15 * 31 + i] * 1.4426950408889634f;
  const float qscale = 0.125f * 1.4426950408889634f;
  for (int job = blockIdx.x; job < 512; job += gridDim.x) {
    const int r = job & 63, b = job >> 6;
    const int r0 = min(max(r - 4, 0), 56);
    bf16x8 qf[2][2];
    int cq[2], c0[2];
#pragma unroll
    for (int nt = 0; nt < 2; ++nt) {
      cq[nt] = qh * 32 + nt * 16 + l15;
      c0[nt] = min(max(cq[nt] - 8, 0), 48);
      const bf16_t* qp = p.na + (size_t)(b * 4096 + r * 64 + cq[nt]) * 768 + hw * 64;
#pragma unroll
      for (int ks = 0; ks < 2; ++ks) qf[nt][ks] = *(const bf16x8*)(qp + ks * 32 + g * 8);
    }
    f32x4 o[4][2];
#pragma unroll
    for (int a = 0; a < 4; ++a)
#pragma unroll
      for (int n = 0; n < 2; ++n) o[a][n] = (f32x4){0.f, 0.f, 0.f, 0.f};
    float mrow[2] = {-1e30f, -1e30f}, lrow[2] = {0.f, 0.f};
    u32x4 rk[2], rv[2];
    auto gload = [&](int t) {
      const int kr = r0 + (t >> 1), kh = (t & 1) * 32;
      const bf16_t* kbase = p.na + (size_t)(b * 4096 + kr * 64 + kh) * 768 + 256;
#pragma unroll
      for (int i = 0; i < 2; ++i) {
        const int c = tid + 512 * i, key = c >> 5, cc = c & 31;
        rk[i] = *(const u32x4*)(kbase + (size_t)key * 768 + cc * 8);
      }
#pragma unroll
      for (int i = 0; i < 2; ++i) {
        const int c = tid + 512 * i, row = c >> 2, cc = c & 3;
        rv[i] = *(const u32x4*)(p.naVT + ((size_t)(b * 256 + row)) * 4096 + kr * 64 + kh + cc * 8);
      }
    };
    auto lstore = [&](int buf) {
      char* kb_ = Ks + buf * NK_BUF;
      char* vb_ = Vs + buf * NV_BUF;
#pragma unroll
      for (int i = 0; i < 2; ++i) {
        const int c = tid + 512 * i, key = c >> 5, cc = c & 31;
        *(u32x4*)(kb_ + key * NK_ROW + cc * 16) = rk[i];
      }
#pragma unroll
      for (int i = 0; i < 2; ++i) {
        const int c = tid + 512 * i, row = c >> 2, cc = c & 3;
        u32x2 lo, hi;
        lo.x = rv[i].x; lo.y = rv[i].y; hi.x = rv[i].z; hi.y = rv[i].w;
        *(u32x2*)(vb_ + row * NV_ROW + cc * 16) = lo;
        *(u32x2*)(vb_ + row * NV_ROW + cc * 16 + 8) = hi;
      }
    };
    gload(0);
    __syncthreads();
    lstore(0);
    gload(1);
    for (int t = 0; t < 16; ++t) {
      __syncthreads();
      if (t + 1 < 16) {
        lstore((t + 1) & 1);
        if (t + 2 < 16) gload(t + 2);
      }
      __builtin_amdgcn_sched_barrier(0);
      const char* kb_ = Ks + (t & 1) * NK_BUF;
      const char* vb_ = Vs + (t & 1) * NV_BUF + hw * 64 * NV_ROW;
      const int kh = (t & 1) * 32;
      f32x4 s[2][2];
#pragma unroll
      for (int a = 0; a < 2; ++a)
#pragma unroll
        for (int n = 0; n < 2; ++n) s[a][n] = (f32x4){0.f, 0.f, 0.f, 0.f};
#pragma unroll
      for (int mt = 0; mt < 2; ++mt)
#pragma unroll
        for (int ks = 0; ks < 2; ++ks) {
          const bf16x8 kf = *(const bf16x8*)(kb_ + (mt * 16 + l15) * NK_ROW + hw * 128 + ks * 64 + g * 16);
#pragma unroll
          for (int nt = 0; nt < 2; ++nt)
            s[mt][nt] = __builtin_amdgcn_mfma_f32_16x16x32_bf16(kf, qf[nt][ks], s[mt][nt], 0, 0, 0);
        }
      const float* brow = rp + (hw * 15 + (r0 + (t >> 1) - r + 7)) * 31;
      bf16x8 pf[2];
#pragma unroll
      for (int nt = 0; nt < 2; ++nt) {
        float mx = -1e30f;
#pragma unroll
        for (int mt = 0; mt < 2; ++mt)
#pragma unroll
          for (int j = 0; j < 4; ++j) {
            const int kc = kh + mt * 16 + g * 4 + j;
            const bool valid = (unsigned)(kc - c0[nt]) < 16u;
            const int dc = min(max(kc - cq[nt] + 15, 0), 30);
            const float sc = valid ? (s[mt][nt][j] * qscale + brow[dc]) : -1e30f;
            s[mt][nt][j] = sc;
            mx = fmaxf(mx, sc);
          }
        mx = fmaxf(mx, __shfl_xor(mx, 16));
        mx = fmaxf(mx, __shfl_xor(mx, 32));
        const float mnew = fmaxf(mrow[nt], mx);
        const float alpha = __builtin_amdgcn_exp2f(mrow[nt] - mnew);
        mrow[nt] = mnew;
        float ls = 0.f;
#pragma unroll
        for (int mt = 0; mt < 2; ++mt)
#pragma unroll
          for (int j = 0; j < 4; ++j) {
            const float e = (s[mt][nt][j] > -1e29f) ? __builtin_amdgcn_exp2f(s[mt][nt][j] - mnew) : 0.f;
            s[mt][nt][j] = e;
            ls += e;
          }
        lrow[nt] = lrow[nt] * alpha + ls;
#pragma unroll
        for (int a = 0; a < 4; ++a) o[a][nt] *= alpha;
        u32x4 w;
        w.x = cvt_pk_bf16(s[0][nt][0], s[0][nt][1]);
        w.y = cvt_pk_bf16(s[0][nt][2], s[0][nt][3]);
        w.z = cvt_pk_bf16(s[1][nt][0], s[1][nt][1]);
        w.w = cvt_pk_bf16(s[1][nt][2], s[1][nt][3]);
        pf[nt] = __builtin_bit_cast(bf16x8, w);
      }
#pragma unroll
      for (int mt = 0; mt < 4; ++mt) {
        const u32x2 lo = *(const u32x2*)(vb_ + (mt * 16 + l15) * NV_ROW + (4 * g) * 2);
        const u32x2 hi = *(const u32x2*)(vb_ + (mt * 16 + l15) * NV_ROW + (16 + 4 * g) * 2);
        u32x4 w;
        w.x = lo.x; w.y = lo.y; w.z = hi.x; w.w = hi.y;
        const bf16x8 vf = __builtin_bit_cast(bf16x8, w);
#pragma unroll
        for (int nt = 0; nt < 2; ++nt)
          o[mt][nt] = __builtin_amdgcn_mfma_f32_16x16x32_bf16(vf, pf[nt], o[mt][nt], 0, 0, 0);
      }
    }
#pragma unroll
    for (int nt = 0; nt < 2; ++nt) {
      float lt = lrow[nt];
      lt += __shfl_xor(lt, 16);
      lt += __shfl_xor(lt, 32);
      const float inv = 1.0f / lt;
      const int tok = b * 4096 + r * 64 + cq[nt];
#pragma unroll
      for (int mt = 0; mt < 4; ++mt) {
        u32x2 w;
        w.x = cvt_pk_bf16(o[mt][nt][0] * inv, o[mt][nt][1] * inv);
        w.y = cvt_pk_bf16(o[mt][nt][2] * inv, o[mt][nt][3] * inv);
        *(u32x2*)(p.o_c + (size_t)tok * 256 + hw * 64 + mt * 16 + g * 4) = w;
      }
    }
  }
}


__device__ void attn_phase(const P& p, char* smem) {
  int tid_ = threadIdx.x;
  asm volatile("" : "+v"(tid_));
  const int tid = tid_, lane = tid & 63, wave = tid >> 6, l15 = lane & 15, g = lane >> 4;
  char* Ks = smem;
  char* Vs = smem + 2 * KBUF;
  for (int job = vblock(); job < 768; job += gridDim.x) {
    const int qblk = job & 15, bh = job >> 4;
    const int b = bh / 6, h = bh % 6;
    const bf16_t* Q = p.qb + (size_t)bh * 4096 * 96;
    const bf16_t* Kg = p.kb + (size_t)bh * 4096 * 96;
    const bf16_t* Vt = p.vT + (size_t)bh * 64 * 4096;
    const int q0 = qblk * 256 + wave * 32;
    bf16x8 qf[2][3];
#pragma unroll
    for (int nt = 0; nt < 2; ++nt)
#pragma unroll
      for (int ks = 0; ks < 3; ++ks)
        qf[nt][ks] = *(const bf16x8*)(Q + (size_t)(q0 + nt * 16 + l15) * 96 + ks * 32 + g * 8);
    f32x4 o[4][2];
#pragma unroll
    for (int a = 0; a < 4; ++a)
#pragma unroll
      for (int n = 0; n < 2; ++n) o[a][n] = (f32x4){0.f, 0.f, 0.f, 0.f};
    float mrow[2] = {-1e30f, -1e30f}, lrow[2] = {0.f, 0.f};

    u32x4 rk[2];
    u32x4 rv;
    const int kr1 = (tid + 512) / 12, kc1 = (tid + 512) - kr1 * 12;
    const int kr0 = tid / 12, kc0 = tid - kr0 * 12;
    auto gload = [&](int kt) {
      const u32x4* kp = (const u32x4*)(Kg + (size_t)kt * 64 * 96);
      rk[0] = kp[tid];
      if (tid < 256) rk[1] = kp[tid + 512];
      rv = *(const u32x4*)(Vt + (size_t)(tid >> 3) * 4096 + kt * 64 + (tid & 7) * 8);
    };
    auto lstore = [&](int buf) {
      char* kb_ = Ks + buf * KBUF;
      char* vb_ = Vs + buf * VBUF;
      *(u32x4*)(kb_ + kr0 * KROW + kc0 * 16) = rk[0];
      if (tid < 256) *(u32x4*)(kb_ + kr1 * KROW + kc1 * 16) = rk[1];
      u32x2 lo, hi;
      lo.x = rv.x; lo.y = rv.y; hi.x = rv.z; hi.y = rv.w;
      *(u32x2*)(vb_ + (tid >> 3) * VROW + (tid & 7) * 16) = lo;
      *(u32x2*)(vb_ + (tid >> 3) * VROW + (tid & 7) * 16 + 8) = hi;
    };
    const int NKT = 64;
    gload(0);
    __syncthreads();
    lstore(0);
    gload(1);
    for (int kt = 0; kt < NKT; ++kt) {
      __syncthreads();
      if (kt + 1 < NKT) {
        lstore((kt + 1) & 1);
        if (kt + 2 < NKT) gload(kt + 2);
      }
      __builtin_amdgcn_sched_barrier(0);
      const char* kb_ = Ks + (kt & 1) * KBUF;
      const char* vb_ = Vs + (kt & 1) * VBUF;
      f32x4 s[4][2];
#pragma unroll
      for (int a = 0; a < 4; ++a)
#pragma unroll
        for (int n = 0; n < 2; ++n) s[a][n] = (f32x4){0.f, 0.f, 0.f, 0.f};
#pragma unroll
      for (int mt = 0; mt < 4; ++mt)
#pragma unroll
        for (int ks = 0; ks < 3; ++ks) {
          const bf16x8 kf = *(const bf16x8*)(kb_ + (mt * 16 + l15) * KROW + (ks * 32 + g * 8) * 2);
#pragma unroll
          for (int nt = 0; nt < 2; ++nt)
            s[mt][nt] = __builtin_amdgcn_mfma_f32_16x16x32_bf16(kf, qf[nt][ks], s[mt][nt], 0, 0, 0);
        }
      bf16x8 pf[2][2];
#pragma unroll
      for (int nt = 0; nt < 2; ++nt) {
        float mx = s[0][nt][0];
#pragma unroll
        for (int mt = 0; mt < 4; ++mt)
#pragma unroll
          for (int j = 0; j < 4; ++j) mx = fmaxf(mx, s[mt][nt][j]);
        mx = fmaxf(mx, __shfl_xor(mx, 16));
        mx = fmaxf(mx, __shfl_xor(mx, 32));
        if (__any(mx > mrow[nt] + 8.0f)) {
          const float mnew = fmaxf(mrow[nt], mx);
          const float alpha = __builtin_amdgcn_exp2f(mrow[nt] - mnew);
          mrow[nt] = mnew;
          lrow[nt] *= alpha;
#pragma unroll
          for (int a = 0; a < 4; ++a) o[a][nt] *= alpha;
        }
        const float mref = mrow[nt];
        float ls = 0.f;
#pragma unroll
        for (int mt = 0; mt < 4; ++mt)
#pragma unroll
          for (int j = 0; j < 4; ++j) {
            const float e = __builtin_amdgcn_exp2f(s[mt][nt][j] - mref);
            s[mt][nt][j] = e;
            ls += e;
          }
        lrow[nt] += ls;
#pragma unroll
        for (int kk = 0; kk < 2; ++kk) {
          u32x4 w;
          w.x = cvt_pk_bf16(s[2 * kk][nt][0], s[2 * kk][nt][1]);
          w.y = cvt_pk_bf16(s[2 * kk][nt][2], s[2 * kk][nt][3]);
          w.z = cvt_pk_bf16(s[2 * kk + 1][nt][0], s[2 * kk + 1][nt][1]);
          w.w = cvt_pk_bf16(s[2 * kk + 1][nt][2], s[2 * kk + 1][nt][3]);
          pf[kk][nt] = __builtin_bit_cast(bf16x8, w);
        }
      }
#pragma unroll
      for (int kk = 0; kk < 2; ++kk)
#pragma unroll
        for (int mt = 0; mt < 4; ++mt) {
          const u32x2 lo = *(const u32x2*)(vb_ + (mt * 16 + l15) * VROW + (32 * kk + 4 * g) * 2);
          const u32x2 hi = *(const u32x2*)(vb_ + (mt * 16 + l15) * VROW + (32 * kk + 16 + 4 * g) * 2);
          u32x4 w;
          w.x = lo.x; w.y = lo.y; w.z = hi.x; w.w = hi.y;
          const bf16x8 vf = __builtin_bit_cast(bf16x8, w);
#pragma unroll
          for (int nt = 0; nt < 2; ++nt)
            o[mt][nt] = __builtin_amdgcn_mfma_f32_16x16x32_bf16(vf, pf[kk][nt], o[mt][nt], 0, 0, 0);
        }
    }
#pragma unroll
    for (int nt = 0; nt < 2; ++nt) {
      float lt = lrow[nt];
      lt += __shfl_xor(lt, 16);
      lt += __shfl_xor(lt, 32);
      const float inv = 1.0f / lt;
      const int tok = b * 4096 + q0 + nt * 16 + l15;
#pragma unroll
      for (int mt = 0; mt < 4; ++mt) {
        u32x2 w;
        w.x = cvt_pk_bf16(o[mt][nt][0] * inv, o[mt][nt][1] * inv);
        w.y = cvt_pk_bf16(o[mt][nt][2] * inv, o[mt][nt][3] * inv);
        *(u32x2*)(p.o_a + (size_t)tok * 384 + h * 64 + mt * 16 + g * 4) = w;
      }
    }
  }
}

__device__ void mixnorm_phase(const P& p, char* smem) {
  int tid_ = threadIdx.x;
  asm volatile("" : "+v"(tid_));
  const int tid = tid_;
  for (int job = blockIdx.x; job < NTOK / 32; job += gridDim.x) {
    const int tok0 = job * 32, b = tok0 >> 12, s0 = tok0 & 4095;
    __syncthreads();
#pragma unroll
    for (int i = 0; i < 3; ++i) {
      const int c = tid + 512 * i, row = c / 48, cc = c % 48;
      *(u32x4*)(smem + row * 2048 + cc * 16) = *(const u32x4*)(p.o_a + (size_t)(tok0 + row) * 384 + cc * 8);
    }
#pragma unroll
    for (int i = 0; i < 2; ++i) {
      const int c = tid + 512 * i, row = c >> 5, cc = c & 31;
      *(u32x4*)(smem + row * 2048 + 1536 + cc * 16) = *(const u32x4*)(p.o_c + (size_t)(tok0 + row) * 256 + cc * 8);
    }
#pragma unroll
    for (int i = 0; i < 3; ++i) {
      const int c = tid + 512 * i, ch = c >> 2, tc = c & 3;
      const u32x4 v = *(const u32x4*)(p.ybT + ((size_t)(b * 384 + ch)) * 4096 + s0 + tc * 8);
      bf16_t* dst = (bf16_t*)smem + (size_t)(tc * 8) * 1024 + 384 + ch;
      dst[0 * 1024] = (bf16_t)(v.x & 0xffff); dst[1 * 1024] = (bf16_t)(v.x >> 16);
      dst[2 * 1024] = (bf16_t)(v.y & 0xffff); dst[3 * 1024] = (bf16_t)(v.y >> 16);
      dst[4 * 1024] = (bf16_t)(v.z & 0xffff); dst[5 * 1024] = (bf16_t)(v.z >> 16);
      dst[6 * 1024] = (bf16_t)(v.w & 0xffff); dst[7 * 1024] = (bf16_t)(v.w >> 16);
    }
    __syncthreads();
    const int tok = tid >> 4, sub = tid & 15;
    float ss[3] = {0.f, 0.f, 0.f};
#pragma unroll
    for (int gi = 0; gi < 3; ++gi) {
      const int i0 = (gi == 0) ? 0 : (gi == 1 ? 3 : 6), i1 = (gi == 0) ? 3 : (gi == 1 ? 6 : 8);
      float acc = 0.f;
#pragma unroll 2
      for (int i = i0; i < i1; ++i) {
        const u32x4 v = *(const u32x4*)(smem + tok * 2048 + (sub + 16 * i) * 16);
        float a;
        a = bflo(v.x); acc += a * a; a = bfhi(v.x); acc += a * a;
        a = bflo(v.y); acc += a * a; a = bfhi(v.y); acc += a * a;
        a = bflo(v.z); acc += a * a; a = bfhi(v.z); acc += a * a;
        a = bflo(v.w); acc += a * a; a = bfhi(v.w); acc += a * a;
      }
      acc += __shfl_xor(acc, 1);
      acc += __shfl_xor(acc, 2);
      acc += __shfl_xor(acc, 4);
      acc += __shfl_xor(acc, 8);
      ss[gi] = acc;
    }
    float rs[3];
    rs[0] = rsqrtf(ss[0] * (1.0f / 384.0f) + 1e-6f);
    rs[1] = rsqrtf(ss[1] * (1.0f / 384.0f) + 1e-6f);
    rs[2] = rsqrtf(ss[2] * (1.0f / 256.0f) + 1e-6f);
#pragma unroll
    for (int gi = 0; gi < 3; ++gi) {
      const int i0 = (gi == 0) ? 0 : (gi == 1 ? 3 : 6), i1 = (gi == 0) ? 3 : (gi == 1 ? 6 : 8);
      const float r = rs[gi];
#pragma unroll 2
      for (int i = i0; i < i1; ++i) {
        const u32x4 v = *(const u32x4*)(smem + tok * 2048 + (sub + 16 * i) * 16);
        u32x4 w;
        w.x = cvt_pk_bf16(bflo(v.x) * r, bfhi(v.x) * r);
        w.y = cvt_pk_bf16(bflo(v.y) * r, bfhi(v.y) * r);
        w.z = cvt_pk_bf16(bflo(v.z) * r, bfhi(v.z) * r);
        w.w = cvt_pk_bf16(bflo(v.w) * r, bfhi(v.w) * r);
        *(u32x4*)(p.y + (size_t)(tok0 + tok) * 1024 + (sub + 16 * i) * 8) = w;
      }
    }
  }
}

enum { EPI_INPROJ = 0, EPI_QUP = 1, EPI_KVUP = 2, EPI_OUTPROJ = 3, EPI_SWIGLU = 4, EPI_DOWN = 5 };

template <int EPI>
__device__ void gemm_phase(const P& p, int l, const bf16_t* __restrict__ A, int lda, const bf16_t* __restrict__ Bt,
                           int K, int nN, char* smem) {
  int tid_ = threadIdx.x;
  asm volatile("" : "+v"(tid_));
  const int tid = tid_, lane = tid & 63, wave = tid >> 6, wm = wave >> 2, wn = wave & 3, l15 = lane & 15,
            g = lane >> 4;
  const int ntiles = 128 * nN;
  const int srow = tid >> 3, skc = tid & 7;
  const int sw_off = srow * 128 + ((skc ^ ((srow >> 1) & 7)) * 16);
  const int rsw = (l15 >> 1) & 7;
  for (int tile = vblock(); tile < ntiles; tile += gridDim.x) {
    const int gsz_ = 4 * nN, grp_ = tile / gsz_, w_ = tile - grp_ * gsz_;
    const int ni = w_ >> 2, mi = grp_ * 4 + (w_ & 3);
    const int m0 = mi * 256, n0 = ni * 256;
    f32x4 acc[8][4];
#pragma unroll
    for (int a = 0; a < 8; ++a)
#pragma unroll
      for (int b = 0; b < 4; ++b) acc[a][b] = (f32x4){0.f, 0.f, 0.f, 0.f};
    const bf16_t* Ag = A + (size_t)(m0 + srow) * lda + skc * 8;
    const bf16_t* Bg = Bt + (size_t)(n0 + srow) * K + skc * 8;
    u32x4 ra[4], rb[4];
    auto gl = [&](int kt) {
#pragma unroll
      for (int i = 0; i < 4; ++i) ra[i] = *(const u32x4*)(Ag + (size_t)i * 64 * lda + kt * 64);
#pragma unroll
      for (int i = 0; i < 4; ++i) rb[i] = *(const u32x4*)(Bg + (size_t)i * 64 * K + kt * 64);
    };
    auto st = [&](int buf) {
      char* nb = smem + buf * 65536;
#pragma unroll
      for (int i = 0; i < 4; ++i) *(u32x4*)(nb + sw_off + i * 8192) = ra[i];
#pragma unroll
      for (int i = 0; i < 4; ++i) *(u32x4*)(nb + 32768 + sw_off + i * 8192) = rb[i];
    };
    const int nk = K / 64;
    gl(0);
    float rs_row = 1.f;
    if (EPI == EPI_INPROJ || EPI == EPI_SWIGLU) {
      if (tid < 256) {
        const f32x4* pp = (const f32x4*)(p.part_x + (size_t)(m0 + tid) * 16);
        const f32x4 a0 = pp[0], a1 = pp[1], a2 = pp[2], a3 = pp[3];
        const float tot = (a0[0] + a0[1] + a0[2] + a0[3]) + (a1[0] + a1[1] + a1[2] + a1[3]) +
                          (a2[0] + a2[1] + a2[2] + a2[3]) + (a3[0] + a3[1] + a3[2] + a3[3]);
        rs_row = rsqrtf(tot * (1.0f / 1024.0f) + 1e-6f);
      }
    } else if (EPI == EPI_QUP) {
      if (tid < 256) {
        const f32x4 a0 = *(const f32x4*)(p.part_q + (size_t)(m0 + tid) * 4);
        rs_row = rsqrtf((a0[0] + a0[1] + a0[2] + a0[3]) * (1.0f / 256.0f) + 1e-6f);
      }
    } else if (EPI == EPI_KVUP) {
      if (tid < 256) {
        const float2 a0 = *(const float2*)(p.part_kv + (size_t)(m0 + tid) * 2);
        rs_row = rsqrtf((a0.x + a0.y) * (1.0f / 128.0f) + 1e-6f);
      }
    }
    float* s_rs = (float*)(smem + 131072);
    __syncthreads();
    st(0);
    if (EPI != EPI_OUTPROJ && EPI != EPI_DOWN && true) {
      if (tid < 256) s_rs[tid] = rs_row;
    }
    __syncthreads();
    for (int kt = 0; kt < nk; ++kt) {
      if (kt + 1 < nk) gl(kt + 1);
      __builtin_amdgcn_sched_barrier(0);
      const char* Ab = smem + (kt & 1) * 65536;
      const char* Bb = Ab + 32768;
#pragma unroll
      for (int ks = 0; ks < 2; ++ks) {
        bf16x8 bfr[4];
#pragma unroll
        for (int nt = 0; nt < 4; ++nt)
          bfr[nt] = *(const bf16x8*)(Bb + (wn * 64 + nt * 16 + l15) * 128 + (((ks * 4 + g) ^ rsw) * 16));
        bf16x8 af[2][2];
#pragma unroll
        for (int mt = 0; mt < 2; ++mt)
          af[0][mt] = *(const bf16x8*)(Ab + (wm * 128 + mt * 16 + l15) * 128 + (((ks * 4 + g) ^ rsw) * 16));
#pragma unroll
        for (int mh = 0; mh < 4; ++mh) {
          if (mh < 3) {
#pragma unroll
            for (int mt = 0; mt < 2; ++mt)
              af[(mh + 1) & 1][mt] = *(const bf16x8*)(Ab + (wm * 128 + ((mh + 1) * 2 + mt) * 16 + l15) * 128 + (((ks * 4 + g) ^ rsw) * 16));
          }
          __builtin_amdgcn_sched_barrier(0);
#pragma unroll
          for (int mt = 0; mt < 2; ++mt)
#pragma unroll
            for (int nt = 0; nt < 4; ++nt)
              acc[mh * 2 + mt][nt] = __builtin_amdgcn_mfma_f32_16x16x32_bf16(bfr[nt], af[mh & 1][mt], acc[mh * 2 + mt][nt], 0, 0, 0);
          __builtin_amdgcn_sched_barrier(0);
        }
      }
      if (kt + 1 < nk) st((kt + 1) & 1);
      __syncthreads();
    }
    int opq_ = 0;
    asm volatile("" : "+v"(opq_));
    const int rbase = m0 + wm * 128 + l15 + opq_;
    const int cbase = n0 + wn * 64 + g * 4 + opq_;
    if (EPI == EPI_INPROJ) {
      const int wc0 = n0 + wn * 64;
#pragma unroll
      for (int mt = 0; mt < 8; ++mt) {
        const int row = rbase + mt * 16;
        const float rs = s_rs[row - m0];
        const int bb = row >> 12, ss = row & 4095;
        float sq = 0.f;
#pragma unroll
        for (int nt = 0; nt < 4; ++nt) {
          const int ct = wc0 + nt * 16;
          const int col = cbase + nt * 16;
          f32x4 v = acc[mt][nt] * rs;
          if (ct < 384) {
            sq += v[0] * v[0] + v[1] * v[1] + v[2] * v[2] + v[3] * v[3];
            u32x2 w;
            w.x = cvt_pk_bf16(v[0], v[1]);
            w.y = cvt_pk_bf16(v[2], v[3]);
            *(u32x2*)(p.projA + (size_t)row * 416 + col) = w;
          } else if (ct == 384) {
            if (nt < 3) {
              const f32x4 v2 = acc[mt][(nt + 1) & 3] * rs;
              const int i0 = col - 384;
              const float2* cs = p.ropecs + ss * 16 + i0;
              float o1[4], o2[4];
#pragma unroll
              for (int j = 0; j < 4; ++j) {
                const float2 c_s = cs[j];
                o1[j] = v[j] * c_s.x - v2[j] * c_s.y;
                o2[j] = v[j] * c_s.y + v2[j] * c_s.x;
              }
              u32x2 w;
              w.x = cvt_pk_bf16(o1[0], o1[1]);
              w.y = cvt_pk_bf16(o1[2], o1[3]);
              *(u32x2*)(p.projA + (size_t)row * 416 + 384 + i0) = w;
              w.x = cvt_pk_bf16(o2[0], o2[1]);
              w.y = cvt_pk_bf16(o2[2], o2[3]);
              *(u32x2*)(p.projA + (size_t)row * 416 + 400 + i0) = w;
            }
          } else if (ct == 400) {
          } else if (ct < 1568) {
            const int hc = col - 416;
            bf16_t* dst = p.hyT + ((size_t)(bb * 1152 + hc)) * 4096 + ss;
            dst[0] = f2bf(v[0]);
            dst[4096] = f2bf(v[1]);
            dst[2 * 4096] = f2bf(v[2]);
            dst[3 * 4096] = f2bf(v[3]);
          } else if (ct < 2080) {
            u32x2 w;
            w.x = cvt_pk_bf16(v[0], v[1]);
            w.y = cvt_pk_bf16(v[2], v[3]);
            *(u32x2*)(p.na + (size_t)row * 768 + (col - 1568)) = w;
          } else if (ct < 2336) {
            const int vc = col - 2080;
            bf16_t* dst = p.naVT + ((size_t)(bb * 256 + vc)) * 4096 + ss;
            dst[0] = f2bf(v[0]);
            dst[4096] = f2bf(v[1]);
            dst[2 * 4096] = f2bf(v[2]);
            dst[3 * 4096] = f2bf(v[3]);
          }
        }
        if (wc0 < 384) {
          sq += __shfl_xor(sq, 16);
          sq += __shfl_xor(sq, 32);
          if (g == 0) {
            if (wc0 < 256) p.part_q[(size_t)row * 4 + (wc0 >> 6)] = sq;
            else p.part_kv[(size_t)row * 2 + ((wc0 - 256) >> 6)] = sq;
          }
        }
      }
    } else if (EPI == EPI_QUP) {
      const int wc0 = n0 + wn * 64;
      const float qscale = 0.10206207261596575f * 1.4426950408889634f;
#pragma unroll
      for (int mt = 0; mt < 8; ++mt) {
        const int row = rbase + mt * 16;
        const float rs = s_rs[row - m0] * qscale;
        const int bb = row >> 12, ss = row & 4095;
#pragma unroll
        for (int nt = 0; nt < 4; ++nt) {
          const int T = (wc0 >> 4) + nt;
          if (T < 36) {
            const int hh = T / 6, tt = T % 6;
            bf16_t* qrow = p.qb + ((size_t)((bb * 6 + hh) * 4096 + ss)) * 96;
            const f32x4 v = acc[mt][nt] * rs;
            if (tt < 4) {
              u32x2 w;
              w.x = cvt_pk_bf16(v[0], v[1]);
              w.y = cvt_pk_bf16(v[2], v[3]);
              *(u32x2*)(qrow + tt * 16 + g * 4) = w;
            } else if (tt == 4) {
              if (nt < 3) {
                const f32x4 v2 = acc[mt][(nt + 1) & 3] * rs;
                const float2* cs = p.ropecs + ss * 16 + g * 4;
                float o1[4], o2[4];
#pragma unroll
                for (int j = 0; j < 4; ++j) {
                  const float2 c_s = cs[j];
                  o1[j] = v[j] * c_s.x - v2[j] * c_s.y;
                  o2[j] = v[j] * c_s.y + v2[j] * c_s.x;
                }
                u32x2 w;
                w.x = cvt_pk_bf16(o1[0], o1[1]);
                w.y = cvt_pk_bf16(o1[2], o1[3]);
                *(u32x2*)(qrow + 64 + g * 4) = w;
                w.x = cvt_pk_bf16(o2[0], o2[1]);
                w.y = cvt_pk_bf16(o2[2], o2[3]);
                *(u32x2*)(qrow + 80 + g * 4) = w;
              }
            }
          }
        }
      }
    } else if (EPI == EPI_KVUP) {
      const int hh = ni * 2 + (wn >> 1);
#pragma unroll
      for (int mt = 0; mt < 8; ++mt) {
        const int row = rbase + mt * 16;
        const float rs = s_rs[row - m0];
        const int bb = row >> 12, ss = row & 4095;
#pragma unroll
        for (int nt = 0; nt < 4; ++nt) {
          const f32x4 v = acc[mt][nt] * rs;
          if ((wn & 1) == 0) {
            u32x2 w;
            w.x = cvt_pk_bf16(v[0], v[1]);
            w.y = cvt_pk_bf16(v[2], v[3]);
            *(u32x2*)(p.kb + ((size_t)((bb * 6 + hh) * 4096 + ss)) * 96 + nt * 16 + g * 4) = w;
          } else {
            const int dv = nt * 16 + g * 4;
            bf16_t* dst = p.vT + ((size_t)((bb * 6 + hh) * 64 + dv)) * 4096 + ss;
            dst[0] = f2bf(v[0]);
            dst[4096] = f2bf(v[1]);
            dst[2 * 4096] = f2bf(v[2]);
            dst[3 * 4096] = f2bf(v[3]);
          }
        }
      }
#pragma unroll
      for (int i = 0; i < 2; ++i) {
        const int c = tid + 512 * i, rr = c >> 2, cc = c & 3;
        const int row = m0 + rr, bb = row >> 12, ss = row & 4095;
        const u32x4 v = *(const u32x4*)(p.projA + (size_t)row * 416 + 384 + cc * 8);
        *(u32x4*)(p.kb + ((size_t)((bb * 6 + ni * 2) * 4096 + ss)) * 96 + 64 + cc * 8) = v;
        *(u32x4*)(p.kb + ((size_t)((bb * 6 + ni * 2 + 1) * 4096 + ss)) * 96 + 64 + cc * 8) = v;
      }
    } else if (EPI == EPI_OUTPROJ || EPI == EPI_DOWN) {
      const int slot = (n0 + wn * 64) >> 6;
#pragma unroll
      for (int mt = 0; mt < 8; ++mt) {
        const int row = rbase + mt * 16;
        float sq = 0.f;
#pragma unroll
        for (int nt = 0; nt < 4; ++nt) {
          const int col = cbase + nt * 16;
          const u32x2 xr = *(const u32x2*)(p.xb + (size_t)row * 1024 + col);
          const f32x4 xo = (f32x4){bflo(xr.x), bfhi(xr.x), bflo(xr.y), bfhi(xr.y)};
          const f32x4 v = acc[mt][nt] + xo;
          sq += v[0] * v[0] + v[1] * v[1] + v[2] * v[2] + v[3] * v[3];
          {
            u32x2 w;
            w.x = cvt_pk_bf16(v[0], v[1]);
            w.y = cvt_pk_bf16(v[2], v[3]);
            *(u32x2*)(p.xb + (size_t)row * 1024 + col) = w;
          }
        }
        sq += __shfl_xor(sq, 16);
        sq += __shfl_xor(sq, 32);
        if (g == 0) p.part_x[(size_t)row * 16 + slot] = sq;
      }
    } else if (EPI == EPI_SWIGLU) {
      const int fbase = ((n0 + wn * 64) >> 1) + g * 4;
#pragma unroll
      for (int mt = 0; mt < 8; ++mt) {
        const int row = rbase + mt * 16;
        const float rs = s_rs[row - m0];
#pragma unroll
        for (int i = 0; i < 2; ++i) {
          const f32x4 gt = acc[mt][2 * i] * rs, up = acc[mt][2 * i + 1] * rs;
          float hv[4];
#pragma unroll
          for (int j = 0; j < 4; ++j) hv[j] = gt[j] * __builtin_amdgcn_rcpf(1.0f + __expf(-gt[j])) * up[j];
          u32x2 w;
          w.x = cvt_pk_bf16(hv[0], hv[1]);
          w.y = cvt_pk_bf16(hv[2], hv[3]);
          *(u32x2*)(p.hidden + (size_t)row * 2816 + fbase + i * 16) = w;
        }
      }
    }
  }
}

__device__ void final_norm_phase(const P& p) {
  int tid_ = threadIdx.x;
  asm volatile("" : "+v"(tid_));
  const int tid = tid_, lane = tid & 63, wave = tid >> 6;
  for (int row = blockIdx.x * 8 + wave; row < NTOK; row += gridDim.x * 8) {
    const f32x4* pp = (const f32x4*)(p.part_x + (size_t)row * 16);
    const f32x4 a0 = pp[0], a1 = pp[1], a2 = pp[2], a3 = pp[3];
    const float tot = (a0[0] + a0[1] + a0[2] + a0[3]) + (a1[0] + a1[1] + a1[2] + a1[3]) +
                      (a2[0] + a2[1] + a2[2] + a2[3]) + (a3[0] + a3[1] + a3[2] + a3[3]);
    const float rs = rsqrtf(tot * (1.0f / 1024.0f) + 1e-6f);
    const bf16_t* xr = p.xb + (size_t)row * 1024;
    float* orow = p.out + (size_t)row * 1024;
#pragma unroll
    for (int i = 0; i < 2; ++i) {
      const int c0 = lane * 8 + 512 * i;
      const u32x4 xv = *(const u32x4*)(xr + c0);
      const f32x4 g0 = *(const f32x4*)(p.final_g + c0), g1 = *(const f32x4*)(p.final_g + c0 + 4);
      f32x4 o0 = (f32x4){bflo(xv.x), bfhi(xv.x), bflo(xv.y), bfhi(xv.y)};
      f32x4 o1 = (f32x4){bflo(xv.z), bfhi(xv.z), bflo(xv.w), bfhi(xv.w)};
      o0 = o0 * rs * g0;
      o1 = o1 * rs * g1;
      *(f32x4*)(orow + c0) = o0;
      *(f32x4*)(orow + c0 + 4) = o1;
    }
  }
}


template <int S>
__device__ __forceinline__ void run_stage(const P& p, int l, char* smem) {
  if (S == 0) prep_phase(p, l, smem);
  if (S == 1) {
    filt_fft_phase(p, l, smem);
    gemm_phase<EPI_INPROJ>(p, l, p.xb, 1024, p.Win, 1024, 10, smem);
  }
  if (S == 2) {
    hyena_phase<0>(p, l, smem);
    gemm_phase<EPI_QUP>(p, l, p.projA, 416, p.Wuq, 256, 3, smem);
    gemm_phase<EPI_KVUP>(p, l, p.projA + 256, 416, p.Wukv, 128, 3, smem);
    natten_phase(p, l, smem);
  }
  if (S == 3) {
    hyena_phase<1>(p, l, smem);
    attn_phase(p, smem);
  }
  if (S == 4) mixnorm_phase(p, smem);
  if (S == 5) gemm_phase<EPI_OUTPROJ>(p, l, p.y, 1024, p.Wout, 1024, 4, smem);
  if (S == 6) gemm_phase<EPI_SWIGLU>(p, l, p.xb, 1024, p.Wgu, 1024, 22, smem);
  if (S == 7) gemm_phase<EPI_DOWN>(p, l, p.hidden, 2816, p.Wdown, 2816, 4, smem);
  if (S == 8) final_norm_phase(p);
}

__device__ __forceinline__ void grid_barrier(unsigned* bar, unsigned target) {
  asm volatile("s_waitcnt vmcnt(0)" ::: "memory");
  __syncthreads();
  if (threadIdx.x == 0) {
    __builtin_amdgcn_fence(__ATOMIC_RELEASE, "agent");
    asm volatile("s_waitcnt vmcnt(0)" ::: "memory");
    __hip_atomic_fetch_add(bar, 1u, __ATOMIC_RELAXED, __HIP_MEMORY_SCOPE_AGENT);
    unsigned spins = 0;
    while (__hip_atomic_load(bar, __ATOMIC_RELAXED, __HIP_MEMORY_SCOPE_AGENT) < target && spins < (1u << 22)) {
      __builtin_amdgcn_s_sleep(1);
      ++spins;
    }
    __builtin_amdgcn_fence(__ATOMIC_ACQUIRE, "agent");
    asm volatile("s_waitcnt vmcnt(0)" ::: "memory");
  }
  __syncthreads();
}

__global__ void __launch_bounds__(NTHREADS) k_main(P p) {
  extern __shared__ __attribute__((aligned(16))) char smem[];
  cg::grid_group grid = cg::this_grid();
  if (blockIdx.x == 0 && threadIdx.x == 0) __hip_atomic_store(p.bar, 0u, __ATOMIC_RELAXED, __HIP_MEMORY_SCOPE_AGENT);
  run_stage<0>(p, 0, smem); grid.sync();
  run_stage<1>(p, 0, smem); grid_barrier(p.bar, 1u * gridDim.x);
  run_stage<2>(p, 0, smem); grid_barrier(p.bar, 2u * gridDim.x);
  run_stage<3>(p, 0, smem); grid_barrier(p.bar, 3u * gridDim.x);
  run_stage<4>(p, 0, smem); grid_barrier(p.bar, 4u * gridDim.x);
  run_stage<5>(p, 0, smem); grid_barrier(p.bar, 5u * gridDim.x);
  run_stage<6>(p, 0, smem); grid_barrier(p.bar, 6u * gridDim.x);
  run_stage<7>(p, 0, smem); grid_barrier(p.bar, 7u * gridDim.x);
  run_stage<0>(p, 1, smem); grid_barrier(p.bar, 8u * gridDim.x);
  run_stage<1>(p, 1, smem); grid_barrier(p.bar, 9u * gridDim.x);
  run_stage<2>(p, 1, smem); grid_barrier(p.bar, 10u * gridDim.x);
  run_stage<3>(p, 1, smem); grid_barrier(p.bar, 11u * gridDim.x);
  run_stage<4>(p, 1, smem); grid_barrier(p.bar, 12u * gridDim.x);
  run_stage<5>(p, 1, smem); grid_barrier(p.bar, 13u * gridDim.x);
  run_stage<6>(p, 1, smem); grid_barrier(p.bar, 14u * gridDim.x);
  run_stage<7>(p, 1, smem); grid_barrier(p.bar, 15u * gridDim.x);
  run_stage<8>(p, 1, smem);
}


extern "C" void kernel_launch(void* const* d_in, const int* in_sizes, int n_in, void* d_out, int out_size, void* d_ws,
                              size_t ws_size, hipStream_t stream) {
  static int grid_blocks = 0;
  if (!grid_blocks) {
    int dev = 0, cus = 0;
    (void)hipGetDevice(&dev);
    (void)hipDeviceGetAttribute(&cus, hipDeviceAttributeMultiprocessorCount, dev);
    if (cus <= 0) cus = 256;
    int per_cu = 0;
    (void)hipFuncSetAttribute((const void*)k_main, hipFuncAttributeMaxDynamicSharedMemorySize, LDS_BYTES);
    (void)hipOccupancyMaxActiveBlocksPerMultiprocessor(&per_cu, k_main, NTHREADS, LDS_BYTES);
    if (per_cu > 1) per_cu = 1;
    if (per_cu < 1) per_cu = 1;
    grid_blocks = cus * per_cu;
  }
  P p;
  memset(&p, 0, sizeof(p));
  const float* const* in = (const float* const*)d_in;
  p.x = in[0]; p.norm1_g = in[1]; p.w_in = in[2]; p.q_norm_g = in[3]; p.w_uq = in[4]; p.kv_norm_g = in[5];
  p.w_ukv = in[6]; p.conv_w = in[7]; p.conv_b = in[8]; p.fw1 = in[9]; p.fb1 = in[10]; p.ff1 = in[11];
  p.fw2 = in[12]; p.fb2 = in[13]; p.ff2 = in[14]; p.fw3 = in[15]; p.skip = in[16]; p.rpb = in[17];
  p.mix_g = in[18]; p.w_out = in[19]; p.norm2_g = in[20]; p.w_gate = in[21]; p.w_up = in[22]; p.w_down = in[23];
  p.final_g = in[24];
  p.out = (float*)d_out;
  char* ws = (char*)d_ws;
  size_t off = 0;
  auto take = [&](size_t bytes) {
    char* r = ws + off;
    off += (bytes + 255) & ~(size_t)255;
    return r;
  };
  p.Win = (bf16_t*)take((size_t)2560 * 1024 * 2);
  p.Wuq = (bf16_t*)take((size_t)768 * 256 * 2);
  p.Wukv = (bf16_t*)take((size_t)768 * 128 * 2);
  p.Wout = (bf16_t*)take((size_t)1024 * 1024 * 2);
  p.Wgu = (bf16_t*)take((size_t)5632 * 1024 * 2);
  p.Wdown = (bf16_t*)take((size_t)1024 * 2816 * 2);
  p.ropecs = (float2*)take((size_t)65536 * 8);
  p.tw = (float2*)take((size_t)8192 * 8);
  p.bar = (unsigned*)take(256);
  p.part_x = (float*)take((size_t)NTOK * 16 * 4);
  p.part_q = (float*)take((size_t)NTOK * 4 * 4);
  p.part_kv = (float*)take((size_t)NTOK * 2 * 4);
  p.xb = (bf16_t*)take((size_t)NTOK * 1024 * 2);
  p.H2 = (float2*)take((size_t)768 * 8192 * 8);
  p.z1T = (bf16_t*)take((size_t)1536 * 4096 * 4);
  p.filtT = (float*)p.z1T;
  p.vT = (bf16_t*)take((size_t)8 * 6 * 64 * 4096 * 2);
  p.o_a = (bf16_t*)take((size_t)NTOK * 384 * 2);
  p.o_c = (bf16_t*)take((size_t)NTOK * 256 * 2);
  char* big = take(0);
  p.projA = (bf16_t*)take((size_t)NTOK * 416 * 2);
  p.hyT = (bf16_t*)take((size_t)8 * 1152 * 4096 * 2);
  p.na = (bf16_t*)take((size_t)NTOK * 768 * 2);
  p.qb = (bf16_t*)take((size_t)8 * 6 * 4096 * 96 * 2);
  p.kb = (bf16_t*)take((size_t)8 * 6 * 4096 * 96 * 2);
  p.hidden = (bf16_t*)big;
  p.ybT = (bf16_t*)take((size_t)8 * 384 * 4096 * 2);
  p.naVT = (bf16_t*)take((size_t)8 * 4 * 64 * 4096 * 2);
  p.y = p.qb;
  if (off > ws_size) {
    fprintf(stderr, "workspace too small: need %zu have %zu\n", off, ws_size);
    return;
  }
  void* args[] = {&p};
  hipError_t e = hipLaunchCooperativeKernel((void*)k_main, dim3(grid_blocks), dim3(NTHREADS), args, LDS_BYTES, stream);
  if (e != hipSuccess) fprintf(stderr, "cooperative launch failed: %s (grid %d)\n", hipGetErrorString(e), grid_blocks);
}
```

```cpp
#include <hip/hip_runtime.h>
#include <hip/hip_cooperative_groups.h>
#include <cstdio>
#include <cstring>
#include <cstdint>
#include <cmath>
#include <type_traits>
namespace cg = cooperative_groups;


typedef unsigned short bf16_t;
typedef short bf16x8 __attribute__((ext_vector_type(8)));
typedef float f32x4 __attribute__((ext_vector_type(4)));
typedef unsigned u32x4 __attribute__((ext_vector_type(4)));
typedef unsigned u32x2 __attribute__((ext_vector_type(2)));

constexpr int NTOK = 32768, SEQ = 4096;
constexpr int NTHREADS = 512;
constexpr int LDS_BYTES = 147456;
constexpr int TW_LDS_OFF = 69632;
#define PADI(i) ((i) + ((i) >> 4))

struct P {
  const float *x, *norm1_g, *w_in, *q_norm_g, *w_uq, *kv_norm_g, *w_ukv, *conv_w, *conv_b, *fw1, *fb1, *ff1, *fw2, *fb2,
      *ff2, *fw3, *skip, *rpb, *mix_g, *w_out, *norm2_g, *w_gate, *w_up, *w_down, *final_g;
  float* out;
  bf16_t *Win, *Wuq, *Wukv, *Wout, *Wgu, *Wdown;
  bf16_t *xb, *projA, *hyT, *na, *qb, *kb, *vT, *o_a, *o_c, *y, *hidden, *ybT, *naVT;
  float2* H2;
  float* filtT;
  bf16_t* z1T;
  float *part_x, *part_q, *part_kv;
  float2* ropecs;
  float2* tw;
  unsigned* bar;
  unsigned pad0_, pad1_;
};

typedef __bf16 bf16v2_t __attribute__((ext_vector_type(2)));
typedef float f32x2_t __attribute__((ext_vector_type(2)));
__device__ __forceinline__ unsigned cvt_pk_bf16(float lo, float hi) {
  const f32x2_t v = {lo, hi};
  const bf16v2_t r = __builtin_convertvector(v, bf16v2_t);
  return __builtin_bit_cast(unsigned, r);
}
__device__ __forceinline__ bf16_t f2bf(float f) { return (bf16_t)(cvt_pk_bf16(f, 0.f) & 0xffffu); }
__device__ __forceinline__ float bf2f(bf16_t h) { return __uint_as_float(((unsigned)h) << 16); }
__device__ __forceinline__ float bflo(unsigned u) { return __uint_as_float(u << 16); }
__device__ __forceinline__ float bfhi(unsigned u) { return __uint_as_float(u & 0xffff0000u); }

__device__ __forceinline__ void fast_sincos_rev(float rev, float* s, float* c) {
  const float fr = rev - rintf(rev);
  *s = __builtin_amdgcn_sinf(fr);
  *c = __builtin_amdgcn_cosf(fr);
}
__device__ __forceinline__ float fast_sin(float x) {
  const float rev = x * 0.15915494309189535f;
  const float fr = rev - rintf(rev);
  return __builtin_amdgcn_sinf(fr);
}

__device__ __forceinline__ int vblock() {
  const int G = gridDim.x, b = blockIdx.x;
  return ((G & 7) == 0) ? ((b & 7) * (G >> 3) + (b >> 3)) : b;
}

__device__ void conv_w(const float* __restrict__ W, int K, int N, int Npad, const float* __restrict__ g, bf16_t* Bt,
                       int mode, char* smem) {
  float* tile = (float*)smem;
  int tid_ = threadIdx.x;
  asm volatile("" : "+v"(tid_));
  const int tid = tid_;
  const int nkt = K / 64, nnt = Npad / 64;
  for (int job = blockIdx.x; job < nkt * nnt; job += gridDim.x) {
    const int kt = job % nkt, ntile = job / nkt;
    const int k0 = kt * 64, n0 = ntile * 64;
    __syncthreads();
#pragma unroll
    for (int i = 0; i < 2; ++i) {
      const int k = (tid >> 4) + 32 * i, nq = (tid & 15) * 4, n = n0 + nq;
      f32x4 v = {0.f, 0.f, 0.f, 0.f};
      if (n < N) {
        v = *(const f32x4*)(W + (size_t)(k0 + k) * N + n);
        if (g) v = v * g[k0 + k];
      }
      tile[k * 65 + nq + 0] = v[0];
      tile[k * 65 + nq + 1] = v[1];
      tile[k * 65 + nq + 2] = v[2];
      tile[k * 65 + nq + 3] = v[3];
    }
    __syncthreads();
    {
      const int c = tid, n = c >> 3, kc = c & 7;
      float e[8];
#pragma unroll
      for (int q = 0; q < 8; ++q) e[q] = tile[(kc * 8 + q) * 65 + n];
      u32x4 w;
      w.x = cvt_pk_bf16(e[0], e[1]);
      w.y = cvt_pk_bf16(e[2], e[3]);
      w.z = cvt_pk_bf16(e[4], e[5]);
      w.w = cvt_pk_bf16(e[6], e[7]);
      const int nn = n0 + n;
      int dest = nn;
      if (mode == 1 || mode == 2) {
        const int f = nn & 31;
        dest = 64 * (nn >> 5) + (mode == 2 ? 32 : 0) + ((f >> 2) & 1) * 16 + (f >> 3) * 4 + (f & 3);
      }
      *(u32x4*)(Bt + (size_t)dest * K + k0 + kc * 8) = w;
    }
  }
}

__device__ void filt_mlp(const P& p, int l, char* smem) {
  float* zf = (float*)smem;
  float* h1 = zf + 16 * 17;
  float* h2 = h1 + 64 * 16;
  int tid_ = threadIdx.x;
  asm volatile("" : "+v"(tid_));
  const int tid = tid_, tl = tid & 15, kk = tid >> 4;
  const float* w1 = p.fw1 + l * 17 * 64;
  const float* b1 = p.fb1 + l * 64;
  const float* f1 = p.ff1 + l * 64;
  const float* w2 = p.fw2 + l * 64 * 64;
  const float* b2 = p.fb2 + l * 64;
  const float* f2 = p.ff2 + l * 64;
  const float* w3 = p.fw3 + (size_t)l * 64 * 1536;
  for (int job = blockIdx.x; job < 256; job += gridDim.x) {
    const int t0 = job * 16;
    __syncthreads();
    {
      const int t = t0 + tl;
      if (kk < 8) {
        const float band = 1e-4f + (float)kk * ((7.0f - 1e-4f) / 7.0f);
        const float ang = ((6.283185307179586f * (float)t) * band) / 4096.0f;
        float s, c;
        fast_sincos_rev(ang * 0.15915494309189535f, &s, &c);
        zf[tl * 17 + 1 + kk] = c;
        zf[tl * 17 + 9 + kk] = s;
      } else if (kk == 8) {
        zf[tl * 17] = (float)t / 4095.0f;
      }
    }
    __syncthreads();
#pragma unroll
    for (int m = 0; m < 2; ++m) {
      const int j = kk + 32 * m;
      float a = b1[j];
#pragma unroll 1
      for (int f = 0; f < 17; ++f) a += zf[tl * 17 + f] * w1[f * 64 + j];
      h1[j * 16 + tl] = fast_sin(f1[j] * a);
    }
    __syncthreads();
#pragma unroll
    for (int m = 0; m < 2; ++m) {
      const int j = kk + 32 * m;
      float a = b2[j];
#pragma unroll 16
      for (int i = 0; i < 64; ++i) a += h1[i * 16 + tl] * w2[i * 64 + j];
      h2[j * 16 + tl] = fast_sin(f2[j] * a);
    }
    __syncthreads();
#pragma unroll 1
    for (int mm = 0; mm < 3; ++mm) {
      const int col = tid + 512 * mm;
      float acc[16];
#pragma unroll
      for (int q = 0; q < 16; ++q) acc[q] = 0.f;
#pragma unroll 1
      for (int j0 = 0; j0 < 64; j0 += 8) {
        float wv[8];
#pragma unroll
        for (int q = 0; q < 8; ++q) wv[q] = w3[(size_t)(j0 + q) * 1536 + col];
#pragma unroll
        for (int q = 0; q < 8; ++q) {
          const float w = wv[q];
          const f32x4* hp = (const f32x4*)(h2 + (j0 + q) * 16);
          const f32x4 a0 = hp[0], a1 = hp[1], a2 = hp[2], a3 = hp[3];
          acc[0] += a0[0] * w; acc[1] += a0[1] * w; acc[2] += a0[2] * w; acc[3] += a0[3] * w;
          acc[4] += a1[0] * w; acc[5] += a1[1] * w; acc[6] += a1[2] * w; acc[7] += a1[3] * w;
          acc[8] += a2[0] * w; acc[9] += a2[1] * w; acc[10] += a2[2] * w; acc[11] += a2[3] * w;
          acc[12] += a3[0] * w; acc[13] += a3[1] * w; acc[14] += a3[2] * w; acc[15] += a3[3] * w;
        }
      }
      const int c = col % 384;
      const float lo = -3.0701134573253945f, hi = -15.350567286626972f;
      const float delta = fabsf(lo + (hi - lo) * ((float)c / 383.0f));
      float* dst = p.filtT + (size_t)col * 4096 + t0;
#pragma unroll
      for (int q = 0; q < 16; ++q) {
        const float tn = (float)(t0 + q) / 4095.0f;
        dst[q] = acc[q] * __expf(-tn * delta);
      }
    }
  }
}

__device__ void prep_phase(const P& p, int l, char* smem) {
  for (int w = 0; w < 7; ++w) {
    const float* W; const float* g; bf16_t* Bt; int K, N, Npad, mode = 0;
    switch (w) {
      case 0: W = p.w_in + (size_t)l * 1024 * 2336; K = 1024; N = 2336; Npad = 2560; g = p.norm1_g + l * 1024; Bt = p.Win; break;
      case 1: W = p.w_uq + (size_t)l * 256 * 576; K = 256; N = 576; Npad = 768; g = p.q_norm_g + l * 256; Bt = p.Wuq; break;
      case 2: W = p.w_ukv + (size_t)l * 128 * 768; K = 128; N = 768; Npad = 768; g = p.kv_norm_g + l * 128; Bt = p.Wukv; break;
      case 3: W = p.w_out + (size_t)l * 1024 * 1024; K = 1024; N = 1024; Npad = 1024; g = p.mix_g + l * 1024; Bt = p.Wout; break;
      case 4: W = p.w_gate + (size_t)l * 1024 * 2816; K = 1024; N = 2816; Npad = 2816; g = p.norm2_g + l * 1024; Bt = p.Wgu; mode = 1; break;
      case 5: W = p.w_up + (size_t)l * 1024 * 2816; K = 1024; N = 2816; Npad = 2816; g = p.norm2_g + l * 1024; Bt = p.Wgu; mode = 2; break;
      default: W = p.w_down + (size_t)l * 2816 * 1024; K = 2816; N = 1024; Npad = 1024; g = nullptr; Bt = p.Wdown; break;
    }
    conv_w(W, K, N, Npad, g, Bt, mode, smem);
  }
  filt_mlp(p, l, smem);
  if (l == 0) {
    int tid_ = threadIdx.x;
  asm volatile("" : "+v"(tid_));
  const int tid = tid_, lane = tid & 63, wave = tid >> 6;
    for (int row = blockIdx.x * 8 + wave; row < NTOK; row += gridDim.x * 8) {
      const float* xr = p.x + (size_t)row * 1024;
      bf16_t* xo = p.xb + (size_t)row * 1024;
      float s = 0.f;
#pragma unroll
      for (int i = 0; i < 4; ++i) {
        const f32x4 v = *(const f32x4*)(xr + lane * 4 + 256 * i);
        s += v[0] * v[0] + v[1] * v[1] + v[2] * v[2] + v[3] * v[3];
        u32x2 w;
        w.x = cvt_pk_bf16(v[0], v[1]);
        w.y = cvt_pk_bf16(v[2], v[3]);
        *(u32x2*)(xo + lane * 4 + 256 * i) = w;
      }
#pragma unroll
      for (int o = 1; o < 64; o <<= 1) s += __shfl_xor(s, o);
      if (lane < 16) p.part_x[(size_t)row * 16 + lane] = (lane == 0) ? s : 0.f;
    }
    for (int i = blockIdx.x * 512 + tid; i < 65536 + 8192; i += gridDim.x * 512) {
      if (i < 65536) {
        const int pos = i >> 4, k = i & 15;
        const float ang = (float)pos * __builtin_amdgcn_exp2f(-(float)k * 0.8304820237218405f);
        float s, c;
        fast_sincos_rev(ang * 0.15915494309189535f, &s, &c);
        p.ropecs[i] = make_float2(c, s);
      } else {
        const int k = i - 65536;
        const int ms = 1 << (31 - __clz(k + 1));
        const int pp = k + 1 - ms;
        float s, c;
        fast_sincos_rev((float)pp / (float)(2 * ms), &s, &c);
        p.tw[k] = make_float2(c, -s);
      }
    }
  }
}

template <int LOGR, int MTOP, bool INV, bool ZIN = false, bool HOUT = false>
__device__ __forceinline__ void fft_pass(float2* sm, const float2* tw) {
  constexpr int R = 1 << LOGR;
  constexpr int q = MTOP >> (LOGR - 1);
  constexpr int ntask = 8192 / R;
  for (int T = threadIdx.x; T < ntask; T += NTHREADS) {
    const int i = T & (q - 1);
    const int blk = T / q;
    const int base = blk * (2 * MTOP) + i;
    float2 v[R];
#pragma unroll
    for (int e = 0; e < R; ++e) {
      if (ZIN && e >= R / 2) v[e] = make_float2(0.f, 0.f);
      else v[e] = sm[PADI(base + e * q)];
    }
    if (!INV) {
#pragma unroll
      for (int s = 0; s < LOGR; ++s) {
        constexpr int dummy = 0;
        (void)dummy;
        const int hs = 1 << (LOGR - 1 - s);
        const int ms = MTOP >> s;
#pragma unroll
        for (int e = 0; e < R; ++e) {
          if ((e & hs) == 0) {
            const int pp = i + (e & (hs - 1)) * q;
            const float2 w = tw[(ms - 1) + pp];
            const float2 a = v[e], b = v[e + hs];
            v[e] = make_float2(a.x + b.x, a.y + b.y);
            const float dx = a.x - b.x, dy = a.y - b.y;
            v[e + hs] = make_float2(dx * w.x - dy * w.y, dx * w.y + dy * w.x);
          }
        }
      }
    } else {
#pragma unroll
      for (int s = LOGR - 1; s >= 0; --s) {
        const int hs = 1 << (LOGR - 1 - s);
        const int ms = MTOP >> s;
#pragma unroll
        for (int e = 0; e < R; ++e) {
          if ((e & hs) == 0) {
            const int pp = i + (e & (hs - 1)) * q;
            const float2 w = tw[(ms - 1) + pp];
            const float2 a = v[e], b = v[e + hs];
            const float tx = b.x * w.x + b.y * w.y, ty = b.y * w.x - b.x * w.y;
            v[e] = make_float2(a.x + tx, a.y + ty);
            v[e + hs] = make_float2(a.x - tx, a.y - ty);
          }
        }
      }
    }
#pragma unroll
    for (int e = 0; e < R; ++e) {
      if (HOUT && e >= R / 2) continue;
      sm[PADI(base + e * q)] = v[e];
    }
  }
  __syncthreads();
}

__device__ __forceinline__ void fft_fwd(float2* sm, const float2* tw) {
  fft_pass<4, 4096, false>(sm, tw);
  fft_pass<4, 256, false>(sm, tw);
  fft_pass<4, 16, false>(sm, tw);
  fft_pass<1, 1, false>(sm, tw);
}
__device__ __forceinline__ void fft_inv(float2* sm, const float2* tw) {
  fft_pass<1, 1, true>(sm, tw);
  fft_pass<3, 8, true>(sm, tw);
  fft_pass<3, 64, true>(sm, tw);
  fft_pass<3, 512, true>(sm, tw);
  fft_pass<3, 4096, true>(sm, tw);
}

__device__ void filt_fft_phase(const P& p, int l, char* smem) {
  float2* sm = (float2*)smem;
  float2* tws = (float2*)(smem + TW_LDS_OFF);
  int tid_ = threadIdx.x;
  asm volatile("" : "+v"(tid_));
  const int tid = tid_;
  for (int i = tid; i < 8192; i += NTHREADS) tws[i] = p.tw[i];
  for (int jj = blockIdx.x; jj < 384; jj += gridDim.x) {
    const int o = jj / 192, c = jj % 192;
    const int jobF = o * 384 + c, jobG = jobF + 192;
    const float* hf1 = p.filtT + ((size_t)((o * 2 + 0) * 384 + c)) * 4096;
    const float* hb1 = p.filtT + ((size_t)((o * 2 + 1) * 384 + c)) * 4096;
    const float* hf2 = hf1 + (size_t)192 * 4096;
    const float* hb2 = hb1 + (size_t)192 * 4096;
    const float sk1 = p.skip[(l * 2 + o) * 384 + c], sk2 = p.skip[(l * 2 + o) * 384 + c + 192];
    __syncthreads();
    for (int n = tid; n < 8192; n += NTHREADS) {
      float v1, v2;
      if (n == 0) { v1 = hf1[0] + hb1[0] + sk1; v2 = hf2[0] + hb2[0] + sk2; }
      else if (n < 4096) { v1 = hf1[n]; v2 = hf2[n]; }
      else if (n == 4096) { v1 = 0.f; v2 = 0.f; }
      else { v1 = hb1[8192 - n]; v2 = hb2[8192 - n]; }
      sm[PADI(n)] = make_float2(v1, v2);
    }
    __syncthreads();
    fft_fwd(sm, tws);
    float2* dF = p.H2 + (size_t)jobF * 8192;
    float2* dG = p.H2 + (size_t)jobG * 8192;
    const float sc = 0.5f / 8192.0f;
    for (int n = tid; n < 8192; n += NTHREADS) {
      const int k = (int)(__brev((unsigned)n) >> 19);
      const int np = (int)(__brev((unsigned)((8192 - k) & 8191)) >> 19);
      const float2 a = sm[PADI(n)], b = sm[PADI(np)];
      dF[n] = make_float2((a.x + b.x) * sc, (a.y - b.y) * sc);
      dG[n] = make_float2((a.y + b.y) * sc, (b.x - a.x) * sc);
    }
  }
}

__device__ __forceinline__ float short_conv(const bf16_t* row, int t, float w0, float w1, float w2, float bias) {
  const float xm = (t > 0) ? bf2f(row[t - 1]) : 0.f;
  const float x0 = bf2f(row[t]);
  const float xp = (t < SEQ - 1) ? bf2f(row[t + 1]) : 0.f;
  return w0 * xm + w1 * x0 + w2 * xp + bias;
}

__device__ __forceinline__ void conv8(const bf16_t* row, int t0, float w0, float w1, float w2, float bias, float (&out)[8]) {
  const u32x4 v = *(const u32x4*)(row + t0);
  float x[10];
  x[0] = (t0 > 0) ? bf2f(row[t0 - 1]) : 0.f;
  x[1] = bflo(v.x); x[2] = bfhi(v.x); x[3] = bflo(v.y); x[4] = bfhi(v.y);
  x[5] = bflo(v.z); x[6] = bfhi(v.z); x[7] = bflo(v.w); x[8] = bfhi(v.w);
  x[9] = (t0 + 8 < SEQ) ? bf2f(row[t0 + 8]) : 0.f;
#pragma unroll
  for (int k = 0; k < 8; ++k) out[k] = w0 * x[k] + w1 * x[k + 1] + w2 * x[k + 2] + bias;
}

struct RawRow { u32x4 v; float lo, hi; };
__device__ __forceinline__ RawRow load_raw(const bf16_t* row, int t0) {
  RawRow r;
  r.v = *(const u32x4*)(row + t0);
  r.lo = (t0 > 0) ? bf2f(row[t0 - 1]) : 0.f;
  r.hi = (t0 + 8 < SEQ) ? bf2f(row[t0 + 8]) : 0.f;
  return r;
}
__device__ __forceinline__ void conv8_raw(const RawRow& r, float w0, float w1, float w2, float bias, float (&out)[8]) {
  float x[10];
  x[0] = r.lo;
  x[1] = bflo(r.v.x); x[2] = bfhi(r.v.x); x[3] = bflo(r.v.y); x[4] = bfhi(r.v.y);
  x[5] = bflo(r.v.z); x[6] = bfhi(r.v.z); x[7] = bflo(r.v.w); x[8] = bfhi(r.v.w);
  x[9] = r.hi;
#pragma unroll
  for (int k = 0; k < 8; ++k) out[k] = w0 * x[k] + w1 * x[k + 1] + w2 * x[k + 2] + bias;
}

__device__ __forceinline__ void fft_mid(float2* sm, const f32x4 (&hpre)[8]) {
#pragma unroll
  for (int it = 0; it < 8; ++it) {
    const int T = threadIdx.x + it * NTHREADS;
    const float2 a = sm[PADI(2 * T)], b = sm[PADI(2 * T + 1)];
    const f32x4 h = hpre[it];
    const float sx = a.x + b.x, sy = a.y + b.y, dx = a.x - b.x, dy = a.y - b.y;
    const float Ax = sx * h[0] - sy * h[1], Ay = sx * h[1] + sy * h[0];
    const float Bx = dx * h[2] - dy * h[3], By = dx * h[3] + dy * h[2];
    sm[PADI(2 * T)] = make_float2(Ax + Bx, Ay + By);
    sm[PADI(2 * T + 1)] = make_float2(Ax - Bx, Ay - By);
  }
  __syncthreads();
}

template <int ORD>
__device__ void hyena_phase(const P& p, int l, char* smem) {
  float2* sm = (float2*)smem;
  float2* tws = (float2*)(smem + TW_LDS_OFF);
  int tid_ = threadIdx.x;
  asm volatile("" : "+v"(tid_));
  const int tid = tid_;
  for (int i = tid; i < 8192; i += NTHREADS) tws[i] = p.tw[i];
  const float* cw = p.conv_w + (size_t)l * 3 * 1152;
  const float* cb = p.conv_b + (size_t)l * 1152;
  const int t0 = tid * 8;
  for (int job = vblock(); job < 1536; job += gridDim.x) {
    const int pair = job & 3, c = job >> 2;
    const int b1 = pair * 2, b2 = b1 + 1;
    const int gc = (ORD == 0 ? 384 : 768) + c;
    const RawRow gr1 = load_raw(p.hyT + ((size_t)(b1 * 1152 + gc)) * 4096, t0);
    const RawRow gr2 = load_raw(p.hyT + ((size_t)(b2 * 1152 + gc)) * 4096, t0);
    __syncthreads();
    {
      float u1[8], u2[8];
      if (ORD == 0) {
        const bf16_t* r1 = p.hyT + ((size_t)(b1 * 1152 + c)) * 4096;
        const bf16_t* r2 = p.hyT + ((size_t)(b2 * 1152 + c)) * 4096;
        const float w0 = cw[c], w1 = cw[1152 + c], w2 = cw[2304 + c], bi = cb[c];
        conv8(r1, t0, w0, w1, w2, bi, u1);
        conv8(r2, t0, w0, w1, w2, bi, u2);
      } else {
        const u32x4 a0 = *(const u32x4*)(p.z1T + ((size_t)(b1 * 384 + c)) * 4096 + t0);
        const u32x4 c0_ = *(const u32x4*)(p.z1T + ((size_t)(b2 * 384 + c)) * 4096 + t0);
        u1[0] = bflo(a0.x); u1[1] = bfhi(a0.x); u1[2] = bflo(a0.y); u1[3] = bfhi(a0.y); u1[4] = bflo(a0.z); u1[5] = bfhi(a0.z); u1[6] = bflo(a0.w); u1[7] = bfhi(a0.w);
        u2[0] = bflo(c0_.x); u2[1] = bfhi(c0_.x); u2[2] = bflo(c0_.y); u2[3] = bfhi(c0_.y); u2[4] = bflo(c0_.z); u2[5] = bfhi(c0_.z); u2[6] = bflo(c0_.w); u2[7] = bfhi(c0_.w);
      }
#pragma unroll
      for (int k = 0; k < 8; ++k) {
        sm[PADI(t0 + k)] = make_float2(u1[k], u2[k]);
      }
    }
    __syncthreads();
    fft_pass<4, 4096, false, true, false>(sm, tws);
    fft_pass<4, 256, false>(sm, tws);
    f32x4 hpre[8];
    {
      const float2* H = p.H2 + ((size_t)(ORD * 384 + c)) * 8192;
#pragma unroll
      for (int it = 0; it < 8; ++it) hpre[it] = *(const f32x4*)(H + 2 * (tid + it * NTHREADS));
    }
    fft_pass<4, 16, false>(sm, tws);
    fft_mid(sm, hpre);
    fft_pass<4, 16, true>(sm, tws);
    fft_pass<4, 256, true>(sm, tws);
    fft_pass<4, 4096, true, false, true>(sm, tws);
    {
      const float w0 = cw[gc], w1 = cw[1152 + gc], w2 = cw[2304 + gc], bi = cb[gc];
      float q1[8], q2[8];
      conv8_raw(gr1, w0, w1, w2, bi, q1);
      conv8_raw(gr2, w0, w1, w2, bi, q2);
#pragma unroll
      for (int k = 0; k < 8; ++k) {
        const float2 yv = sm[PADI(t0 + k)];
        q1[k] *= yv.x;
        q2[k] *= yv.y;
      }
      {
        bf16_t* dbase = (ORD == 0) ? p.z1T : p.ybT;
        u32x4 w1_, w2_;
        w1_.x = cvt_pk_bf16(q1[0], q1[1]); w1_.y = cvt_pk_bf16(q1[2], q1[3]); w1_.z = cvt_pk_bf16(q1[4], q1[5]); w1_.w = cvt_pk_bf16(q1[6], q1[7]);
        w2_.x = cvt_pk_bf16(q2[0], q2[1]); w2_.y = cvt_pk_bf16(q2[2], q2[3]); w2_.z = cvt_pk_bf16(q2[4], q2[5]); w2_.w = cvt_pk_bf16(q2[6], q2[7]);
        *(u32x4*)(dbase + ((size_t)(b1 * 384 + c)) * 4096 + t0) = w1_;
        *(u32x4*)(dbase + ((size_t)(b2 * 384 + c)) * 4096 + t0) = w2_;
      }
    }
  }
}

constexpr int KROW = 208;
constexpr int VROW = 136;
constexpr int KBUF = 64 * KROW, VBUF = 64 * VROW;

constexpr int NK_ROW = 528;
constexpr int NK_BUF = 32 * NK_ROW;
constexpr int NV_ROW = 72;
constexpr int NV_BUF = 256 * NV_ROW;
constexpr int NRPB_OFF = 2 * NK_BUF + 2 * NV_BUF;

__device__ void natten_phase(const P& p, int l, char* smem) {
  int tid_ = threadIdx.x;
  asm volatile("" : "+v"(tid_));
  const int tid = tid_, lane = tid & 63, wave = tid >> 6, l15 = lane & 15, g = lane >> 4;
  const int hw = wave >> 1, qh = wave & 1;
  char* Ks = smem;
  char* Vs = smem + 2 * NK_BUF;
  float* rp = (float*)(smem + NRPB_OFF);
  __syncthreads();
  for (int i = tid; i < 4 * 15 * 31; i += NTHREADS) rp[i] = p.rpb[(size_t)l * 4 * 15 * 31 + i] * 1.4426950408889634f;
  const float qscale = 0.125f * 1.4426950408889634f;
  for (int job = blockIdx.x; job < 512; job += gridDim.x) {
    const int r = job & 63, b = job >> 6;
    const int r0 = min(max(r - 4, 0), 56);
    bf16x8 qf[2][2];
    int cq[2], c0[2];
#pragma unroll
    for (int nt = 0; nt < 2; ++nt) {
      cq[nt] = qh * 32 + nt * 16 + l15;
      c0[nt] = min(max(cq[nt] - 8, 0), 48);
      const bf16_t* qp = p.na + (size_t)(b * 4096 + r * 64 + cq[nt]) * 768 + hw * 64;
#pragma unroll
      for (int ks = 0; ks < 2; ++ks) qf[nt][ks] = *(const bf16x8*)(qp + ks * 32 + g * 8);
    }
    f32x4 o[4][2];
#pragma unroll
    for (int a = 0; a < 4; ++a)
#pragma unroll
      for (int n = 0; n < 2; ++n) o[a][n] = (f32x4){0.f, 0.f, 0.f, 0.f};
    float mrow[2] = {-1e30f, -1e30f}, lrow[2] = {0.f, 0.f};
    u32x4 rk[2], rv[2];
    auto gload = [&](int t) {
      const int kr = r0 + (t >> 1), kh = (t & 1) * 32;
      const bf16_t* kbase = p.na + (size_t)(b * 4096 + kr * 64 + kh) * 768 + 256;
#pragma unroll
      for (int i = 0; i < 2; ++i) {
        const int c = tid + 512 * i, key = c >> 5, cc = c & 31;
        rk[i] = *(const u32x4*)(kbase + (size_t)key * 768 + cc * 8);
      }
#pragma unroll
      for (int i = 0; i < 2; ++i) {
        const int c = tid + 512 * i, row = c >> 2, cc = c & 3;
        rv[i] = *(const u32x4*)(p.naVT + ((size_t)(b * 256 + row)) * 4096 + kr * 64 + kh + cc * 8);
      }
    };
    auto lstore = [&](int buf) {
      char* kb_ = Ks + buf * NK_BUF;
      char* vb_ = Vs + buf * NV_BUF;
#pragma unroll
      for (int i = 0; i < 2; ++i) {
        const int c = tid + 512 * i, key = c >> 5, cc = c & 31;
        *(u32x4*)(kb_ + key * NK_ROW + cc * 16) = rk[i];
      }
#pragma unroll
      for (int i = 0; i < 2; ++i) {
        const int c = tid + 512 * i, row = c >> 2, cc = c & 3;
        u32x2 lo, hi;
        lo.x = rv[i].x; lo.y = rv[i].y; hi.x = rv[i].z; hi.y = rv[i].w;
        *(u32x2*)(vb_ + row * NV_ROW + cc * 16) = lo;
        *(u32x2*)(vb_ + row * NV_ROW + cc * 16 + 8) = hi;
      }
    };
    gload(0);
    __syncthreads();
    lstore(0);
    gload(1);
    for (int t = 0; t < 16; ++t) {
      __syncthreads();
      if (t + 1 < 16) {
        lstore((t + 1) & 1);
        if (t + 2 < 16) gload(t + 2);
      }
      __builtin_amdgcn_sched_barrier(0);
      const char* kb_ = Ks + (t & 1) * NK_BUF;
      const char* vb_ = Vs + (t & 1) * NV_BUF + hw * 64 * NV_ROW;
      const int kh = (t & 1) * 32;
      f32x4 s[2][2];
#pragma unroll
      for (int a = 0; a < 2; ++a)
#pragma unroll
        for (int n = 0; n < 2; ++n) s[a][n] = (f32x4){0.f, 0.f, 0.f, 0.f};
#pragma unroll
      for (int mt = 0; mt < 2; ++mt)
#pragma unroll
        for (int ks = 0; ks < 2; ++ks) {
          const bf16x8 kf = *(const bf16x8*)(kb_ + (mt * 16 + l15) * NK_ROW + hw * 128 + ks * 64 + g * 16);
#pragma unroll
          for (int nt = 0; nt < 2; ++nt)
            s[mt][nt] = __builtin_amdgcn_mfma_f32_16x16x32_bf16(kf, qf[nt][ks], s[mt][nt], 0, 0, 0);
        }
      const float* brow = rp + (hw * 15 + (r0 + (t >> 1) - r + 7)) * 31;
      bf16x8 pf[2];
#pragma unroll
      for (int nt = 0; nt < 2; ++nt) {
        float mx = -1e30f;
#pragma unroll
        for (int mt = 0; mt < 2; ++mt)
#pragma unroll
          for (int j = 0; j < 4; ++j) {
            const int kc = kh + mt * 16 + g * 4 + j;
            const bool valid = (unsigned)(kc - c0[nt]) < 16u;
            const int dc = min(max(kc - cq[nt] + 15, 0), 30);
            const float sc = valid ? (s[mt][nt][j] * qscale + brow[dc]) : -1e30f;
            s[mt][nt][j] = sc;
            mx = fmaxf(mx, sc);
          }
        mx = fmaxf(mx, __shfl_xor(mx, 16));
        mx = fmaxf(mx, __shfl_xor(mx, 32));
        const float mnew = fmaxf(mrow[nt], mx);
        const float alpha = __builtin_amdgcn_exp2f(mrow[nt] - mnew);
        mrow[nt] = mnew;
        float ls = 0.f;
#pragma unroll
        for (int mt = 0; mt < 2; ++mt)
#pragma unroll
          for (int j = 0; j < 4; ++j) {
            const float e = (s[mt][nt][j] > -1e29f) ? __builtin_amdgcn_exp2f(s[mt][nt][j] - mnew) : 0.f;
            s[mt][nt][j] = e;
            ls += e;
          }
        lrow[nt] = lrow[nt] * alpha + ls;
#pragma unroll
        for (int a = 0; a < 4; ++a) o[a][nt] *= alpha;
        u32x4 w;
        w.x = cvt_pk_bf16(s[0][nt][0], s[0][nt][1]);
        w.y = cvt_pk_bf16(s[0][nt][2], s[0][nt][3]);
        w.z = cvt_pk_bf16(s[1][nt][0], s[1][nt][1]);
        w.w = cvt_pk_bf16(s[1][nt][2], s[1][nt][3]);
        pf[nt] = __builtin_bit_cast(bf16x8, w);
      }
#pragma unroll
      for (int mt = 0; mt < 4; ++mt) {
        const u32x2 lo = *(const u32x2*)(vb_ + (mt * 16 + l15) * NV_ROW + (4 * g) * 2);
        const u32x2 hi = *(const u32x2*)(vb_ + (mt * 16 + l15) * NV_ROW + (16 + 4 * g) * 2);
        u32x4 w;
        w.x = lo.x; w.y = lo.y; w.z = hi.x; w.w = hi.y;
        const bf16x8 vf = __builtin_bit_cast(bf16x8, w);
#pragma unroll
        for (int nt = 0; nt < 2; ++nt)
          o[mt][nt] = __builtin_amdgcn_mfma_f32_16x16x32_bf16(vf, pf[nt], o[mt][nt], 0, 0, 0);
      }
    }
#pragma unroll
    for (int nt = 0; nt < 2; ++nt) {
      float lt = lrow[nt];
      lt += __shfl_xor(lt, 16);
      lt += __shfl_xor(lt, 32);
      const float inv = 1.0f / lt;
      const int tok = b * 4096 + r * 64 + cq[nt];
#pragma unroll
      for (int mt = 0; mt < 4; ++mt) {
        u32x2 w;
        w.x = cvt_pk_bf16(o[mt][nt][0] * inv, o[mt][nt][1] * inv);
        w.y = cvt_pk_bf16(o[mt][nt][2] * inv, o[mt][nt][3] * inv);
        *(u32x2*)(p.o_c + (size_t)tok * 256 + hw * 64 + mt * 16 + g * 4) = w;
      }
    }
  }
}


__device__ void attn_phase(const P& p, char* smem) {
  int tid_ = threadIdx.x;
  asm volatile("" : "+v"(tid_));
  const int tid = tid_, lane = tid & 63, wave = tid >> 6, l15 = lane & 15, g = lane >> 4;
  char* Ks = smem;
  char* Vs = smem + 2 * KBUF;
  for (int job = vblock(); job < 768; job += gridDim.x) {
    const int qblk = job & 15, bh = job >> 4;
    const int b = bh / 6, h = bh % 6;
    const bf16_t* Q = p.qb + (size_t)bh * 4096 * 96;
    const bf16_t* Kg = p.kb + (size_t)bh * 4096 * 96;
    const bf16_t* Vt = p.vT + (size_t)bh * 64 * 4096;
    const int q0 = qblk * 256 + wave * 32;
    bf16x8 qf[2][3];
#pragma unroll
    for (int nt = 0; nt < 2; ++nt)
#pragma unroll
      for (int ks = 0; ks < 3; ++ks)
        qf[nt][ks] = *(const bf16x8*)(Q + (size_t)(q0 + nt * 16 + l15) * 96 + ks * 32 + g * 8);
    f32x4 o[4][2];
#pragma unroll
    for (int a = 0; a < 4; ++a)
#pragma unroll
      for (int n = 0; n < 2; ++n) o[a][n] = (f32x4){0.f, 0.f, 0.f, 0.f};
    float mrow[2] = {-1e30f, -1e30f}, lrow[2] = {0.f, 0.f};

    u32x4 rk[2];
    u32x4 rv;
    const int kr1 = (tid + 512) / 12, kc1 = (tid + 512) - kr1 * 12;
    const int kr0 = tid / 12, kc0 = tid - kr0 * 12;
    auto gload = [&](int kt) {
      const u32x4* kp = (const u32x4*)(Kg + (size_t)kt * 64 * 96);
      rk[0] = kp[tid];
      if (tid < 256) rk[1] = kp[tid + 512];
      rv = *(const u32x4*)(Vt + (size_t)(tid >> 3) * 4096 + kt * 64 + (tid & 7) * 8);
    };
    auto lstore = [&](int buf) {
      char* kb_ = Ks + buf * KBUF;
      char* vb_ = Vs + buf * VBUF;
      *(u32x4*)(kb_ + kr0 * KROW + kc0 * 16) = rk[0];
      if (tid < 256) *(u32x4*)(kb_ + kr1 * KROW + kc1 * 16) = rk[1];
      u32x2 lo, hi;
      lo.x = rv.x; lo.y = rv.y; hi.x = rv.z; hi.y = rv.w;
      *(u32x2*)(vb_ + (tid >> 3) * VROW + (tid & 7) * 16) = lo;
      *(u32x2*)(vb_ + (tid >> 3) * VROW + (tid & 7) * 16 + 8) = hi;
    };
    const int NKT = 64;
    gload(0);
    __syncthreads();
    lstore(0);
    gload(1);
    for (int kt = 0; kt < NKT; ++kt) {
      __syncthreads();
      if (kt + 1 < NKT) {
        lstore((kt + 1) & 1);
        if (kt + 2 < NKT) gload(kt + 2);
      }
      __builtin_amdgcn_sched_barrier(0);
      const char* kb_ = Ks + (kt & 1) * KBUF;
      const char* vb_ = Vs + (kt & 1) * VBUF;
      f32x4 s[4][2];
#pragma unroll
      for (int a = 0; a < 4; ++a)
#pragma unroll
        for (int n = 0; n < 2; ++n) s[a][n] = (f32x4){0.f, 0.f, 0.f, 0.f};
#pragma unroll
      for (int mt = 0; mt < 4; ++mt)
#pragma unroll
        for (int ks = 0; ks < 3; ++ks) {
          const bf16x8 kf = *(const bf16x8*)(kb_ + (mt * 16 + l15) * KROW + (ks * 32 + g * 8) * 2);
#pragma unroll
          for (int nt = 0; nt < 2; ++nt)
            s[mt][nt] = __builtin_amdgcn_mfma_f32_16x16x32_bf16(kf, qf[nt][ks], s[mt][nt], 0, 0, 0);
        }
      bf16x8 pf[2][2];
#pragma unroll
      for (int nt = 0; nt < 2; ++nt) {
        float mx = s[0][nt][0];
#pragma unroll
        for (int mt = 0; mt < 4; ++mt)
#pragma unroll
          for (int j = 0; j < 4; ++j) mx = fmaxf(mx, s[mt][nt][j]);
        mx = fmaxf(mx, __shfl_xor(mx, 16));
        mx = fmaxf(mx, __shfl_xor(mx, 32));
        if (__any(mx > mrow[nt] + 8.0f)) {
          const float mnew = fmaxf(mrow[nt], mx);
          const float alpha = __builtin_amdgcn_exp2f(mrow[nt] - mnew);
          mrow[nt] = mnew;
          lrow[nt] *= alpha;
#pragma unroll
          for (int a = 0; a < 4; ++a) o[a][nt] *= alpha;
        }
        const float mref = mrow[nt];
        float ls = 0.f;
#pragma unroll
        for (int mt = 0; mt < 4; ++mt)
#pragma unroll
          for (int j = 0; j < 4; ++j) {
            const float e = __builtin_amdgcn_exp2f(s[mt][nt][j] - mref);
            s[mt][nt][j] = e;
            ls += e;
          }
        lrow[nt] += ls;
#pragma unroll
        for (int kk = 0; kk < 2; ++kk) {
          u32x4 w;
          w.x = cvt_pk_bf16(s[2 * kk][nt][0], s[2 * kk][nt][1]);
          w.y = cvt_pk_bf16(s[2 * kk][nt][2], s[2 * kk][nt][3]);
          w.z = cvt_pk_bf16(s[2 * kk + 1][nt][0], s[2 * kk + 1][nt][1]);
          w.w = cvt_pk_bf16(s[2 * kk + 1][nt][2], s[2 * kk + 1][nt][3]);
          pf[kk][nt] = __builtin_bit_cast(bf16x8, w);
        }
      }
#pragma unroll
      for (int kk = 0; kk < 2; ++kk)
#pragma unroll
        for (int mt = 0; mt < 4; ++mt) {
          const u32x2 lo = *(const u32x2*)(vb_ + (mt * 16 + l15) * VROW + (32 * kk + 4 * g) * 2);
          const u32x2 hi = *(const u32x2*)(vb_ + (mt * 16 + l15) * VROW + (32 * kk + 16 + 4 * g) * 2);
          u32x4 w;
          w.x = lo.x; w.y = lo.y; w.z = hi.x; w.w = hi.y;
          const bf16x8 vf = __builtin_bit_cast(bf16x8, w);
#pragma unroll
          for (int nt = 0; nt < 2; ++nt)
            o[mt][nt] = __builtin_amdgcn_mfma_f32_16x16x32_bf16(vf, pf[kk][nt], o[mt][nt], 0, 0, 0);
        }
    }
#pragma unroll
    for (int nt = 0; nt < 2; ++nt) {
      float lt = lrow[nt];
      lt += __shfl_xor(lt, 16);
      lt += __shfl_xor(lt, 32);
      const float inv = 1.0f / lt;
      const int tok = b * 4096 + q0 + nt * 16 + l15;
#pragma unroll
      for (int mt = 0; mt < 4; ++mt) {
        u32x2 w;
        w.x = cvt_pk_bf16(o[mt][nt][0] * inv, o[mt][nt][1] * inv);
        w.y = cvt_pk_bf16(o[mt][nt][2] * inv, o[mt][nt][3] * inv);
        *(u32x2*)(p.o_a + (size_t)tok * 384 + h * 64 + mt * 16 + g * 4) = w;
      }
    }
  }
}

__device__ void mixnorm_phase(const P& p, char* smem) {
  int tid_ = threadIdx.x;
  asm volatile("" : "+v"(tid_));
  const int tid = tid_;
  for (int job = blockIdx.x; job < NTOK / 32; job += gridDim.x) {
    const int tok0 = job * 32, b = tok0 >> 12, s0 = tok0 & 4095;
    __syncthreads();
#pragma unroll
    for (int i = 0; i < 3; ++i) {
      const int c = tid + 512 * i, row = c / 48, cc = c % 48;
      *(u32x4*)(smem + row * 2048 + cc * 16) = *(const u32x4*)(p.o_a + (size_t)(tok0 + row) * 384 + cc * 8);
    }
#pragma unroll
    for (int i = 0; i < 2; ++i) {
      const int c = tid + 512 * i, row = c >> 5, cc = c & 31;
      *(u32x4*)(smem + row * 2048 + 1536 + cc * 16) = *(const u32x4*)(p.o_c + (size_t)(tok0 + row) * 256 + cc * 8);
    }
#pragma unroll
    for (int i = 0; i < 3; ++i) {
      const int c = tid + 512 * i, ch = c >> 2, tc = c & 3;
      const u32x4 v = *(const u32x4*)(p.ybT + ((size_t)(b * 384 + ch)) * 4096 + s0 + tc * 8);
      bf16_t* dst = (bf16_t*)smem + (size_t)(tc * 8) * 1024 + 384 + ch;
      dst[0 * 1024] = (bf16_t)(v.x & 0xffff); dst[1 * 1024] = (bf16_t)(v.x >> 16);
      dst[2 * 1024] = (bf16_t)(v.y & 0xffff); dst[3 * 1024] = (bf16_t)(v.y >> 16);
      dst[4 * 1024] = (bf16_t)(v.z & 0xffff); dst[5 * 1024] = (bf16_t)(v.z >> 16);
      dst[6 * 1024] = (bf16_t)(v.w & 0xffff); dst[7 * 1024] = (bf16_t)(v.w >> 16);
    }
    __syncthreads();
    const int tok = tid >> 4, sub = tid & 15;
    float ss[3] = {0.f, 0.f, 0.f};
#pragma unroll
    for (int gi = 0; gi < 3; ++gi) {
      const int i0 = (gi == 0) ? 0 : (gi == 1 ? 3 : 6), i1 = (gi == 0) ? 3 : (gi == 1 ? 6 : 8);
      float acc = 0.f;
#pragma unroll 2
      for (int i = i0; i < i1; ++i) {
        const u32x4 v = *(const u32x4*)(smem + tok * 2048 + (sub + 16 * i) * 16);
        float a;
        a = bflo(v.x); acc += a * a; a = bfhi(v.x); acc += a * a;
        a = bflo(v.y); acc += a * a; a = bfhi(v.y); acc += a * a;
        a = bflo(v.z); acc += a * a; a = bfhi(v.z); acc += a * a;
        a = bflo(v.w); acc += a * a; a = bfhi(v.w); acc += a * a;
      }
      acc += __shfl_xor(acc, 1);
      acc += __shfl_xor(acc, 2);
      acc += __shfl_xor(acc, 4);
      acc += __shfl_xor(acc, 8);
      ss[gi] = acc;
    }
    float rs[3];
    rs[0] = rsqrtf(ss[0] * (1.0f / 384.0f) + 1e-6f);
    rs[1] = rsqrtf(ss[1] * (1.0f / 384.0f) + 1e-6f);
    rs[2] = rsqrtf(ss[2] * (1.0f / 256.0f) + 1e-6f);
#pragma unroll
    for (int gi = 0; gi < 3; ++gi) {
      const int i0 = (gi == 0) ? 0 : (gi == 1 ? 3 : 6), i1 = (gi == 0) ? 3 : (gi == 1 ? 6 : 8);
      const float r = rs[gi];
#pragma unroll 2
      for (int i = i0; i < i1; ++i) {
        const u32x4 v = *(const u32x4*)(smem + tok * 2048 + (sub + 16 * i) * 16);
        u32x4 w;
        w.x = cvt_pk_bf16(bflo(v.x) * r, bfhi(v.x) * r);
        w.y = cvt_pk_bf16(bflo(v.y) * r, bfhi(v.y) * r);
        w.z = cvt_pk_bf16(bflo(v.z) * r, bfhi(v.z) * r);
        w.w = cvt_pk_bf16(bflo(v.w) * r, bfhi(v.w) * r);
        *(u32x4*)(p.y + (size_t)(tok0 + tok) * 1024 + (sub + 16 * i) * 8) = w;
      }
    }
  }
}

enum { EPI_INPROJ = 0, EPI_QUP = 1, EPI_KVUP = 2, EPI_OUTPROJ = 3, EPI_SWIGLU = 4, EPI_DOWN = 5 };

template <int EPI>
__device__ void gemm_phase(const P& p, int l, const bf16_t* __restrict__ A, int lda, const bf16_t* __restrict__ Bt,
                           int K, int nN, char* smem) {
  int tid_ = threadIdx.x;
  asm volatile("" : "+v"(tid_));
  const int tid = tid_, lane = tid & 63, wave = tid >> 6, wm = wave >> 2, wn = wave & 3, l15 = lane & 15,
            g = lane >> 4;
  const int ntiles = 128 * nN;
  const int srow = tid >> 3, skc = tid & 7;
  const int sw_off = srow * 128 + ((skc ^ ((srow >> 1) & 7)) * 16);
  const int rsw = (l15 >> 1) & 7;
  for (int tile = vblock(); tile < ntiles; tile += gridDim.x) {
    const int gsz_ = 4 * nN, grp_ = tile / gsz_, w_ = tile - grp_ * gsz_;
    const int ni = w_ >> 2, mi = grp_ * 4 + (w_ & 3);
    const int m0 = mi * 256, n0 = ni * 256;
    f32x4 acc[8][4];
#pragma unroll
    for (int a = 0; a < 8; ++a)
#pragma unroll
      for (int b = 0; b < 4; ++b) acc[a][b] = (f32x4){0.f, 0.f, 0.f, 0.f};
    const bf16_t* Ag = A + (size_t)(m0 + srow) * lda + skc * 8;
    const bf16_t* Bg = Bt + (size_t)(n0 + srow) * K + skc * 8;
    u32x4 ra[4], rb[4];
    auto gl = [&](int kt) {
#pragma unroll
      for (int i = 0; i < 4; ++i) ra[i] = *(const u32x4*)(Ag + (size_t)i * 64 * lda + kt * 64);
#pragma unroll
      for (int i = 0; i < 4; ++i) rb[i] = *(const u32x4*)(Bg + (size_t)i * 64 * K + kt * 64);
    };
    auto st = [&](int buf) {
      char* nb = smem + buf * 65536;
#pragma unroll
      for (int i = 0; i < 4; ++i) *(u32x4*)(nb + sw_off + i * 8192) = ra[i];
#pragma unroll
      for (int i = 0; i < 4; ++i) *(u32x4*)(nb + 32768 + sw_off + i * 8192) = rb[i];
    };
    const int nk = K / 64;
    gl(0);
    float rs_row = 1.f;
    if (EPI == EPI_INPROJ || EPI == EPI_SWIGLU) {
      if (tid < 256) {
        const f32x4* pp = (const f32x4*)(p.part_x + (size_t)(m0 + tid) * 16);
        const f32x4 a0 = pp[0], a1 = pp[1], a2 = pp[2], a3 = pp[3];
        const float tot = (a0[0] + a0[1] + a0[2] + a0[3]) + (a1[0] + a1[1] + a1[2] + a1[3]) +
                          (a2[0] + a2[1] + a2[2] + a2[3]) + (a3[0] + a3[1] + a3[2] + a3[3]);
        rs_row = rsqrtf(tot * (1.0f / 1024.0f) + 1e-6f);
      }
    } else if (EPI == EPI_QUP) {
      if (tid < 256) {
        const f32x4 a0 = *(const f32x4*)(p.part_q + (size_t)(m0 + tid) * 4);
        rs_row = rsqrtf((a0[0] + a0[1] + a0[2] + a0[3]) * (1.0f / 256.0f) + 1e-6f);
      }
    } else if (EPI == EPI_KVUP) {
      if (tid < 256) {
        const float2 a0 = *(const float2*)(p.part_kv + (size_t)(m0 + tid) * 2);
        rs_row = rsqrtf((a0.x + a0.y) * (1.0f / 128.0f) + 1e-6f);
      }
    }
    float* s_rs = (float*)(smem + 131072);
    __syncthreads();
    st(0);
    if (EPI != EPI_OUTPROJ && EPI != EPI_DOWN && true) {
      if (tid < 256) s_rs[tid] = rs_row;
    }
    __syncthreads();
    for (int kt = 0; kt < nk; ++kt) {
      if (kt + 1 < nk) gl(kt + 1);
      __builtin_amdgcn_sched_barrier(0);
      const char* Ab = smem + (kt & 1) * 65536;
      const char* Bb = Ab + 32768;
#pragma unroll
      for (int ks = 0; ks < 2; ++ks) {
        bf16x8 bfr[4];
#pragma unroll
        for (int nt = 0; nt < 4; ++nt)
          bfr[nt] = *(const bf16x8*)(Bb + (wn * 64 + nt * 16 + l15) * 128 + (((ks * 4 + g) ^ rsw) * 16));
        bf16x8 af[2][2];
#pragma unroll
        for (int mt = 0; mt < 2; ++mt)
          af[0][mt] = *(const bf16x8*)(Ab + (wm * 128 + mt * 16 + l15) * 128 + (((ks * 4 + g) ^ rsw) * 16));
#pragma unroll
        for (int mh = 0; mh < 4; ++mh) {
          if (mh < 3) {
#pragma unroll
            for (int mt = 0; mt < 2; ++mt)
              af[(mh + 1) & 1][mt] = *(const bf16x8*)(Ab + (wm * 128 + ((mh + 1) * 2 + mt) * 16 + l15) * 128 + (((ks * 4 + g) ^ rsw) * 16));
          }
          __builtin_amdgcn_sched_barrier(0);
#pragma unroll
          for (int mt = 0; mt < 2; ++mt)
#pragma unroll
            for (int nt = 0; nt < 4; ++nt)
              acc[mh * 2 + mt][nt] = __builtin_amdgcn_mfma_f32_16x16x32_bf16(bfr[nt], af[mh & 1][mt], acc[mh * 2 + mt][nt], 0, 0, 0);
          __builtin_amdgcn_sched_barrier(0);
        }
      }
      if (kt + 1 < nk) st((kt + 1) & 1);
      __syncthreads();
    }
    int opq_ = 0;
    asm volatile("" : "+v"(opq_));
    const int rbase = m0 + wm * 128 + l15 + opq_;
    const int cbase = n0 + wn * 64 + g * 4 + opq_;
    if (EPI == EPI_INPROJ) {
      const int wc0 = n0 + wn * 64;
#pragma unroll
      for (int mt = 0; mt < 8; ++mt) {
        const int row = rbase + mt * 16;
        const float rs = s_rs[row - m0];
        const int bb = row >> 12, ss = row & 4095;
        float sq = 0.f;
#pragma unroll
        for (int nt = 0; nt < 4; ++nt) {
          const int ct = wc0 + nt * 16;
          const int col = cbase + nt * 16;
          f32x4 v = acc[mt][nt] * rs;
          if (ct < 384) {
            sq += v[0] * v[0] + v[1] * v[1] + v[2] * v[2] + v[3] * v[3];
            u32x2 w;
            w.x = cvt_pk_bf16(v[0], v[1]);
            w.y = cvt_pk_bf16(v[2], v[3]);
            *(u32x2*)(p.projA + (size_t)row * 416 + col) = w;
          } else if (ct == 384) {
            if (nt < 3) {
              const f32x4 v2 = acc[mt][(nt + 1) & 3] * rs;
              const int i0 = col - 384;
              const float2* cs = p.ropecs + ss * 16 + i0;
              float o1[4], o2[4];
#pragma unroll
              for (int j = 0; j < 4; ++j) {
                const float2 c_s = cs[j];
                o1[j] = v[j] * c_s.x - v2[j] * c_s.y;
                o2[j] = v[j] * c_s.y + v2[j] * c_s.x;
              }
              u32x2 w;
              w.x = cvt_pk_bf16(o1[0], o1[1]);
              w.y = cvt_pk_bf16(o1[2], o1[3]);
              *(u32x2*)(p.projA + (size_t)row * 416 + 384 + i0) = w;
              w.x = cvt_pk_bf16(o2[0], o2[1]);
              w.y = cvt_pk_bf16(o2[2], o2[3]);
              *(u32x2*)(p.projA + (size_t)row * 416 + 400 + i0) = w;
            }
          } else if (ct == 400) {
          } else if (ct < 1568) {
            const int hc = col - 416;
            bf16_t* dst = p.hyT + ((size_t)(bb * 1152 + hc)) * 4096 + ss;
            dst[0] = f2bf(v[0]);
            dst[4096] = f2bf(v[1]);
            dst[2 * 4096] = f2bf(v[2]);
            dst[3 * 4096] = f2bf(v[3]);
          } else if (ct < 2080) {
            u32x2 w;
            w.x = cvt_pk_bf16(v[0], v[1]);
            w.y = cvt_pk_bf16(v[2], v[3]);
            *(u32x2*)(p.na + (size_t)row * 768 + (col - 1568)) = w;
          } else if (ct < 2336) {
            const int vc = col - 2080;
            bf16_t* dst = p.naVT + ((size_t)(bb * 256 + vc)) * 4096 + ss;
            dst[0] = f2bf(v[0]);
            dst[4096] = f2bf(v[1]);
            dst[2 * 4096] = f2bf(v[2]);
            dst[3 * 4096] = f2bf(v[3]);
          }
        }
        if (wc0 < 384) {
          sq += __shfl_xor(sq, 16);
          sq += __shfl_xor(sq, 32);
          if (g == 0) {
            if (wc0 < 256) p.part_q[(size_t)row * 4 + (wc0 >> 6)] = sq;
            else p.part_kv[(size_t)row * 2 + ((wc0 - 256) >> 6)] = sq;
          }
        }
      }
    } else if (EPI == EPI_QUP) {
      const int wc0 = n0 + wn * 64;
      const float qscale = 0.10206207261596575f * 1.4426950408889634f;
#pragma unroll
      for (int mt = 0; mt < 8; ++mt) {
        const int row = rbase + mt * 16;
        const float rs = s_rs[row - m0] * qscale;
        const int bb = row >> 12, ss = row & 4095;
#pragma unroll
        for (int nt = 0; nt < 4; ++nt) {
          const int T = (wc0 >> 4) + nt;
          if (T < 36) {
            const int hh = T / 6, tt = T % 6;
            bf16_t* qrow = p.qb + ((size_t)((bb * 6 + hh) * 4096 + ss)) * 96;
            const f32x4 v = acc[mt][nt] * rs;
            if (tt < 4) {
              u32x2 w;
              w.x = cvt_pk_bf16(v[0], v[1]);
              w.y = cvt_pk_bf16(v[2], v[3]);
              *(u32x2*)(qrow + tt * 16 + g * 4) = w;
            } else if (tt == 4) {
              if (nt < 3) {
                const f32x4 v2 = acc[mt][(nt + 1) & 3] * rs;
                const float2* cs = p.ropecs + ss * 16 + g * 4;
                float o1[4], o2[4];
#pragma unroll
                for (int j = 0; j < 4; ++j) {
                  const float2 c_s = cs[j];
                  o1[j] = v[j] * c_s.x - v2[j] * c_s.y;
                  o2[j] = v[j] * c_s.y + v2[j] * c_s.x;
                }
                u32x2 w;
                w.x = cvt_pk_bf16(o1[0], o1[1]);
                w.y = cvt_pk_bf16(o1[2], o1[3]);
                *(u32x2*)(qrow + 64 + g * 4) = w;
                w.x = cvt_pk_bf16(o2[0], o2[1]);
                w.y = cvt_pk_bf16(o2[2], o2[3]);
                *(u32x2*)(qrow + 80 + g * 4) = w;
              }
            }
          }
        }
      }
    } else if (EPI == EPI_KVUP) {
      const int hh = ni * 2 + (wn >> 1);
#pragma unroll
      for (int mt = 0; mt < 8; ++mt) {
        const int row = rbase + mt * 16;
        const float rs = s_rs[row - m0];
        const int bb = row >> 12, ss = row & 4095;
#pragma unroll
        for (int nt = 0; nt < 4; ++nt) {
          const f32x4 v = acc[mt][nt] * rs;
          if ((wn & 1) == 0) {
            u32x2 w;
            w.x = cvt_pk_bf16(v[0], v[1]);
            w.y = cvt_pk_bf16(v[2], v[3]);
            *(u32x2*)(p.kb + ((size_t)((bb * 6 + hh) * 4096 + ss)) * 96 + nt * 16 + g * 4) = w;
          } else {
            const int dv = nt * 16 + g * 4;
            bf16_t* dst = p.vT + ((size_t)((bb * 6 + hh) * 64 + dv)) * 4096 + ss;
            dst[0] = f2bf(v[0]);
            dst[4096] = f2bf(v[1]);
            dst[2 * 4096] = f2bf(v[2]);
            dst[3 * 4096] = f2bf(v[3]);
          }
        }
      }
#pragma unroll
      for (int i = 0; i < 2; ++i) {
        const int c = tid + 512 * i, rr = c >> 2, cc = c & 3;
        const int row = m0 + rr, bb = row >> 12, ss = row & 4095;
        const u32x4 v = *(const u32x4*)(p.projA + (size_t)row * 416 + 384 + cc * 8);
        *(u32x4*)(p.kb + ((size_t)((bb * 6 + ni * 2) * 4096 + ss)) * 96 + 64 + cc * 8) = v;
        *(u32x4*)(p.kb + ((size_t)((bb * 6 + ni * 2 + 1) * 4096 + ss)) * 96 + 64 + cc * 8) = v;
      }
    } else if (EPI == EPI_OUTPROJ || EPI == EPI_DOWN) {
      const int slot = (n0 + wn * 64) >> 6;
#pragma unroll
      for (int mt = 0; mt < 8; ++mt) {
        const int row = rbase + mt * 16;
        float sq = 0.f;
#pragma unroll
        for (int nt = 0; nt < 4; ++nt) {
          const int col = cbase + nt * 16;
          const u32x2 xr = *(const u32x2*)(p.xb + (size_t)row * 1024 + col);
          const f32x4 xo = (f32x4){bflo(xr.x), bfhi(xr.x), bflo(xr.y), bfhi(xr.y)};
          const f32x4 v = acc[mt][nt] + xo;
          sq += v[0] * v[0] + v[1] * v[1] + v[2] * v[2] + v[3] * v[3];
          {
            u32x2 w;
            w.x = cvt_pk_bf16(v[0], v[1]);
            w.y = cvt_pk_bf16(v[2], v[3]);
            *(u32x2*)(p.xb + (size_t)row * 1024 + col) = w;
          }
        }
        sq += __shfl_xor(sq, 16);
        sq += __shfl_xor(sq, 32);
        if (g == 0) p.part_x[(size_t)row * 16 + slot] = sq;
      }
    } else if (EPI == EPI_SWIGLU) {
      const int fbase = ((n0 + wn * 64) >> 1) + g * 8;
#pragma unroll
      for (int mt = 0; mt < 8; ++mt) {
        const int row = rbase + mt * 16;
        const float rs = s_rs[row - m0];
        float hv[8];
#pragma unroll
        for (int i = 0; i < 2; ++i) {
          const f32x4 gt = acc[mt][i] * rs, up = acc[mt][2 + i] * rs;
#pragma unroll
          for (int j = 0; j < 4; ++j) hv[i * 4 + j] = gt[j] * __builtin_amdgcn_rcpf(1.0f + __expf(-gt[j])) * up[j];
        }
        u32x4 w;
        w.x = cvt_pk_bf16(hv[0], hv[1]);
        w.y = cvt_pk_bf16(hv[2], hv[3]);
        w.z = cvt_pk_bf16(hv[4], hv[5]);
        w.w = cvt_pk_bf16(hv[6], hv[7]);
        *(u32x4*)(p.hidden + (size_t)row * 2816 + fbase) = w;
      }
    }
  }
}

__device__ void final_norm_phase(const P& p) {
  int tid_ = threadIdx.x;
  asm volatile("" : "+v"(tid_));
  const int tid = tid_, lane = tid & 63, wave = tid >> 6;
  for (int row = blockIdx.x * 8 + wave; row < NTOK; row += gridDim.x * 8) {
    const f32x4* pp = (const f32x4*)(p.part_x + (size_t)row * 16);
    const f32x4 a0 = pp[0], a1 = pp[1], a2 = pp[2], a3 = pp[3];
    const float tot = (a0[0] + a0[1] + a0[2] + a0[3]) + (a1[0] + a1[1] + a1[2] + a1[3]) +
                      (a2[0] + a2[1] + a2[2] + a2[3]) + (a3[0] + a3[1] + a3[2] + a3[3]);
    const float rs = rsqrtf(tot * (1.0f / 1024.0f) + 1e-6f);
    const bf16_t* xr = p.xb + (size_t)row * 1024;
    float* orow = p.out + (size_t)row * 1024;
#pragma unroll
    for (int i = 0; i < 2; ++i) {
      const int c0 = lane * 8 + 512 * i;
      const u32x4 xv = *(const u32x4*)(xr + c0);
      const f32x4 g0 = *(const f32x4*)(p.final_g + c0), g1 = *(const f32x4*)(p.final_g + c0 + 4);
      f32x4 o0 = (f32x4){bflo(xv.x), bfhi(xv.x), bflo(xv.y), bfhi(xv.y)};
      f32x4 o1 = (f32x4){bflo(xv.z), bfhi(xv.z), bflo(xv.w), bfhi(xv.w)};
      o0 = o0 * rs * g0;
      o1 = o1 * rs * g1;
      *(f32x4*)(orow + c0) = o0;
      *(f32x4*)(orow + c0 + 4) = o1;
    }
  }
}


template <int S>
__device__ __forceinline__ void run_stage(const P& p, int l, char* smem) {
  if (S == 0) prep_phase(p, l, smem);
  if (S == 1) {
    filt_fft_phase(p, l, smem);
    gemm_phase<EPI_INPROJ>(p, l, p.xb, 1024, p.Win, 1024, 10, smem);
  }
  if (S == 2) {
    hyena_phase<0>(p, l, smem);
    gemm_phase<EPI_QUP>(p, l, p.projA, 416, p.Wuq, 256, 3, smem);
    gemm_phase<EPI_KVUP>(p, l, p.projA + 256, 416, p.Wukv, 128, 3, smem);
    natten_phase(p, l, smem);
  }
  if (S == 3) {
    hyena_phase<1>(p, l, smem);
    attn_phase(p, smem);
  }
  if (S == 4) mixnorm_phase(p, smem);
  if (S == 5) gemm_phase<EPI_OUTPROJ>(p, l, p.y, 1024, p.Wout, 1024, 4, smem);
  if (S == 6) gemm_phase<EPI_SWIGLU>(p, l, p.xb, 1024, p.Wgu, 1024, 22, smem);
  if (S == 7) gemm_phase<EPI_DOWN>(p, l, p.hidden, 2816, p.Wdown, 2816, 4, smem);
  if (S == 8) final_norm_phase(p);
}

__device__ __forceinline__ void grid_barrier(unsigned* bar, unsigned target) {
  asm volatile("s_waitcnt vmcnt(0)" ::: "memory");
  __syncthreads();
  if (threadIdx.x == 0) {
    __builtin_amdgcn_fence(__ATOMIC_RELEASE, "agent");
    asm volatile("s_waitcnt vmcnt(0)" ::: "memory");
    __hip_atomic_fetch_add(bar, 1u, __ATOMIC_RELAXED, __HIP_MEMORY_SCOPE_AGENT);
    unsigned spins = 0;
    while (__hip_atomic_load(bar, __ATOMIC_RELAXED, __HIP_MEMORY_SCOPE_AGENT) < target && spins < (1u << 22)) {
      __builtin_amdgcn_s_sleep(1);
      ++spins;
    }
    __builtin_amdgcn_fence(__ATOMIC_ACQUIRE, "agent");
    asm volatile("s_waitcnt vmcnt(0)" ::: "memory");
  }
  __syncthreads();
}

__global__ void __launch_bounds__(NTHREADS) k_main(P p) {
  extern __shared__ __attribute__((aligned(16))) char smem[];
  cg::grid_group grid = cg::this_grid();
  if (blockIdx.x == 0 && threadIdx.x == 0) __hip_atomic_store(p.bar, 0u, __ATOMIC_RELAXED, __HIP_MEMORY_SCOPE_AGENT);
  run_stage<0>(p, 0, smem); grid.sync();
  run_stage<1>(p, 0, smem); grid_barrier(p.bar, 1u * gridDim.x);
  run_stage<2>(p, 0, smem); grid_barrier(p.bar, 2u * gridDim.x);
  run_stage<3>(p, 0, smem); grid_barrier(p.bar, 3u * gridDim.x);
  run_stage<4>(p, 0, smem); grid_barrier(p.bar, 4u * gridDim.x);
  run_stage<5>(p, 0, smem); grid_barrier(p.bar, 5u * gridDim.x);
  run_stage<6>(p, 0, smem); grid_barrier(p.bar, 6u * gridDim.x);
  run_stage<7>(p, 0, smem); grid_barrier(p.bar, 7u * gridDim.x);
  run_stage<0>(p, 1, smem); grid_barrier(p.bar, 8u * gridDim.x);
  run_stage<1>(p, 1, smem); grid_barrier(p.bar, 9u * gridDim.x);
  run_stage<2>(p, 1, smem); grid_barrier(p.bar, 10u * gridDim.x);
  run_stage<3>(p, 1, smem); grid_barrier(p.bar, 11u * gridDim.x);
  run_stage<4>(p, 1, smem); grid_barrier(p.bar, 12u * gridDim.x);
  run_stage<5>(p, 1, smem); grid_barrier(p.bar, 13u * gridDim.x);
  run_stage<6>(p, 1, smem); grid_barrier(p.bar, 14u * gridDim.x);
  run_stage<7>(p, 1, smem); grid_barrier(p.bar, 15u * gridDim.x);
  run_stage<8>(p, 1, smem);
}


extern "C" void kernel_launch(void* const* d_in, const int* in_sizes, int n_in, void* d_out, int out_size, void* d_ws,
                              size_t ws_size, hipStream_t stream) {
  static int grid_blocks = 0;
  if (!grid_blocks) {
    int dev = 0, cus = 0;
    (void)hipGetDevice(&dev);
    (void)hipDeviceGetAttribute(&cus, hipDeviceAttributeMultiprocessorCount, dev);
    if (cus <= 0) cus = 256;
    int per_cu = 0;
    (void)hipFuncSetAttribute((const void*)k_main, hipFuncAttributeMaxDynamicSharedMemorySize, LDS_BYTES);
    (void)hipOccupancyMaxActiveBlocksPerMultiprocessor(&per_cu, k_main, NTHREADS, LDS_BYTES);
    if (per_cu > 1) per_cu = 1;
    if (per_cu < 1) per_cu = 1;
    grid_blocks = cus * per_cu;
  }
  P p;
  memset(&p, 0, sizeof(p));
  const float* const* in = (const float* const*)d_in;
  p.x = in[0]; p.norm1_g = in[1]; p.w_in = in[2]; p.q_norm_g = in[3]; p.w_uq = in[4]; p.kv_norm_g = in[5];
  p.w_ukv = in[6]; p.conv_w = in[7]; p.conv_b = in[8]; p.fw1 = in[9]; p.fb1 = in[10]; p.ff1 = in[11];
  p.fw2 = in[12]; p.fb2 = in[13]; p.ff2 = in[14]; p.fw3 = in[15]; p.skip = in[16]; p.rpb = in[17];
  p.mix_g = in[18]; p.w_out = in[19]; p.norm2_g = in[20]; p.w_gate = in[21]; p.w_up = in[22]; p.w_down = in[23];
  p.final_g = in[24];
  p.out = (float*)d_out;
  char* ws = (char*)d_ws;
  size_t off = 0;
  auto take = [&](size_t bytes) {
    char* r = ws + off;
    off += (bytes + 255) & ~(size_t)255;
    return r;
  };
  p.Win = (bf16_t*)take((size_t)2560 * 1024 * 2);
  p.Wuq = (bf16_t*)take((size_t)768 * 256 * 2);
  p.Wukv = (bf16_t*)take((size_t)768 * 128 * 2);
  p.Wout = (bf16_t*)take((size_t)1024 * 1024 * 2);
  p.Wgu = (bf16_t*)take((size_t)5632 * 1024 * 2);
  p.Wdown = (bf16_t*)take((size_t)1024 * 2816 * 2);
  p.ropecs = (float2*)take((size_t)65536 * 8);
  p.tw = (float2*)take((size_t)8192 * 8);
  p.bar = (unsigned*)take(256);
  p.part_x = (float*)take((size_t)NTOK * 16 * 4);
  p.part_q = (float*)take((size_t)NTOK * 4 * 4);
  p.part_kv = (float*)take((size_t)NTOK * 2 * 4);
  p.xb = (bf16_t*)take((size_t)NTOK * 1024 * 2);
  p.H2 = (float2*)take((size_t)768 * 8192 * 8);
  p.z1T = (bf16_t*)take((size_t)1536 * 4096 * 4);
  p.filtT = (float*)p.z1T;
  p.vT = (bf16_t*)take((size_t)8 * 6 * 64 * 4096 * 2);
  p.o_a = (bf16_t*)take((size_t)NTOK * 384 * 2);
  p.o_c = (bf16_t*)take((size_t)NTOK * 256 * 2);
  char* big = take(0);
  p.projA = (bf16_t*)take((size_t)NTOK * 416 * 2);
  p.hyT = (bf16_t*)take((size_t)8 * 1152 * 4096 * 2);
  p.na = (bf16_t*)take((size_t)NTOK * 768 * 2);
  p.qb = (bf16_t*)take((size_t)8 * 6 * 4096 * 96 * 2);
  p.kb = (bf16_t*)take((size_t)8 * 6 * 4096 * 96 * 2);
  p.hidden = (bf16_t*)big;
  p.ybT = (bf16_t*)take((size_t)8 * 384 * 4096 * 2);
  p.naVT = (bf16_t*)take((size_t)8 * 4 * 64 * 4096 * 2);
  p.y = p.qb;
  if (off > ws_size) {
    fprintf(stderr, "workspace too small: need %zu have %zu\n", off, ws_size);
    return;
  }
  void* args[] = {&p};
  hipError_t e = hipLaunchCooperativeKernel((void*)k_main, dim3(grid_blocks), dim3(NTHREADS), args, LDS_BYTES, stream);
  if (e != hipSuccess) fprintf(stderr, "cooperative launch failed: %s (grid %d)\n", hipGetErrorString(e), grid_blocks);
}
```

```cpp
#include <hip/hip_runtime.h>
#include <hip/hip_cooperative_groups.h>
#include <cstdio>
#include <cstring>
#include <cstdint>
#include <cmath>
#include <type_traits>
namespace cg = cooperative_groups;


typedef unsigned short bf16_t;
typedef short bf16x8 __attribute__((ext_vector_type(8)));
typedef float f32x4 __attribute__((ext_vector_type(4)));
typedef unsigned u32x4 __attribute__((ext_vector_type(4)));
typedef unsigned u32x2 __attribute__((ext_vector_type(2)));

constexpr int NTOK = 32768, SEQ = 4096;
constexpr int NTHREADS = 512;
constexpr int LDS_BYTES = 147456;
constexpr int TW_LDS_OFF = 69632;
#define PADI(i) ((i) + ((i) >> 4))

struct P {
  const float *x, *norm1_g, *w_in, *q_norm_g, *w_uq, *kv_norm_g, *w_ukv, *conv_w, *conv_b, *fw1, *fb1, *ff1, *fw2, *fb2,
      *ff2, *fw3, *skip, *rpb, *mix_g, *w_out, *norm2_g, *w_gate, *w_up, *w_down, *final_g;
  float* out;
  bf16_t *Win, *Wuq, *Wukv, *Wout, *Wgu, *Wdown;
  bf16_t *xb, *projA, *hyT, *na, *qb, *kb, *vT, *o_a, *o_c, *y, *hidden, *ybT, *naVT;
  float2* H2;
  float* filtT;
  bf16_t* z1T;
  float *part_x, *part_q, *part_kv;
  float2* ropecs;
  float2* tw;
  unsigned* bar;
  unsigned pad0_, pad1_;
};

typedef __bf16 bf16v2_t __attribute__((ext_vector_type(2)));
typedef float f32x2_t __attribute__((ext_vector_type(2)));
__device__ __forceinline__ unsigned cvt_pk_bf16(float lo, float hi) {
  const f32x2_t v = {lo, hi};
  const bf16v2_t r = __builtin_convertvector(v, bf16v2_t);
  return __builtin_bit_cast(unsigned, r);
}
__device__ __forceinline__ bf16_t f2bf(float f) { return (bf16_t)(cvt_pk_bf16(f, 0.f) & 0xffffu); }
__device__ __forceinline__ float bf2f(bf16_t h) { return __uint_as_float(((unsigned)h) << 16); }
__device__ __forceinline__ float bflo(unsigned u) { return __uint_as_float(u << 16); }
__device__ __forceinline__ float bfhi(unsigned u) { return __uint_as_float(u & 0xffff0000u); }

__device__ __forceinline__ void fast_sincos_rev(float rev, float* s, float* c) {
  const float fr = rev - rintf(rev);
  *s = __builtin_amdgcn_sinf(fr);
  *c = __builtin_amdgcn_cosf(fr);
}
__device__ __forceinline__ float fast_sin(float x) {
  const float rev = x * 0.15915494309189535f;
  const float fr = rev - rintf(rev);
  return __builtin_amdgcn_sinf(fr);
}

__device__ __forceinline__ int vblock() {
  const int G = gridDim.x, b = blockIdx.x;
  return ((G & 7) == 0) ? ((b & 7) * (G >> 3) + (b >> 3)) : b;
}

__device__ void conv_w(const float* __restrict__ W, int K, int N, int Npad, const float* __restrict__ g, bf16_t* Bt,
                       int mode, char* smem) {
  float* tile = (float*)smem;
  int tid_ = threadIdx.x;
  asm volatile("" : "+v"(tid_));
  const int tid = tid_;
  const int nkt = K / 64, nnt = Npad / 64;
  for (int job = blockIdx.x; job < nkt * nnt; job += gridDim.x) {
    const int kt = job % nkt, ntile = job / nkt;
    const int k0 = kt * 64, n0 = ntile * 64;
    __syncthreads();
#pragma unroll
    for (int i = 0; i < 2; ++i) {
      const int k = (tid >> 4) + 32 * i, nq = (tid & 15) * 4, n = n0 + nq;
      f32x4 v = {0.f, 0.f, 0.f, 0.f};
      if (n < N) {
        v = *(const f32x4*)(W + (size_t)(k0 + k) * N + n);
        if (g) v = v * g[k0 + k];
      }
      tile[k * 65 + nq + 0] = v[0];
      tile[k * 65 + nq + 1] = v[1];
      tile[k * 65 + nq + 2] = v[2];
      tile[k * 65 + nq + 3] = v[3];
    }
    __syncthreads();
    {
      const int c = tid, n = c >> 3, kc = c & 7;
      float e[8];
#pragma unroll
      for (int q = 0; q < 8; ++q) e[q] = tile[(kc * 8 + q) * 65 + n];
      u32x4 w;
      w.x = cvt_pk_bf16(e[0], e[1]);
      w.y = cvt_pk_bf16(e[2], e[3]);
      w.z = cvt_pk_bf16(e[4], e[5]);
      w.w = cvt_pk_bf16(e[6], e[7]);
      const int nn = n0 + n;
      int dest = nn;
      if (mode == 3) {
        const int f = nn & 31;
        dest = (nn & ~31) + ((f >> 2) & 1) * 16 + (f >> 3) * 4 + (f & 3);
      }
      if (mode == 1 || mode == 2) {
        const int f = nn & 31;
        dest = 64 * (nn >> 5) + (mode == 2 ? 32 : 0) + ((f >> 2) & 1) * 16 + (f >> 3) * 4 + (f & 3);
      }
      *(u32x4*)(Bt + (size_t)dest * K + k0 + kc * 8) = w;
    }
  }
}

__device__ void filt_mlp(const P& p, int l, char* smem) {
  float* zf = (float*)smem;
  float* h1 = zf + 16 * 17;
  float* h2 = h1 + 64 * 16;
  int tid_ = threadIdx.x;
  asm volatile("" : "+v"(tid_));
  const int tid = tid_, tl = tid & 15, kk = tid >> 4;
  const float* w1 = p.fw1 + l * 17 * 64;
  const float* b1 = p.fb1 + l * 64;
  const float* f1 = p.ff1 + l * 64;
  const float* w2 = p.fw2 + l * 64 * 64;
  const float* b2 = p.fb2 + l * 64;
  const float* f2 = p.ff2 + l * 64;
  const float* w3 = p.fw3 + (size_t)l * 64 * 1536;
  for (int job = blockIdx.x; job < 256; job += gridDim.x) {
    const int t0 = job * 16;
    __syncthreads();
    {
      const int t = t0 + tl;
      if (kk < 8) {
        const float band = 1e-4f + (float)kk * ((7.0f - 1e-4f) / 7.0f);
        const float ang = ((6.283185307179586f * (float)t) * band) / 4096.0f;
        float s, c;
        fast_sincos_rev(ang * 0.15915494309189535f, &s, &c);
        zf[tl * 17 + 1 + kk] = c;
        zf[tl * 17 + 9 + kk] = s;
      } else if (kk == 8) {
        zf[tl * 17] = (float)t / 4095.0f;
      }
    }
    __syncthreads();
#pragma unroll
    for (int m = 0; m < 2; ++m) {
      const int j = kk + 32 * m;
      float a = b1[j];
#pragma unroll 1
      for (int f = 0; f < 17; ++f) a += zf[tl * 17 + f] * w1[f * 64 + j];
      h1[j * 16 + tl] = fast_sin(f1[j] * a);
    }
    __syncthreads();
#pragma unroll
    for (int m = 0; m < 2; ++m) {
      const int j = kk + 32 * m;
      float a = b2[j];
#pragma unroll 16
      for (int i = 0; i < 64; ++i) a += h1[i * 16 + tl] * w2[i * 64 + j];
      h2[j * 16 + tl] = fast_sin(f2[j] * a);
    }
    __syncthreads();
#pragma unroll 1
    for (int mm = 0; mm < 3; ++mm) {
      const int col = tid + 512 * mm;
      float acc[16];
#pragma unroll
      for (int q = 0; q < 16; ++q) acc[q] = 0.f;
#pragma unroll 1
      for (int j0 = 0; j0 < 64; j0 += 8) {
        float wv[8];
#pragma unroll
        for (int q = 0; q < 8; ++q) wv[q] = w3[(size_t)(j0 + q) * 1536 + col];
#pragma unroll
        for (int q = 0; q < 8; ++q) {
          const float w = wv[q];
          const f32x4* hp = (const f32x4*)(h2 + (j0 + q) * 16);
          const f32x4 a0 = hp[0], a1 = hp[1], a2 = hp[2], a3 = hp[3];
          acc[0] += a0[0] * w; acc[1] += a0[1] * w; acc[2] += a0[2] * w; acc[3] += a0[3] * w;
          acc[4] += a1[0] * w; acc[5] += a1[1] * w; acc[6] += a1[2] * w; acc[7] += a1[3] * w;
          acc[8] += a2[0] * w; acc[9] += a2[1] * w; acc[10] += a2[2] * w; acc[11] += a2[3] * w;
          acc[12] += a3[0] * w; acc[13] += a3[1] * w; acc[14] += a3[2] * w; acc[15] += a3[3] * w;
        }
      }
      const int c = col % 384;
      const float lo = -3.0701134573253945f, hi = -15.350567286626972f;
      const float delta = fabsf(lo + (hi - lo) * ((float)c / 383.0f));
      float* dst = p.filtT + (size_t)col * 4096 + t0;
#pragma unroll
      for (int q = 0; q < 16; ++q) {
        const float tn = (float)(t0 + q) / 4095.0f;
        dst[q] = acc[q] * __expf(-tn * delta);
      }
    }
  }
}

__device__ void prep_phase(const P& p, int l, char* smem) {
  for (int w = 0; w < 7; ++w) {
    const float* W; const float* g; bf16_t* Bt; int K, N, Npad, mode = 0;
    switch (w) {
      case 0: W = p.w_in + (size_t)l * 1024 * 2336; K = 1024; N = 2336; Npad = 2560; g = p.norm1_g + l * 1024; Bt = p.Win; break;
      case 1: W = p.w_uq + (size_t)l * 256 * 576; K = 256; N = 576; Npad = 768; g = p.q_norm_g + l * 256; Bt = p.Wuq; break;
      case 2: W = p.w_ukv + (size_t)l * 128 * 768; K = 128; N = 768; Npad = 768; g = p.kv_norm_g + l * 128; Bt = p.Wukv; break;
      case 3: W = p.w_out + (size_t)l * 1024 * 1024; K = 1024; N = 1024; Npad = 1024; g = p.mix_g + l * 1024; Bt = p.Wout; mode = 3; break;
      case 4: W = p.w_gate + (size_t)l * 1024 * 2816; K = 1024; N = 2816; Npad = 2816; g = p.norm2_g + l * 1024; Bt = p.Wgu; mode = 1; break;
      case 5: W = p.w_up + (size_t)l * 1024 * 2816; K = 1024; N = 2816; Npad = 2816; g = p.norm2_g + l * 1024; Bt = p.Wgu; mode = 2; break;
      default: W = p.w_down + (size_t)l * 2816 * 1024; K = 2816; N = 1024; Npad = 1024; g = nullptr; Bt = p.Wdown; mode = 3; break;
    }
    conv_w(W, K, N, Npad, g, Bt, mode, smem);
  }
  filt_mlp(p, l, smem);
  if (l == 0) {
    int tid_ = threadIdx.x;
  asm volatile("" : "+v"(tid_));
  const int tid = tid_, lane = tid & 63, wave = tid >> 6;
    for (int row = blockIdx.x * 8 + wave; row < NTOK; row += gridDim.x * 8) {
      const float* xr = p.x + (size_t)row * 1024;
      bf16_t* xo = p.xb + (size_t)row * 1024;
      float s = 0.f;
#pragma unroll
      for (int i = 0; i < 4; ++i) {
        const f32x4 v = *(const f32x4*)(xr + lane * 4 + 256 * i);
        s += v[0] * v[0] + v[1] * v[1] + v[2] * v[2] + v[3] * v[3];
        u32x2 w;
        w.x = cvt_pk_bf16(v[0], v[1]);
        w.y = cvt_pk_bf16(v[2], v[3]);
        *(u32x2*)(xo + lane * 4 + 256 * i) = w;
      }
#pragma unroll
      for (int o = 1; o < 64; o <<= 1) s += __shfl_xor(s, o);
      if (lane < 16) p.part_x[(size_t)row * 16 + lane] = (lane == 0) ? s : 0.f;
    }
    for (int i = blockIdx.x * 512 + tid; i < 65536 + 8192; i += gridDim.x * 512) {
      if (i < 65536) {
        const int pos = i >> 4, k = i & 15;
        const float ang = (float)pos * __builtin_amdgcn_exp2f(-(float)k * 0.8304820237218405f);
        float s, c;
        fast_sincos_rev(ang * 0.15915494309189535f, &s, &c);
        p.ropecs[i] = make_float2(c, s);
      } else {
        const int k = i - 65536;
        const int ms = 1 << (31 - __clz(k + 1));
        const int pp = k + 1 - ms;
        float s, c;
        fast_sincos_rev((float)pp / (float)(2 * ms), &s, &c);
        p.tw[k] = make_float2(c, -s);
      }
    }
  }
}

template <int LOGR, int MTOP, bool INV, bool ZIN = false, bool HOUT = false>
__device__ __forceinline__ void fft_pass(float2* sm, const float2* tw) {
  constexpr int R = 1 << LOGR;
  constexpr int q = MTOP >> (LOGR - 1);
  constexpr int ntask = 8192 / R;
  for (int T = threadIdx.x; T < ntask; T += NTHREADS) {
    const int i = T & (q - 1);
    const int blk = T / q;
    const int base = blk * (2 * MTOP) + i;
    float2 v[R];
#pragma unroll
    for (int e = 0; e < R; ++e) {
      if (ZIN && e >= R / 2) v[e] = make_float2(0.f, 0.f);
      else v[e] = sm[PADI(base + e * q)];
    }
    if (!INV) {
#pragma unroll
      for (int s = 0; s < LOGR; ++s) {
        constexpr int dummy = 0;
        (void)dummy;
        const int hs = 1 << (LOGR - 1 - s);
        const int ms = MTOP >> s;
#pragma unroll
        for (int e = 0; e < R; ++e) {
          if ((e & hs) == 0) {
            const int pp = i + (e & (hs - 1)) * q;
            const float2 w = tw[(ms - 1) + pp];
            const float2 a = v[e], b = v[e + hs];
            v[e] = make_float2(a.x + b.x, a.y + b.y);
            const float dx = a.x - b.x, dy = a.y - b.y;
            v[e + hs] = make_float2(dx * w.x - dy * w.y, dx * w.y + dy * w.x);
          }
        }
      }
    } else {
#pragma unroll
      for (int s = LOGR - 1; s >= 0; --s) {
        const int hs = 1 << (LOGR - 1 - s);
        const int ms = MTOP >> s;
#pragma unroll
        for (int e = 0; e < R; ++e) {
          if ((e & hs) == 0) {
            const int pp = i + (e & (hs - 1)) * q;
            const float2 w = tw[(ms - 1) + pp];
            const float2 a = v[e], b = v[e + hs];
            const float tx = b.x * w.x + b.y * w.y, ty = b.y * w.x - b.x * w.y;
            v[e] = make_float2(a.x + tx, a.y + ty);
            v[e + hs] = make_float2(a.x - tx, a.y - ty);
          }
        }
      }
    }
#pragma unroll
    for (int e = 0; e < R; ++e) {
      if (HOUT && e >= R / 2) continue;
      sm[PADI(base + e * q)] = v[e];
    }
  }
  __syncthreads();
}

__device__ __forceinline__ void fft_fwd(float2* sm, const float2* tw) {
  fft_pass<4, 4096, false>(sm, tw);
  fft_pass<4, 256, false>(sm, tw);
  fft_pass<4, 16, false>(sm, tw);
  fft_pass<1, 1, false>(sm, tw);
}
__device__ __forceinline__ void fft_inv(float2* sm, const float2* tw) {
  fft_pass<1, 1, true>(sm, tw);
  fft_pass<3, 8, true>(sm, tw);
  fft_pass<3, 64, true>(sm, tw);
  fft_pass<3, 512, true>(sm, tw);
  fft_pass<3, 4096, true>(sm, tw);
}

__device__ void filt_fft_phase(const P& p, int l, char* smem) {
  float2* sm = (float2*)smem;
  float2* tws = (float2*)(smem + TW_LDS_OFF);
  int tid_ = threadIdx.x;
  asm volatile("" : "+v"(tid_));
  const int tid = tid_;
  for (int i = tid; i < 8192; i += NTHREADS) tws[i] = p.tw[i];
  for (int jj = blockIdx.x; jj < 384; jj += gridDim.x) {
    const int o = jj / 192, c = jj % 192;
    const int jobF = o * 384 + c, jobG = jobF + 192;
    const float* hf1 = p.filtT + ((size_t)((o * 2 + 0) * 384 + c)) * 4096;
    const float* hb1 = p.filtT + ((size_t)((o * 2 + 1) * 384 + c)) * 4096;
    const float* hf2 = hf1 + (size_t)192 * 4096;
    const float* hb2 = hb1 + (size_t)192 * 4096;
    const float sk1 = p.skip[(l * 2 + o) * 384 + c], sk2 = p.skip[(l * 2 + o) * 384 + c + 192];
    __syncthreads();
    for (int n = tid; n < 8192; n += NTHREADS) {
      float v1, v2;
      if (n == 0) { v1 = hf1[0] + hb1[0] + sk1; v2 = hf2[0] + hb2[0] + sk2; }
      else if (n < 4096) { v1 = hf1[n]; v2 = hf2[n]; }
      else if (n == 4096) { v1 = 0.f; v2 = 0.f; }
      else { v1 = hb1[8192 - n]; v2 = hb2[8192 - n]; }
      sm[PADI(n)] = make_float2(v1, v2);
    }
    __syncthreads();
    fft_fwd(sm, tws);
    float2* dF = p.H2 + (size_t)jobF * 8192;
    float2* dG = p.H2 + (size_t)jobG * 8192;
    const float sc = 0.5f / 8192.0f;
    for (int n = tid; n < 8192; n += NTHREADS) {
      const int k = (int)(__brev((unsigned)n) >> 19);
      const int np = (int)(__brev((unsigned)((8192 - k) & 8191)) >> 19);
      const float2 a = sm[PADI(n)], b = sm[PADI(np)];
      dF[n] = make_float2((a.x + b.x) * sc, (a.y - b.y) * sc);
      dG[n] = make_float2((a.y + b.y) * sc, (b.x - a.x) * sc);
    }
  }
}

__device__ __forceinline__ float short_conv(const bf16_t* row, int t, float w0, float w1, float w2, float bias) {
  const float xm = (t > 0) ? bf2f(row[t - 1]) : 0.f;
  const float x0 = bf2f(row[t]);
  const float xp = (t < SEQ - 1) ? bf2f(row[t + 1]) : 0.f;
  return w0 * xm + w1 * x0 + w2 * xp + bias;
}

__device__ __forceinline__ void conv8(const bf16_t* row, int t0, float w0, float w1, float w2, float bias, float (&out)[8]) {
  const u32x4 v = *(const u32x4*)(row + t0);
  float x[10];
  x[0] = (t0 > 0) ? bf2f(row[t0 - 1]) : 0.f;
  x[1] = bflo(v.x); x[2] = bfhi(v.x); x[3] = bflo(v.y); x[4] = bfhi(v.y);
  x[5] = bflo(v.z); x[6] = bfhi(v.z); x[7] = bflo(v.w); x[8] = bfhi(v.w);
  x[9] = (t0 + 8 < SEQ) ? bf2f(row[t0 + 8]) : 0.f;
#pragma unroll
  for (int k = 0; k < 8; ++k) out[k] = w0 * x[k] + w1 * x[k + 1] + w2 * x[k + 2] + bias;
}

struct RawRow { u32x4 v; float lo, hi; };
__device__ __forceinline__ RawRow load_raw(const bf16_t* row, int t0) {
  RawRow r;
  r.v = *(const u32x4*)(row + t0);
  r.lo = (t0 > 0) ? bf2f(row[t0 - 1]) : 0.f;
  r.hi = (t0 + 8 < SEQ) ? bf2f(row[t0 + 8]) : 0.f;
  return r;
}
__device__ __forceinline__ void conv8_raw(const RawRow& r, float w0, float w1, float w2, float bias, float (&out)[8]) {
  float x[10];
  x[0] = r.lo;
  x[1] = bflo(r.v.x); x[2] = bfhi(r.v.x); x[3] = bflo(r.v.y); x[4] = bfhi(r.v.y);
  x[5] = bflo(r.v.z); x[6] = bfhi(r.v.z); x[7] = bflo(r.v.w); x[8] = bfhi(r.v.w);
  x[9] = r.hi;
#pragma unroll
  for (int k = 0; k < 8; ++k) out[k] = w0 * x[k] + w1 * x[k + 1] + w2 * x[k + 2] + bias;
}

__device__ __forceinline__ void fft_mid(float2* sm, const f32x4 (&hpre)[8]) {
#pragma unroll
  for (int it = 0; it < 8; ++it) {
    const int T = threadIdx.x + it * NTHREADS;
    const float2 a = sm[PADI(2 * T)], b = sm[PADI(2 * T + 1)];
    const f32x4 h = hpre[it];
    const float sx = a.x + b.x, sy = a.y + b.y, dx = a.x - b.x, dy = a.y - b.y;
    const float Ax = sx * h[0] - sy * h[1], Ay = sx * h[1] + sy * h[0];
    const float Bx = dx * h[2] - dy * h[3], By = dx * h[3] + dy * h[2];
    sm[PADI(2 * T)] = make_float2(Ax + Bx, Ay + By);
    sm[PADI(2 * T + 1)] = make_float2(Ax - Bx, Ay - By);
  }
  __syncthreads();
}

template <int ORD>
__device__ void hyena_phase(const P& p, int l, char* smem) {
  float2* sm = (float2*)smem;
  float2* tws = (float2*)(smem + TW_LDS_OFF);
  int tid_ = threadIdx.x;
  asm volatile("" : "+v"(tid_));
  const int tid = tid_;
  for (int i = tid; i < 8192; i += NTHREADS) tws[i] = p.tw[i];
  const float* cw = p.conv_w + (size_t)l * 3 * 1152;
  const float* cb = p.conv_b + (size_t)l * 1152;
  const int t0 = tid * 8;
  for (int job = vblock(); job < 1536; job += gridDim.x) {
    const int pair = job & 3, c = job >> 2;
    const int b1 = pair * 2, b2 = b1 + 1;
    const int gc = (ORD == 0 ? 384 : 768) + c;
    const RawRow gr1 = load_raw(p.hyT + ((size_t)(b1 * 1152 + gc)) * 4096, t0);
    const RawRow gr2 = load_raw(p.hyT + ((size_t)(b2 * 1152 + gc)) * 4096, t0);
    __syncthreads();
    {
      float u1[8], u2[8];
      if (ORD == 0) {
        const bf16_t* r1 = p.hyT + ((size_t)(b1 * 1152 + c)) * 4096;
        const bf16_t* r2 = p.hyT + ((size_t)(b2 * 1152 + c)) * 4096;
        const float w0 = cw[c], w1 = cw[1152 + c], w2 = cw[2304 + c], bi = cb[c];
        conv8(r1, t0, w0, w1, w2, bi, u1);
        conv8(r2, t0, w0, w1, w2, bi, u2);
      } else {
        const u32x4 a0 = *(const u32x4*)(p.z1T + ((size_t)(b1 * 384 + c)) * 4096 + t0);
        const u32x4 c0_ = *(const u32x4*)(p.z1T + ((size_t)(b2 * 384 + c)) * 4096 + t0);
        u1[0] = bflo(a0.x); u1[1] = bfhi(a0.x); u1[2] = bflo(a0.y); u1[3] = bfhi(a0.y); u1[4] = bflo(a0.z); u1[5] = bfhi(a0.z); u1[6] = bflo(a0.w); u1[7] = bfhi(a0.w);
        u2[0] = bflo(c0_.x); u2[1] = bfhi(c0_.x); u2[2] = bflo(c0_.y); u2[3] = bfhi(c0_.y); u2[4] = bflo(c0_.z); u2[5] = bfhi(c0_.z); u2[6] = bflo(c0_.w); u2[7] = bfhi(c0_.w);
      }
#pragma unroll
      for (int k = 0; k < 8; ++k) {
        sm[PADI(t0 + k)] = make_float2(u1[k], u2[k]);
      }
    }
    __syncthreads();
    fft_pass<4, 4096, false, true, false>(sm, tws);
    fft_pass<4, 256, false>(sm, tws);
    f32x4 hpre[8];
    {
      const float2* H = p.H2 + ((size_t)(ORD * 384 + c)) * 8192;
#pragma unroll
      for (int it = 0; it < 8; ++it) hpre[it] = *(const f32x4*)(H + 2 * (tid + it * NTHREADS));
    }
    fft_pass<4, 16, false>(sm, tws);
    fft_mid(sm, hpre);
    fft_pass<4, 16, true>(sm, tws);
    fft_pass<4, 256, true>(sm, tws);
    fft_pass<4, 4096, true, false, true>(sm, tws);
    {
      const float w0 = cw[gc], w1 = cw[1152 + gc], w2 = cw[2304 + gc], bi = cb[gc];
      float q1[8], q2[8];
      conv8_raw(gr1, w0, w1, w2, bi, q1);
      conv8_raw(gr2, w0, w1, w2, bi, q2);
#pragma unroll
      for (int k = 0; k < 8; ++k) {
        const float2 yv = sm[PADI(t0 + k)];
        q1[k] *= yv.x;
        q2[k] *= yv.y;
      }
      {
        bf16_t* dbase = (ORD == 0) ? p.z1T : p.ybT;
        u32x4 w1_, w2_;
        w1_.x = cvt_pk_bf16(q1[0], q1[1]); w1_.y = cvt_pk_bf16(q1[2], q1[3]); w1_.z = cvt_pk_bf16(q1[4], q1[5]); w1_.w = cvt_pk_bf16(q1[6], q1[7]);
        w2_.x = cvt_pk_bf16(q2[0], q2[1]); w2_.y = cvt_pk_bf16(q2[2], q2[3]); w2_.z = cvt_pk_bf16(q2[4], q2[5]); w2_.w = cvt_pk_bf16(q2[6], q2[7]);
        *(u32x4*)(dbase + ((size_t)(b1 * 384 + c)) * 4096 + t0) = w1_;
        *(u32x4*)(dbase + ((size_t)(b2 * 384 + c)) * 4096 + t0) = w2_;
      }
    }
  }
}

constexpr int KROW = 208;
constexpr int VROW = 136;
constexpr int KBUF = 64 * KROW, VBUF = 64 * VROW;

constexpr int NK_ROW = 528;
constexpr int NK_BUF = 32 * NK_ROW;
constexpr int NV_ROW = 72;
constexpr int NV_BUF = 256 * NV_ROW;
constexpr int NRPB_OFF = 2 * NK_BUF + 2 * NV_BUF;

__device__ void natten_phase(const P& p, int l, char* smem) {
  int tid_ = threadIdx.x;
  asm volatile("" : "+v"(tid_));
  const int tid = tid_, lane = tid & 63, wave = tid >> 6, l15 = lane & 15, g = lane >> 4;
  const int hw = wave >> 1, qh = wave & 1;
  char* Ks = smem;
  char* Vs = smem + 2 * NK_BUF;
  float* rp = (float*)(smem + NRPB_OFF);
  __syncthreads();
  for (int i = tid; i < 4 * 15 * 31; i += NTHREADS) rp[i] = p.rpb[(size_t)l * 4 * 15 * 31 + i] * 1.4426950408889634f;
  const float qscale = 0.125f * 1.4426950408889634f;
  for (int job = blockIdx.x; job < 512; job += gridDim.x) {
    const int r = job & 63, b = job >> 6;
    const int r0 = min(max(r - 4, 0), 56);
    bf16x8 qf[2][2];
    int cq[2], c0[2];
#pragma unroll
    for (int nt = 0; nt < 2; ++nt) {
      cq[nt] = qh * 32 + nt * 16 + l15;
      c0[nt] = min(max(cq[nt] - 8, 0), 48);
      const bf16_t* qp = p.na + (size_t)(b * 4096 + r * 64 + cq[nt]) * 768 + hw * 64;
#pragma unroll
      for (int ks = 0; ks < 2; ++ks) qf[nt][ks] = *(const bf16x8*)(qp + ks * 32 + g * 8);
    }
    f32x4 o[4][2];
#pragma unroll
    for (int a = 0; a < 4; ++a)
#pragma unroll
      for (int n = 0; n < 2; ++n) o[a][n] = (f32x4){0.f, 0.f, 0.f, 0.f};
    float mrow[2] = {-1e30f, -1e30f}, lrow[2] = {0.f, 0.f};
    u32x4 rk[2], rv[2];
    auto gload = [&](int t) {
      const int kr = r0 + (t >> 1), kh = (t & 1) * 32;
      const bf16_t* kbase = p.na + (size_t)(b * 4096 + kr * 64 + kh) * 768 + 256;
#pragma unroll
      for (int i = 0; i < 2; ++i) {
        const int c = tid + 512 * i, key = c >> 5, cc = c & 31;
        rk[i] = *(const u32x4*)(kbase + (size_t)key * 768 + cc * 8);
      }
#pragma unroll
      for (int i = 0; i < 2; ++i) {
        const int c = tid + 512 * i, row = c >> 2, cc = c & 3;
        rv[i] = *(const u32x4*)(p.naVT + ((size_t)(b * 256 + row)) * 4096 + kr * 64 + kh + cc * 8);
      }
    };
    auto lstore = [&](int buf) {
      char* kb_ = Ks + buf * NK_BUF;
      char* vb_ = Vs + buf * NV_BUF;
#pragma unroll
      for (int i = 0; i < 2; ++i) {
        const int c = tid + 512 * i, key = c >> 5, cc = c & 31;
        *(u32x4*)(kb_ + key * NK_ROW + cc * 16) = rk[i];
      }
#pragma unroll
      for (int i = 0; i < 2; ++i) {
        const int c = tid + 512 * i, row = c >> 2, cc = c & 3;
        u32x2 lo, hi;
        lo.x = rv[i].x; lo.y = rv[i].y; hi.x = rv[i].z; hi.y = rv[i].w;
        *(u32x2*)(vb_ + row * NV_ROW + cc * 16) = lo;
        *(u32x2*)(vb_ + row * NV_ROW + cc * 16 + 8) = hi;
      }
    };
    gload(0);
    __syncthreads();
    lstore(0);
    gload(1);
    for (int t = 0; t < 16; ++t) {
      __syncthreads();
      if (t + 1 < 16) {
        lstore((t + 1) & 1);
        if (t + 2 < 16) gload(t + 2);
      }
      __builtin_amdgcn_sched_barrier(0);
      const char* kb_ = Ks + (t & 1) * NK_BUF;
      const char* vb_ = Vs + (t & 1) * NV_BUF + hw * 64 * NV_ROW;
      const int kh = (t & 1) * 32;
      f32x4 s[2][2];
#pragma unroll
      for (int a = 0; a < 2; ++a)
#pragma unroll
        for (int n = 0; n < 2; ++n) s[a][n] = (f32x4){0.f, 0.f, 0.f, 0.f};
#pragma unroll
      for (int mt = 0; mt < 2; ++mt)
#pragma unroll
        for (int ks = 0; ks < 2; ++ks) {
          const bf16x8 kf = *(const bf16x8*)(kb_ + (mt * 16 + l15) * NK_ROW + hw * 128 + ks * 64 + g * 16);
#pragma unroll
          for (int nt = 0; nt < 2; ++nt)
            s[mt][nt] = __builtin_amdgcn_mfma_f32_16x16x32_bf16(kf, qf[nt][ks], s[mt][nt], 0, 0, 0);
        }
      const float* brow = rp + (hw * 15 + (r0 + (t >> 1) - r + 7)) * 31;
      bf16x8 pf[2];
#pragma unroll
      for (int nt = 0; nt < 2; ++nt) {
        float mx = -1e30f;
#pragma unroll
        for (int mt = 0; mt < 2; ++mt)
#pragma unroll
          for (int j = 0; j < 4; ++j) {
            const int kc = kh + mt * 16 + g * 4 + j;
            const bool valid = (unsigned)(kc - c0[nt]) < 16u;
            const int dc = min(max(kc - cq[nt] + 15, 0), 30);
            const float sc = valid ? (s[mt][nt][j] * qscale + brow[dc]) : -1e30f;
            s[mt][nt][j] = sc;
            mx = fmaxf(mx, sc);
          }
        mx = fmaxf(mx, __shfl_xor(mx, 16));
        mx = fmaxf(mx, __shfl_xor(mx, 32));
        const float mnew = fmaxf(mrow[nt], mx);
        const float alpha = __builtin_amdgcn_exp2f(mrow[nt] - mnew);
        mrow[nt] = mnew;
        float ls = 0.f;
#pragma unroll
        for (int mt = 0; mt < 2; ++mt)
#pragma unroll
          for (int j = 0; j < 4; ++j) {
            const float e = (s[mt][nt][j] > -1e29f) ? __builtin_amdgcn_exp2f(s[mt][nt][j] - mnew) : 0.f;
            s[mt][nt][j] = e;
            ls += e;
          }
        lrow[nt] = lrow[nt] * alpha + ls;
#pragma unroll
        for (int a = 0; a < 4; ++a) o[a][nt] *= alpha;
        u32x4 w;
        w.x = cvt_pk_bf16(s[0][nt][0], s[0][nt][1]);
        w.y = cvt_pk_bf16(s[0][nt][2], s[0][nt][3]);
        w.z = cvt_pk_bf16(s[1][nt][0], s[1][nt][1]);
        w.w = cvt_pk_bf16(s[1][nt][2], s[1][nt][3]);
        pf[nt] = __builtin_bit_cast(bf16x8, w);
      }
#pragma unroll
      for (int mt = 0; mt < 4; ++mt) {
        const u32x2 lo = *(const u32x2*)(vb_ + (mt * 16 + l15) * NV_ROW + (4 * g) * 2);
        const u32x2 hi = *(const u32x2*)(vb_ + (mt * 16 + l15) * NV_ROW + (16 + 4 * g) * 2);
        u32x4 w;
        w.x = lo.x; w.y = lo.y; w.z = hi.x; w.w = hi.y;
        const bf16x8 vf = __builtin_bit_cast(bf16x8, w);
#pragma unroll
        for (int nt = 0; nt < 2; ++nt)
          o[mt][nt] = __builtin_amdgcn_mfma_f32_16x16x32_bf16(vf, pf[nt], o[mt][nt], 0, 0, 0);
      }
    }
#pragma unroll
    for (int nt = 0; nt < 2; ++nt) {
      float lt = lrow[nt];
      lt += __shfl_xor(lt, 16);
      lt += __shfl_xor(lt, 32);
      const float inv = 1.0f / lt;
      const int tok = b * 4096 + r * 64 + cq[nt];
#pragma unroll
      for (int mt = 0; mt < 4; ++mt) {
        u32x2 w;
        w.x = cvt_pk_bf16(o[mt][nt][0] * inv, o[mt][nt][1] * inv);
        w.y = cvt_pk_bf16(o[mt][nt][2] * inv, o[mt][nt][3] * inv);
        *(u32x2*)(p.o_c + (size_t)tok * 256 + hw * 64 + mt * 16 + g * 4) = w;
      }
    }
  }
}


__device__ void attn_phase(const P& p, char* smem) {
  int tid_ = threadIdx.x;
  asm volatile("" : "+v"(tid_));
  const int tid = tid_, lane = tid & 63, wave = tid >> 6, l15 = lane & 15, g = lane >> 4;
  char* Ks = smem;
  char* Vs = smem + 2 * KBUF;
  for (int job = vblock(); job < 768; job += gridDim.x) {
    const int qblk = job & 15, bh = job >> 4;
    const int b = bh / 6, h = bh % 6;
    const bf16_t* Q = p.qb + (size_t)bh * 4096 * 96;
    const bf16_t* Kg = p.kb + (size_t)bh * 4096 * 96;
    const bf16_t* Vt = p.vT + (size_t)bh * 64 * 4096;
    const int q0 = qblk * 256 + wave * 32;
    bf16x8 qf[2][3];
#pragma unroll
    for (int nt = 0; nt < 2; ++nt)
#pragma unroll
      for (int ks = 0; ks < 3; ++ks)
        qf[nt][ks] = *(const bf16x8*)(Q + (size_t)(q0 + nt * 16 + l15) * 96 + ks * 32 + g * 8);
    f32x4 o[4][2];
#pragma unroll
    for (int a = 0; a < 4; ++a)
#pragma unroll
      for (int n = 0; n < 2; ++n) o[a][n] = (f32x4){0.f, 0.f, 0.f, 0.f};
    float mrow[2] = {-1e30f, -1e30f}, lrow[2] = {0.f, 0.f};

    u32x4 rk[2];
    u32x4 rv;
    const int kr1 = (tid + 512) / 12, kc1 = (tid + 512) - kr1 * 12;
    const int kr0 = tid / 12, kc0 = tid - kr0 * 12;
    auto gload = [&](int kt) {
      const u32x4* kp = (const u32x4*)(Kg + (size_t)kt * 64 * 96);
      rk[0] = kp[tid];
      if (tid < 256) rk[1] = kp[tid + 512];
      rv = *(const u32x4*)(Vt + (size_t)(tid >> 3) * 4096 + kt * 64 + (tid & 7) * 8);
    };
    auto lstore = [&](int buf) {
      char* kb_ = Ks + buf * KBUF;
      char* vb_ = Vs + buf * VBUF;
      *(u32x4*)(kb_ + kr0 * KROW + kc0 * 16) = rk[0];
      if (tid < 256) *(u32x4*)(kb_ + kr1 * KROW + kc1 * 16) = rk[1];
      u32x2 lo, hi;
      lo.x = rv.x; lo.y = rv.y; hi.x = rv.z; hi.y = rv.w;
      *(u32x2*)(vb_ + (tid >> 3) * VROW + (tid & 7) * 16) = lo;
      *(u32x2*)(vb_ + (tid >> 3) * VROW + (tid & 7) * 16 + 8) = hi;
    };
    const int NKT = 64;
    gload(0);
    __syncthreads();
    lstore(0);
    gload(1);
    for (int kt = 0; kt < NKT; ++kt) {
      __syncthreads();
      if (kt + 1 < NKT) {
        lstore((kt + 1) & 1);
        if (kt + 2 < NKT) gload(kt + 2);
      }
      __builtin_amdgcn_sched_barrier(0);
      const char* kb_ = Ks + (kt & 1) * KBUF;
      const char* vb_ = Vs + (kt & 1) * VBUF;
      f32x4 s[4][2];
#pragma unroll
      for (int a = 0; a < 4; ++a)
#pragma unroll
        for (int n = 0; n < 2; ++n) s[a][n] = (f32x4){0.f, 0.f, 0.f, 0.f};
#pragma unroll
      for (int mt = 0; mt < 4; ++mt)
#pragma unroll
        for (int ks = 0; ks < 3; ++ks) {
          const bf16x8 kf = *(const bf16x8*)(kb_ + (mt * 16 + l15) * KROW + (ks * 32 + g * 8) * 2);
#pragma unroll
          for (int nt = 0; nt < 2; ++nt)
            s[mt][nt] = __builtin_amdgcn_mfma_f32_16x16x32_bf16(kf, qf[nt][ks], s[mt][nt], 0, 0, 0);
        }
      bf16x8 pf[2][2];
#pragma unroll
      for (int nt = 0; nt < 2; ++nt) {
        float mx = s[0][nt][0];
#pragma unroll
        for (int mt = 0; mt < 4; ++mt)
#pragma unroll
          for (int j = 0; j < 4; ++j) mx = fmaxf(mx, s[mt][nt][j]);
        mx = fmaxf(mx, __shfl_xor(mx, 16));
        mx = fmaxf(mx, __shfl_xor(mx, 32));
        if (__any(mx > mrow[nt] + 8.0f)) {
          const float mnew = fmaxf(mrow[nt], mx);
          const float alpha = __builtin_amdgcn_exp2f(mrow[nt] - mnew);
          mrow[nt] = mnew;
          lrow[nt] *= alpha;
#pragma unroll
          for (int a = 0; a < 4; ++a) o[a][nt] *= alpha;
        }
        const float mref = mrow[nt];
        float ls = 0.f;
#pragma unroll
        for (int mt = 0; mt < 4; ++mt)
#pragma unroll
          for (int j = 0; j < 4; ++j) {
            const float e = __builtin_amdgcn_exp2f(s[mt][nt][j] - mref);
            s[mt][nt][j] = e;
            ls += e;
          }
        lrow[nt] += ls;
#pragma unroll
        for (int kk = 0; kk < 2; ++kk) {
          u32x4 w;
          w.x = cvt_pk_bf16(s[2 * kk][nt][0], s[2 * kk][nt][1]);
          w.y = cvt_pk_bf16(s[2 * kk][nt][2], s[2 * kk][nt][3]);
          w.z = cvt_pk_bf16(s[2 * kk + 1][nt][0], s[2 * kk + 1][nt][1]);
          w.w = cvt_pk_bf16(s[2 * kk + 1][nt][2], s[2 * kk + 1][nt][3]);
          pf[kk][nt] = __builtin_bit_cast(bf16x8, w);
        }
      }
#pragma unroll
      for (int kk = 0; kk < 2; ++kk)
#pragma unroll
        for (int mt = 0; mt < 4; ++mt) {
          const u32x2 lo = *(const u32x2*)(vb_ + (mt * 16 + l15) * VROW + (32 * kk + 4 * g) * 2);
          const u32x2 hi = *(const u32x2*)(vb_ + (mt * 16 + l15) * VROW + (32 * kk + 16 + 4 * g) * 2);
          u32x4 w;
          w.x = lo.x; w.y = lo.y; w.z = hi.x; w.w = hi.y;
          const bf16x8 vf = __builtin_bit_cast(bf16x8, w);
#pragma unroll
          for (int nt = 0; nt < 2; ++nt)
            o[mt][nt] = __builtin_amdgcn_mfma_f32_16x16x32_bf16(vf, pf[kk][nt], o[mt][nt], 0, 0, 0);
        }
    }
#pragma unroll
    for (int nt = 0; nt < 2; ++nt) {
      float lt = lrow[nt];
      lt += __shfl_xor(lt, 16);
      lt += __shfl_xor(lt, 32);
      const float inv = 1.0f / lt;
      const int tok = b * 4096 + q0 + nt * 16 + l15;
#pragma unroll
      for (int mt = 0; mt < 4; ++mt) {
        u32x2 w;
        w.x = cvt_pk_bf16(o[mt][nt][0] * inv, o[mt][nt][1] * inv);
        w.y = cvt_pk_bf16(o[mt][nt][2] * inv, o[mt][nt][3] * inv);
        *(u32x2*)(p.o_a + (size_t)tok * 384 + h * 64 + mt * 16 + g * 4) = w;
      }
    }
  }
}

__device__ void mixnorm_phase(const P& p, char* smem) {
  int tid_ = threadIdx.x;
  asm volatile("" : "+v"(tid_));
  const int tid = tid_;
  for (int job = blockIdx.x; job < NTOK / 32; job += gridDim.x) {
    const int tok0 = job * 32, b = tok0 >> 12, s0 = tok0 & 4095;
    __syncthreads();
#pragma unroll
    for (int i = 0; i < 3; ++i) {
      const int c = tid + 512 * i, row = c / 48, cc = c % 48;
      *(u32x4*)(smem + row * 2048 + cc * 16) = *(const u32x4*)(p.o_a + (size_t)(tok0 + row) * 384 + cc * 8);
    }
#pragma unroll
    for (int i = 0; i < 2; ++i) {
      const int c = tid + 512 * i, row = c >> 5, cc = c & 31;
      *(u32x4*)(smem + row * 2048 + 1536 + cc * 16) = *(const u32x4*)(p.o_c + (size_t)(tok0 + row) * 256 + cc * 8);
    }
#pragma unroll
    for (int i = 0; i < 3; ++i) {
      const int c = tid + 512 * i, ch = c >> 2, tc = c & 3;
      const u32x4 v = *(const u32x4*)(p.ybT + ((size_t)(b * 384 + ch)) * 4096 + s0 + tc * 8);
      bf16_t* dst = (bf16_t*)smem + (size_t)(tc * 8) * 1024 + 384 + ch;
      dst[0 * 1024] = (bf16_t)(v.x & 0xffff); dst[1 * 1024] = (bf16_t)(v.x >> 16);
      dst[2 * 1024] = (bf16_t)(v.y & 0xffff); dst[3 * 1024] = (bf16_t)(v.y >> 16);
      dst[4 * 1024] = (bf16_t)(v.z & 0xffff); dst[5 * 1024] = (bf16_t)(v.z >> 16);
      dst[6 * 1024] = (bf16_t)(v.w & 0xffff); dst[7 * 1024] = (bf16_t)(v.w >> 16);
    }
    __syncthreads();
    const int tok = tid >> 4, sub = tid & 15;
    float ss[3] = {0.f, 0.f, 0.f};
#pragma unroll
    for (int gi = 0; gi < 3; ++gi) {
      const int i0 = (gi == 0) ? 0 : (gi == 1 ? 3 : 6), i1 = (gi == 0) ? 3 : (gi == 1 ? 6 : 8);
      float acc = 0.f;
#pragma unroll 2
      for (int i = i0; i < i1; ++i) {
        const u32x4 v = *(const u32x4*)(smem + tok * 2048 + (sub + 16 * i) * 16);
        float a;
        a = bflo(v.x); acc += a * a; a = bfhi(v.x); acc += a * a;
        a = bflo(v.y); acc += a * a; a = bfhi(v.y); acc += a * a;
        a = bflo(v.z); acc += a * a; a = bfhi(v.z); acc += a * a;
        a = bflo(v.w); acc += a * a; a = bfhi(v.w); acc += a * a;
      }
      acc += __shfl_xor(acc, 1);
      acc += __shfl_xor(acc, 2);
      acc += __shfl_xor(acc, 4);
      acc += __shfl_xor(acc, 8);
      ss[gi] = acc;
    }
    float rs[3];
    rs[0] = rsqrtf(ss[0] * (1.0f / 384.0f) + 1e-6f);
    rs[1] = rsqrtf(ss[1] * (1.0f / 384.0f) + 1e-6f);
    rs[2] = rsqrtf(ss[2] * (1.0f / 256.0f) + 1e-6f);
#pragma unroll
    for (int gi = 0; gi < 3; ++gi) {
      const int i0 = (gi == 0) ? 0 : (gi == 1 ? 3 : 6), i1 = (gi == 0) ? 3 : (gi == 1 ? 6 : 8);
      const float r = rs[gi];
#pragma unroll 2
      for (int i = i0; i < i1; ++i) {
        const u32x4 v = *(const u32x4*)(smem + tok * 2048 + (sub + 16 * i) * 16);
        u32x4 w;
        w.x = cvt_pk_bf16(bflo(v.x) * r, bfhi(v.x) * r);
        w.y = cvt_pk_bf16(bflo(v.y) * r, bfhi(v.y) * r);
        w.z = cvt_pk_bf16(bflo(v.z) * r, bfhi(v.z) * r);
        w.w = cvt_pk_bf16(bflo(v.w) * r, bfhi(v.w) * r);
        *(u32x4*)(p.y + (size_t)(tok0 + tok) * 1024 + (sub + 16 * i) * 8) = w;
      }
    }
  }
}

enum { EPI_INPROJ = 0, EPI_QUP = 1, EPI_KVUP = 2, EPI_OUTPROJ = 3, EPI_SWIGLU = 4, EPI_DOWN = 5 };

template <int EPI>
__device__ void gemm_phase(const P& p, int l, const bf16_t* __restrict__ A, int lda, const bf16_t* __restrict__ Bt,
                           int K, int nN, char* smem) {
  int tid_ = threadIdx.x;
  asm volatile("" : "+v"(tid_));
  const int tid = tid_, lane = tid & 63, wave = tid >> 6, wm = wave >> 2, wn = wave & 3, l15 = lane & 15,
            g = lane >> 4;
  const int ntiles = 128 * nN;
  const int srow = tid >> 3, skc = tid & 7;
  const int sw_off = srow * 128 + ((skc ^ ((srow >> 1) & 7)) * 16);
  const int rsw = (l15 >> 1) & 7;
  for (int tile = vblock(); tile < ntiles; tile += gridDim.x) {
    const int gsz_ = 4 * nN, grp_ = tile / gsz_, w_ = tile - grp_ * gsz_;
    const int ni = w_ >> 2, mi = grp_ * 4 + (w_ & 3);
    const int m0 = mi * 256, n0 = ni * 256;
    f32x4 acc[8][4];
#pragma unroll
    for (int a = 0; a < 8; ++a)
#pragma unroll
      for (int b = 0; b < 4; ++b) acc[a][b] = (f32x4){0.f, 0.f, 0.f, 0.f};
    const bf16_t* Ag = A + (size_t)(m0 + srow) * lda + skc * 8;
    const bf16_t* Bg = Bt + (size_t)(n0 + srow) * K + skc * 8;
    u32x4 ra[4], rb[4];
    auto gl = [&](int kt) {
#pragma unroll
      for (int i = 0; i < 4; ++i) ra[i] = *(const u32x4*)(Ag + (size_t)i * 64 * lda + kt * 64);
#pragma unroll
      for (int i = 0; i < 4; ++i) rb[i] = *(const u32x4*)(Bg + (size_t)i * 64 * K + kt * 64);
    };
    auto st = [&](int buf) {
      char* nb = smem + buf * 65536;
#pragma unroll
      for (int i = 0; i < 4; ++i) *(u32x4*)(nb + sw_off + i * 8192) = ra[i];
#pragma unroll
      for (int i = 0; i < 4; ++i) *(u32x4*)(nb + 32768 + sw_off + i * 8192) = rb[i];
    };
    const int nk = K / 64;
    gl(0);
    float rs_row = 1.f;
    if (EPI == EPI_INPROJ || EPI == EPI_SWIGLU) {
      if (tid < 256) {
        const f32x4* pp = (const f32x4*)(p.part_x + (size_t)(m0 + tid) * 16);
        const f32x4 a0 = pp[0], a1 = pp[1], a2 = pp[2], a3 = pp[3];
        const float tot = (a0[0] + a0[1] + a0[2] + a0[3]) + (a1[0] + a1[1] + a1[2] + a1[3]) +
                          (a2[0] + a2[1] + a2[2] + a2[3]) + (a3[0] + a3[1] + a3[2] + a3[3]);
        rs_row = rsqrtf(tot * (1.0f / 1024.0f) + 1e-6f);
      }
    } else if (EPI == EPI_QUP) {
      if (tid < 256) {
        const f32x4 a0 = *(const f32x4*)(p.part_q + (size_t)(m0 + tid) * 4);
        rs_row = rsqrtf((a0[0] + a0[1] + a0[2] + a0[3]) * (1.0f / 256.0f) + 1e-6f);
      }
    } else if (EPI == EPI_KVUP) {
      if (tid < 256) {
        const float2 a0 = *(const float2*)(p.part_kv + (size_t)(m0 + tid) * 2);
        rs_row = rsqrtf((a0.x + a0.y) * (1.0f / 128.0f) + 1e-6f);
      }
    }
    float* s_rs = (float*)(smem + 131072);
    __syncthreads();
    st(0);
    if (EPI != EPI_OUTPROJ && EPI != EPI_DOWN && true) {
      if (tid < 256) s_rs[tid] = rs_row;
    }
    __syncthreads();
    for (int kt = 0; kt < nk; ++kt) {
      if (kt + 1 < nk) gl(kt + 1);
      __builtin_amdgcn_sched_barrier(0);
      const char* Ab = smem + (kt & 1) * 65536;
      const char* Bb = Ab + 32768;
#pragma unroll
      for (int ks = 0; ks < 2; ++ks) {
        bf16x8 bfr[4];
#pragma unroll
        for (int nt = 0; nt < 4; ++nt)
          bfr[nt] = *(const bf16x8*)(Bb + (wn * 64 + nt * 16 + l15) * 128 + (((ks * 4 + g) ^ rsw) * 16));
        bf16x8 af[2][2];
#pragma unroll
        for (int mt = 0; mt < 2; ++mt)
          af[0][mt] = *(const bf16x8*)(Ab + (wm * 128 + mt * 16 + l15) * 128 + (((ks * 4 + g) ^ rsw) * 16));
#pragma unroll
        for (int mh = 0; mh < 4; ++mh) {
          if (mh < 3) {
#pragma unroll
            for (int mt = 0; mt < 2; ++mt)
              af[(mh + 1) & 1][mt] = *(const bf16x8*)(Ab + (wm * 128 + ((mh + 1) * 2 + mt) * 16 + l15) * 128 + (((ks * 4 + g) ^ rsw) * 16));
          }
          __builtin_amdgcn_sched_barrier(0);
#pragma unroll
          for (int mt = 0; mt < 2; ++mt)
#pragma unroll
            for (int nt = 0; nt < 4; ++nt)
              acc[mh * 2 + mt][nt] = __builtin_amdgcn_mfma_f32_16x16x32_bf16(bfr[nt], af[mh & 1][mt], acc[mh * 2 + mt][nt], 0, 0, 0);
          __builtin_amdgcn_sched_barrier(0);
        }
      }
      if (kt + 1 < nk) st((kt + 1) & 1);
      __syncthreads();
    }
    int opq_ = 0;
    asm volatile("" : "+v"(opq_));
    const int rbase = m0 + wm * 128 + l15 + opq_;
    const int cbase = n0 + wn * 64 + g * 4 + opq_;
    if (EPI == EPI_INPROJ) {
      const int wc0 = n0 + wn * 64;
#pragma unroll
      for (int mt = 0; mt < 8; ++mt) {
        const int row = rbase + mt * 16;
        const float rs = s_rs[row - m0];
        const int bb = row >> 12, ss = row & 4095;
        float sq = 0.f;
#pragma unroll
        for (int nt = 0; nt < 4; ++nt) {
          const int ct = wc0 + nt * 16;
          const int col = cbase + nt * 16;
          f32x4 v = acc[mt][nt] * rs;
          if (ct < 384) {
            sq += v[0] * v[0] + v[1] * v[1] + v[2] * v[2] + v[3] * v[3];
            u32x2 w;
            w.x = cvt_pk_bf16(v[0], v[1]);
            w.y = cvt_pk_bf16(v[2], v[3]);
            *(u32x2*)(p.projA + (size_t)row * 416 + col) = w;
          } else if (ct == 384) {
            if (nt < 3) {
              const f32x4 v2 = acc[mt][(nt + 1) & 3] * rs;
              const int i0 = col - 384;
              const float2* cs = p.ropecs + ss * 16 + i0;
              float o1[4], o2[4];
#pragma unroll
              for (int j = 0; j < 4; ++j) {
                const float2 c_s = cs[j];
                o1[j] = v[j] * c_s.x - v2[j] * c_s.y;
                o2[j] = v[j] * c_s.y + v2[j] * c_s.x;
              }
              u32x2 w;
              w.x = cvt_pk_bf16(o1[0], o1[1]);
              w.y = cvt_pk_bf16(o1[2], o1[3]);
              *(u32x2*)(p.projA + (size_t)row * 416 + 384 + i0) = w;
              w.x = cvt_pk_bf16(o2[0], o2[1]);
              w.y = cvt_pk_bf16(o2[2], o2[3]);
              *(u32x2*)(p.projA + (size_t)row * 416 + 400 + i0) = w;
            }
          } else if (ct == 400) {
          } else if (ct < 1568) {
            const int hc = col - 416;
            bf16_t* dst = p.hyT + ((size_t)(bb * 1152 + hc)) * 4096 + ss;
            dst[0] = f2bf(v[0]);
            dst[4096] = f2bf(v[1]);
            dst[2 * 4096] = f2bf(v[2]);
            dst[3 * 4096] = f2bf(v[3]);
          } else if (ct < 2080) {
            u32x2 w;
            w.x = cvt_pk_bf16(v[0], v[1]);
            w.y = cvt_pk_bf16(v[2], v[3]);
            *(u32x2*)(p.na + (size_t)row * 768 + (col - 1568)) = w;
          } else if (ct < 2336) {
            const int vc = col - 2080;
            bf16_t* dst = p.naVT + ((size_t)(bb * 256 + vc)) * 4096 + ss;
            dst[0] = f2bf(v[0]);
            dst[4096] = f2bf(v[1]);
            dst[2 * 4096] = f2bf(v[2]);
            dst[3 * 4096] = f2bf(v[3]);
          }
        }
        if (wc0 < 384) {
          sq += __shfl_xor(sq, 16);
          sq += __shfl_xor(sq, 32);
          if (g == 0) {
            if (wc0 < 256) p.part_q[(size_t)row * 4 + (wc0 >> 6)] = sq;
            else p.part_kv[(size_t)row * 2 + ((wc0 - 256) >> 6)] = sq;
          }
        }
      }
    } else if (EPI == EPI_QUP) {
      const int wc0 = n0 + wn * 64;
      const float qscale = 0.10206207261596575f * 1.4426950408889634f;
#pragma unroll
      for (int mt = 0; mt < 8; ++mt) {
        const int row = rbase + mt * 16;
        const float rs = s_rs[row - m0] * qscale;
        const int bb = row >> 12, ss = row & 4095;
#pragma unroll
        for (int nt = 0; nt < 4; ++nt) {
          const int T = (wc0 >> 4) + nt;
          if (T < 36) {
            const int hh = T / 6, tt = T % 6;
            bf16_t* qrow = p.qb + ((size_t)((bb * 6 + hh) * 4096 + ss)) * 96;
            const f32x4 v = acc[mt][nt] * rs;
            if (tt < 4) {
              u32x2 w;
              w.x = cvt_pk_bf16(v[0], v[1]);
              w.y = cvt_pk_bf16(v[2], v[3]);
              *(u32x2*)(qrow + tt * 16 + g * 4) = w;
            } else if (tt == 4) {
              if (nt < 3) {
                const f32x4 v2 = acc[mt][(nt + 1) & 3] * rs;
                const float2* cs = p.ropecs + ss * 16 + g * 4;
                float o1[4], o2[4];
#pragma unroll
                for (int j = 0; j < 4; ++j) {
                  const float2 c_s = cs[j];
                  o1[j] = v[j] * c_s.x - v2[j] * c_s.y;
                  o2[j] = v[j] * c_s.y + v2[j] * c_s.x;
                }
                u32x2 w;
                w.x = cvt_pk_bf16(o1[0], o1[1]);
                w.y = cvt_pk_bf16(o1[2], o1[3]);
                *(u32x2*)(qrow + 64 + g * 4) = w;
                w.x = cvt_pk_bf16(o2[0], o2[1]);
                w.y = cvt_pk_bf16(o2[2], o2[3]);
                *(u32x2*)(qrow + 80 + g * 4) = w;
              }
            }
          }
        }
      }
    } else if (EPI == EPI_KVUP) {
      const int hh = ni * 2 + (wn >> 1);
#pragma unroll
      for (int mt = 0; mt < 8; ++mt) {
        const int row = rbase + mt * 16;
        const float rs = s_rs[row - m0];
        const int bb = row >> 12, ss = row & 4095;
#pragma unroll
        for (int nt = 0; nt < 4; ++nt) {
          const f32x4 v = acc[mt][nt] * rs;
          if ((wn & 1) == 0) {
            u32x2 w;
            w.x = cvt_pk_bf16(v[0], v[1]);
            w.y = cvt_pk_bf16(v[2], v[3]);
            *(u32x2*)(p.kb + ((size_t)((bb * 6 + hh) * 4096 + ss)) * 96 + nt * 16 + g * 4) = w;
          } else {
            const int dv = nt * 16 + g * 4;
            bf16_t* dst = p.vT + ((size_t)((bb * 6 + hh) * 64 + dv)) * 4096 + ss;
            dst[0] = f2bf(v[0]);
            dst[4096] = f2bf(v[1]);
            dst[2 * 4096] = f2bf(v[2]);
            dst[3 * 4096] = f2bf(v[3]);
          }
        }
      }
#pragma unroll
      for (int i = 0; i < 2; ++i) {
        const int c = tid + 512 * i, rr = c >> 2, cc = c & 3;
        const int row = m0 + rr, bb = row >> 12, ss = row & 4095;
        const u32x4 v = *(const u32x4*)(p.projA + (size_t)row * 416 + 384 + cc * 8);
        *(u32x4*)(p.kb + ((size_t)((bb * 6 + ni * 2) * 4096 + ss)) * 96 + 64 + cc * 8) = v;
        *(u32x4*)(p.kb + ((size_t)((bb * 6 + ni * 2 + 1) * 4096 + ss)) * 96 + 64 + cc * 8) = v;
      }
    } else if (EPI == EPI_OUTPROJ || EPI == EPI_DOWN) {
      const int slot = (n0 + wn * 64) >> 6;
      const int cb8 = n0 + wn * 64 + g * 8;
#pragma unroll
      for (int mt = 0; mt < 8; ++mt) {
        const int row = rbase + mt * 16;
        float sq = 0.f;
#pragma unroll
        for (int q = 0; q < 2; ++q) {
          const int col = cb8 + q * 32;
          const u32x4 xr = *(const u32x4*)(p.xb + (size_t)row * 1024 + col);
          const f32x4 v0 = acc[mt][2 * q] + (f32x4){bflo(xr.x), bfhi(xr.x), bflo(xr.y), bfhi(xr.y)};
          const f32x4 v1 = acc[mt][2 * q + 1] + (f32x4){bflo(xr.z), bfhi(xr.z), bflo(xr.w), bfhi(xr.w)};
          sq += v0[0] * v0[0] + v0[1] * v0[1] + v0[2] * v0[2] + v0[3] * v0[3];
          sq += v1[0] * v1[0] + v1[1] * v1[1] + v1[2] * v1[2] + v1[3] * v1[3];
          u32x4 w;
          w.x = cvt_pk_bf16(v0[0], v0[1]);
          w.y = cvt_pk_bf16(v0[2], v0[3]);
          w.z = cvt_pk_bf16(v1[0], v1[1]);
          w.w = cvt_pk_bf16(v1[2], v1[3]);
          *(u32x4*)(p.xb + (size_t)row * 1024 + col) = w;
        }
        sq += __shfl_xor(sq, 16);
        sq += __shfl_xor(sq, 32);
        if (g == 0) p.part_x[(size_t)row * 16 + slot] = sq;
      }
    } else if (EPI == EPI_SWIGLU) {
      const int fbase = ((n0 + wn * 64) >> 1) + g * 8;
#pragma unroll
      for (int mt = 0; mt < 8; ++mt) {
        const int row = rbase + mt * 16;
        const float rs = s_rs[row - m0];
        float hv[8];
#pragma unroll
        for (int i = 0; i < 2; ++i) {
          const f32x4 gt = acc[mt][i] * rs, up = acc[mt][2 + i] * rs;
#pragma unroll
          for (int j = 0; j < 4; ++j) hv[i * 4 + j] = gt[j] * __builtin_amdgcn_rcpf(1.0f + __expf(-gt[j])) * up[j];
        }
        u32x4 w;
        w.x = cvt_pk_bf16(hv[0], hv[1]);
        w.y = cvt_pk_bf16(hv[2], hv[3]);
        w.z = cvt_pk_bf16(hv[4], hv[5]);
        w.w = cvt_pk_bf16(hv[6], hv[7]);
        *(u32x4*)(p.hidden + (size_t)row * 2816 + fbase) = w;
      }
    }
  }
}

__device__ void final_norm_phase(const P& p) {
  int tid_ = threadIdx.x;
  asm volatile("" : "+v"(tid_));
  const int tid = tid_, lane = tid & 63, wave = tid >> 6;
  for (int row = blockIdx.x * 8 + wave; row < NTOK; row += gridDim.x * 8) {
    const f32x4* pp = (const f32x4*)(p.part_x + (size_t)row * 16);
    const f32x4 a0 = pp[0], a1 = pp[1], a2 = pp[2], a3 = pp[3];
    const float tot = (a0[0] + a0[1] + a0[2] + a0[3]) + (a1[0] + a1[1] + a1[2] + a1[3]) +
                      (a2[0] + a2[1] + a2[2] + a2[3]) + (a3[0] + a3[1] + a3[2] + a3[3]);
    const float rs = rsqrtf(tot * (1.0f / 1024.0f) + 1e-6f);
    const bf16_t* xr = p.xb + (size_t)row * 1024;
    float* orow = p.out + (size_t)row * 1024;
#pragma unroll
    for (int i = 0; i < 2; ++i) {
      const int c0 = lane * 8 + 512 * i;
      const u32x4 xv = *(const u32x4*)(xr + c0);
      const f32x4 g0 = *(const f32x4*)(p.final_g + c0), g1 = *(const f32x4*)(p.final_g + c0 + 4);
      f32x4 o0 = (f32x4){bflo(xv.x), bfhi(xv.x), bflo(xv.y), bfhi(xv.y)};
      f32x4 o1 = (f32x4){bflo(xv.z), bfhi(xv.z), bflo(xv.w), bfhi(xv.w)};
      o0 = o0 * rs * g0;
      o1 = o1 * rs * g1;
      *(f32x4*)(orow + c0) = o0;
      *(f32x4*)(orow + c0 + 4) = o1;
    }
  }
}


template <int S>
__device__ __forceinline__ void run_stage(const P& p, int l, char* smem) {
  if (S == 0) prep_phase(p, l, smem);
  if (S == 1) {
    filt_fft_phase(p, l, smem);
    gemm_phase<EPI_INPROJ>(p, l, p.xb, 1024, p.Win, 1024, 10, smem);
  }
  if (S == 2) {
    hyena_phase<0>(p, l, smem);
    gemm_phase<EPI_QUP>(p, l, p.projA, 416, p.Wuq, 256, 3, smem);
    gemm_phase<EPI_KVUP>(p, l, p.projA + 256, 416, p.Wukv, 128, 3, smem);
    natten_phase(p, l, smem);
  }
  if (S == 3) {
    hyena_phase<1>(p, l, smem);
    attn_phase(p, smem);
  }
  if (S == 4) mixnorm_phase(p, smem);
  if (S == 5) gemm_phase<EPI_OUTPROJ>(p, l, p.y, 1024, p.Wout, 1024, 4, smem);
  if (S == 6) gemm_phase<EPI_SWIGLU>(p, l, p.xb, 1024, p.Wgu, 1024, 22, smem);
  if (S == 7) gemm_phase<EPI_DOWN>(p, l, p.hidden, 2816, p.Wdown, 2816, 4, smem);
  if (S == 8) final_norm_phase(p);
}

__device__ __forceinline__ void grid_barrier(unsigned* bar, unsigned target) {
  asm volatile("s_waitcnt vmcnt(0)" ::: "memory");
  __syncthreads();
  if (threadIdx.x == 0) {
    __builtin_amdgcn_fence(__ATOMIC_RELEASE, "agent");
    asm volatile("s_waitcnt vmcnt(0)" ::: "memory");
    __hip_atomic_fetch_add(bar, 1u, __ATOMIC_RELAXED, __HIP_MEMORY_SCOPE_AGENT);
    unsigned spins = 0;
    while (__hip_atomic_load(bar, __ATOMIC_RELAXED, __HIP_MEMORY_SCOPE_AGENT) < target && spins < (1u << 22)) {
      __builtin_amdgcn_s_sleep(1);
      ++spins;
    }
    __builtin_amdgcn_fence(__ATOMIC_ACQUIRE, "agent");
    asm volatile("s_waitcnt vmcnt(0)" ::: "memory");
  }
  __syncthreads();
}

__global__ void __launch_bounds__(NTHREADS) k_main(P p) {
  extern __shared__ __attribute__((aligned(16))) char smem[];
  cg::grid_group grid = cg::this_grid();
  if (blockIdx.x == 0 && threadIdx.x == 0) __hip_atomic_store(p.bar, 0u, __ATOMIC_RELAXED, __HIP_MEMORY_SCOPE_AGENT);
  run_stage<0>(p, 0, smem); grid.sync();
  run_stage<1>(p, 0, smem); grid_barrier(p.bar, 1u * gridDim.x);
  run_stage<2>(p, 0, smem); grid_barrier(p.bar, 2u * gridDim.x);
  run_stage<3>(p, 0, smem); grid_barrier(p.bar, 3u * gridDim.x);
  run_stage<4>(p, 0, smem); grid_barrier(p.bar, 4u * gridDim.x);
  run_stage<5>(p, 0, smem); grid_barrier(p.bar, 5u * gridDim.x);
  run_stage<6>(p, 0, smem); grid_barrier(p.bar, 6u * gridDim.x);
  run_stage<7>(p, 0, smem); grid_barrier(p.bar, 7u * gridDim.x);
  run_stage<0>(p, 1, smem); grid_barrier(p.bar, 8u * gridDim.x);
  run_stage<1>(p, 1, smem); grid_barrier(p.bar, 9u * gridDim.x);
  run_stage<2>(p, 1, smem); grid_barrier(p.bar, 10u * gridDim.x);
  run_stage<3>(p, 1, smem); grid_barrier(p.bar, 11u * gridDim.x);
  run_stage<4>(p, 1, smem); grid_barrier(p.bar, 12u * gridDim.x);
  run_stage<5>(p, 1, smem); grid_barrier(p.bar, 13u * gridDim.x);
  run_stage<6>(p, 1, smem); grid_barrier(p.bar, 14u * gridDim.x);
  run_stage<7>(p, 1, smem); grid_barrier(p.bar, 15u * gridDim.x);
  run_stage<8>(p, 1, smem);
}


extern "C" void kernel_launch(void* const* d_in, const int* in_sizes, int n_in, void* d_out, int out_size, void* d_ws,
                              size_t ws_size, hipStream_t stream) {
  static int grid_blocks = 0;
  if (!grid_blocks) {
    int dev = 0, cus = 0;
    (void)hipGetDevice(&dev);
    (void)hipDeviceGetAttribute(&cus, hipDeviceAttributeMultiprocessorCount, dev);
    if (cus <= 0) cus = 256;
    int per_cu = 0;
    (void)hipFuncSetAttribute((const void*)k_main, hipFuncAttributeMaxDynamicSharedMemorySize, LDS_BYTES);
    (void)hipOccupancyMaxActiveBlocksPerMultiprocessor(&per_cu, k_main, NTHREADS, LDS_BYTES);
    if (per_cu > 1) per_cu = 1;
    if (per_cu < 1) per_cu = 1;
    grid_blocks = cus * per_cu;
  }
  P p;
  memset(&p, 0, sizeof(p));
  const float* const* in = (const float* const*)d_in;
  p.x = in[0]; p.norm1_g = in[1]; p.w_in = in[2]; p.q_norm_g = in[3]; p.w_uq = in[4]; p.kv_norm_g = in[5];
  p.w_ukv = in[6]; p.conv_w = in[7]; p.conv_b = in[8]; p.fw1 = in[9]; p.fb1 = in[10]; p.ff1 = in[11];
  p.fw2 = in[12]; p.fb2 = in[13]; p.ff2 = in[14]; p.fw3 = in[15]; p.skip = in[16]; p.rpb = in[17];
  p.mix_g = in[18]; p.w_out = in[19]; p.norm2_g = in[20]; p.w_gate = in[21]; p.w_up = in[22]; p.w_down = in[23];
  p.final_g = in[24];
  p.out = (float*)d_out;
  char* ws = (char*)d_ws;
  size_t off = 0;
  auto take = [&](size_t bytes) {
    char* r = ws + off;
    off += (bytes + 255) & ~(size_t)255;
    return r;
  };
  p.Win = (bf16_t*)take((size_t)2560 * 1024 * 2);
  p.Wuq = (bf16_t*)take((size_t)768 * 256 * 2);
  p.Wukv = (bf16_t*)take((size_t)768 * 128 * 2);
  p.Wout = (bf16_t*)take((size_t)1024 * 1024 * 2);
  p.Wgu = (bf16_t*)take((size_t)5632 * 1024 * 2);
  p.Wdown = (bf16_t*)take((size_t)1024 * 2816 * 2);
  p.ropecs = (float2*)take((size_t)65536 * 8);
  p.tw = (float2*)take((size_t)8192 * 8);
  p.bar = (unsigned*)take(256);
  p.part_x = (float*)take((size_t)NTOK * 16 * 4);
  p.part_q = (float*)take((size_t)NTOK * 4 * 4);
  p.part_kv = (float*)take((size_t)NTOK * 2 * 4);
  p.xb = (bf16_t*)take((size_t)NTOK * 1024 * 2);
  p.H2 = (float2*)take((size_t)768 * 8192 * 8);
  p.z1T = (bf16_t*)take((size_t)1536 * 4096 * 4);
  p.filtT = (float*)p.z1T;
  p.vT = (bf16_t*)take((size_t)8 * 6 * 64 * 4096 * 2);
  p.o_a = (bf16_t*)take((size_t)NTOK * 384 * 2);
  p.o_c = (bf16_t*)take((size_t)NTOK * 256 * 2);
  char* big = take(0);
  p.projA = (bf16_t*)take((size_t)NTOK * 416 * 2);
  p.hyT = (bf16_t*)take((size_t)8 * 1152 * 4096 * 2);
  p.na = (bf16_t*)take((size_t)NTOK * 768 * 2);
  p.qb = (bf16_t*)take((size_t)8 * 6 * 4096 * 96 * 2);
  p.kb = (bf16_t*)take((size_t)8 * 6 * 4096 * 96 * 2);
  p.hidden = (bf16_t*)big;
  p.ybT = (bf16_t*)take((size_t)8 * 384 * 4096 * 2);
  p.naVT = (bf16_t*)take((size_t)8 * 4 * 64 * 4096 * 2);
  p.y = p.qb;
  if (off > ws_size) {
    fprintf(stderr, "workspace too small: need %zu have %zu\n", off, ws_size);
    return;
  }
  void* args[] = {&p};
  hipError_t e = hipLaunchCooperativeKernel((void*)k_main, dim3(grid_blocks), dim3(NTHREADS), args, LDS_BYTES, stream);
  if (e != hipSuccess) fprintf(stderr, "cooperative launch failed: %s (grid %d)\n", hipGetErrorString(e), grid_blocks);
}
```

```cpp
#include <hip/hip_runtime.h>
#include <hip/hip_cooperative_groups.h>
#include <cstdio>
#include <cstring>
#include <cstdint>
#include <cmath>
#include <type_traits>
namespace cg = cooperative_groups;


typedef unsigned short bf16_t;
typedef short bf16x8 __attribute__((ext_vector_type(8)));
typedef float f32x4 __attribute__((ext_vector_type(4)));
typedef unsigned u32x4 __attribute__((ext_vector_type(4)));
typedef unsigned u32x2 __attribute__((ext_vector_type(2)));

constexpr int NTOK = 32768, SEQ = 4096;
constexpr int NTHREADS = 512;
constexpr int LDS_BYTES = 147456;
constexpr int TW_LDS_OFF = 69632;
#define PADI(i) ((i) + ((i) >> 4))

struct P {
  const float *x, *norm1_g, *w_in, *q_norm_g, *w_uq, *kv_norm_g, *w_ukv, *conv_w, *conv_b, *fw1, *fb1, *ff1, *fw2, *fb2,
      *ff2, *fw3, *skip, *rpb, *mix_g, *w_out, *norm2_g, *w_gate, *w_up, *w_down, *final_g;
  float* out;
  bf16_t *Win, *Wuq, *Wukv, *Wout, *Wgu, *Wdown;
  bf16_t *xb, *projA, *hyT, *na, *qb, *kb, *vT, *o_a, *o_c, *y, *hidden, *ybT, *naVT;
  float2* H2;
  float* filtT;
  bf16_t* z1T;
  float *part_x, *part_q, *part_kv;
  float2* ropecs;
  float2* tw;
  unsigned* bar;
  unsigned pad0_, pad1_;
};

typedef __bf16 bf16v2_t __attribute__((ext_vector_type(2)));
typedef float f32x2_t __attribute__((ext_vector_type(2)));
__device__ __forceinline__ unsigned cvt_pk_bf16(float lo, float hi) {
  const f32x2_t v = {lo, hi};
  const bf16v2_t r = __builtin_convertvector(v, bf16v2_t);
  return __builtin_bit_cast(unsigned, r);
}
__device__ __forceinline__ bf16_t f2bf(float f) { return (bf16_t)(cvt_pk_bf16(f, 0.f) & 0xffffu); }
__device__ __forceinline__ float bf2f(bf16_t h) { return __uint_as_float(((unsigned)h) << 16); }
__device__ __forceinline__ float bflo(unsigned u) { return __uint_as_float(u << 16); }
__device__ __forceinline__ float bfhi(unsigned u) { return __uint_as_float(u & 0xffff0000u); }

__device__ __forceinline__ void fast_sincos_rev(float rev, float* s, float* c) {
  const float fr = rev - rintf(rev);
  *s = __builtin_amdgcn_sinf(fr);
  *c = __builtin_amdgcn_cosf(fr);
}
__device__ __forceinline__ float fast_sin(float x) {
  const float rev = x * 0.15915494309189535f;
  const float fr = rev - rintf(rev);
  return __builtin_amdgcn_sinf(fr);
}

__device__ __forceinline__ int vblock() {
  const int G = gridDim.x, b = blockIdx.x;
  return ((G & 7) == 0) ? ((b & 7) * (G >> 3) + (b >> 3)) : b;
}

__device__ void conv_w(const float* __restrict__ W, int K, int N, int Npad, const float* __restrict__ g, bf16_t* Bt,
                       int mode, char* smem) {
  float* tile = (float*)smem;
  int tid_ = threadIdx.x;
  asm volatile("" : "+v"(tid_));
  const int tid = tid_;
  const int nkt = K / 64, nnt = Npad / 64;
  for (int job = blockIdx.x; job < nkt * nnt; job += gridDim.x) {
    const int kt = job % nkt, ntile = job / nkt;
    const int k0 = kt * 64, n0 = ntile * 64;
    __syncthreads();
#pragma unroll
    for (int i = 0; i < 2; ++i) {
      const int k = (tid >> 4) + 32 * i, nq = (tid & 15) * 4, n = n0 + nq;
      f32x4 v = {0.f, 0.f, 0.f, 0.f};
      if (n < N) {
        v = *(const f32x4*)(W + (size_t)(k0 + k) * N + n);
        if (g) v = v * g[k0 + k];
      }
      tile[k * 65 + nq + 0] = v[0];
      tile[k * 65 + nq + 1] = v[1];
      tile[k * 65 + nq + 2] = v[2];
      tile[k * 65 + nq + 3] = v[3];
    }
    __syncthreads();
    {
      const int c = tid, n = c >> 3, kc = c & 7;
      float e[8];
#pragma unroll
      for (int q = 0; q < 8; ++q) e[q] = tile[(kc * 8 + q) * 65 + n];
      u32x4 w;
      w.x = cvt_pk_bf16(e[0], e[1]);
      w.y = cvt_pk_bf16(e[2], e[3]);
      w.z = cvt_pk_bf16(e[4], e[5]);
      w.w = cvt_pk_bf16(e[6], e[7]);
      const int nn = n0 + n;
      int dest = nn;
      if (mode == 4 && (nn < 384 || (nn >= 1568 && nn < 2080))) {
        const int f = nn & 31;
        dest = (nn & ~31) + ((f >> 2) & 1) * 16 + (f >> 3) * 4 + (f & 3);
      }
      if (mode == 3) {
        const int f = nn & 31;
        dest = (nn & ~31) + ((f >> 2) & 1) * 16 + (f >> 3) * 4 + (f & 3);
      }
      if (mode == 1 || mode == 2) {
        const int f = nn & 31;
        dest = 64 * (nn >> 5) + (mode == 2 ? 32 : 0) + ((f >> 2) & 1) * 16 + (f >> 3) * 4 + (f & 3);
      }
      *(u32x4*)(Bt + (size_t)dest * K + k0 + kc * 8) = w;
    }
  }
}

__device__ void filt_mlp(const P& p, int l, char* smem) {
  float* zf = (float*)smem;
  float* h1 = zf + 16 * 17;
  float* h2 = h1 + 64 * 16;
  int tid_ = threadIdx.x;
  asm volatile("" : "+v"(tid_));
  const int tid = tid_, tl = tid & 15, kk = tid >> 4;
  const float* w1 = p.fw1 + l * 17 * 64;
  const float* b1 = p.fb1 + l * 64;
  const float* f1 = p.ff1 + l * 64;
  const float* w2 = p.fw2 + l * 64 * 64;
  const float* b2 = p.fb2 + l * 64;
  const float* f2 = p.ff2 + l * 64;
  const float* w3 = p.fw3 + (size_t)l * 64 * 1536;
  for (int job = blockIdx.x; job < 256; job += gridDim.x) {
    const int t0 = job * 16;
    __syncthreads();
    {
      const int t = t0 + tl;
      if (kk < 8) {
        const float band = 1e-4f + (float)kk * ((7.0f - 1e-4f) / 7.0f);
        const float ang = ((6.283185307179586f * (float)t) * band) / 4096.0f;
        float s, c;
        fast_sincos_rev(ang * 0.15915494309189535f, &s, &c);
        zf[tl * 17 + 1 + kk] = c;
        zf[tl * 17 + 9 + kk] = s;
      } else if (kk == 8) {
        zf[tl * 17] = (float)t / 4095.0f;
      }
    }
    __syncthreads();
#pragma unroll
    for (int m = 0; m < 2; ++m) {
      const int j = kk + 32 * m;
      float a = b1[j];
#pragma unroll 1
      for (int f = 0; f < 17; ++f) a += zf[tl * 17 + f] * w1[f * 64 + j];
      h1[j * 16 + tl] = fast_sin(f1[j] * a);
    }
    __syncthreads();
#pragma unroll
    for (int m = 0; m < 2; ++m) {
      const int j = kk + 32 * m;
      float a = b2[j];
#pragma unroll 16
      for (int i = 0; i < 64; ++i) a += h1[i * 16 + tl] * w2[i * 64 + j];
      h2[j * 16 + tl] = fast_sin(f2[j] * a);
    }
    __syncthreads();
#pragma unroll 1
    for (int mm = 0; mm < 3; ++mm) {
      const int col = tid + 512 * mm;
      float acc[16];
#pragma unroll
      for (int q = 0; q < 16; ++q) acc[q] = 0.f;
#pragma unroll 1
      for (int j0 = 0; j0 < 64; j0 += 8) {
        float wv[8];
#pragma unroll
        for (int q = 0; q < 8; ++q) wv[q] = w3[(size_t)(j0 + q) * 1536 + col];
#pragma unroll
        for (int q = 0; q < 8; ++q) {
          const float w = wv[q];
          const f32x4* hp = (const f32x4*)(h2 + (j0 + q) * 16);
          const f32x4 a0 = hp[0], a1 = hp[1], a2 = hp[2], a3 = hp[3];
          acc[0] += a0[0] * w; acc[1] += a0[1] * w; acc[2] += a0[2] * w; acc[3] += a0[3] * w;
          acc[4] += a1[0] * w; acc[5] += a1[1] * w; acc[6] += a1[2] * w; acc[7] += a1[3] * w;
          acc[8] += a2[0] * w; acc[9] += a2[1] * w; acc[10] += a2[2] * w; acc[11] += a2[3] * w;
          acc[12] += a3[0] * w; acc[13] += a3[1] * w; acc[14] += a3[2] * w; acc[15] += a3[3] * w;
        }
      }
      const int c = col % 384;
      const float lo = -3.0701134573253945f, hi = -15.350567286626972f;
      const float delta = fabsf(lo + (hi - lo) * ((float)c / 383.0f));
      float* dst = p.filtT + (size_t)col * 4096 + t0;
#pragma unroll
      for (int q = 0; q < 16; ++q) {
        const float tn = (float)(t0 + q) / 4095.0f;
        dst[q] = acc[q] * __expf(-tn * delta);
      }
    }
  }
}

__device__ void prep_phase(const P& p, int l, char* smem) {
  for (int w = 0; w < 7; ++w) {
    const float* W; const float* g; bf16_t* Bt; int K, N, Npad, mode = 0;
    switch (w) {
      case 0: W = p.w_in + (size_t)l * 1024 * 2336; K = 1024; N = 2336; Npad = 2560; g = p.norm1_g + l * 1024; Bt = p.Win; mode = 4; break;
      case 1: W = p.w_uq + (size_t)l * 256 * 576; K = 256; N = 576; Npad = 768; g = p.q_norm_g + l * 256; Bt = p.Wuq; break;
      case 2: W = p.w_ukv + (size_t)l * 128 * 768; K = 128; N = 768; Npad = 768; g = p.kv_norm_g + l * 128; Bt = p.Wukv; break;
      case 3: W = p.w_out + (size_t)l * 1024 * 1024; K = 1024; N = 1024; Npad = 1024; g = p.mix_g + l * 1024; Bt = p.Wout; mode = 3; break;
      case 4: W = p.w_gate + (size_t)l * 1024 * 2816; K = 1024; N = 2816; Npad = 2816; g = p.norm2_g + l * 1024; Bt = p.Wgu; mode = 1; break;
      case 5: W = p.w_up + (size_t)l * 1024 * 2816; K = 1024; N = 2816; Npad = 2816; g = p.norm2_g + l * 1024; Bt = p.Wgu; mode = 2; break;
      default: W = p.w_down + (size_t)l * 2816 * 1024; K = 2816; N = 1024; Npad = 1024; g = nullptr; Bt = p.Wdown; mode = 3; break;
    }
    conv_w(W, K, N, Npad, g, Bt, mode, smem);
  }
  filt_mlp(p, l, smem);
  if (l == 0) {
    int tid_ = threadIdx.x;
  asm volatile("" : "+v"(tid_));
  const int tid = tid_, lane = tid & 63, wave = tid >> 6;
    for (int row = blockIdx.x * 8 + wave; row < NTOK; row += gridDim.x * 8) {
      const float* xr = p.x + (size_t)row * 1024;
      bf16_t* xo = p.xb + (size_t)row * 1024;
      float s = 0.f;
#pragma unroll
      for (int i = 0; i < 4; ++i) {
        const f32x4 v = *(const f32x4*)(xr + lane * 4 + 256 * i);
        s += v[0] * v[0] + v[1] * v[1] + v[2] * v[2] + v[3] * v[3];
        u32x2 w;
        w.x = cvt_pk_bf16(v[0], v[1]);
        w.y = cvt_pk_bf16(v[2], v[3]);
        *(u32x2*)(xo + lane * 4 + 256 * i) = w;
      }
#pragma unroll
      for (int o = 1; o < 64; o <<= 1) s += __shfl_xor(s, o);
      if (lane < 16) p.part_x[(size_t)row * 16 + lane] = (lane == 0) ? s : 0.f;
    }
    for (int i = blockIdx.x * 512 + tid; i < 65536 + 8192; i += gridDim.x * 512) {
      if (i < 65536) {
        const int pos = i >> 4, k = i & 15;
        const float ang = (float)pos * __builtin_amdgcn_exp2f(-(float)k * 0.8304820237218405f);
        float s, c;
        fast_sincos_rev(ang * 0.15915494309189535f, &s, &c);
        p.ropecs[i] = make_float2(c, s);
      } else {
        const int k = i - 65536;
        const int ms = 1 << (31 - __clz(k + 1));
        const int pp = k + 1 - ms;
        float s, c;
        fast_sincos_rev((float)pp / (float)(2 * ms), &s, &c);
        p.tw[k] = make_float2(c, -s);
      }
    }
  }
}

template <int LOGR, int MTOP, bool INV, bool ZIN = false, bool HOUT = false>
__device__ __forceinline__ void fft_pass(float2* sm, const float2* tw) {
  constexpr int R = 1 << LOGR;
  constexpr int q = MTOP >> (LOGR - 1);
  constexpr int ntask = 8192 / R;
  for (int T = threadIdx.x; T < ntask; T += NTHREADS) {
    const int i = T & (q - 1);
    const int blk = T / q;
    const int base = blk * (2 * MTOP) + i;
    float2 v[R];
#pragma unroll
    for (int e = 0; e < R; ++e) {
      if (ZIN && e >= R / 2) v[e] = make_float2(0.f, 0.f);
      else v[e] = sm[PADI(base + e * q)];
    }
    if (!INV) {
#pragma unroll
      for (int s = 0; s < LOGR; ++s) {
        constexpr int dummy = 0;
        (void)dummy;
        const int hs = 1 << (LOGR - 1 - s);
        const int ms = MTOP >> s;
#pragma unroll
        for (int e = 0; e < R; ++e) {
          if ((e & hs) == 0) {
            const int pp = i + (e & (hs - 1)) * q;
            const float2 w = tw[(ms - 1) + pp];
            const float2 a = v[e], b = v[e + hs];
            v[e] = make_float2(a.x + b.x, a.y + b.y);
            const float dx = a.x - b.x, dy = a.y - b.y;
            v[e + hs] = make_float2(dx * w.x - dy * w.y, dx * w.y + dy * w.x);
          }
        }
      }
    } else {
#pragma unroll
      for (int s = LOGR - 1; s >= 0; --s) {
        const int hs = 1 << (LOGR - 1 - s);
        const int ms = MTOP >> s;
#pragma unroll
        for (int e = 0; e < R; ++e) {
          if ((e & hs) == 0) {
            const int pp = i + (e & (hs - 1)) * q;
            const float2 w = tw[(ms - 1) + pp];
            const float2 a = v[e], b = v[e + hs];
            const float tx = b.x * w.x + b.y * w.y, ty = b.y * w.x - b.x * w.y;
            v[e] = make_float2(a.x + tx, a.y + ty);
            v[e + hs] = make_float2(a.x - tx, a.y - ty);
          }
        }
      }
    }
#pragma unroll
    for (int e = 0; e < R; ++e) {
      if (HOUT && e >= R / 2) continue;
      sm[PADI(base + e * q)] = v[e];
    }
  }
  __syncthreads();
}

__device__ __forceinline__ void fft_fwd(float2* sm, const float2* tw) {
  fft_pass<4, 4096, false>(sm, tw);
  fft_pass<4, 256, false>(sm, tw);
  fft_pass<4, 16, false>(sm, tw);
  fft_pass<1, 1, false>(sm, tw);
}
__device__ __forceinline__ void fft_inv(float2* sm, const float2* tw) {
  fft_pass<1, 1, true>(sm, tw);
  fft_pass<3, 8, true>(sm, tw);
  fft_pass<3, 64, true>(sm, tw);
  fft_pass<3, 512, true>(sm, tw);
  fft_pass<3, 4096, true>(sm, tw);
}

__device__ void filt_fft_phase(const P& p, int l, char* smem) {
  float2* sm = (float2*)smem;
  float2* tws = (float2*)(smem + TW_LDS_OFF);
  int tid_ = threadIdx.x;
  asm volatile("" : "+v"(tid_));
  const int tid = tid_;
  for (int i = tid; i < 8192; i += NTHREADS) tws[i] = p.tw[i];
  for (int jj = blockIdx.x; jj < 384; jj += gridDim.x) {
    const int o = jj / 192, c = jj % 192;
    const int jobF = o * 384 + c, jobG = jobF + 192;
    const float* hf1 = p.filtT + ((size_t)((o * 2 + 0) * 384 + c)) * 4096;
    const float* hb1 = p.filtT + ((size_t)((o * 2 + 1) * 384 + c)) * 4096;
    const float* hf2 = hf1 + (size_t)192 * 4096;
    const float* hb2 = hb1 + (size_t)192 * 4096;
    const float sk1 = p.skip[(l * 2 + o) * 384 + c], sk2 = p.skip[(l * 2 + o) * 384 + c + 192];
    __syncthreads();
    for (int n = tid; n < 8192; n += NTHREADS) {
      float v1, v2;
      if (n == 0) { v1 = hf1[0] + hb1[0] + sk1; v2 = hf2[0] + hb2[0] + sk2; }
      else if (n < 4096) { v1 = hf1[n]; v2 = hf2[n]; }
      else if (n == 4096) { v1 = 0.f; v2 = 0.f; }
      else { v1 = hb1[8192 - n]; v2 = hb2[8192 - n]; }
      sm[PADI(n)] = make_float2(v1, v2);
    }
    __syncthreads();
    fft_fwd(sm, tws);
    float2* dF = p.H2 + (size_t)jobF * 8192;
    float2* dG = p.H2 + (size_t)jobG * 8192;
    const float sc = 0.5f / 8192.0f;
    for (int n = tid; n < 8192; n += NTHREADS) {
      const int k = (int)(__brev((unsigned)n) >> 19);
      const int np = (int)(__brev((unsigned)((8192 - k) & 8191)) >> 19);
      const float2 a = sm[PADI(n)], b = sm[PADI(np)];
      dF[n] = make_float2((a.x + b.x) * sc, (a.y - b.y) * sc);
      dG[n] = make_float2((a.y + b.y) * sc, (b.x - a.x) * sc);
    }
  }
}

__device__ __forceinline__ float short_conv(const bf16_t* row, int t, float w0, float w1, float w2, float bias) {
  const float xm = (t > 0) ? bf2f(row[t - 1]) : 0.f;
  const float x0 = bf2f(row[t]);
  const float xp = (t < SEQ - 1) ? bf2f(row[t + 1]) : 0.f;
  return w0 * xm + w1 * x0 + w2 * xp + bias;
}

__device__ __forceinline__ void conv8(const bf16_t* row, int t0, float w0, float w1, float w2, float bias, float (&out)[8]) {
  const u32x4 v = *(const u32x4*)(row + t0);
  float x[10];
  x[0] = (t0 > 0) ? bf2f(row[t0 - 1]) : 0.f;
  x[1] = bflo(v.x); x[2] = bfhi(v.x); x[3] = bflo(v.y); x[4] = bfhi(v.y);
  x[5] = bflo(v.z); x[6] = bfhi(v.z); x[7] = bflo(v.w); x[8] = bfhi(v.w);
  x[9] = (t0 + 8 < SEQ) ? bf2f(row[t0 + 8]) : 0.f;
#pragma unroll
  for (int k = 0; k < 8; ++k) out[k] = w0 * x[k] + w1 * x[k + 1] + w2 * x[k + 2] + bias;
}

struct RawRow { u32x4 v; float lo, hi; };
__device__ __forceinline__ RawRow load_raw(const bf16_t* row, int t0) {
  RawRow r;
  r.v = *(const u32x4*)(row + t0);
  r.lo = (t0 > 0) ? bf2f(row[t0 - 1]) : 0.f;
  r.hi = (t0 + 8 < SEQ) ? bf2f(row[t0 + 8]) : 0.f;
  return r;
}
__device__ __forceinline__ void conv8_raw(const RawRow& r, float w0, float w1, float w2, float bias, float (&out)[8]) {
  float x[10];
  x[0] = r.lo;
  x[1] = bflo(r.v.x); x[2] = bfhi(r.v.x); x[3] = bflo(r.v.y); x[4] = bfhi(r.v.y);
  x[5] = bflo(r.v.z); x[6] = bfhi(r.v.z); x[7] = bflo(r.v.w); x[8] = bfhi(r.v.w);
  x[9] = r.hi;
#pragma unroll
  for (int k = 0; k < 8; ++k) out[k] = w0 * x[k] + w1 * x[k + 1] + w2 * x[k + 2] + bias;
}

__device__ __forceinline__ void fft_mid(float2* sm, const f32x4 (&hpre)[8]) {
#pragma unroll
  for (int it = 0; it < 8; ++it) {
    const int T = threadIdx.x + it * NTHREADS;
    const float2 a = sm[PADI(2 * T)], b = sm[PADI(2 * T + 1)];
    const f32x4 h = hpre[it];
    const float sx = a.x + b.x, sy = a.y + b.y, dx = a.x - b.x, dy = a.y - b.y;
    const float Ax = sx * h[0] - sy * h[1], Ay = sx * h[1] + sy * h[0];
    const float Bx = dx * h[2] - dy * h[3], By = dx * h[3] + dy * h[2];
    sm[PADI(2 * T)] = make_float2(Ax + Bx, Ay + By);
    sm[PADI(2 * T + 1)] = make_float2(Ax - Bx, Ay - By);
  }
  __syncthreads();
}

template <int ORD>
__device__ void hyena_phase(const P& p, int l, char* smem) {
  float2* sm = (float2*)smem;
  float2* tws = (float2*)(smem + TW_LDS_OFF);
  int tid_ = threadIdx.x;
  asm volatile("" : "+v"(tid_));
  const int tid = tid_;
  for (int i = tid; i < 8192; i += NTHREADS) tws[i] = p.tw[i];
  const float* cw = p.conv_w + (size_t)l * 3 * 1152;
  const float* cb = p.conv_b + (size_t)l * 1152;
  const int t0 = tid * 8;
  for (int job = vblock(); job < 1536; job += gridDim.x) {
    const int pair = job & 3, c = job >> 2;
    const int b1 = pair * 2, b2 = b1 + 1;
    const int gc = (ORD == 0 ? 384 : 768) + c;
    const RawRow gr1 = load_raw(p.hyT + ((size_t)(b1 * 1152 + gc)) * 4096, t0);
    const RawRow gr2 = load_raw(p.hyT + ((size_t)(b2 * 1152 + gc)) * 4096, t0);
    __syncthreads();
    {
      float u1[8], u2[8];
      if (ORD == 0) {
        const bf16_t* r1 = p.hyT + ((size_t)(b1 * 1152 + c)) * 4096;
        const bf16_t* r2 = p.hyT + ((size_t)(b2 * 1152 + c)) * 4096;
        const float w0 = cw[c], w1 = cw[1152 + c], w2 = cw[2304 + c], bi = cb[c];
        conv8(r1, t0, w0, w1, w2, bi, u1);
        conv8(r2, t0, w0, w1, w2, bi, u2);
      } else {
        const u32x4 a0 = *(const u32x4*)(p.z1T + ((size_t)(b1 * 384 + c)) * 4096 + t0);
        const u32x4 c0_ = *(const u32x4*)(p.z1T + ((size_t)(b2 * 384 + c)) * 4096 + t0);
        u1[0] = bflo(a0.x); u1[1] = bfhi(a0.x); u1[2] = bflo(a0.y); u1[3] = bfhi(a0.y); u1[4] = bflo(a0.z); u1[5] = bfhi(a0.z); u1[6] = bflo(a0.w); u1[7] = bfhi(a0.w);
        u2[0] = bflo(c0_.x); u2[1] = bfhi(c0_.x); u2[2] = bflo(c0_.y); u2[3] = bfhi(c0_.y); u2[4] = bflo(c0_.z); u2[5] = bfhi(c0_.z); u2[6] = bflo(c0_.w); u2[7] = bfhi(c0_.w);
      }
#pragma unroll
      for (int k = 0; k < 8; ++k) {
        sm[PADI(t0 + k)] = make_float2(u1[k], u2[k]);
      }
    }
    __syncthreads();
    fft_pass<4, 4096, false, true, false>(sm, tws);
    fft_pass<4, 256, false>(sm, tws);
    f32x4 hpre[8];
    {
      const float2* H = p.H2 + ((size_t)(ORD * 384 + c)) * 8192;
#pragma unroll
      for (int it = 0; it < 8; ++it) hpre[it] = *(const f32x4*)(H + 2 * (tid + it * NTHREADS));
    }
    fft_pass<4, 16, false>(sm, tws);
    fft_mid(sm, hpre);
    fft_pass<4, 16, true>(sm, tws);
    fft_pass<4, 256, true>(sm, tws);
    fft_pass<4, 4096, true, false, true>(sm, tws);
    {
      const float w0 = cw[gc], w1 = cw[1152 + gc], w2 = cw[2304 + gc], bi = cb[gc];
      float q1[8], q2[8];
      conv8_raw(gr1, w0, w1, w2, bi, q1);
      conv8_raw(gr2, w0, w1, w2, bi, q2);
#pragma unroll
      for (int k = 0; k < 8; ++k) {
        const float2 yv = sm[PADI(t0 + k)];
        q1[k] *= yv.x;
        q2[k] *= yv.y;
      }
      {
        bf16_t* dbase = (ORD == 0) ? p.z1T : p.ybT;
        u32x4 w1_, w2_;
        w1_.x = cvt_pk_bf16(q1[0], q1[1]); w1_.y = cvt_pk_bf16(q1[2], q1[3]); w1_.z = cvt_pk_bf16(q1[4], q1[5]); w1_.w = cvt_pk_bf16(q1[6], q1[7]);
        w2_.x = cvt_pk_bf16(q2[0], q2[1]); w2_.y = cvt_pk_bf16(q2[2], q2[3]); w2_.z = cvt_pk_bf16(q2[4], q2[5]); w2_.w = cvt_pk_bf16(q2[6], q2[7]);
        *(u32x4*)(dbase + ((size_t)(b1 * 384 + c)) * 4096 + t0) = w1_;
        *(u32x4*)(dbase + ((size_t)(b2 * 384 + c)) * 4096 + t0) = w2_;
      }
    }
  }
}

constexpr int KROW = 208;
constexpr int VROW = 136;
constexpr int KBUF = 64 * KROW, VBUF = 64 * VROW;

constexpr int NK_ROW = 528;
constexpr int NK_BUF = 32 * NK_ROW;
constexpr int NV_ROW = 72;
constexpr int NV_BUF = 256 * NV_ROW;
constexpr int NRPB_OFF = 2 * NK_BUF + 2 * NV_BUF;

__device__ void natten_phase(const P& p, int l, char* smem) {
  int tid_ = threadIdx.x;
  asm volatile("" : "+v"(tid_));
  const int tid = tid_, lane = tid & 63, wave = tid >> 6, l15 = lane & 15, g = lane >> 4;
  const int hw = wave >> 1, qh = wave & 1;
  char* Ks = smem;
  char* Vs = smem + 2 * NK_BUF;
  float* rp = (float*)(smem + NRPB_OFF);
  __syncthreads();
  for (int i = tid; i < 4 * 15 * 31; i += NTHREADS) rp[i] = p.rpb[(size_t)l * 4 * 15 * 31 + i] * 1.4426950408889634f;
  const float qscale = 0.125f * 1.4426950408889634f;
  for (int job = blockIdx.x; job < 512; job += gridDim.x) {
    const int r = job & 63, b = job >> 6;
    const int r0 = min(max(r - 4, 0), 56);
    bf16x8 qf[2][2];
    int cq[2], c0[2];
#pragma unroll
    for (int nt = 0; nt < 2; ++nt) {
      cq[nt] = qh * 32 + nt * 16 + l15;
      c0[nt] = min(max(cq[nt] - 8, 0), 48);
      const bf16_t* qp = p.na + (size_t)(b * 4096 + r * 64 + cq[nt]) * 768 + hw * 64;
#pragma unroll
      for (int ks = 0; ks < 2; ++ks) qf[nt][ks] = *(const bf16x8*)(qp + ks * 32 + g * 8);
    }
    f32x4 o[4][2];
#pragma unroll
    for (int a = 0; a < 4; ++a)
#pragma unroll
      for (int n = 0; n < 2; ++n) o[a][n] = (f32x4){0.f, 0.f, 0.f, 0.f};
    float mrow[2] = {-1e30f, -1e30f}, lrow[2] = {0.f, 0.f};
    u32x4 rk[2], rv[2];
    auto gload = [&](int t) {
      const int kr = r0 + (t >> 1), kh = (t & 1) * 32;
      const bf16_t* kbase = p.na + (size_t)(b * 4096 + kr * 64 + kh) * 768 + 256;
#pragma unroll
      for (int i = 0; i < 2; ++i) {
        const int c = tid + 512 * i, key = c >> 5, cc = c & 31;
        rk[i] = *(const u32x4*)(kbase + (size_t)key * 768 + cc * 8);
      }
#pragma unroll
      for (int i = 0; i < 2; ++i) {
        const int c = tid + 512 * i, row = c >> 2, cc = c & 3;
        rv[i] = *(const u32x4*)(p.naVT + ((size_t)(b * 256 + row)) * 4096 + kr * 64 + kh + cc * 8);
      }
    };
    auto lstore = [&](int buf) {
      char* kb_ = Ks + buf * NK_BUF;
      char* vb_ = Vs + buf * NV_BUF;
#pragma unroll
      for (int i = 0; i < 2; ++i) {
        const int c = tid + 512 * i, key = c >> 5, cc = c & 31;
        *(u32x4*)(kb_ + key * NK_ROW + cc * 16) = rk[i];
      }
#pragma unroll
      for (int i = 0; i < 2; ++i) {
        const int c = tid + 512 * i, row = c >> 2, cc = c & 3;
        u32x2 lo, hi;
        lo.x = rv[i].x; lo.y = rv[i].y; hi.x = rv[i].z; hi.y = rv[i].w;
        *(u32x2*)(vb_ + row * NV_ROW + cc * 16) = lo;
        *(u32x2*)(vb_ + row * NV_ROW + cc * 16 + 8) = hi;
      }
    };
    gload(0);
    __syncthreads();
    lstore(0);
    gload(1);
    for (int t = 0; t < 16; ++t) {
      __syncthreads();
      if (t + 1 < 16) {
        lstore((t + 1) & 1);
        if (t + 2 < 16) gload(t + 2);
      }
      __builtin_amdgcn_sched_barrier(0);
      const char* kb_ = Ks + (t & 1) * NK_BUF;
      const char* vb_ = Vs + (t & 1) * NV_BUF + hw * 64 * NV_ROW;
      const int kh = (t & 1) * 32;
      f32x4 s[2][2];
#pragma unroll
      for (int a = 0; a < 2; ++a)
#pragma unroll
        for (int n = 0; n < 2; ++n) s[a][n] = (f32x4){0.f, 0.f, 0.f, 0.f};
#pragma unroll
      for (int mt = 0; mt < 2; ++mt)
#pragma unroll
        for (int ks = 0; ks < 2; ++ks) {
          const bf16x8 kf = *(const bf16x8*)(kb_ + (mt * 16 + l15) * NK_ROW + hw * 128 + ks * 64 + g * 16);
#pragma unroll
          for (int nt = 0; nt < 2; ++nt)
            s[mt][nt] = __builtin_amdgcn_mfma_f32_16x16x32_bf16(kf, qf[nt][ks], s[mt][nt], 0, 0, 0);
        }
      const float* brow = rp + (hw * 15 + (r0 + (t >> 1) - r + 7)) * 31;
      bf16x8 pf[2];
#pragma unroll
      for (int nt = 0; nt < 2; ++nt) {
        float mx = -1e30f;
#pragma unroll
        for (int mt = 0; mt < 2; ++mt)
#pragma unroll
          for (int j = 0; j < 4; ++j) {
            const int kc = kh + mt * 16 + g * 4 + j;
            const bool valid = (unsigned)(kc - c0[nt]) < 16u;
            const int dc = min(max(kc - cq[nt] + 15, 0), 30);
            const float sc = valid ? (s[mt][nt][j] * qscale + brow[dc]) : -1e30f;
            s[mt][nt][j] = sc;
            mx = fmaxf(mx, sc);
          }
        mx = fmaxf(mx, __shfl_xor(mx, 16));
        mx = fmaxf(mx, __shfl_xor(mx, 32));
        const float mnew = fmaxf(mrow[nt], mx);
        const float alpha = __builtin_amdgcn_exp2f(mrow[nt] - mnew);
        mrow[nt] = mnew;
        float ls = 0.f;
#pragma unroll
        for (int mt = 0; mt < 2; ++mt)
#pragma unroll
          for (int j = 0; j < 4; ++j) {
            const float e = (s[mt][nt][j] > -1e29f) ? __builtin_amdgcn_exp2f(s[mt][nt][j] - mnew) : 0.f;
            s[mt][nt][j] = e;
            ls += e;
          }
        lrow[nt] = lrow[nt] * alpha + ls;
#pragma unroll
        for (int a = 0; a < 4; ++a) o[a][nt] *= alpha;
        u32x4 w;
        w.x = cvt_pk_bf16(s[0][nt][0], s[0][nt][1]);
        w.y = cvt_pk_bf16(s[0][nt][2], s[0][nt][3]);
        w.z = cvt_pk_bf16(s[1][nt][0], s[1][nt][1]);
        w.w = cvt_pk_bf16(s[1][nt][2], s[1][nt][3]);
        pf[nt] = __builtin_bit_cast(bf16x8, w);
      }
#pragma unroll
      for (int mt = 0; mt < 4; ++mt) {
        const u32x2 lo = *(const u32x2*)(vb_ + (mt * 16 + l15) * NV_ROW + (4 * g) * 2);
        const u32x2 hi = *(const u32x2*)(vb_ + (mt * 16 + l15) * NV_ROW + (16 + 4 * g) * 2);
        u32x4 w;
        w.x = lo.x; w.y = lo.y; w.z = hi.x; w.w = hi.y;
        const bf16x8 vf = __builtin_bit_cast(bf16x8, w);
#pragma unroll
        for (int nt = 0; nt < 2; ++nt)
          o[mt][nt] = __builtin_amdgcn_mfma_f32_16x16x32_bf16(vf, pf[nt], o[mt][nt], 0, 0, 0);
      }
    }
#pragma unroll
    for (int nt = 0; nt < 2; ++nt) {
      float lt = lrow[nt];
      lt += __shfl_xor(lt, 16);
      lt += __shfl_xor(lt, 32);
      const float inv = 1.0f / lt;
      const int tok = b * 4096 + r * 64 + cq[nt];
#pragma unroll
      for (int mt = 0; mt < 4; ++mt) {
        u32x2 w;
        w.x = cvt_pk_bf16(o[mt][nt][0] * inv, o[mt][nt][1] * inv);
        w.y = cvt_pk_bf16(o[mt][nt][2] * inv, o[mt][nt][3] * inv);
        *(u32x2*)(p.o_c + (size_t)tok * 256 + hw * 64 + mt * 16 + g * 4) = w;
      }
    }
  }
}


__device__ void attn_phase(const P& p, char* smem) {
  int tid_ = threadIdx.x;
  asm volatile("" : "+v"(tid_));
  const int tid = tid_, lane = tid & 63, wave = tid >> 6, l15 = lane & 15, g = lane >> 4;
  char* Ks = smem;
  char* Vs = smem + 2 * KBUF;
  for (int job = vblock(); job < 768; job += gridDim.x) {
    const int qblk = job & 15, bh = job >> 4;
    const int b = bh / 6, h = bh % 6;
    const bf16_t* Q = p.qb + (size_t)bh * 4096 * 96;
    const bf16_t* Kg = p.kb + (size_t)bh * 4096 * 96;
    const bf16_t* Vt = p.vT + (size_t)bh * 64 * 4096;
    const int q0 = qblk * 256 + wave * 32;
    bf16x8 qf[2][3];
#pragma unroll
    for (int nt = 0; nt < 2; ++nt)
#pragma unroll
      for (int ks = 0; ks < 3; ++ks)
        qf[nt][ks] = *(const bf16x8*)(Q + (size_t)(q0 + nt * 16 + l15) * 96 + ks * 32 + g * 8);
    f32x4 o[4][2];
#pragma unroll
    for (int a = 0; a < 4; ++a)
#pragma unroll
      for (int n = 0; n < 2; ++n) o[a][n] = (f32x4){0.f, 0.f, 0.f, 0.f};
    float mrow[2] = {-1e30f, -1e30f}, lrow[2] = {0.f, 0.f};

    u32x4 rk[2];
    u32x4 rv;
    const int kr1 = (tid + 512) / 12, kc1 = (tid + 512) - kr1 * 12;
    const int kr0 = tid / 12, kc0 = tid - kr0 * 12;
    auto gload = [&](int kt) {
      const u32x4* kp = (const u32x4*)(Kg + (size_t)kt * 64 * 96);
      rk[0] = kp[tid];
      if (tid < 256) rk[1] = kp[tid + 512];
      rv = *(const u32x4*)(Vt + (size_t)(tid >> 3) * 4096 + kt * 64 + (tid & 7) * 8);
    };
    auto lstore = [&](int buf) {
      char* kb_ = Ks + buf * KBUF;
      char* vb_ = Vs + buf * VBUF;
      *(u32x4*)(kb_ + kr0 * KROW + kc0 * 16) = rk[0];
      if (tid < 256) *(u32x4*)(kb_ + kr1 * KROW + kc1 * 16) = rk[1];
      u32x2 lo, hi;
      lo.x = rv.x; lo.y = rv.y; hi.x = rv.z; hi.y = rv.w;
      *(u32x2*)(vb_ + (tid >> 3) * VROW + (tid & 7) * 16) = lo;
      *(u32x2*)(vb_ + (tid >> 3) * VROW + (tid & 7) * 16 + 8) = hi;
    };
    const int NKT = 64;
    gload(0);
    __syncthreads();
    lstore(0);
    gload(1);
    for (int kt = 0; kt < NKT; ++kt) {
      __syncthreads();
      if (kt + 1 < NKT) {
        lstore((kt + 1) & 1);
        if (kt + 2 < NKT) gload(kt + 2);
      }
      __builtin_amdgcn_sched_barrier(0);
      const char* kb_ = Ks + (kt & 1) * KBUF;
      const char* vb_ = Vs + (kt & 1) * VBUF;
      f32x4 s[4][2];
#pragma unroll
      for (int a = 0; a < 4; ++a)
#pragma unroll
        for (int n = 0; n < 2; ++n) s[a][n] = (f32x4){0.f, 0.f, 0.f, 0.f};
#pragma unroll
      for (int mt = 0; mt < 4; ++mt)
#pragma unroll
        for (int ks = 0; ks < 3; ++ks) {
          const bf16x8 kf = *(const bf16x8*)(kb_ + (mt * 16 + l15) * KROW + (ks * 32 + g * 8) * 2);
#pragma unroll
          for (int nt = 0; nt < 2; ++nt)
            s[mt][nt] = __builtin_amdgcn_mfma_f32_16x16x32_bf16(kf, qf[nt][ks], s[mt][nt], 0, 0, 0);
        }
      bf16x8 pf[2][2];
#pragma unroll
      for (int nt = 0; nt < 2; ++nt) {
        float mx = s[0][nt][0];
#pragma unroll
        for (int mt = 0; mt < 4; ++mt)
#pragma unroll
          for (int j = 0; j < 4; ++j) mx = fmaxf(mx, s[mt][nt][j]);
        mx = fmaxf(mx, __shfl_xor(mx, 16));
        mx = fmaxf(mx, __shfl_xor(mx, 32));
        if (__any(mx > mrow[nt] + 8.0f)) {
          const float mnew = fmaxf(mrow[nt], mx);
          const float alpha = __builtin_amdgcn_exp2f(mrow[nt] - mnew);
          mrow[nt] = mnew;
          lrow[nt] *= alpha;
#pragma unroll
          for (int a = 0; a < 4; ++a) o[a][nt] *= alpha;
        }
        const float mref = mrow[nt];
        float ls = 0.f;
#pragma unroll
        for (int mt = 0; mt < 4; ++mt)
#pragma unroll
          for (int j = 0; j < 4; ++j) {
            const float e = __builtin_amdgcn_exp2f(s[mt][nt][j] - mref);
            s[mt][nt][j] = e;
            ls += e;
          }
        lrow[nt] += ls;
#pragma unroll
        for (int kk = 0; kk < 2; ++kk) {
          u32x4 w;
          w.x = cvt_pk_bf16(s[2 * kk][nt][0], s[2 * kk][nt][1]);
          w.y = cvt_pk_bf16(s[2 * kk][nt][2], s[2 * kk][nt][3]);
          w.z = cvt_pk_bf16(s[2 * kk + 1][nt][0], s[2 * kk + 1][nt][1]);
          w.w = cvt_pk_bf16(s[2 * kk + 1][nt][2], s[2 * kk + 1][nt][3]);
          pf[kk][nt] = __builtin_bit_cast(bf16x8, w);
        }
      }
#pragma unroll
      for (int kk = 0; kk < 2; ++kk)
#pragma unroll
        for (int mt = 0; mt < 4; ++mt) {
          const u32x2 lo = *(const u32x2*)(vb_ + (mt * 16 + l15) * VROW + (32 * kk + 4 * g) * 2);
          const u32x2 hi = *(const u32x2*)(vb_ + (mt * 16 + l15) * VROW + (32 * kk + 16 + 4 * g) * 2);
          u32x4 w;
          w.x = lo.x; w.y = lo.y; w.z = hi.x; w.w = hi.y;
          const bf16x8 vf = __builtin_bit_cast(bf16x8, w);
#pragma unroll
          for (int nt = 0; nt < 2; ++nt)
            o[mt][nt] = __builtin_amdgcn_mfma_f32_16x16x32_bf16(vf, pf[kk][nt], o[mt][nt], 0, 0, 0);
        }
    }
#pragma unroll
    for (int nt = 0; nt < 2; ++nt) {
      float lt = lrow[nt];
      lt += __shfl_xor(lt, 16);
      lt += __shfl_xor(lt, 32);
      const float inv = 1.0f / lt;
      const int tok = b * 4096 + q0 + nt * 16 + l15;
#pragma unroll
      for (int mt = 0; mt < 4; ++mt) {
        u32x2 w;
        w.x = cvt_pk_bf16(o[mt][nt][0] * inv, o[mt][nt][1] * inv);
        w.y = cvt_pk_bf16(o[mt][nt][2] * inv, o[mt][nt][3] * inv);
        *(u32x2*)(p.o_a + (size_t)tok * 384 + h * 64 + mt * 16 + g * 4) = w;
      }
    }
  }
}

__device__ void mixnorm_phase(const P& p, char* smem) {
  int tid_ = threadIdx.x;
  asm volatile("" : "+v"(tid_));
  const int tid = tid_;
  for (int job = blockIdx.x; job < NTOK / 32; job += gridDim.x) {
    const int tok0 = job * 32, b = tok0 >> 12, s0 = tok0 & 4095;
    __syncthreads();
#pragma unroll
    for (int i = 0; i < 3; ++i) {
      const int c = tid + 512 * i, row = c / 48, cc = c % 48;
      *(u32x4*)(smem + row * 2048 + cc * 16) = *(const u32x4*)(p.o_a + (size_t)(tok0 + row) * 384 + cc * 8);
    }
#pragma unroll
    for (int i = 0; i < 2; ++i) {
      const int c = tid + 512 * i, row = c >> 5, cc = c & 31;
      *(u32x4*)(smem + row * 2048 + 1536 + cc * 16) = *(const u32x4*)(p.o_c + (size_t)(tok0 + row) * 256 + cc * 8);
    }
#pragma unroll
    for (int i = 0; i < 3; ++i) {
      const int c = tid + 512 * i, ch = c >> 2, tc = c & 3;
      const u32x4 v = *(const u32x4*)(p.ybT + ((size_t)(b * 384 + ch)) * 4096 + s0 + tc * 8);
      bf16_t* dst = (bf16_t*)smem + (size_t)(tc * 8) * 1024 + 384 + ch;
      dst[0 * 1024] = (bf16_t)(v.x & 0xffff); dst[1 * 1024] = (bf16_t)(v.x >> 16);
      dst[2 * 1024] = (bf16_t)(v.y & 0xffff); dst[3 * 1024] = (bf16_t)(v.y >> 16);
      dst[4 * 1024] = (bf16_t)(v.z & 0xffff); dst[5 * 1024] = (bf16_t)(v.z >> 16);
      dst[6 * 1024] = (bf16_t)(v.w & 0xffff); dst[7 * 1024] = (bf16_t)(v.w >> 16);
    }
    __syncthreads();
    const int tok = tid >> 4, sub = tid & 15;
    float ss[3] = {0.f, 0.f, 0.f};
#pragma unroll
    for (int gi = 0; gi < 3; ++gi) {
      const int i0 = (gi == 0) ? 0 : (gi == 1 ? 3 : 6), i1 = (gi == 0) ? 3 : (gi == 1 ? 6 : 8);
      float acc = 0.f;
#pragma unroll 2
      for (int i = i0; i < i1; ++i) {
        const u32x4 v = *(const u32x4*)(smem + tok * 2048 + (sub + 16 * i) * 16);
        float a;
        a = bflo(v.x); acc += a * a; a = bfhi(v.x); acc += a * a;
        a = bflo(v.y); acc += a * a; a = bfhi(v.y); acc += a * a;
        a = bflo(v.z); acc += a * a; a = bfhi(v.z); acc += a * a;
        a = bflo(v.w); acc += a * a; a = bfhi(v.w); acc += a * a;
      }
      acc += __shfl_xor(acc, 1);
      acc += __shfl_xor(acc, 2);
      acc += __shfl_xor(acc, 4);
      acc += __shfl_xor(acc, 8);
      ss[gi] = acc;
    }
    float rs[3];
    rs[0] = rsqrtf(ss[0] * (1.0f / 384.0f) + 1e-6f);
    rs[1] = rsqrtf(ss[1] * (1.0f / 384.0f) + 1e-6f);
    rs[2] = rsqrtf(ss[2] * (1.0f / 256.0f) + 1e-6f);
#pragma unroll
    for (int gi = 0; gi < 3; ++gi) {
      const int i0 = (gi == 0) ? 0 : (gi == 1 ? 3 : 6), i1 = (gi == 0) ? 3 : (gi == 1 ? 6 : 8);
      const float r = rs[gi];
#pragma unroll 2
      for (int i = i0; i < i1; ++i) {
        const u32x4 v = *(const u32x4*)(smem + tok * 2048 + (sub + 16 * i) * 16);
        u32x4 w;
        w.x = cvt_pk_bf16(bflo(v.x) * r, bfhi(v.x) * r);
        w.y = cvt_pk_bf16(bflo(v.y) * r, bfhi(v.y) * r);
        w.z = cvt_pk_bf16(bflo(v.z) * r, bfhi(v.z) * r);
        w.w = cvt_pk_bf16(bflo(v.w) * r, bfhi(v.w) * r);
        *(u32x4*)(p.y + (size_t)(tok0 + tok) * 1024 + (sub + 16 * i) * 8) = w;
      }
    }
  }
}

enum { EPI_INPROJ = 0, EPI_QUP = 1, EPI_KVUP = 2, EPI_OUTPROJ = 3, EPI_SWIGLU = 4, EPI_DOWN = 5 };

template <int EPI>
__device__ void gemm_phase(const P& p, int l, const bf16_t* __restrict__ A, int lda, const bf16_t* __restrict__ Bt,
                           int K, int nN, char* smem) {
  int tid_ = threadIdx.x;
  asm volatile("" : "+v"(tid_));
  const int tid = tid_, lane = tid & 63, wave = tid >> 6, wm = wave >> 2, wn = wave & 3, l15 = lane & 15,
            g = lane >> 4;
  const int ntiles = 128 * nN;
  const int srow = tid >> 3, skc = tid & 7;
  const int sw_off = srow * 128 + ((skc ^ ((srow >> 1) & 7)) * 16);
  const int rsw = (l15 >> 1) & 7;
  for (int tile = vblock(); tile < ntiles; tile += gridDim.x) {
    const int gsz_ = 4 * nN, grp_ = tile / gsz_, w_ = tile - grp_ * gsz_;
    const int ni = w_ >> 2, mi = grp_ * 4 + (w_ & 3);
    const int m0 = mi * 256, n0 = ni * 256;
    f32x4 acc[8][4];
#pragma unroll
    for (int a = 0; a < 8; ++a)
#pragma unroll
      for (int b = 0; b < 4; ++b) acc[a][b] = (f32x4){0.f, 0.f, 0.f, 0.f};
    const bf16_t* Ag = A + (size_t)(m0 + srow) * lda + skc * 8;
    const bf16_t* Bg = Bt + (size_t)(n0 + srow) * K + skc * 8;
    u32x4 ra[4], rb[4];
    auto gl = [&](int kt) {
#pragma unroll
      for (int i = 0; i < 4; ++i) ra[i] = *(const u32x4*)(Ag + (size_t)i * 64 * lda + kt * 64);
#pragma unroll
      for (int i = 0; i < 4; ++i) rb[i] = *(const u32x4*)(Bg + (size_t)i * 64 * K + kt * 64);
    };
    auto st = [&](int buf) {
      char* nb = smem + buf * 65536;
#pragma unroll
      for (int i = 0; i < 4; ++i) *(u32x4*)(nb + sw_off + i * 8192) = ra[i];
#pragma unroll
      for (int i = 0; i < 4; ++i) *(u32x4*)(nb + 32768 + sw_off + i * 8192) = rb[i];
    };
    const int nk = K / 64;
    gl(0);
    float rs_row = 1.f;
    if (EPI == EPI_INPROJ || EPI == EPI_SWIGLU) {
      if (tid < 256) {
        const f32x4* pp = (const f32x4*)(p.part_x + (size_t)(m0 + tid) * 16);
        const f32x4 a0 = pp[0], a1 = pp[1], a2 = pp[2], a3 = pp[3];
        const float tot = (a0[0] + a0[1] + a0[2] + a0[3]) + (a1[0] + a1[1] + a1[2] + a1[3]) +
                          (a2[0] + a2[1] + a2[2] + a2[3]) + (a3[0] + a3[1] + a3[2] + a3[3]);
        rs_row = rsqrtf(tot * (1.0f / 1024.0f) + 1e-6f);
      }
    } else if (EPI == EPI_QUP) {
      if (tid < 256) {
        const f32x4 a0 = *(const f32x4*)(p.part_q + (size_t)(m0 + tid) * 4);
        rs_row = rsqrtf((a0[0] + a0[1] + a0[2] + a0[3]) * (1.0f / 256.0f) + 1e-6f);
      }
    } else if (EPI == EPI_KVUP) {
      if (tid < 256) {
        const float2 a0 = *(const float2*)(p.part_kv + (size_t)(m0 + tid) * 2);
        rs_row = rsqrtf((a0.x + a0.y) * (1.0f / 128.0f) + 1e-6f);
      }
    }
    float* s_rs = (float*)(smem + 131072);
    __syncthreads();
    st(0);
    if (EPI != EPI_OUTPROJ && EPI != EPI_DOWN && true) {
      if (tid < 256) s_rs[tid] = rs_row;
    }
    __syncthreads();
    for (int kt = 0; kt < nk; ++kt) {
      if (kt + 1 < nk) gl(kt + 1);
      __builtin_amdgcn_sched_barrier(0);
      const char* Ab = smem + (kt & 1) * 65536;
      const char* Bb = Ab + 32768;
#pragma unroll
      for (int ks = 0; ks < 2; ++ks) {
        bf16x8 bfr[4];
#pragma unroll
        for (int nt = 0; nt < 4; ++nt)
          bfr[nt] = *(const bf16x8*)(Bb + (wn * 64 + nt * 16 + l15) * 128 + (((ks * 4 + g) ^ rsw) * 16));
        bf16x8 af[2][2];
#pragma unroll
        for (int mt = 0; mt < 2; ++mt)
          af[0][mt] = *(const bf16x8*)(Ab + (wm * 128 + mt * 16 + l15) * 128 + (((ks * 4 + g) ^ rsw) * 16));
#pragma unroll
        for (int mh = 0; mh < 4; ++mh) {
          if (mh < 3) {
#pragma unroll
            for (int mt = 0; mt < 2; ++mt)
              af[(mh + 1) & 1][mt] = *(const bf16x8*)(Ab + (wm * 128 + ((mh + 1) * 2 + mt) * 16 + l15) * 128 + (((ks * 4 + g) ^ rsw) * 16));
          }
          __builtin_amdgcn_sched_barrier(0);
#pragma unroll
          for (int mt = 0; mt < 2; ++mt)
#pragma unroll
            for (int nt = 0; nt < 4; ++nt)
              acc[mh * 2 + mt][nt] = __builtin_amdgcn_mfma_f32_16x16x32_bf16(bfr[nt], af[mh & 1][mt], acc[mh * 2 + mt][nt], 0, 0, 0);
          __builtin_amdgcn_sched_barrier(0);
        }
      }
      if (kt + 1 < nk) st((kt + 1) & 1);
      __syncthreads();
    }
    int opq_ = 0;
    asm volatile("" : "+v"(opq_));
    const int rbase = m0 + wm * 128 + l15 + opq_;
    const int cbase = n0 + wn * 64 + g * 4 + opq_;
    if (EPI == EPI_INPROJ) {
      const int wc0 = n0 + wn * 64;
#pragma unroll
      for (int mt = 0; mt < 8; ++mt) {
        const int row = rbase + mt * 16;
        const float rs = s_rs[row - m0];
        const int bb = row >> 12, ss = row & 4095;
        float sq = 0.f;
#pragma unroll
        for (int nt = 0; nt < 4; ++nt) {
          const int ct = wc0 + nt * 16;
          const int col = cbase + nt * 16;
          f32x4 v = acc[mt][nt] * rs;
          if (ct < 384) {
            if ((nt & 1) == 0) {
              const f32x4 v1 = acc[mt][(nt + 1) & 3] * rs;
              sq += v[0] * v[0] + v[1] * v[1] + v[2] * v[2] + v[3] * v[3];
              sq += v1[0] * v1[0] + v1[1] * v1[1] + v1[2] * v1[2] + v1[3] * v1[3];
              u32x4 w;
              w.x = cvt_pk_bf16(v[0], v[1]);
              w.y = cvt_pk_bf16(v[2], v[3]);
              w.z = cvt_pk_bf16(v1[0], v1[1]);
              w.w = cvt_pk_bf16(v1[2], v1[3]);
              *(u32x4*)(p.projA + (size_t)row * 416 + wc0 + (nt >> 1) * 32 + g * 8) = w;
            }
          } else if (ct == 384) {
            if (nt < 3) {
              const f32x4 v2 = acc[mt][(nt + 1) & 3] * rs;
              const int i0 = col - 384;
              const float2* cs = p.ropecs + ss * 16 + i0;
              float o1[4], o2[4];
#pragma unroll
              for (int j = 0; j < 4; ++j) {
                const float2 c_s = cs[j];
                o1[j] = v[j] * c_s.x - v2[j] * c_s.y;
                o2[j] = v[j] * c_s.y + v2[j] * c_s.x;
              }
              u32x2 w;
              w.x = cvt_pk_bf16(o1[0], o1[1]);
              w.y = cvt_pk_bf16(o1[2], o1[3]);
              *(u32x2*)(p.projA + (size_t)row * 416 + 384 + i0) = w;
              w.x = cvt_pk_bf16(o2[0], o2[1]);
              w.y = cvt_pk_bf16(o2[2], o2[3]);
              *(u32x2*)(p.projA + (size_t)row * 416 + 400 + i0) = w;
            }
          } else if (ct == 400) {
          } else if (ct < 1568) {
            const int hc = col - 416;
            bf16_t* dst = p.hyT + ((size_t)(bb * 1152 + hc)) * 4096 + ss;
            dst[0] = f2bf(v[0]);
            dst[4096] = f2bf(v[1]);
            dst[2 * 4096] = f2bf(v[2]);
            dst[3 * 4096] = f2bf(v[3]);
          } else if (ct < 2080) {
            if ((nt & 1) == 0) {
              const f32x4 v1 = acc[mt][(nt + 1) & 3] * rs;
              u32x4 w;
              w.x = cvt_pk_bf16(v[0], v[1]);
              w.y = cvt_pk_bf16(v[2], v[3]);
              w.z = cvt_pk_bf16(v1[0], v1[1]);
              w.w = cvt_pk_bf16(v1[2], v1[3]);
              *(u32x4*)(p.na + (size_t)row * 768 + (wc0 + (nt >> 1) * 32 + g * 8 - 1568)) = w;
            }
          } else if (ct < 2336) {
            const int vc = col - 2080;
            bf16_t* dst = p.naVT + ((size_t)(bb * 256 + vc)) * 4096 + ss;
            dst[0] = f2bf(v[0]);
            dst[4096] = f2bf(v[1]);
            dst[2 * 4096] = f2bf(v[2]);
            dst[3 * 4096] = f2bf(v[3]);
          }
        }
        if (wc0 < 384) {
          sq += __shfl_xor(sq, 16);
          sq += __shfl_xor(sq, 32);
          if (g == 0) {
            if (wc0 < 256) p.part_q[(size_t)row * 4 + (wc0 >> 6)] = sq;
            else p.part_kv[(size_t)row * 2 + ((wc0 - 256) >> 6)] = sq;
          }
        }
      }
    } else if (EPI == EPI_QUP) {
      const int wc0 = n0 + wn * 64;
      const float qscale = 0.10206207261596575f * 1.4426950408889634f;
#pragma unroll
      for (int mt = 0; mt < 8; ++mt) {
        const int row = rbase + mt * 16;
        const float rs = s_rs[row - m0] * qscale;
        const int bb = row >> 12, ss = row & 4095;
#pragma unroll
        for (int nt = 0; nt < 4; ++nt) {
          const int T = (wc0 >> 4) + nt;
          if (T < 36) {
            const int hh = T / 6, tt = T % 6;
            bf16_t* qrow = p.qb + ((size_t)((bb * 6 + hh) * 4096 + ss)) * 96;
            const f32x4 v = acc[mt][nt] * rs;
            if (tt < 4) {
              u32x2 w;
              w.x = cvt_pk_bf16(v[0], v[1]);
              w.y = cvt_pk_bf16(v[2], v[3]);
              *(u32x2*)(qrow + tt * 16 + g * 4) = w;
            } else if (tt == 4) {
              if (nt < 3) {
                const f32x4 v2 = acc[mt][(nt + 1) & 3] * rs;
                const float2* cs = p.ropecs + ss * 16 + g * 4;
                float o1[4], o2[4];
#pragma unroll
                for (int j = 0; j < 4; ++j) {
                  const float2 c_s = cs[j];
                  o1[j] = v[j] * c_s.x - v2[j] * c_s.y;
                  o2[j] = v[j] * c_s.y + v2[j] * c_s.x;
                }
                u32x2 w;
                w.x = cvt_pk_bf16(o1[0], o1[1]);
                w.y = cvt_pk_bf16(o1[2], o1[3]);
                *(u32x2*)(qrow + 64 + g * 4) = w;
                w.x = cvt_pk_bf16(o2[0], o2[1]);
                w.y = cvt_pk_bf16(o2[2], o2[3]);
                *(u32x2*)(qrow + 80 + g * 4) = w;
              }
            }
          }
        }
      }
    } else if (EPI == EPI_KVUP) {
      const int hh = ni * 2 + (wn >> 1);
#pragma unroll
      for (int mt = 0; mt < 8; ++mt) {
        const int row = rbase + mt * 16;
        const float rs = s_rs[row - m0];
        const int bb = row >> 12, ss = row & 4095;
#pragma unroll
        for (int nt = 0; nt < 4; ++nt) {
          const f32x4 v = acc[mt][nt] * rs;
          if ((wn & 1) == 0) {
            u32x2 w;
            w.x = cvt_pk_bf16(v[0], v[1]);
            w.y = cvt_pk_bf16(v[2], v[3]);
            *(u32x2*)(p.kb + ((size_t)((bb * 6 + hh) * 4096 + ss)) * 96 + nt * 16 + g * 4) = w;
          } else {
            const int dv = nt * 16 + g * 4;
            bf16_t* dst = p.vT + ((size_t)((bb * 6 + hh) * 64 + dv)) * 4096 + ss;
            dst[0] = f2bf(v[0]);
            dst[4096] = f2bf(v[1]);
            dst[2 * 4096] = f2bf(v[2]);
            dst[3 * 4096] = f2bf(v[3]);
          }
        }
      }
#pragma unroll
      for (int i = 0; i < 2; ++i) {
        const int c = tid + 512 * i, rr = c >> 2, cc = c & 3;
        const int row = m0 + rr, bb = row >> 12, ss = row & 4095;
        const u32x4 v = *(const u32x4*)(p.projA + (size_t)row * 416 + 384 + cc * 8);
        *(u32x4*)(p.kb + ((size_t)((bb * 6 + ni * 2) * 4096 + ss)) * 96 + 64 + cc * 8) = v;
        *(u32x4*)(p.kb + ((size_t)((bb * 6 + ni * 2 + 1) * 4096 + ss)) * 96 + 64 + cc * 8) = v;
      }
    } else if (EPI == EPI_OUTPROJ || EPI == EPI_DOWN) {
      const int slot = (n0 + wn * 64) >> 6;
      const int cb8 = n0 + wn * 64 + g * 8;
#pragma unroll
      for (int mt = 0; mt < 8; ++mt) {
        const int row = rbase + mt * 16;
        float sq = 0.f;
#pragma unroll
        for (int q = 0; q < 2; ++q) {
          const int col = cb8 + q * 32;
          const u32x4 xr = *(const u32x4*)(p.xb + (size_t)row * 1024 + col);
          const f32x4 v0 = acc[mt][2 * q] + (f32x4){bflo(xr.x), bfhi(xr.x), bflo(xr.y), bfhi(xr.y)};
          const f32x4 v1 = acc[mt][2 * q + 1] + (f32x4){bflo(xr.z), bfhi(xr.z), bflo(xr.w), bfhi(xr.w)};
          sq += v0[0] * v0[0] + v0[1] * v0[1] + v0[2] * v0[2] + v0[3] * v0[3];
          sq += v1[0] * v1[0] + v1[1] * v1[1] + v1[2] * v1[2] + v1[3] * v1[3];
          u32x4 w;
          w.x = cvt_pk_bf16(v0[0], v0[1]);
          w.y = cvt_pk_bf16(v0[2], v0[3]);
          w.z = cvt_pk_bf16(v1[0], v1[1]);
          w.w = cvt_pk_bf16(v1[2], v1[3]);
          *(u32x4*)(p.xb + (size_t)row * 1024 + col) = w;
        }
        sq += __shfl_xor(sq, 16);
        sq += __shfl_xor(sq, 32);
        if (g == 0) p.part_x[(size_t)row * 16 + slot] = sq;
      }
    } else if (EPI == EPI_SWIGLU) {
      const int fbase = ((n0 + wn * 64) >> 1) + g * 8;
#pragma unroll
      for (int mt = 0; mt < 8; ++mt) {
        const int row = rbase + mt * 16;
        const float rs = s_rs[row - m0];
        float hv[8];
#pragma unroll
        for (int i = 0; i < 2; ++i) {
          const f32x4 gt = acc[mt][i] * rs, up = acc[mt][2 + i] * rs;
#pragma unroll
          for (int j = 0; j < 4; ++j) hv[i * 4 + j] = gt[j] * __builtin_amdgcn_rcpf(1.0f + __expf(-gt[j])) * up[j];
        }
        u32x4 w;
        w.x = cvt_pk_bf16(hv[0], hv[1]);
        w.y = cvt_pk_bf16(hv[2], hv[3]);
        w.z = cvt_pk_bf16(hv[4], hv[5]);
        w.w = cvt_pk_bf16(hv[6], hv[7]);
        *(u32x4*)(p.hidden + (size_t)row * 2816 + fbase) = w;
      }
    }
  }
}

__device__ void final_norm_phase(const P& p) {
  int tid_ = threadIdx.x;
  asm volatile("" : "+v"(tid_));
  const int tid = tid_, lane = tid & 63, wave = tid >> 6;
  for (int row = blockIdx.x * 8 + wave; row < NTOK; row += gridDim.x * 8) {
    const f32x4* pp = (const f32x4*)(p.part_x + (size_t)row * 16);
    const f32x4 a0 = pp[0], a1 = pp[1], a2 = pp[2], a3 = pp[3];
    const float tot = (a0[0] + a0[1] + a0[2] + a0[3]) + (a1[0] + a1[1] + a1[2] + a1[3]) +
                      (a2[0] + a2[1] + a2[2] + a2[3]) + (a3[0] + a3[1] + a3[2] + a3[3]);
    const float rs = rsqrtf(tot * (1.0f / 1024.0f) + 1e-6f);
    const bf16_t* xr = p.xb + (size_t)row * 1024;
    float* orow = p.out + (size_t)row * 1024;
#pragma unroll
    for (int i = 0; i < 2; ++i) {
      const int c0 = lane * 8 + 512 * i;
      const u32x4 xv = *(const u32x4*)(xr + c0);
      const f32x4 g0 = *(const f32x4*)(p.final_g + c0), g1 = *(const f32x4*)(p.final_g + c0 + 4);
      f32x4 o0 = (f32x4){bflo(xv.x), bfhi(xv.x), bflo(xv.y), bfhi(xv.y)};
      f32x4 o1 = (f32x4){bflo(xv.z), bfhi(xv.z), bflo(xv.w), bfhi(xv.w)};
      o0 = o0 * rs * g0;
      o1 = o1 * rs * g1;
      *(f32x4*)(orow + c0) = o0;
      *(f32x4*)(orow + c0 + 4) = o1;
    }
  }
}


template <int S>
__device__ __forceinline__ void run_stage(const P& p, int l, char* smem) {
  if (S == 0) prep_phase(p, l, smem);
  if (S == 1) {
    filt_fft_phase(p, l, smem);
    gemm_phase<EPI_INPROJ>(p, l, p.xb, 1024, p.Win, 1024, 10, smem);
  }
  if (S == 2) {
    hyena_phase<0>(p, l, smem);
    gemm_phase<EPI_QUP>(p, l, p.projA, 416, p.Wuq, 256, 3, smem);
    gemm_phase<EPI_KVUP>(p, l, p.projA + 256, 416, p.Wukv, 128, 3, smem);
    natten_phase(p, l, smem);
  }
  if (S == 3) {
    hyena_phase<1>(p, l, smem);
    attn_phase(p, smem);
  }
  if (S == 4) mixnorm_phase(p, smem);
  if (S == 5) gemm_phase<EPI_OUTPROJ>(p, l, p.y, 1024, p.Wout, 1024, 4, smem);
  if (S == 6) gemm_phase<EPI_SWIGLU>(p, l, p.xb, 1024, p.Wgu, 1024, 22, smem);
  if (S == 7) gemm_phase<EPI_DOWN>(p, l, p.hidden, 2816, p.Wdown, 2816, 4, smem);
  if (S == 8) final_norm_phase(p);
}

__device__ __forceinline__ void grid_barrier(unsigned* bar, unsigned target) {
  asm volatile("s_waitcnt vmcnt(0)" ::: "memory");
  __syncthreads();
  if (threadIdx.x == 0) {
    __builtin_amdgcn_fence(__ATOMIC_RELEASE, "agent");
    asm volatile("s_waitcnt vmcnt(0)" ::: "memory");
    __hip_atomic_fetch_add(bar, 1u, __ATOMIC_RELAXED, __HIP_MEMORY_SCOPE_AGENT);
    unsigned spins = 0;
    while (__hip_atomic_load(bar, __ATOMIC_RELAXED, __HIP_MEMORY_SCOPE_AGENT) < target && spins < (1u << 22)) {
      __builtin_amdgcn_s_sleep(1);
      ++spins;
    }
    __builtin_amdgcn_fence(__ATOMIC_ACQUIRE, "agent");
    asm volatile("s_waitcnt vmcnt(0)" ::: "memory");
  }
  __syncthreads();
}

__global__ void __launch_bounds__(NTHREADS) k_main(P p) {
  extern __shared__ __attribute__((aligned(16))) char smem[];
  cg::grid_group grid = cg::this_grid();
  if (blockIdx.x == 0 && threadIdx.x == 0) __hip_atomic_store(p.bar, 0u, __ATOMIC_RELAXED, __HIP_MEMORY_SCOPE_AGENT);
  run_stage<0>(p, 0, smem); grid.sync();
  run_stage<1>(p, 0, smem); grid_barrier(p.bar, 1u * gridDim.x);
  run_stage<2>(p, 0, smem); grid_barrier(p.bar, 2u * gridDim.x);
  run_stage<3>(p, 0, smem); grid_barrier(p.bar, 3u * gridDim.x);
  run_stage<4>(p, 0, smem); grid_barrier(p.bar, 4u * gridDim.x);
  run_stage<5>(p, 0, smem); grid_barrier(p.bar, 5u * gridDim.x);
  run_stage<6>(p, 0, smem); grid_barrier(p.bar, 6u * gridDim.x);
  run_stage<7>(p, 0, smem); grid_barrier(p.bar, 7u * gridDim.x);
  run_stage<0>(p, 1, smem); grid_barrier(p.bar, 8u * gridDim.x);
  run_stage<1>(p, 1, smem); grid_barrier(p.bar, 9u * gridDim.x);
  run_stage<2>(p, 1, smem); grid_barrier(p.bar, 10u * gridDim.x);
  run_stage<3>(p, 1, smem); grid_barrier(p.bar, 11u * gridDim.x);
  run_stage<4>(p, 1, smem); grid_barrier(p.bar, 12u * gridDim.x);
  run_stage<5>(p, 1, smem); grid_barrier(p.bar, 13u * gridDim.x);
  run_stage<6>(p, 1, smem); grid_barrier(p.bar, 14u * gridDim.x);
  run_stage<7>(p, 1, smem); grid_barrier(p.bar, 15u * gridDim.x);
  run_stage<8>(p, 1, smem);
}


extern "C" void kernel_launch(void* const* d_in, const int* in_sizes, int n_in, void* d_out, int out_size, void* d_ws,
                              size_t ws_size, hipStream_t stream) {
  static int grid_blocks = 0;
  if (!grid_blocks) {
    int dev = 0, cus = 0;
    (void)hipGetDevice(&dev);
    (void)hipDeviceGetAttribute(&cus, hipDeviceAttributeMultiprocessorCount, dev);
    if (cus <= 0) cus = 256;
    int per_cu = 0;
    (void)hipFuncSetAttribute((const void*)k_main, hipFuncAttributeMaxDynamicSharedMemorySize, LDS_BYTES);
    (void)hipOccupancyMaxActiveBlocksPerMultiprocessor(&per_cu, k_main, NTHREADS, LDS_BYTES);
    if (per_cu > 1) per_cu = 1;
    if (per_cu < 1) per_cu = 1;
    grid_blocks = cus * per_cu;
  }
  P p;
  memset(&p, 0, sizeof(p));
  const float* const* in = (const float* const*)d_in;
  p.x = in[0]; p.norm1_g = in[1]; p.w_in = in[2]; p.q_norm_g = in[3]; p.w_uq = in[4]; p.kv_norm_g = in[5];
  p.w_ukv = in[6]; p.conv_w = in[7]; p.conv_b = in[8]; p.fw1 = in[9]; p.fb1 = in[10]; p.ff1 = in[11];
  p.fw2 = in[12]; p.fb2 = in[13]; p.ff2 = in[14]; p.fw3 = in[15]; p.skip = in[16]; p.rpb = in[17];
  p.mix_g = in[18]; p.w_out = in[19]; p.norm2_g = in[20]; p.w_gate = in[21]; p.w_up = in[22]; p.w_down = in[23];
  p.final_g = in[24];
  p.out = (float*)d_out;
  char* ws = (char*)d_ws;
  size_t off = 0;
  auto take = [&](size_t bytes) {
    char* r = ws + off;
    off += (bytes + 255) & ~(size_t)255;
    return r;
  };
  p.Win = (bf16_t*)take((size_t)2560 * 1024 * 2);
  p.Wuq = (bf16_t*)take((size_t)768 * 256 * 2);
  p.Wukv = (bf16_t*)take((size_t)768 * 128 * 2);
  p.Wout = (bf16_t*)take((size_t)1024 * 1024 * 2);
  p.Wgu = (bf16_t*)take((size_t)5632 * 1024 * 2);
  p.Wdown = (bf16_t*)take((size_t)1024 * 2816 * 2);
  p.ropecs = (float2*)take((size_t)65536 * 8);
  p.tw = (float2*)take((size_t)8192 * 8);
  p.bar = (unsigned*)take(256);
  p.part_x = (float*)take((size_t)NTOK * 16 * 4);
  p.part_q = (float*)take((size_t)NTOK * 4 * 4);
  p.part_kv = (float*)take((size_t)NTOK * 2 * 4);
  p.xb = (bf16_t*)take((size_t)NTOK * 1024 * 2);
  p.H2 = (float2*)take((size_t)768 * 8192 * 8);
  p.z1T = (bf16_t*)take((size_t)1536 * 4096 * 4);
  p.filtT = (float*)p.z1T;
  p.vT = (bf16_t*)take((size_t)8 * 6 * 64 * 4096 * 2);
  p.o_a = (bf16_t*)take((size_t)NTOK * 384 * 2);
  p.o_c = (bf16_t*)take((size_t)NTOK * 256 * 2);
  char* big = take(0);
  p.projA = (bf16_t*)take((size_t)NTOK * 416 * 2);
  p.hyT = (bf16_t*)take((size_t)8 * 1152 * 4096 * 2);
  p.na = (bf16_t*)take((size_t)NTOK * 768 * 2);
  p.qb = (bf16_t*)take((size_t)8 * 6 * 4096 * 96 * 2);
  p.kb = (bf16_t*)take((size_t)8 * 6 * 4096 * 96 * 2);
  p.hidden = (bf16_t*)big;
  p.ybT = (bf16_t*)take((size_t)8 * 384 * 4096 * 2);
  p.naVT = (bf16_t*)take((size_t)8 * 4 * 64 * 4096 * 2);
  p.y = p.qb;
  if (off > ws_size) {
    fprintf(stderr, "workspace too small: need %zu have %zu\n", off, ws_size);
    return;
  }
  void* args[] = {&p};
  hipError_t e = hipLaunchCooperativeKernel((void*)k_main, dim3(grid_blocks), dim3(NTHREADS), args, LDS_BYTES, stream);
  if (e != hipSuccess) fprintf(stderr, "cooperative launch failed: %s (grid %d)\n", hipGetErrorString(e), grid_blocks);
}
```

```cpp
#include <hip/hip_runtime.h>
#include <hip/hip_cooperative_groups.h>
#include <cstdio>
#include <cstring>
#include <cstdint>
#include <cmath>
#include <type_traits>
namespace cg = cooperative_groups;


typedef unsigned short bf16_t;
typedef short bf16x8 __attribute__((ext_vector_type(8)));
typedef float f32x4 __attribute__((ext_vector_type(4)));
typedef unsigned u32x4 __attribute__((ext_vector_type(4)));
typedef unsigned u32x2 __attribute__((ext_vector_type(2)));

constexpr int NTOK = 32768, SEQ = 4096;
constexpr int NTHREADS = 512;
constexpr int LDS_BYTES = 147456;
constexpr int TW_LDS_OFF = 69632;
#define PADI(i) ((i) + ((i) >> 4))

struct P {
  const float *x, *norm1_g, *w_in, *q_norm_g, *w_uq, *kv_norm_g, *w_ukv, *conv_w, *conv_b, *fw1, *fb1, *ff1, *fw2, *fb2,
      *ff2, *fw3, *skip, *rpb, *mix_g, *w_out, *norm2_g, *w_gate, *w_up, *w_down, *final_g;
  float* out;
  bf16_t *Win, *Wuq, *Wukv, *Wout, *Wgu, *Wdown;
  bf16_t *xb, *projA, *hyT, *na, *qb, *kb, *vT, *o_a, *o_c, *y, *hidden, *ybT, *naVT;
  float2* H2;
  float* filtT;
  bf16_t* z1T;
  float *part_x, *part_q, *part_kv;
  float2* ropecs;
  float2* tw;
  unsigned* bar;
  unsigned pad0_, pad1_;
};

typedef __bf16 bf16v2_t __attribute__((ext_vector_type(2)));
typedef float f32x2_t __attribute__((ext_vector_type(2)));
__device__ __forceinline__ unsigned cvt_pk_bf16(float lo, float hi) {
  const f32x2_t v = {lo, hi};
  const bf16v2_t r = __builtin_convertvector(v, bf16v2_t);
  return __builtin_bit_cast(unsigned, r);
}
__device__ __forceinline__ bf16_t f2bf(float f) { return (bf16_t)(cvt_pk_bf16(f, 0.f) & 0xffffu); }
__device__ __forceinline__ float bf2f(bf16_t h) { return __uint_as_float(((unsigned)h) << 16); }
__device__ __forceinline__ float bflo(unsigned u) { return __uint_as_float(u << 16); }
__device__ __forceinline__ float bfhi(unsigned u) { return __uint_as_float(u & 0xffff0000u); }

__device__ __forceinline__ void fast_sincos_rev(float rev, float* s, float* c) {
  const float fr = rev - rintf(rev);
  *s = __builtin_amdgcn_sinf(fr);
  *c = __builtin_amdgcn_cosf(fr);
}
__device__ __forceinline__ float fast_sin(float x) {
  const float rev = x * 0.15915494309189535f;
  const float fr = rev - rintf(rev);
  return __builtin_amdgcn_sinf(fr);
}

__device__ __forceinline__ int vblock() {
  const int G = gridDim.x, b = blockIdx.x;
  return ((G & 7) == 0) ? ((b & 7) * (G >> 3) + (b >> 3)) : b;
}

__device__ void conv_w(const float* __restrict__ W, int K, int N, int Npad, const float* __restrict__ g, bf16_t* Bt,
                       int mode, char* smem) {
  float* tile = (float*)smem;
  int tid_ = threadIdx.x;
  asm volatile("" : "+v"(tid_));
  const int tid = tid_;
  const int nkt = K / 64, nnt = Npad / 64;
  for (int job = blockIdx.x; job < nkt * nnt; job += gridDim.x) {
    const int kt = job % nkt, ntile = job / nkt;
    const int k0 = kt * 64, n0 = ntile * 64;
    __syncthreads();
#pragma unroll
    for (int i = 0; i < 2; ++i) {
      const int k = (tid >> 4) + 32 * i, nq = (tid & 15) * 4, n = n0 + nq;
      f32x4 v = {0.f, 0.f, 0.f, 0.f};
      if (n < N) {
        v = *(const f32x4*)(W + (size_t)(k0 + k) * N + n);
        if (g) v = v * g[k0 + k];
      }
      tile[k * 65 + nq + 0] = v[0];
      tile[k * 65 + nq + 1] = v[1];
      tile[k * 65 + nq + 2] = v[2];
      tile[k * 65 + nq + 3] = v[3];
    }
    __syncthreads();
    {
      const int c = tid, n = c >> 3, kc = c & 7;
      float e[8];
#pragma unroll
      for (int q = 0; q < 8; ++q) e[q] = tile[(kc * 8 + q) * 65 + n];
      u32x4 w;
      w.x = cvt_pk_bf16(e[0], e[1]);
      w.y = cvt_pk_bf16(e[2], e[3]);
      w.z = cvt_pk_bf16(e[4], e[5]);
      w.w = cvt_pk_bf16(e[6], e[7]);
      const int nn = n0 + n;
      int dest = nn;
      if (mode == 4 && (nn < 384 || (nn >= 1568 && nn < 2080))) {
        const int f = nn & 31;
        dest = (nn & ~31) + ((f >> 2) & 1) * 16 + (f >> 3) * 4 + (f & 3);
      }
      if ((mode == 5 && (nn & 127) < 64) || (mode == 6 && nn < 576 && (nn % 96) < 64)) {
        const int f = nn & 31;
        dest = (nn & ~31) + ((f >> 2) & 1) * 16 + (f >> 3) * 4 + (f & 3);
      }
      if (mode == 3) {
        const int f = nn & 31;
        dest = (nn & ~31) + ((f >> 2) & 1) * 16 + (f >> 3) * 4 + (f & 3);
      }
      if (mode == 1 || mode == 2) {
        const int f = nn & 31;
        dest = 64 * (nn >> 5) + (mode == 2 ? 32 : 0) + ((f >> 2) & 1) * 16 + (f >> 3) * 4 + (f & 3);
      }
      *(u32x4*)(Bt + (size_t)dest * K + k0 + kc * 8) = w;
    }
  }
}

__device__ void filt_mlp(const P& p, int l, char* smem) {
  float* zf = (float*)smem;
  float* h1 = zf + 16 * 17;
  float* h2 = h1 + 64 * 16;
  int tid_ = threadIdx.x;
  asm volatile("" : "+v"(tid_));
  const int tid = tid_, tl = tid & 15, kk = tid >> 4;
  const float* w1 = p.fw1 + l * 17 * 64;
  const float* b1 = p.fb1 + l * 64;
  const float* f1 = p.ff1 + l * 64;
  const float* w2 = p.fw2 + l * 64 * 64;
  const float* b2 = p.fb2 + l * 64;
  const float* f2 = p.ff2 + l * 64;
  const float* w3 = p.fw3 + (size_t)l * 64 * 1536;
  for (int job = blockIdx.x; job < 256; job += gridDim.x) {
    const int t0 = job * 16;
    __syncthreads();
    {
      const int t = t0 + tl;
      if (kk < 8) {
        const float band = 1e-4f + (float)kk * ((7.0f - 1e-4f) / 7.0f);
        const float ang = ((6.283185307179586f * (float)t) * band) / 4096.0f;
        float s, c;
        fast_sincos_rev(ang * 0.15915494309189535f, &s, &c);
        zf[tl * 17 + 1 + kk] = c;
        zf[tl * 17 + 9 + kk] = s;
      } else if (kk == 8) {
        zf[tl * 17] = (float)t / 4095.0f;
      }
    }
    __syncthreads();
#pragma unroll
    for (int m = 0; m < 2; ++m) {
      const int j = kk + 32 * m;
      float a = b1[j];
#pragma unroll 1
      for (int f = 0; f < 17; ++f) a += zf[tl * 17 + f] * w1[f * 64 + j];
      h1[j * 16 + tl] = fast_sin(f1[j] * a);
    }
    __syncthreads();
#pragma unroll
    for (int m = 0; m < 2; ++m) {
      const int j = kk + 32 * m;
      float a = b2[j];
#pragma unroll 16
      for (int i = 0; i < 64; ++i) a += h1[i * 16 + tl] * w2[i * 64 + j];
      h2[j * 16 + tl] = fast_sin(f2[j] * a);
    }
    __syncthreads();
#pragma unroll 1
    for (int mm = 0; mm < 3; ++mm) {
      const int col = tid + 512 * mm;
      float acc[16];
#pragma unroll
      for (int q = 0; q < 16; ++q) acc[q] = 0.f;
#pragma unroll 1
      for (int j0 = 0; j0 < 64; j0 += 8) {
        float wv[8];
#pragma unroll
        for (int q = 0; q < 8; ++q) wv[q] = w3[(size_t)(j0 + q) * 1536 + col];
#pragma unroll
        for (int q = 0; q < 8; ++q) {
          const float w = wv[q];
          const f32x4* hp = (const f32x4*)(h2 + (j0 + q) * 16);
          const f32x4 a0 = hp[0], a1 = hp[1], a2 = hp[2], a3 = hp[3];
          acc[0] += a0[0] * w; acc[1] += a0[1] * w; acc[2] += a0[2] * w; acc[3] += a0[3] * w;
          acc[4] += a1[0] * w; acc[5] += a1[1] * w; acc[6] += a1[2] * w; acc[7] += a1[3] * w;
          acc[8] += a2[0] * w; acc[9] += a2[1] * w; acc[10] += a2[2] * w; acc[11] += a2[3] * w;
          acc[12] += a3[0] * w; acc[13] += a3[1] * w; acc[14] += a3[2] * w; acc[15] += a3[3] * w;
        }
      }
      const int c = col % 384;
      const float lo = -3.0701134573253945f, hi = -15.350567286626972f;
      const float delta = fabsf(lo + (hi - lo) * ((float)c / 383.0f));
      float* dst = p.filtT + (size_t)col * 4096 + t0;
#pragma unroll
      for (int q = 0; q < 16; ++q) {
        const float tn = (float)(t0 + q) / 4095.0f;
        dst[q] = acc[q] * __expf(-tn * delta);
      }
    }
  }
}

__device__ void prep_phase(const P& p, int l, char* smem) {
  for (int w = 0; w < 7; ++w) {
    const float* W; const float* g; bf16_t* Bt; int K, N, Npad, mode = 0;
    switch (w) {
      case 0: W = p.w_in + (size_t)l * 1024 * 2336; K = 1024; N = 2336; Npad = 2560; g = p.norm1_g + l * 1024; Bt = p.Win; mode = 4; break;
      case 1: W = p.w_uq + (size_t)l * 256 * 576; K = 256; N = 576; Npad = 768; g = p.q_norm_g + l * 256; Bt = p.Wuq; mode = 6; break;
      case 2: W = p.w_ukv + (size_t)l * 128 * 768; K = 128; N = 768; Npad = 768; g = p.kv_norm_g + l * 128; Bt = p.Wukv; mode = 5; break;
      case 3: W = p.w_out + (size_t)l * 1024 * 1024; K = 1024; N = 1024; Npad = 1024; g = p.mix_g + l * 1024; Bt = p.Wout; mode = 3; break;
      case 4: W = p.w_gate + (size_t)l * 1024 * 2816; K = 1024; N = 2816; Npad = 2816; g = p.norm2_g + l * 1024; Bt = p.Wgu; mode = 1; break;
      case 5: W = p.w_up + (size_t)l * 1024 * 2816; K = 1024; N = 2816; Npad = 2816; g = p.norm2_g + l * 1024; Bt = p.Wgu; mode = 2; break;
      default: W = p.w_down + (size_t)l * 2816 * 1024; K = 2816; N = 1024; Npad = 1024; g = nullptr; Bt = p.Wdown; mode = 3; break;
    }
    conv_w(W, K, N, Npad, g, Bt, mode, smem);
  }
  filt_mlp(p, l, smem);
  if (l == 0) {
    int tid_ = threadIdx.x;
  asm volatile("" : "+v"(tid_));
  const int tid = tid_, lane = tid & 63, wave = tid >> 6;
    for (int row = blockIdx.x * 8 + wave; row < NTOK; row += gridDim.x * 8) {
      const float* xr = p.x + (size_t)row * 1024;
      bf16_t* xo = p.xb + (size_t)row * 1024;
      float s = 0.f;
#pragma unroll
      for (int i = 0; i < 4; ++i) {
        const f32x4 v = *(const f32x4*)(xr + lane * 4 + 256 * i);
        s += v[0] * v[0] + v[1] * v[1] + v[2] * v[2] + v[3] * v[3];
        u32x2 w;
        w.x = cvt_pk_bf16(v[0], v[1]);
        w.y = cvt_pk_bf16(v[2], v[3]);
        *(u32x2*)(xo + lane * 4 + 256 * i) = w;
      }
#pragma unroll
      for (int o = 1; o < 64; o <<= 1) s += __shfl_xor(s, o);
      if (lane < 16) p.part_x[(size_t)row * 16 + lane] = (lane == 0) ? s : 0.f;
    }
    for (int i = blockIdx.x * 512 + tid; i < 65536 + 8192; i += gridDim.x * 512) {
      if (i < 65536) {
        const int pos = i >> 4, k = i & 15;
        const float ang = (float)pos * __builtin_amdgcn_exp2f(-(float)k * 0.8304820237218405f);
        float s, c;
        fast_sincos_rev(ang * 0.15915494309189535f, &s, &c);
        p.ropecs[i] = make_float2(c, s);
      } else {
        const int k = i - 65536;
        const int ms = 1 << (31 - __clz(k + 1));
        const int pp = k + 1 - ms;
        float s, c;
        fast_sincos_rev((float)pp / (float)(2 * ms), &s, &c);
        p.tw[k] = make_float2(c, -s);
      }
    }
  }
}

template <int LOGR, int MTOP, bool INV, bool ZIN = false, bool HOUT = false>
__device__ __forceinline__ void fft_pass(float2* sm, const float2* tw) {
  constexpr int R = 1 << LOGR;
  constexpr int q = MTOP >> (LOGR - 1);
  constexpr int ntask = 8192 / R;
  for (int T = threadIdx.x; T < ntask; T += NTHREADS) {
    const int i = T & (q - 1);
    const int blk = T / q;
    const int base = blk * (2 * MTOP) + i;
    float2 v[R];
#pragma unroll
    for (int e = 0; e < R; ++e) {
      if (ZIN && e >= R / 2) v[e] = make_float2(0.f, 0.f);
      else v[e] = sm[PADI(base + e * q)];
    }
    if (!INV) {
#pragma unroll
      for (int s = 0; s < LOGR; ++s) {
        constexpr int dummy = 0;
        (void)dummy;
        const int hs = 1 << (LOGR - 1 - s);
        const int ms = MTOP >> s;
#pragma unroll
        for (int e = 0; e < R; ++e) {
          if ((e & hs) == 0) {
            const int pp = i + (e & (hs - 1)) * q;
            const float2 w = tw[(ms - 1) + pp];
            const float2 a = v[e], b = v[e + hs];
            v[e] = make_float2(a.x + b.x, a.y + b.y);
            const float dx = a.x - b.x, dy = a.y - b.y;
            v[e + hs] = make_float2(dx * w.x - dy * w.y, dx * w.y + dy * w.x);
          }
        }
      }
    } else {
#pragma unroll
      for (int s = LOGR - 1; s >= 0; --s) {
        const int hs = 1 << (LOGR - 1 - s);
        const int ms = MTOP >> s;
#pragma unroll
        for (int e = 0; e < R; ++e) {
          if ((e & hs) == 0) {
            const int pp = i + (e & (hs - 1)) * q;
            const float2 w = tw[(ms - 1) + pp];
            const float2 a = v[e], b = v[e + hs];
            const float tx = b.x * w.x + b.y * w.y, ty = b.y * w.x - b.x * w.y;
            v[e] = make_float2(a.x + tx, a.y + ty);
            v[e + hs] = make_float2(a.x - tx, a.y - ty);
          }
        }
      }
    }
#pragma unroll
    for (int e = 0; e < R; ++e) {
      if (HOUT && e >= R / 2) continue;
      sm[PADI(base + e * q)] = v[e];
    }
  }
  __syncthreads();
}

__device__ __forceinline__ void fft_fwd(float2* sm, const float2* tw) {
  fft_pass<4, 4096, false>(sm, tw);
  fft_pass<4, 256, false>(sm, tw);
  fft_pass<4, 16, false>(sm, tw);
  fft_pass<1, 1, false>(sm, tw);
}
__device__ __forceinline__ void fft_inv(float2* sm, const float2* tw) {
  fft_pass<1, 1, true>(sm, tw);
  fft_pass<3, 8, true>(sm, tw);
  fft_pass<3, 64, true>(sm, tw);
  fft_pass<3, 512, true>(sm, tw);
  fft_pass<3, 4096, true>(sm, tw);
}

__device__ void filt_fft_phase(const P& p, int l, char* smem) {
  float2* sm = (float2*)smem;
  float2* tws = (float2*)(smem + TW_LDS_OFF);
  int tid_ = threadIdx.x;
  asm volatile("" : "+v"(tid_));
  const int tid = tid_;
  for (int i = tid; i < 8192; i += NTHREADS) tws[i] = p.tw[i];
  for (int jj = blockIdx.x; jj < 384; jj += gridDim.x) {
    const int o = jj / 192, c = jj % 192;
    const int jobF = o * 384 + c, jobG = jobF + 192;
    const float* hf1 = p.filtT + ((size_t)((o * 2 + 0) * 384 + c)) * 4096;
    const float* hb1 = p.filtT + ((size_t)((o * 2 + 1) * 384 + c)) * 4096;
    const float* hf2 = hf1 + (size_t)192 * 4096;
    const float* hb2 = hb1 + (size_t)192 * 4096;
    const float sk1 = p.skip[(l * 2 + o) * 384 + c], sk2 = p.skip[(l * 2 + o) * 384 + c + 192];
    __syncthreads();
    for (int n = tid; n < 8192; n += NTHREADS) {
      float v1, v2;
      if (n == 0) { v1 = hf1[0] + hb1[0] + sk1; v2 = hf2[0] + hb2[0] + sk2; }
      else if (n < 4096) { v1 = hf1[n]; v2 = hf2[n]; }
      else if (n == 4096) { v1 = 0.f; v2 = 0.f; }
      else { v1 = hb1[8192 - n]; v2 = hb2[8192 - n]; }
      sm[PADI(n)] = make_float2(v1, v2);
    }
    __syncthreads();
    fft_fwd(sm, tws);
    float2* dF = p.H2 + (size_t)jobF * 8192;
    float2* dG = p.H2 + (size_t)jobG * 8192;
    const float sc = 0.5f / 8192.0f;
    for (int n = tid; n < 8192; n += NTHREADS) {
      const int k = (int)(__brev((unsigned)n) >> 19);
      const int np = (int)(__brev((unsigned)((8192 - k) & 8191)) >> 19);
      const float2 a = sm[PADI(n)], b = sm[PADI(np)];
      dF[n] = make_float2((a.x + b.x) * sc, (a.y - b.y) * sc);
      dG[n] = make_float2((a.y + b.y) * sc, (b.x - a.x) * sc);
    }
  }
}

__device__ __forceinline__ float short_conv(const bf16_t* row, int t, float w0, float w1, float w2, float bias) {
  const float xm = (t > 0) ? bf2f(row[t - 1]) : 0.f;
  const float x0 = bf2f(row[t]);
  const float xp = (t < SEQ - 1) ? bf2f(row[t + 1]) : 0.f;
  return w0 * xm + w1 * x0 + w2 * xp + bias;
}

__device__ __forceinline__ void conv8(const bf16_t* row, int t0, float w0, float w1, float w2, float bias, float (&out)[8]) {
  const u32x4 v = *(const u32x4*)(row + t0);
  float x[10];
  x[0] = (t0 > 0) ? bf2f(row[t0 - 1]) : 0.f;
  x[1] = bflo(v.x); x[2] = bfhi(v.x); x[3] = bflo(v.y); x[4] = bfhi(v.y);
  x[5] = bflo(v.z); x[6] = bfhi(v.z); x[7] = bflo(v.w); x[8] = bfhi(v.w);
  x[9] = (t0 + 8 < SEQ) ? bf2f(row[t0 + 8]) : 0.f;
#pragma unroll
  for (int k = 0; k < 8; ++k) out[k] = w0 * x[k] + w1 * x[k + 1] + w2 * x[k + 2] + bias;
}

struct RawRow { u32x4 v; float lo, hi; };
__device__ __forceinline__ RawRow load_raw(const bf16_t* row, int t0) {
  RawRow r;
  r.v = *(const u32x4*)(row + t0);
  r.lo = (t0 > 0) ? bf2f(row[t0 - 1]) : 0.f;
  r.hi = (t0 + 8 < SEQ) ? bf2f(row[t0 + 8]) : 0.f;
  return r;
}
__device__ __forceinline__ void conv8_raw(const RawRow& r, float w0, float w1, float w2, float bias, float (&out)[8]) {
  float x[10];
  x[0] = r.lo;
  x[1] = bflo(r.v.x); x[2] = bfhi(r.v.x); x[3] = bflo(r.v.y); x[4] = bfhi(r.v.y);
  x[5] = bflo(r.v.z); x[6] = bfhi(r.v.z); x[7] = bflo(r.v.w); x[8] = bfhi(r.v.w);
  x[9] = r.hi;
#pragma unroll
  for (int k = 0; k < 8; ++k) out[k] = w0 * x[k] + w1 * x[k + 1] + w2 * x[k + 2] + bias;
}

__device__ __forceinline__ void fft_mid(float2* sm, const f32x4 (&hpre)[8]) {
#pragma unroll
  for (int it = 0; it < 8; ++it) {
    const int T = threadIdx.x + it * NTHREADS;
    const float2 a = sm[PADI(2 * T)], b = sm[PADI(2 * T + 1)];
    const f32x4 h = hpre[it];
    const float sx = a.x + b.x, sy = a.y + b.y, dx = a.x - b.x, dy = a.y - b.y;
    const float Ax = sx * h[0] - sy * h[1], Ay = sx * h[1] + sy * h[0];
    const float Bx = dx * h[2] - dy * h[3], By = dx * h[3] + dy * h[2];
    sm[PADI(2 * T)] = make_float2(Ax + Bx, Ay + By);
    sm[PADI(2 * T + 1)] = make_float2(Ax - Bx, Ay - By);
  }
  __syncthreads();
}

template <int ORD>
__device__ void hyena_phase(const P& p, int l, char* smem) {
  float2* sm = (float2*)smem;
  float2* tws = (float2*)(smem + TW_LDS_OFF);
  int tid_ = threadIdx.x;
  asm volatile("" : "+v"(tid_));
  const int tid = tid_;
  for (int i = tid; i < 8192; i += NTHREADS) tws[i] = p.tw[i];
  const float* cw = p.conv_w + (size_t)l * 3 * 1152;
  const float* cb = p.conv_b + (size_t)l * 1152;
  const int t0 = tid * 8;
  for (int job = vblock(); job < 1536; job += gridDim.x) {
    const int pair = job & 3, c = job >> 2;
    const int b1 = pair * 2, b2 = b1 + 1;
    const int gc = (ORD == 0 ? 384 : 768) + c;
    const RawRow gr1 = load_raw(p.hyT + ((size_t)(b1 * 1152 + gc)) * 4096, t0);
    const RawRow gr2 = load_raw(p.hyT + ((size_t)(b2 * 1152 + gc)) * 4096, t0);
    __syncthreads();
    {
      float u1[8], u2[8];
      if (ORD == 0) {
        const bf16_t* r1 = p.hyT + ((size_t)(b1 * 1152 + c)) * 4096;
        const bf16_t* r2 = p.hyT + ((size_t)(b2 * 1152 + c)) * 4096;
        const float w0 = cw[c], w1 = cw[1152 + c], w2 = cw[2304 + c], bi = cb[c];
        conv8(r1, t0, w0, w1, w2, bi, u1);
        conv8(r2, t0, w0, w1, w2, bi, u2);
      } else {
        const u32x4 a0 = *(const u32x4*)(p.z1T + ((size_t)(b1 * 384 + c)) * 4096 + t0);
        const u32x4 c0_ = *(const u32x4*)(p.z1T + ((size_t)(b2 * 384 + c)) * 4096 + t0);
        u1[0] = bflo(a0.x); u1[1] = bfhi(a0.x); u1[2] = bflo(a0.y); u1[3] = bfhi(a0.y); u1[4] = bflo(a0.z); u1[5] = bfhi(a0.z); u1[6] = bflo(a0.w); u1[7] = bfhi(a0.w);
        u2[0] = bflo(c0_.x); u2[1] = bfhi(c0_.x); u2[2] = bflo(c0_.y); u2[3] = bfhi(c0_.y); u2[4] = bflo(c0_.z); u2[5] = bfhi(c0_.z); u2[6] = bflo(c0_.w); u2[7] = bfhi(c0_.w);
      }
#pragma unroll
      for (int k = 0; k < 8; ++k) {
        sm[PADI(t0 + k)] = make_float2(u1[k], u2[k]);
      }
    }
    __syncthreads();
    fft_pass<4, 4096, false, true, false>(sm, tws);
    fft_pass<4, 256, false>(sm, tws);
    f32x4 hpre[8];
    {
      const float2* H = p.H2 + ((size_t)(ORD * 384 + c)) * 8192;
#pragma unroll
      for (int it = 0; it < 8; ++it) hpre[it] = *(const f32x4*)(H + 2 * (tid + it * NTHREADS));
    }
    fft_pass<4, 16, false>(sm, tws);
    fft_mid(sm, hpre);
    fft_pass<4, 16, true>(sm, tws);
    fft_pass<4, 256, true>(sm, tws);
    fft_pass<4, 4096, true, false, true>(sm, tws);
    {
      const float w0 = cw[gc], w1 = cw[1152 + gc], w2 = cw[2304 + gc], bi = cb[gc];
      float q1[8], q2[8];
      conv8_raw(gr1, w0, w1, w2, bi, q1);
      conv8_raw(gr2, w0, w1, w2, bi, q2);
#pragma unroll
      for (int k = 0; k < 8; ++k) {
        const float2 yv = sm[PADI(t0 + k)];
        q1[k] *= yv.x;
        q2[k] *= yv.y;
      }
      {
        bf16_t* dbase = (ORD == 0) ? p.z1T : p.ybT;
        u32x4 w1_, w2_;
        w1_.x = cvt_pk_bf16(q1[0], q1[1]); w1_.y = cvt_pk_bf16(q1[2], q1[3]); w1_.z = cvt_pk_bf16(q1[4], q1[5]); w1_.w = cvt_pk_bf16(q1[6], q1[7]);
        w2_.x = cvt_pk_bf16(q2[0], q2[1]); w2_.y = cvt_pk_bf16(q2[2], q2[3]); w2_.z = cvt_pk_bf16(q2[4], q2[5]); w2_.w = cvt_pk_bf16(q2[6], q2[7]);
        *(u32x4*)(dbase + ((size_t)(b1 * 384 + c)) * 4096 + t0) = w1_;
        *(u32x4*)(dbase + ((size_t)(b2 * 384 + c)) * 4096 + t0) = w2_;
      }
    }
  }
}

constexpr int KROW = 208;
constexpr int VROW = 136;
constexpr int KBUF = 64 * KROW, VBUF = 64 * VROW;

constexpr int NK_ROW = 528;
constexpr int NK_BUF = 32 * NK_ROW;
constexpr int NV_ROW = 72;
constexpr int NV_BUF = 256 * NV_ROW;
constexpr int NRPB_OFF = 2 * NK_BUF + 2 * NV_BUF;

__device__ void natten_phase(const P& p, int l, char* smem) {
  int tid_ = threadIdx.x;
  asm volatile("" : "+v"(tid_));
  const int tid = tid_, lane = tid & 63, wave = tid >> 6, l15 = lane & 15, g = lane >> 4;
  const int hw = wave >> 1, qh = wave & 1;
  char* Ks = smem;
  char* Vs = smem + 2 * NK_BUF;
  float* rp = (float*)(smem + NRPB_OFF);
  __syncthreads();
  for (int i = tid; i < 4 * 15 * 31; i += NTHREADS) rp[i] = p.rpb[(size_t)l * 4 * 15 * 31 + i] * 1.4426950408889634f;
  const float qscale = 0.125f * 1.4426950408889634f;
  for (int job = blockIdx.x; job < 512; job += gridDim.x) {
    const int r = job & 63, b = job >> 6;
    const int r0 = min(max(r - 4, 0), 56);
    bf16x8 qf[2][2];
    int cq[2], c0[2];
#pragma unroll
    for (int nt = 0; nt < 2; ++nt) {
      cq[nt] = qh * 32 + nt * 16 + l15;
      c0[nt] = min(max(cq[nt] - 8, 0), 48);
      const bf16_t* qp = p.na + (size_t)(b * 4096 + r * 64 + cq[nt]) * 768 + hw * 64;
#pragma unroll
      for (int ks = 0; ks < 2; ++ks) qf[nt][ks] = *(const bf16x8*)(qp + ks * 32 + g * 8);
    }
    f32x4 o[4][2];
#pragma unroll
    for (int a = 0; a < 4; ++a)
#pragma unroll
      for (int n = 0; n < 2; ++n) o[a][n] = (f32x4){0.f, 0.f, 0.f, 0.f};
    float mrow[2] = {-1e30f, -1e30f}, lrow[2] = {0.f, 0.f};
    u32x4 rk[2], rv[2];
    auto gload = [&](int t) {
      const int kr = r0 + (t >> 1), kh = (t & 1) * 32;
      const bf16_t* kbase = p.na + (size_t)(b * 4096 + kr * 64 + kh) * 768 + 256;
#pragma unroll
      for (int i = 0; i < 2; ++i) {
        const int c = tid + 512 * i, key = c >> 5, cc = c & 31;
        rk[i] = *(const u32x4*)(kbase + (size_t)key * 768 + cc * 8);
      }
#pragma unroll
      for (int i = 0; i < 2; ++i) {
        const int c = tid + 512 * i, row = c >> 2, cc = c & 3;
        rv[i] = *(const u32x4*)(p.naVT + ((size_t)(b * 256 + row)) * 4096 + kr * 64 + kh + cc * 8);
      }
    };
    auto lstore = [&](int buf) {
      char* kb_ = Ks + buf * NK_BUF;
      char* vb_ = Vs + buf * NV_BUF;
#pragma unroll
      for (int i = 0; i < 2; ++i) {
        const int c = tid + 512 * i, key = c >> 5, cc = c & 31;
        *(u32x4*)(kb_ + key * NK_ROW + cc * 16) = rk[i];
      }
#pragma unroll
      for (int i = 0; i < 2; ++i) {
        const int c = tid + 512 * i, row = c >> 2, cc = c & 3;
        u32x2 lo, hi;
        lo.x = rv[i].x; lo.y = rv[i].y; hi.x = rv[i].z; hi.y = rv[i].w;
        *(u32x2*)(vb_ + row * NV_ROW + cc * 16) = lo;
        *(u32x2*)(vb_ + row * NV_ROW + cc * 16 + 8) = hi;
      }
    };
    gload(0);
    __syncthreads();
    lstore(0);
    gload(1);
    for (int t = 0; t < 16; ++t) {
      __syncthreads();
      if (t + 1 < 16) {
        lstore((t + 1) & 1);
        if (t + 2 < 16) gload(t + 2);
      }
      __builtin_amdgcn_sched_barrier(0);
      const char* kb_ = Ks + (t & 1) * NK_BUF;
      const char* vb_ = Vs + (t & 1) * NV_BUF + hw * 64 * NV_ROW;
      const int kh = (t & 1) * 32;
      f32x4 s[2][2];
#pragma unroll
      for (int a = 0; a < 2; ++a)
#pragma unroll
        for (int n = 0; n < 2; ++n) s[a][n] = (f32x4){0.f, 0.f, 0.f, 0.f};
#pragma unroll
      for (int mt = 0; mt < 2; ++mt)
#pragma unroll
        for (int ks = 0; ks < 2; ++ks) {
          const bf16x8 kf = *(const bf16x8*)(kb_ + (mt * 16 + l15) * NK_ROW + hw * 128 + ks * 64 + g * 16);
#pragma unroll
          for (int nt = 0; nt < 2; ++nt)
            s[mt][nt] = __builtin_amdgcn_mfma_f32_16x16x32_bf16(kf, qf[nt][ks], s[mt][nt], 0, 0, 0);
        }
      const float* brow = rp + (hw * 15 + (r0 + (t >> 1) - r + 7)) * 31;
      bf16x8 pf[2];
#pragma unroll
      for (int nt = 0; nt < 2; ++nt) {
        float mx = -1e30f;
#pragma unroll
        for (int mt = 0; mt < 2; ++mt)
#pragma unroll
          for (int j = 0; j < 4; ++j) {
            const int kc = kh + mt * 16 + g * 4 + j;
            const bool valid = (unsigned)(kc - c0[nt]) < 16u;
            const int dc = min(max(kc - cq[nt] + 15, 0), 30);
            const float sc = valid ? (s[mt][nt][j] * qscale + brow[dc]) : -1e30f;
            s[mt][nt][j] = sc;
            mx = fmaxf(mx, sc);
          }
        mx = fmaxf(mx, __shfl_xor(mx, 16));
        mx = fmaxf(mx, __shfl_xor(mx, 32));
        const float mnew = fmaxf(mrow[nt], mx);
        const float alpha = __builtin_amdgcn_exp2f(mrow[nt] - mnew);
        mrow[nt] = mnew;
        float ls = 0.f;
#pragma unroll
        for (int mt = 0; mt < 2; ++mt)
#pragma unroll
          for (int j = 0; j < 4; ++j) {
            const float e = (s[mt][nt][j] > -1e29f) ? __builtin_amdgcn_exp2f(s[mt][nt][j] - mnew) : 0.f;
            s[mt][nt][j] = e;
            ls += e;
          }
        lrow[nt] = lrow[nt] * alpha + ls;
#pragma unroll
        for (int a = 0; a < 4; ++a) o[a][nt] *= alpha;
        u32x4 w;
        w.x = cvt_pk_bf16(s[0][nt][0], s[0][nt][1]);
        w.y = cvt_pk_bf16(s[0][nt][2], s[0][nt][3]);
        w.z = cvt_pk_bf16(s[1][nt][0], s[1][nt][1]);
        w.w = cvt_pk_bf16(s[1][nt][2], s[1][nt][3]);
        pf[nt] = __builtin_bit_cast(bf16x8, w);
      }
#pragma unroll
      for (int mt = 0; mt < 4; ++mt) {
        const u32x2 lo = *(const u32x2*)(vb_ + (mt * 16 + l15) * NV_ROW + (4 * g) * 2);
        const u32x2 hi = *(const u32x2*)(vb_ + (mt * 16 + l15) * NV_ROW + (16 + 4 * g) * 2);
        u32x4 w;
        w.x = lo.x; w.y = lo.y; w.z = hi.x; w.w = hi.y;
        const bf16x8 vf = __builtin_bit_cast(bf16x8, w);
#pragma unroll
        for (int nt = 0; nt < 2; ++nt)
          o[mt][nt] = __builtin_amdgcn_mfma_f32_16x16x32_bf16(vf, pf[nt], o[mt][nt], 0, 0, 0);
      }
    }
#pragma unroll
    for (int nt = 0; nt < 2; ++nt) {
      float lt = lrow[nt];
      lt += __shfl_xor(lt, 16);
      lt += __shfl_xor(lt, 32);
      const float inv = 1.0f / lt;
      const int tok = b * 4096 + r * 64 + cq[nt];
#pragma unroll
      for (int mt = 0; mt < 4; ++mt) {
        u32x2 w;
        w.x = cvt_pk_bf16(o[mt][nt][0] * inv, o[mt][nt][1] * inv);
        w.y = cvt_pk_bf16(o[mt][nt][2] * inv, o[mt][nt][3] * inv);
        *(u32x2*)(p.o_c + (size_t)tok * 256 + hw * 64 + mt * 16 + g * 4) = w;
      }
    }
  }
}


__device__ void attn_phase(const P& p, char* smem) {
  int tid_ = threadIdx.x;
  asm volatile("" : "+v"(tid_));
  const int tid = tid_, lane = tid & 63, wave = tid >> 6, l15 = lane & 15, g = lane >> 4;
  char* Ks = smem;
  char* Vs = smem + 2 * KBUF;
  for (int job = vblock(); job < 768; job += gridDim.x) {
    const int qblk = job & 15, bh = job >> 4;
    const int b = bh / 6, h = bh % 6;
    const bf16_t* Q = p.qb + (size_t)bh * 4096 * 96;
    const bf16_t* Kg = p.kb + (size_t)bh * 4096 * 96;
    const bf16_t* Vt = p.vT + (size_t)bh * 64 * 4096;
    const int q0 = qblk * 256 + wave * 32;
    bf16x8 qf[2][3];
#pragma unroll
    for (int nt = 0; nt < 2; ++nt)
#pragma unroll
      for (int ks = 0; ks < 3; ++ks)
        qf[nt][ks] = *(const bf16x8*)(Q + (size_t)(q0 + nt * 16 + l15) * 96 + ks * 32 + g * 8);
    f32x4 o[4][2];
#pragma unroll
    for (int a = 0; a < 4; ++a)
#pragma unroll
      for (int n = 0; n < 2; ++n) o[a][n] = (f32x4){0.f, 0.f, 0.f, 0.f};
    float mrow[2] = {-1e30f, -1e30f}, lrow[2] = {0.f, 0.f};

    u32x4 rk[2];
    u32x4 rv;
    const int kr1 = (tid + 512) / 12, kc1 = (tid + 512) - kr1 * 12;
    const int kr0 = tid / 12, kc0 = tid - kr0 * 12;
    auto gload = [&](int kt) {
      const u32x4* kp = (const u32x4*)(Kg + (size_t)kt * 64 * 96);
      rk[0] = kp[tid];
      if (tid < 256) rk[1] = kp[tid + 512];
      rv = *(const u32x4*)(Vt + (size_t)(tid >> 3) * 4096 + kt * 64 + (tid & 7) * 8);
    };
    auto lstore = [&](int buf) {
      char* kb_ = Ks + buf * KBUF;
      char* vb_ = Vs + buf * VBUF;
      *(u32x4*)(kb_ + kr0 * KROW + kc0 * 16) = rk[0];
      if (tid < 256) *(u32x4*)(kb_ + kr1 * KROW + kc1 * 16) = rk[1];
      u32x2 lo, hi;
      lo.x = rv.x; lo.y = rv.y; hi.x = rv.z; hi.y = rv.w;
      *(u32x2*)(vb_ + (tid >> 3) * VROW + (tid & 7) * 16) = lo;
      *(u32x2*)(vb_ + (tid >> 3) * VROW + (tid & 7) * 16 + 8) = hi;
    };
    const int NKT = 64;
    gload(0);
    __syncthreads();
    lstore(0);
    gload(1);
    for (int kt = 0; kt < NKT; ++kt) {
      __syncthreads();
      if (kt + 1 < NKT) {
        lstore((kt + 1) & 1);
        if (kt + 2 < NKT) gload(kt + 2);
      }
      __builtin_amdgcn_sched_barrier(0);
      const char* kb_ = Ks + (kt & 1) * KBUF;
      const char* vb_ = Vs + (kt & 1) * VBUF;
      f32x4 s[4][2];
#pragma unroll
      for (int a = 0; a < 4; ++a)
#pragma unroll
        for (int n = 0; n < 2; ++n) s[a][n] = (f32x4){0.f, 0.f, 0.f, 0.f};
#pragma unroll
      for (int mt = 0; mt < 4; ++mt)
#pragma unroll
        for (int ks = 0; ks < 3; ++ks) {
          const bf16x8 kf = *(const bf16x8*)(kb_ + (mt * 16 + l15) * KROW + (ks * 32 + g * 8) * 2);
#pragma unroll
          for (int nt = 0; nt < 2; ++nt)
            s[mt][nt] = __builtin_amdgcn_mfma_f32_16x16x32_bf16(kf, qf[nt][ks], s[mt][nt], 0, 0, 0);
        }
      bf16x8 pf[2][2];
#pragma unroll
      for (int nt = 0; nt < 2; ++nt) {
        float mx = s[0][nt][0];
#pragma unroll
        for (int mt = 0; mt < 4; ++mt)
#pragma unroll
          for (int j = 0; j < 4; ++j) mx = fmaxf(mx, s[mt][nt][j]);
        mx = fmaxf(mx, __shfl_xor(mx, 16));
        mx = fmaxf(mx, __shfl_xor(mx, 32));
        if (__any(mx > mrow[nt] + 8.0f)) {
          const float mnew = fmaxf(mrow[nt], mx);
          const float alpha = __builtin_amdgcn_exp2f(mrow[nt] - mnew);
          mrow[nt] = mnew;
          lrow[nt] *= alpha;
#pragma unroll
          for (int a = 0; a < 4; ++a) o[a][nt] *= alpha;
        }
        const float mref = mrow[nt];
        float ls = 0.f;
#pragma unroll
        for (int mt = 0; mt < 4; ++mt)
#pragma unroll
          for (int j = 0; j < 4; ++j) {
            const float e = __builtin_amdgcn_exp2f(s[mt][nt][j] - mref);
            s[mt][nt][j] = e;
            ls += e;
          }
        lrow[nt] += ls;
#pragma unroll
        for (int kk = 0; kk < 2; ++kk) {
          u32x4 w;
          w.x = cvt_pk_bf16(s[2 * kk][nt][0], s[2 * kk][nt][1]);
          w.y = cvt_pk_bf16(s[2 * kk][nt][2], s[2 * kk][nt][3]);
          w.z = cvt_pk_bf16(s[2 * kk + 1][nt][0], s[2 * kk + 1][nt][1]);
          w.w = cvt_pk_bf16(s[2 * kk + 1][nt][2], s[2 * kk + 1][nt][3]);
          pf[kk][nt] = __builtin_bit_cast(bf16x8, w);
        }
      }
#pragma unroll
      for (int kk = 0; kk < 2; ++kk)
#pragma unroll
        for (int mt = 0; mt < 4; ++mt) {
          const u32x2 lo = *(const u32x2*)(vb_ + (mt * 16 + l15) * VROW + (32 * kk + 4 * g) * 2);
          const u32x2 hi = *(const u32x2*)(vb_ + (mt * 16 + l15) * VROW + (32 * kk + 16 + 4 * g) * 2);
          u32x4 w;
          w.x = lo.x; w.y = lo.y; w.z = hi.x; w.w = hi.y;
          const bf16x8 vf = __builtin_bit_cast(bf16x8, w);
#pragma unroll
          for (int nt = 0; nt < 2; ++nt)
            o[mt][nt] = __builtin_amdgcn_mfma_f32_16x16x32_bf16(vf, pf[kk][nt], o[mt][nt], 0, 0, 0);
        }
    }
#pragma unroll
    for (int nt = 0; nt < 2; ++nt) {
      float lt = lrow[nt];
      lt += __shfl_xor(lt, 16);
      lt += __shfl_xor(lt, 32);
      const float inv = 1.0f / lt;
      const int tok = b * 4096 + q0 + nt * 16 + l15;
#pragma unroll
      for (int mt = 0; mt < 4; ++mt) {
        u32x2 w;
        w.x = cvt_pk_bf16(o[mt][nt][0] * inv, o[mt][nt][1] * inv);
        w.y = cvt_pk_bf16(o[mt][nt][2] * inv, o[mt][nt][3] * inv);
        *(u32x2*)(p.o_a + (size_t)tok * 384 + h * 64 + mt * 16 + g * 4) = w;
      }
    }
  }
}

__device__ void mixnorm_phase(const P& p, char* smem) {
  int tid_ = threadIdx.x;
  asm volatile("" : "+v"(tid_));
  const int tid = tid_;
  for (int job = blockIdx.x; job < NTOK / 32; job += gridDim.x) {
    const int tok0 = job * 32, b = tok0 >> 12, s0 = tok0 & 4095;
    __syncthreads();
#pragma unroll
    for (int i = 0; i < 3; ++i) {
      const int c = tid + 512 * i, row = c / 48, cc = c % 48;
      *(u32x4*)(smem + row * 2048 + cc * 16) = *(const u32x4*)(p.o_a + (size_t)(tok0 + row) * 384 + cc * 8);
    }
#pragma unroll
    for (int i = 0; i < 2; ++i) {
      const int c = tid + 512 * i, row = c >> 5, cc = c & 31;
      *(u32x4*)(smem + row * 2048 + 1536 + cc * 16) = *(const u32x4*)(p.o_c + (size_t)(tok0 + row) * 256 + cc * 8);
    }
#pragma unroll
    for (int i = 0; i < 3; ++i) {
      const int c = tid + 512 * i, ch = c >> 2, tc = c & 3;
      const u32x4 v = *(const u32x4*)(p.ybT + ((size_t)(b * 384 + ch)) * 4096 + s0 + tc * 8);
      bf16_t* dst = (bf16_t*)smem + (size_t)(tc * 8) * 1024 + 384 + ch;
      dst[0 * 1024] = (bf16_t)(v.x & 0xffff); dst[1 * 1024] = (bf16_t)(v.x >> 16);
      dst[2 * 1024] = (bf16_t)(v.y & 0xffff); dst[3 * 1024] = (bf16_t)(v.y >> 16);
      dst[4 * 1024] = (bf16_t)(v.z & 0xffff); dst[5 * 1024] = (bf16_t)(v.z >> 16);
      dst[6 * 1024] = (bf16_t)(v.w & 0xffff); dst[7 * 1024] = (bf16_t)(v.w >> 16);
    }
    __syncthreads();
    const int tok = tid >> 4, sub = tid & 15;
    float ss[3] = {0.f, 0.f, 0.f};
#pragma unroll
    for (int gi = 0; gi < 3; ++gi) {
      const int i0 = (gi == 0) ? 0 : (gi == 1 ? 3 : 6), i1 = (gi == 0) ? 3 : (gi == 1 ? 6 : 8);
      float acc = 0.f;
#pragma unroll 2
      for (int i = i0; i < i1; ++i) {
        const u32x4 v = *(const u32x4*)(smem + tok * 2048 + (sub + 16 * i) * 16);
        float a;
        a = bflo(v.x); acc += a * a; a = bfhi(v.x); acc += a * a;
        a = bflo(v.y); acc += a * a; a = bfhi(v.y); acc += a * a;
        a = bflo(v.z); acc += a * a; a = bfhi(v.z); acc += a * a;
        a = bflo(v.w); acc += a * a; a = bfhi(v.w); acc += a * a;
      }
      acc += __shfl_xor(acc, 1);
      acc += __shfl_xor(acc, 2);
      acc += __shfl_xor(acc, 4);
      acc += __shfl_xor(acc, 8);
      ss[gi] = acc;
    }
    float rs[3];
    rs[0] = rsqrtf(ss[0] * (1.0f / 384.0f) + 1e-6f);
    rs[1] = rsqrtf(ss[1] * (1.0f / 384.0f) + 1e-6f);
    rs[2] = rsqrtf(ss[2] * (1.0f / 256.0f) + 1e-6f);
#pragma unroll
    for (int gi = 0; gi < 3; ++gi) {
      const int i0 = (gi == 0) ? 0 : (gi == 1 ? 3 : 6), i1 = (gi == 0) ? 3 : (gi == 1 ? 6 : 8);
      const float r = rs[gi];
#pragma unroll 2
      for (int i = i0; i < i1; ++i) {
        const u32x4 v = *(const u32x4*)(smem + tok * 2048 + (sub + 16 * i) * 16);
        u32x4 w;
        w.x = cvt_pk_bf16(bflo(v.x) * r, bfhi(v.x) * r);
        w.y = cvt_pk_bf16(bflo(v.y) * r, bfhi(v.y) * r);
        w.z = cvt_pk_bf16(bflo(v.z) * r, bfhi(v.z) * r);
        w.w = cvt_pk_bf16(bflo(v.w) * r, bfhi(v.w) * r);
        *(u32x4*)(p.y + (size_t)(tok0 + tok) * 1024 + (sub + 16 * i) * 8) = w;
      }
    }
  }
}

enum { EPI_INPROJ = 0, EPI_QUP = 1, EPI_KVUP = 2, EPI_OUTPROJ = 3, EPI_SWIGLU = 4, EPI_DOWN = 5 };

template <int EPI>
__device__ void gemm_phase(const P& p, int l, const bf16_t* __restrict__ A, int lda, const bf16_t* __restrict__ Bt,
                           int K, int nN, char* smem) {
  int tid_ = threadIdx.x;
  asm volatile("" : "+v"(tid_));
  const int tid = tid_, lane = tid & 63, wave = tid >> 6, wm = wave >> 2, wn = wave & 3, l15 = lane & 15,
            g = lane >> 4;
  const int ntiles = 128 * nN;
  const int srow = tid >> 3, skc = tid & 7;
  const int sw_off = srow * 128 + ((skc ^ ((srow >> 1) & 7)) * 16);
  const int rsw = (l15 >> 1) & 7;
  for (int tile = vblock(); tile < ntiles; tile += gridDim.x) {
    const int gsz_ = 4 * nN, grp_ = tile / gsz_, w_ = tile - grp_ * gsz_;
    const int ni = w_ >> 2, mi = grp_ * 4 + (w_ & 3);
    const int m0 = mi * 256, n0 = ni * 256;
    f32x4 acc[8][4];
#pragma unroll
    for (int a = 0; a < 8; ++a)
#pragma unroll
      for (int b = 0; b < 4; ++b) acc[a][b] = (f32x4){0.f, 0.f, 0.f, 0.f};
    const bf16_t* Ag = A + (size_t)(m0 + srow) * lda + skc * 8;
    const bf16_t* Bg = Bt + (size_t)(n0 + srow) * K + skc * 8;
    u32x4 ra[4], rb[4];
    auto gl = [&](int kt) {
#pragma unroll
      for (int i = 0; i < 4; ++i) ra[i] = *(const u32x4*)(Ag + (size_t)i * 64 * lda + kt * 64);
#pragma unroll
      for (int i = 0; i < 4; ++i) rb[i] = *(const u32x4*)(Bg + (size_t)i * 64 * K + kt * 64);
    };
    auto st = [&](int buf) {
      char* nb = smem + buf * 65536;
#pragma unroll
      for (int i = 0; i < 4; ++i) *(u32x4*)(nb + sw_off + i * 8192) = ra[i];
#pragma unroll
      for (int i = 0; i < 4; ++i) *(u32x4*)(nb + 32768 + sw_off + i * 8192) = rb[i];
    };
    const int nk = K / 64;
    gl(0);
    float rs_row = 1.f;
    if (EPI == EPI_INPROJ || EPI == EPI_SWIGLU) {
      if (tid < 256) {
        const f32x4* pp = (const f32x4*)(p.part_x + (size_t)(m0 + tid) * 16);
        const f32x4 a0 = pp[0], a1 = pp[1], a2 = pp[2], a3 = pp[3];
        const float tot = (a0[0] + a0[1] + a0[2] + a0[3]) + (a1[0] + a1[1] + a1[2] + a1[3]) +
                          (a2[0] + a2[1] + a2[2] + a2[3]) + (a3[0] + a3[1] + a3[2] + a3[3]);
        rs_row = rsqrtf(tot * (1.0f / 1024.0f) + 1e-6f);
      }
    } else if (EPI == EPI_QUP) {
      if (tid < 256) {
        const f32x4 a0 = *(const f32x4*)(p.part_q + (size_t)(m0 + tid) * 4);
        rs_row = rsqrtf((a0[0] + a0[1] + a0[2] + a0[3]) * (1.0f / 256.0f) + 1e-6f);
      }
    } else if (EPI == EPI_KVUP) {
      if (tid < 256) {
        const float2 a0 = *(const float2*)(p.part_kv + (size_t)(m0 + tid) * 2);
        rs_row = rsqrtf((a0.x + a0.y) * (1.0f / 128.0f) + 1e-6f);
      }
    }
    float* s_rs = (float*)(smem + 131072);
    __syncthreads();
    st(0);
    if (EPI != EPI_OUTPROJ && EPI != EPI_DOWN && true) {
      if (tid < 256) s_rs[tid] = rs_row;
    }
    __syncthreads();
    for (int kt = 0; kt < nk; ++kt) {
      if (kt + 1 < nk) gl(kt + 1);
      __builtin_amdgcn_sched_barrier(0);
      const char* Ab = smem + (kt & 1) * 65536;
      const char* Bb = Ab + 32768;
#pragma unroll
      for (int ks = 0; ks < 2; ++ks) {
        bf16x8 bfr[4];
#pragma unroll
        for (int nt = 0; nt < 4; ++nt)
          bfr[nt] = *(const bf16x8*)(Bb + (wn * 64 + nt * 16 + l15) * 128 + (((ks * 4 + g) ^ rsw) * 16));
        bf16x8 af[2][2];
#pragma unroll
        for (int mt = 0; mt < 2; ++mt)
          af[0][mt] = *(const bf16x8*)(Ab + (wm * 128 + mt * 16 + l15) * 128 + (((ks * 4 + g) ^ rsw) * 16));
#pragma unroll
        for (int mh = 0; mh < 4; ++mh) {
          if (mh < 3) {
#pragma unroll
            for (int mt = 0; mt < 2; ++mt)
              af[(mh + 1) & 1][mt] = *(const bf16x8*)(Ab + (wm * 128 + ((mh + 1) * 2 + mt) * 16 + l15) * 128 + (((ks * 4 + g) ^ rsw) * 16));
          }
          __builtin_amdgcn_sched_barrier(0);
#pragma unroll
          for (int mt = 0; mt < 2; ++mt)
#pragma unroll
            for (int nt = 0; nt < 4; ++nt)
              acc[mh * 2 + mt][nt] = __builtin_amdgcn_mfma_f32_16x16x32_bf16(bfr[nt], af[mh & 1][mt], acc[mh * 2 + mt][nt], 0, 0, 0);
          __builtin_amdgcn_sched_barrier(0);
        }
      }
      if (kt + 1 < nk) st((kt + 1) & 1);
      __syncthreads();
    }
    int opq_ = 0;
    asm volatile("" : "+v"(opq_));
    const int rbase = m0 + wm * 128 + l15 + opq_;
    const int cbase = n0 + wn * 64 + g * 4 + opq_;
    if (EPI == EPI_INPROJ) {
      const int wc0 = n0 + wn * 64;
#pragma unroll
      for (int mt = 0; mt < 8; ++mt) {
        const int row = rbase + mt * 16;
        const float rs = s_rs[row - m0];
        const int bb = row >> 12, ss = row & 4095;
        float sq = 0.f;
#pragma unroll
        for (int nt = 0; nt < 4; ++nt) {
          const int ct = wc0 + nt * 16;
          const int col = cbase + nt * 16;
          f32x4 v = acc[mt][nt] * rs;
          if (ct < 384) {
            if ((nt & 1) == 0) {
              const f32x4 v1 = acc[mt][(nt + 1) & 3] * rs;
              sq += v[0] * v[0] + v[1] * v[1] + v[2] * v[2] + v[3] * v[3];
              sq += v1[0] * v1[0] + v1[1] * v1[1] + v1[2] * v1[2] + v1[3] * v1[3];
              u32x4 w;
              w.x = cvt_pk_bf16(v[0], v[1]);
              w.y = cvt_pk_bf16(v[2], v[3]);
              w.z = cvt_pk_bf16(v1[0], v1[1]);
              w.w = cvt_pk_bf16(v1[2], v1[3]);
              *(u32x4*)(p.projA + (size_t)row * 416 + wc0 + (nt >> 1) * 32 + g * 8) = w;
            }
          } else if (ct == 384) {
            if (nt < 3) {
              const f32x4 v2 = acc[mt][(nt + 1) & 3] * rs;
              const int i0 = col - 384;
              const float2* cs = p.ropecs + ss * 16 + i0;
              float o1[4], o2[4];
#pragma unroll
              for (int j = 0; j < 4; ++j) {
                const float2 c_s = cs[j];
                o1[j] = v[j] * c_s.x - v2[j] * c_s.y;
                o2[j] = v[j] * c_s.y + v2[j] * c_s.x;
              }
              u32x2 w;
              w.x = cvt_pk_bf16(o1[0], o1[1]);
              w.y = cvt_pk_bf16(o1[2], o1[3]);
              *(u32x2*)(p.projA + (size_t)row * 416 + 384 + i0) = w;
              w.x = cvt_pk_bf16(o2[0], o2[1]);
              w.y = cvt_pk_bf16(o2[2], o2[3]);
              *(u32x2*)(p.projA + (size_t)row * 416 + 400 + i0) = w;
            }
          } else if (ct == 400) {
          } else if (ct < 1568) {
            const int hc = col - 416;
            bf16_t* dst = p.hyT + ((size_t)(bb * 1152 + hc)) * 4096 + ss;
            dst[0] = f2bf(v[0]);
            dst[4096] = f2bf(v[1]);
            dst[2 * 4096] = f2bf(v[2]);
            dst[3 * 4096] = f2bf(v[3]);
          } else if (ct < 2080) {
            if ((nt & 1) == 0) {
              const f32x4 v1 = acc[mt][(nt + 1) & 3] * rs;
              u32x4 w;
              w.x = cvt_pk_bf16(v[0], v[1]);
              w.y = cvt_pk_bf16(v[2], v[3]);
              w.z = cvt_pk_bf16(v1[0], v1[1]);
              w.w = cvt_pk_bf16(v1[2], v1[3]);
              *(u32x4*)(p.na + (size_t)row * 768 + (wc0 + (nt >> 1) * 32 + g * 8 - 1568)) = w;
            }
          } else if (ct < 2336) {
            const int vc = col - 2080;
            bf16_t* dst = p.naVT + ((size_t)(bb * 256 + vc)) * 4096 + ss;
            dst[0] = f2bf(v[0]);
            dst[4096] = f2bf(v[1]);
            dst[2 * 4096] = f2bf(v[2]);
            dst[3 * 4096] = f2bf(v[3]);
          }
        }
        if (wc0 < 384) {
          sq += __shfl_xor(sq, 16);
          sq += __shfl_xor(sq, 32);
          if (g == 0) {
            if (wc0 < 256) p.part_q[(size_t)row * 4 + (wc0 >> 6)] = sq;
            else p.part_kv[(size_t)row * 2 + ((wc0 - 256) >> 6)] = sq;
          }
        }
      }
    } else if (EPI == EPI_QUP) {
      const int wc0 = n0 + wn * 64;
      const float qscale = 0.10206207261596575f * 1.4426950408889634f;
#pragma unroll
      for (int mt = 0; mt < 8; ++mt) {
        const int row = rbase + mt * 16;
        const float rs = s_rs[row - m0] * qscale;
        const int bb = row >> 12, ss = row & 4095;
#pragma unroll
        for (int nt = 0; nt < 4; ++nt) {
          const int T = (wc0 >> 4) + nt;
          if (T < 36) {
            const int hh = T / 6, tt = T % 6;
            bf16_t* qrow = p.qb + ((size_t)((bb * 6 + hh) * 4096 + ss)) * 96;
            const f32x4 v = acc[mt][nt] * rs;
            if (tt < 4) {
              if ((tt & 1) == 0) {
                const f32x4 v1 = acc[mt][(nt + 1) & 3] * rs;
                u32x4 w;
                w.x = cvt_pk_bf16(v[0], v[1]);
                w.y = cvt_pk_bf16(v[2], v[3]);
                w.z = cvt_pk_bf16(v1[0], v1[1]);
                w.w = cvt_pk_bf16(v1[2], v1[3]);
                *(u32x4*)(qrow + (tt >> 1) * 32 + g * 8) = w;
              }
            } else if (tt == 4) {
              if (nt < 3) {
                const f32x4 v2 = acc[mt][(nt + 1) & 3] * rs;
                const float2* cs = p.ropecs + ss * 16 + g * 4;
                float o1[4], o2[4];
#pragma unroll
                for (int j = 0; j < 4; ++j) {
                  const float2 c_s = cs[j];
                  o1[j] = v[j] * c_s.x - v2[j] * c_s.y;
                  o2[j] = v[j] * c_s.y + v2[j] * c_s.x;
                }
                u32x2 w;
                w.x = cvt_pk_bf16(o1[0], o1[1]);
                w.y = cvt_pk_bf16(o1[2], o1[3]);
                *(u32x2*)(qrow + 64 + g * 4) = w;
                w.x = cvt_pk_bf16(o2[0], o2[1]);
                w.y = cvt_pk_bf16(o2[2], o2[3]);
                *(u32x2*)(qrow + 80 + g * 4) = w;
              }
            }
          }
        }
      }
    } else if (EPI == EPI_KVUP) {
      const int hh = ni * 2 + (wn >> 1);
#pragma unroll
      for (int mt = 0; mt < 8; ++mt) {
        const int row = rbase + mt * 16;
        const float rs = s_rs[row - m0];
        const int bb = row >> 12, ss = row & 4095;
#pragma unroll
        for (int nt = 0; nt < 4; ++nt) {
          const f32x4 v = acc[mt][nt] * rs;
          if ((wn & 1) == 0) {
            if ((nt & 1) == 0) {
              const f32x4 v1 = acc[mt][(nt + 1) & 3] * rs;
              u32x4 w;
              w.x = cvt_pk_bf16(v[0], v[1]);
              w.y = cvt_pk_bf16(v[2], v[3]);
              w.z = cvt_pk_bf16(v1[0], v1[1]);
              w.w = cvt_pk_bf16(v1[2], v1[3]);
              *(u32x4*)(p.kb + ((size_t)((bb * 6 + hh) * 4096 + ss)) * 96 + (nt >> 1) * 32 + g * 8) = w;
            }
          } else {
            const int dv = nt * 16 + g * 4;
            bf16_t* dst = p.vT + ((size_t)((bb * 6 + hh) * 64 + dv)) * 4096 + ss;
            dst[0] = f2bf(v[0]);
            dst[4096] = f2bf(v[1]);
            dst[2 * 4096] = f2bf(v[2]);
            dst[3 * 4096] = f2bf(v[3]);
          }
        }
      }
#pragma unroll
      for (int i = 0; i < 2; ++i) {
        const int c = tid + 512 * i, rr = c >> 2, cc = c & 3;
        const int row = m0 + rr, bb = row >> 12, ss = row & 4095;
        const u32x4 v = *(const u32x4*)(p.projA + (size_t)row * 416 + 384 + cc * 8);
        *(u32x4*)(p.kb + ((size_t)((bb * 6 + ni * 2) * 4096 + ss)) * 96 + 64 + cc * 8) = v;
        *(u32x4*)(p.kb + ((size_t)((bb * 6 + ni * 2 + 1) * 4096 + ss)) * 96 + 64 + cc * 8) = v;
      }
    } else if (EPI == EPI_OUTPROJ || EPI == EPI_DOWN) {
      const int slot = (n0 + wn * 64) >> 6;
      const int cb8 = n0 + wn * 64 + g * 8;
#pragma unroll
      for (int mt = 0; mt < 8; ++mt) {
        const int row = rbase + mt * 16;
        float sq = 0.f;
#pragma unroll
        for (int q = 0; q < 2; ++q) {
          const int col = cb8 + q * 32;
          const u32x4 xr = *(const u32x4*)(p.xb + (size_t)row * 1024 + col);
          const f32x4 v0 = acc[mt][2 * q] + (f32x4){bflo(xr.x), bfhi(xr.x), bflo(xr.y), bfhi(xr.y)};
          const f32x4 v1 = acc[mt][2 * q + 1] + (f32x4){bflo(xr.z), bfhi(xr.z), bflo(xr.w), bfhi(xr.w)};
          sq += v0[0] * v0[0] + v0[1] * v0[1] + v0[2] * v0[2] + v0[3] * v0[3];
          sq += v1[0] * v1[0] + v1[1] * v1[1] + v1[2] * v1[2] + v1[3] * v1[3];
          u32x4 w;
          w.x = cvt_pk_bf16(v0[0], v0[1]);
          w.y = cvt_pk_bf16(v0[2], v0[3]);
          w.z = cvt_pk_bf16(v1[0], v1[1]);
          w.w = cvt_pk_bf16(v1[2], v1[3]);
          *(u32x4*)(p.xb + (size_t)row * 1024 + col) = w;
        }
        sq += __shfl_xor(sq, 16);
        sq += __shfl_xor(sq, 32);
        if (g == 0) p.part_x[(size_t)row * 16 + slot] = sq;
      }
    } else if (EPI == EPI_SWIGLU) {
      const int fbase = ((n0 + wn * 64) >> 1) + g * 8;
#pragma unroll
      for (int mt = 0; mt < 8; ++mt) {
        const int row = rbase + mt * 16;
        const float rs = s_rs[row - m0];
        float hv[8];
#pragma unroll
        for (int i = 0; i < 2; ++i) {
          const f32x4 gt = acc[mt][i] * rs, up = acc[mt][2 + i] * rs;
#pragma unroll
          for (int j = 0; j < 4; ++j) hv[i * 4 + j] = gt[j] * __builtin_amdgcn_rcpf(1.0f + __expf(-gt[j])) * up[j];
        }
        u32x4 w;
        w.x = cvt_pk_bf16(hv[0], hv[1]);
        w.y = cvt_pk_bf16(hv[2], hv[3]);
        w.z = cvt_pk_bf16(hv[4], hv[5]);
        w.w = cvt_pk_bf16(hv[6], hv[7]);
        *(u32x4*)(p.hidden + (size_t)row * 2816 + fbase) = w;
      }
    }
  }
}

__device__ void final_norm_phase(const P& p) {
  int tid_ = threadIdx.x;
  asm volatile("" : "+v"(tid_));
  const int tid = tid_, lane = tid & 63, wave = tid >> 6;
  for (int row = blockIdx.x * 8 + wave; row < NTOK; row += gridDim.x * 8) {
    const f32x4* pp = (const f32x4*)(p.part_x + (size_t)row * 16);
    const f32x4 a0 = pp[0], a1 = pp[1], a2 = pp[2], a3 = pp[3];
    const float tot = (a0[0] + a0[1] + a0[2] + a0[3]) + (a1[0] + a1[1] + a1[2] + a1[3]) +
                      (a2[0] + a2[1] + a2[2] + a2[3]) + (a3[0] + a3[1] + a3[2] + a3[3]);
    const float rs = rsqrtf(tot * (1.0f / 1024.0f) + 1e-6f);
    const bf16_t* xr = p.xb + (size_t)row * 1024;
    float* orow = p.out + (size_t)row * 1024;
#pragma unroll
    for (int i = 0; i < 2; ++i) {
      const int c0 = lane * 8 + 512 * i;
      const u32x4 xv = *(const u32x4*)(xr + c0);
      const f32x4 g0 = *(const f32x4*)(p.final_g + c0), g1 = *(const f32x4*)(p.final_g + c0 + 4);
      f32x4 o0 = (f32x4){bflo(xv.x), bfhi(xv.x), bflo(xv.y), bfhi(xv.y)};
      f32x4 o1 = (f32x4){bflo(xv.z), bfhi(xv.z), bflo(xv.w), bfhi(xv.w)};
      o0 = o0 * rs * g0;
      o1 = o1 * rs * g1;
      *(f32x4*)(orow + c0) = o0;
      *(f32x4*)(orow + c0 + 4) = o1;
    }
  }
}


template <int S>
__device__ __forceinline__ void run_stage(const P& p, int l, char* smem) {
  if (S == 0) prep_phase(p, l, smem);
  if (S == 1) {
    filt_fft_phase(p, l, smem);
    gemm_phase<EPI_INPROJ>(p, l, p.xb, 1024, p.Win, 1024, 10, smem);
  }
  if (S == 2) {
    hyena_phase<0>(p, l, smem);
    gemm_phase<EPI_QUP>(p, l, p.projA, 416, p.Wuq, 256, 3, smem);
    gemm_phase<EPI_KVUP>(p, l, p.projA + 256, 416, p.Wukv, 128, 3, smem);
    natten_phase(p, l, smem);
  }
  if (S == 3) {
    hyena_phase<1>(p, l, smem);
    attn_phase(p, smem);
  }
  if (S == 4) mixnorm_phase(p, smem);
  if (S == 5) gemm_phase<EPI_OUTPROJ>(p, l, p.y, 1024, p.Wout, 1024, 4, smem);
  if (S == 6) gemm_phase<EPI_SWIGLU>(p, l, p.xb, 1024, p.Wgu, 1024, 22, smem);
  if (S == 7) gemm_phase<EPI_DOWN>(p, l, p.hidden, 2816, p.Wdown, 2816, 4, smem);
  if (S == 8) final_norm_phase(p);
}

__device__ __forceinline__ void grid_barrier(unsigned* bar, unsigned target) {
  asm volatile("s_waitcnt vmcnt(0)" ::: "memory");
  __syncthreads();
  if (threadIdx.x == 0) {
    __builtin_amdgcn_fence(__ATOMIC_RELEASE, "agent");
    asm volatile("s_waitcnt vmcnt(0)" ::: "memory");
    __hip_atomic_fetch_add(bar, 1u, __ATOMIC_RELAXED, __HIP_MEMORY_SCOPE_AGENT);
    unsigned spins = 0;
    while (__hip_atomic_load(bar, __ATOMIC_RELAXED, __HIP_MEMORY_SCOPE_AGENT) < target && spins < (1u << 22)) {
      __builtin_amdgcn_s_sleep(1);
      ++spins;
    }
    __builtin_amdgcn_fence(__ATOMIC_ACQUIRE, "agent");
    asm volatile("s_waitcnt vmcnt(0)" ::: "memory");
  }
  __syncthreads();
}

__global__ void __launch_bounds__(NTHREADS) k_main(P p) {
  extern __shared__ __attribute__((aligned(16))) char smem[];
  cg::grid_group grid = cg::this_grid();
  if (blockIdx.x == 0 && threadIdx.x == 0) __hip_atomic_store(p.bar, 0u, __ATOMIC_RELAXED, __HIP_MEMORY_SCOPE_AGENT);
  run_stage<0>(p, 0, smem); grid.sync();
  run_stage<1>(p, 0, smem); grid_barrier(p.bar, 1u * gridDim.x);
  run_stage<2>(p, 0, smem); grid_barrier(p.bar, 2u * gridDim.x);
  run_stage<3>(p, 0, smem); grid_barrier(p.bar, 3u * gridDim.x);
  run_stage<4>(p, 0, smem); grid_barrier(p.bar, 4u * gridDim.x);
  run_stage<5>(p, 0, smem); grid_barrier(p.bar, 5u * gridDim.x);
  run_stage<6>(p, 0, smem); grid_barrier(p.bar, 6u * gridDim.x);
  run_stage<7>(p, 0, smem); grid_barrier(p.bar, 7u * gridDim.x);
  run_stage<0>(p, 1, smem); grid_barrier(p.bar, 8u * gridDim.x);
  run_stage<1>(p, 1, smem); grid_barrier(p.bar, 9u * gridDim.x);
  run_stage<2>(p, 1, smem); grid_barrier(p.bar, 10u * gridDim.x);
  run_stage<3>(p, 1, smem); grid_barrier(p.bar, 11u * gridDim.x);
  run_stage<4>(p, 1, smem); grid_barrier(p.bar, 12u * gridDim.x);
  run_stage<5>(p, 1, smem); grid_barrier(p.bar, 13u * gridDim.x);
  run_stage<6>(p, 1, smem); grid_barrier(p.bar, 14u * gridDim.x);
  run_stage<7>(p, 1, smem); grid_barrier(p.bar, 15u * gridDim.x);
  run_stage<8>(p, 1, smem);
}


extern "C" void kernel_launch(void* const* d_in, const int* in_sizes, int n_in, void* d_out, int out_size, void* d_ws,
                              size_t ws_size, hipStream_t stream) {
  static int grid_blocks = 0;
  if (!grid_blocks) {
    int dev = 0, cus = 0;
    (void)hipGetDevice(&dev);
    (void)hipDeviceGetAttribute(&cus, hipDeviceAttributeMultiprocessorCount, dev);
    if (cus <= 0) cus = 256;
    int per_cu = 0;
    (void)hipFuncSetAttribute((const void*)k_main, hipFuncAttributeMaxDynamicSharedMemorySize, LDS_BYTES);
    (void)hipOccupancyMaxActiveBlocksPerMultiprocessor(&per_cu, k_main, NTHREADS, LDS_BYTES);
    if (per_cu > 1) per_cu = 1;
    if (per_cu < 1) per_cu = 1;
    grid_blocks = cus * per_cu;
  }
  P p;
  memset(&p, 0, sizeof(p));
  const float* const* in = (const float* const*)d_in;
  p.x = in[0]; p.norm1_g = in[1]; p.w_in = in[2]; p.q_norm_g = in[3]; p.w_uq = in[4]; p.kv_norm_g = in[5];
  p.w_ukv = in[6]; p.conv_w = in[7]; p.conv_b = in[8]; p.fw1 = in[9]; p.fb1 = in[10]; p.ff1 = in[11];
  p.fw2 = in[12]; p.fb2 = in[13]; p.ff2 = in[14]; p.fw3 = in[15]; p.skip = in[16]; p.rpb = in[17];
  p.mix_g = in[18]; p.w_out = in[19]; p.norm2_g = in[20]; p.w_gate = in[21]; p.w_up = in[22]; p.w_down = in[23];
  p.final_g = in[24];
  p.out = (float*)d_out;
  char* ws = (char*)d_ws;
  size_t off = 0;
  auto take = [&](size_t bytes) {
    char* r = ws + off;
    off += (bytes + 255) & ~(size_t)255;
    return r;
  };
  p.Win = (bf16_t*)take((size_t)2560 * 1024 * 2);
  p.Wuq = (bf16_t*)take((size_t)768 * 256 * 2);
  p.Wukv = (bf16_t*)take((size_t)768 * 128 * 2);
  p.Wout = (bf16_t*)take((size_t)1024 * 1024 * 2);
  p.Wgu = (bf16_t*)take((size_t)5632 * 1024 * 2);
  p.Wdown = (bf16_t*)take((size_t)1024 * 2816 * 2);
  p.ropecs = (float2*)take((size_t)65536 * 8);
  p.tw = (float2*)take((size_t)8192 * 8);
  p.bar = (unsigned*)take(256);
  p.part_x = (float*)take((size_t)NTOK * 16 * 4);
  p.part_q = (float*)take((size_t)NTOK * 4 * 4);
  p.part_kv = (float*)take((size_t)NTOK * 2 * 4);
  p.xb = (bf16_t*)take((size_t)NTOK * 1024 * 2);
  p.H2 = (float2*)take((size_t)768 * 8192 * 8);
  p.z1T = (bf16_t*)take((size_t)1536 * 4096 * 4);
  p.filtT = (float*)p.z1T;
  p.vT = (bf16_t*)take((size_t)8 * 6 * 64 * 4096 * 2);
  p.o_a = (bf16_t*)take((size_t)NTOK * 384 * 2);
  p.o_c = (bf16_t*)take((size_t)NTOK * 256 * 2);
  char* big = take(0);
  p.projA = (bf16_t*)take((size_t)NTOK * 416 * 2);
  p.hyT = (bf16_t*)take((size_t)8 * 1152 * 4096 * 2);
  p.na = (bf16_t*)take((size_t)NTOK * 768 * 2);
  p.qb = (bf16_t*)take((size_t)8 * 6 * 4096 * 96 * 2);
  p.kb = (bf16_t*)take((size_t)8 * 6 * 4096 * 96 * 2);
  p.hidden = (bf16_t*)big;
  p.ybT = (bf16_t*)take((size_t)8 * 384 * 4096 * 2);
  p.naVT = (bf16_t*)take((size_t)8 * 4 * 64 * 4096 * 2);
  p.y = p.qb;
  if (off > ws_size) {
    fprintf(stderr, "workspace too small: need %zu have %zu\n", off, ws_size);
    return;
  }
  void* args[] = {&p};
  hipError_t e = hipLaunchCooperativeKernel((void*)k_main, dim3(grid_blocks), dim3(NTHREADS), args, LDS_BYTES, stream);
  if (e != hipSuccess) fprintf(stderr, "cooperative launch failed: %s (grid %d)\n", hipGetErrorString(e), grid_blocks);
}
```

```cpp
#include <hip/hip_runtime.h>
#include <hip/hip_cooperative_groups.h>
#include <cstdio>
#include <cstring>
#include <cstdint>
#include <cmath>
#include <type_traits>
namespace cg = cooperative_groups;


typedef unsigned short bf16_t;
typedef short bf16x8 __attribute__((ext_vector_type(8)));
typedef float f32x4 __attribute__((ext_vector_type(4)));
typedef unsigned u32x4 __attribute__((ext_vector_type(4)));
typedef unsigned u32x2 __attribute__((ext_vector_type(2)));

constexpr int NTOK = 32768, SEQ = 4096;
constexpr int NTHREADS = 512;
constexpr int LDS_BYTES = 147456;
constexpr int TW_LDS_OFF = 69632;
#define PADI(i) ((i) + ((i) >> 4))

struct P {
  const float *x, *norm1_g, *w_in, *q_norm_g, *w_uq, *kv_norm_g, *w_ukv, *conv_w, *conv_b, *fw1, *fb1, *ff1, *fw2, *fb2,
      *ff2, *fw3, *skip, *rpb, *mix_g, *w_out, *norm2_g, *w_gate, *w_up, *w_down, *final_g;
  float* out;
  bf16_t *Win, *Wuq, *Wukv, *Wout, *Wgu, *Wdown;
  bf16_t *xb, *projA, *hyT, *na, *qb, *kb, *vT, *o_a, *o_c, *y, *hidden, *ybT, *naVT;
  float2* H2;
  float* filtT;
  bf16_t* z1T;
  float *part_x, *part_q, *part_kv;
  float2* ropecs;
  float2* tw;
  unsigned* bar;
  unsigned pad0_, pad1_;
};

typedef __bf16 bf16v2_t __attribute__((ext_vector_type(2)));
typedef float f32x2_t __attribute__((ext_vector_type(2)));
__device__ __forceinline__ unsigned cvt_pk_bf16(float lo, float hi) {
  const f32x2_t v = {lo, hi};
  const bf16v2_t r = __builtin_convertvector(v, bf16v2_t);
  return __builtin_bit_cast(unsigned, r);
}
__device__ __forceinline__ bf16_t f2bf(float f) { return (bf16_t)(cvt_pk_bf16(f, 0.f) & 0xffffu); }
__device__ __forceinline__ float bf2f(bf16_t h) { return __uint_as_float(((unsigned)h) << 16); }
__device__ __forceinline__ float bflo(unsigned u) { return __uint_as_float(u << 16); }
__device__ __forceinline__ float bfhi(unsigned u) { return __uint_as_float(u & 0xffff0000u); }

__device__ __forceinline__ void fast_sincos_rev(float rev, float* s, float* c) {
  const float fr = rev - rintf(rev);
  *s = __builtin_amdgcn_sinf(fr);
  *c = __builtin_amdgcn_cosf(fr);
}
__device__ __forceinline__ float fast_sin(float x) {
  const float rev = x * 0.15915494309189535f;
  const float fr = rev - rintf(rev);
  return __builtin_amdgcn_sinf(fr);
}

__device__ __forceinline__ int vblock() {
  const int G = gridDim.x, b = blockIdx.x;
  return ((G & 7) == 0) ? ((b & 7) * (G >> 3) + (b >> 3)) : b;
}

__device__ void conv_w(const float* __restrict__ W, int K, int N, int Npad, const float* __restrict__ g, bf16_t* Bt,
                       int mode, char* smem) {
  float* tile = (float*)smem;
  int tid_ = threadIdx.x;
  asm volatile("" : "+v"(tid_));
  const int tid = tid_;
  const int nkt = K / 64, nnt = Npad / 64;
  for (int job = blockIdx.x; job < nkt * nnt; job += gridDim.x) {
    const int kt = job % nkt, ntile = job / nkt;
    const int k0 = kt * 64, n0 = ntile * 64;
    __syncthreads();
#pragma unroll
    for (int i = 0; i < 2; ++i) {
      const int k = (tid >> 4) + 32 * i, nq = (tid & 15) * 4, n = n0 + nq;
      f32x4 v = {0.f, 0.f, 0.f, 0.f};
      if (n < N) {
        v = *(const f32x4*)(W + (size_t)(k0 + k) * N + n);
        if (g) v = v * g[k0 + k];
      }
      tile[k * 65 + nq + 0] = v[0];
      tile[k * 65 + nq + 1] = v[1];
      tile[k * 65 + nq + 2] = v[2];
      tile[k * 65 + nq + 3] = v[3];
    }
    __syncthreads();
    {
      const int c = tid, n = c >> 3, kc = c & 7;
      float e[8];
#pragma unroll
      for (int q = 0; q < 8; ++q) e[q] = tile[(kc * 8 + q) * 65 + n];
      u32x4 w;
      w.x = cvt_pk_bf16(e[0], e[1]);
      w.y = cvt_pk_bf16(e[2], e[3]);
      w.z = cvt_pk_bf16(e[4], e[5]);
      w.w = cvt_pk_bf16(e[6], e[7]);
      const int nn = n0 + n;
      int dest = nn;
      if (mode == 4 && (nn < 384 || (nn >= 1568 && nn < 2080))) {
        const int f = nn & 31;
        dest = (nn & ~31) + ((f >> 2) & 1) * 16 + (f >> 3) * 4 + (f & 3);
      }
      if ((mode == 5 && (nn & 127) < 64) || (mode == 6 && nn < 576 && (nn % 96) < 64)) {
        const int f = nn & 31;
        dest = (nn & ~31) + ((f >> 2) & 1) * 16 + (f >> 3) * 4 + (f & 3);
      }
      if (mode == 3) {
        const int f = nn & 31;
        dest = (nn & ~31) + ((f >> 2) & 1) * 16 + (f >> 3) * 4 + (f & 3);
      }
      if (mode == 1 || mode == 2) {
        const int f = nn & 31;
        dest = 64 * (nn >> 5) + (mode == 2 ? 32 : 0) + ((f >> 2) & 1) * 16 + (f >> 3) * 4 + (f & 3);
      }
      *(u32x4*)(Bt + (size_t)dest * K + k0 + kc * 8) = w;
    }
  }
}

__device__ void filt_mlp(const P& p, int l, char* smem) {
  float* zf = (float*)smem;
  float* h1 = zf + 16 * 17;
  float* h2 = h1 + 64 * 16;
  int tid_ = threadIdx.x;
  asm volatile("" : "+v"(tid_));
  const int tid = tid_, tl = tid & 15, kk = tid >> 4;
  const float* w1 = p.fw1 + l * 17 * 64;
  const float* b1 = p.fb1 + l * 64;
  const float* f1 = p.ff1 + l * 64;
  const float* w2 = p.fw2 + l * 64 * 64;
  const float* b2 = p.fb2 + l * 64;
  const float* f2 = p.ff2 + l * 64;
  const float* w3 = p.fw3 + (size_t)l * 64 * 1536;
  for (int job = blockIdx.x; job < 256; job += gridDim.x) {
    const int t0 = job * 16;
    __syncthreads();
    {
      const int t = t0 + tl;
      if (kk < 8) {
        const float band = 1e-4f + (float)kk * ((7.0f - 1e-4f) / 7.0f);
        const float ang = ((6.283185307179586f * (float)t) * band) / 4096.0f;
        float s, c;
        fast_sincos_rev(ang * 0.15915494309189535f, &s, &c);
        zf[tl * 17 + 1 + kk] = c;
        zf[tl * 17 + 9 + kk] = s;
      } else if (kk == 8) {
        zf[tl * 17] = (float)t / 4095.0f;
      }
    }
    __syncthreads();
#pragma unroll
    for (int m = 0; m < 2; ++m) {
      const int j = kk + 32 * m;
      float a = b1[j];
#pragma unroll 1
      for (int f = 0; f < 17; ++f) a += zf[tl * 17 + f] * w1[f * 64 + j];
      h1[j * 16 + tl] = fast_sin(f1[j] * a);
    }
    __syncthreads();
#pragma unroll
    for (int m = 0; m < 2; ++m) {
      const int j = kk + 32 * m;
      float a = b2[j];
#pragma unroll 16
      for (int i = 0; i < 64; ++i) a += h1[i * 16 + tl] * w2[i * 64 + j];
      h2[j * 16 + tl] = fast_sin(f2[j] * a);
    }
    __syncthreads();
#pragma unroll 1
    for (int mm = 0; mm < 3; ++mm) {
      const int col = tid + 512 * mm;
      float acc[16];
#pragma unroll
      for (int q = 0; q < 16; ++q) acc[q] = 0.f;
#pragma unroll 1
      for (int j0 = 0; j0 < 64; j0 += 8) {
        float wv[8];
#pragma unroll
        for (int q = 0; q < 8; ++q) wv[q] = w3[(size_t)(j0 + q) * 1536 + col];
#pragma unroll
        for (int q = 0; q < 8; ++q) {
          const float w = wv[q];
          const f32x4* hp = (const f32x4*)(h2 + (j0 + q) * 16);
          const f32x4 a0 = hp[0], a1 = hp[1], a2 = hp[2], a3 = hp[3];
          acc[0] += a0[0] * w; acc[1] += a0[1] * w; acc[2] += a0[2] * w; acc[3] += a0[3] * w;
          acc[4] += a1[0] * w; acc[5] += a1[1] * w; acc[6] += a1[2] * w; acc[7] += a1[3] * w;
          acc[8] += a2[0] * w; acc[9] += a2[1] * w; acc[10] += a2[2] * w; acc[11] += a2[3] * w;
          acc[12] += a3[0] * w; acc[13] += a3[1] * w; acc[14] += a3[2] * w; acc[15] += a3[3] * w;
        }
      }
      const int c = col % 384;
      const float lo = -3.0701134573253945f, hi = -15.350567286626972f;
      const float delta = fabsf(lo + (hi - lo) * ((float)c / 383.0f));
      float* dst = p.filtT + (size_t)col * 4096 + t0;
#pragma unroll
      for (int q = 0; q < 16; ++q) {
        const float tn = (float)(t0 + q) / 4095.0f;
        dst[q] = acc[q] * __expf(-tn * delta);
      }
    }
  }
}

__device__ void prep_phase(const P& p, int l, char* smem) {
  for (int w = 0; w < 7; ++w) {
    const float* W; const float* g; bf16_t* Bt; int K, N, Npad, mode = 0;
    switch (w) {
      case 0: W = p.w_in + (size_t)l * 1024 * 2336; K = 1024; N = 2336; Npad = 2560; g = p.norm1_g + l * 1024; Bt = p.Win; mode = 4; break;
      case 1: W = p.w_uq + (size_t)l * 256 * 576; K = 256; N = 576; Npad = 768; g = p.q_norm_g + l * 256; Bt = p.Wuq; mode = 6; break;
      case 2: W = p.w_ukv + (size_t)l * 128 * 768; K = 128; N = 768; Npad = 768; g = p.kv_norm_g + l * 128; Bt = p.Wukv; mode = 5; break;
      case 3: W = p.w_out + (size_t)l * 1024 * 1024; K = 1024; N = 1024; Npad = 1024; g = p.mix_g + l * 1024; Bt = p.Wout; mode = 3; break;
      case 4: W = p.w_gate + (size_t)l * 1024 * 2816; K = 1024; N = 2816; Npad = 2816; g = p.norm2_g + l * 1024; Bt = p.Wgu; mode = 1; break;
      case 5: W = p.w_up + (size_t)l * 1024 * 2816; K = 1024; N = 2816; Npad = 2816; g = p.norm2_g + l * 1024; Bt = p.Wgu; mode = 2; break;
      default: W = p.w_down + (size_t)l * 2816 * 1024; K = 2816; N = 1024; Npad = 1024; g = nullptr; Bt = p.Wdown; mode = 3; break;
    }
    conv_w(W, K, N, Npad, g, Bt, mode, smem);
  }
  filt_mlp(p, l, smem);
  if (l == 0) {
    int tid_ = threadIdx.x;
  asm volatile("" : "+v"(tid_));
  const int tid = tid_, lane = tid & 63, wave = tid >> 6;
    for (int row = blockIdx.x * 8 + wave; row < NTOK; row += gridDim.x * 8) {
      const float* xr = p.x + (size_t)row * 1024;
      bf16_t* xo = p.xb + (size_t)row * 1024;
      float s = 0.f;
#pragma unroll
      for (int i = 0; i < 4; ++i) {
        const f32x4 v = *(const f32x4*)(xr + lane * 4 + 256 * i);
        s += v[0] * v[0] + v[1] * v[1] + v[2] * v[2] + v[3] * v[3];
        u32x2 w;
        w.x = cvt_pk_bf16(v[0], v[1]);
        w.y = cvt_pk_bf16(v[2], v[3]);
        *(u32x2*)(xo + lane * 4 + 256 * i) = w;
      }
#pragma unroll
      for (int o = 1; o < 64; o <<= 1) s += __shfl_xor(s, o);
      if (lane < 16) p.part_x[(size_t)row * 16 + lane] = (lane == 0) ? s : 0.f;
    }
    for (int i = blockIdx.x * 512 + tid; i < 65536 + 8192; i += gridDim.x * 512) {
      if (i < 65536) {
        const int pos = i >> 4, k = i & 15;
        const float ang = (float)pos * __builtin_amdgcn_exp2f(-(float)k * 0.8304820237218405f);
        float s, c;
        fast_sincos_rev(ang * 0.15915494309189535f, &s, &c);
        p.ropecs[i] = make_float2(c, s);
      } else {
        const int k = i - 65536;
        const int ms = 1 << (31 - __clz(k + 1));
        const int pp = k + 1 - ms;
        float s, c;
        fast_sincos_rev((float)pp / (float)(2 * ms), &s, &c);
        p.tw[k] = make_float2(c, -s);
      }
    }
  }
}

template <int LOGR, int MTOP, bool INV, bool ZIN = false, bool HOUT = false>
__device__ __forceinline__ void fft_pass(float2* sm, const float2* tw) {
  constexpr int R = 1 << LOGR;
  constexpr int q = MTOP >> (LOGR - 1);
  constexpr int ntask = 8192 / R;
  for (int T = threadIdx.x; T < ntask; T += NTHREADS) {
    const int i = T & (q - 1);
    const int blk = T / q;
    const int base = blk * (2 * MTOP) + i;
    float2 v[R];
#pragma unroll
    for (int e = 0; e < R; ++e) {
      if (ZIN && e >= R / 2) v[e] = make_float2(0.f, 0.f);
      else v[e] = sm[PADI(base + e * q)];
    }
    if (!INV) {
#pragma unroll
      for (int s = 0; s < LOGR; ++s) {
        constexpr int dummy = 0;
        (void)dummy;
        const int hs = 1 << (LOGR - 1 - s);
        const int ms = MTOP >> s;
#pragma unroll
        for (int e = 0; e < R; ++e) {
          if ((e & hs) == 0) {
            const int pp = i + (e & (hs - 1)) * q;
            const float2 w = tw[(ms - 1) + pp];
            const float2 a = v[e], b = v[e + hs];
            v[e] = make_float2(a.x + b.x, a.y + b.y);
            const float dx = a.x - b.x, dy = a.y - b.y;
            v[e + hs] = make_float2(dx * w.x - dy * w.y, dx * w.y + dy * w.x);
          }
        }
      }
    } else {
#pragma unroll
      for (int s = LOGR - 1; s >= 0; --s) {
        const int hs = 1 << (LOGR - 1 - s);
        const int ms = MTOP >> s;
#pragma unroll
        for (int e = 0; e < R; ++e) {
          if ((e & hs) == 0) {
            const int pp = i + (e & (hs - 1)) * q;
            const float2 w = tw[(ms - 1) + pp];
            const float2 a = v[e], b = v[e + hs];
            const float tx = b.x * w.x + b.y * w.y, ty = b.y * w.x - b.x * w.y;
            v[e] = make_float2(a.x + tx, a.y + ty);
            v[e + hs] = make_float2(a.x - tx, a.y - ty);
          }
        }
      }
    }
#pragma unroll
    for (int e = 0; e < R; ++e) {
      if (HOUT && e >= R / 2) continue;
      sm[PADI(base + e * q)] = v[e];
    }
  }
  __syncthreads();
}

__device__ __forceinline__ void fft_fwd(float2* sm, const float2* tw) {
  fft_pass<4, 4096, false>(sm, tw);
  fft_pass<4, 256, false>(sm, tw);
  fft_pass<4, 16, false>(sm, tw);
  fft_pass<1, 1, false>(sm, tw);
}
__device__ __forceinline__ void fft_inv(float2* sm, const float2* tw) {
  fft_pass<1, 1, true>(sm, tw);
  fft_pass<3, 8, true>(sm, tw);
  fft_pass<3, 64, true>(sm, tw);
  fft_pass<3, 512, true>(sm, tw);
  fft_pass<3, 4096, true>(sm, tw);
}

__device__ void filt_fft_phase(const P& p, int l, char* smem) {
  float2* sm = (float2*)smem;
  float2* tws = (float2*)(smem + TW_LDS_OFF);
  int tid_ = threadIdx.x;
  asm volatile("" : "+v"(tid_));
  const int tid = tid_;
  for (int i = tid; i < 8192; i += NTHREADS) tws[i] = p.tw[i];
  for (int jj = blockIdx.x; jj < 384; jj += gridDim.x) {
    const int o = jj / 192, c = jj % 192;
    const int jobF = o * 384 + c, jobG = jobF + 192;
    const float* hf1 = p.filtT + ((size_t)((o * 2 + 0) * 384 + c)) * 4096;
    const float* hb1 = p.filtT + ((size_t)((o * 2 + 1) * 384 + c)) * 4096;
    const float* hf2 = hf1 + (size_t)192 * 4096;
    const float* hb2 = hb1 + (size_t)192 * 4096;
    const float sk1 = p.skip[(l * 2 + o) * 384 + c], sk2 = p.skip[(l * 2 + o) * 384 + c + 192];
    __syncthreads();
    for (int n = tid; n < 8192; n += NTHREADS) {
      float v1, v2;
      if (n == 0) { v1 = hf1[0] + hb1[0] + sk1; v2 = hf2[0] + hb2[0] + sk2; }
      else if (n < 4096) { v1 = hf1[n]; v2 = hf2[n]; }
      else if (n == 4096) { v1 = 0.f; v2 = 0.f; }
      else { v1 = hb1[8192 - n]; v2 = hb2[8192 - n]; }
      sm[PADI(n)] = make_float2(v1, v2);
    }
    __syncthreads();
    fft_fwd(sm, tws);
    float2* dF = p.H2 + (size_t)jobF * 8192;
    float2* dG = p.H2 + (size_t)jobG * 8192;
    const float sc = 0.5f / 8192.0f;
    for (int n = tid; n < 8192; n += NTHREADS) {
      const int k = (int)(__brev((unsigned)n) >> 19);
      const int np = (int)(__brev((unsigned)((8192 - k) & 8191)) >> 19);
      const float2 a = sm[PADI(n)], b = sm[PADI(np)];
      dF[n] = make_float2((a.x + b.x) * sc, (a.y - b.y) * sc);
      dG[n] = make_float2((a.y + b.y) * sc, (b.x - a.x) * sc);
    }
  }
}

__device__ __forceinline__ float short_conv(const bf16_t* row, int t, float w0, float w1, float w2, float bias) {
  const float xm = (t > 0) ? bf2f(row[t - 1]) : 0.f;
  const float x0 = bf2f(row[t]);
  const float xp = (t < SEQ - 1) ? bf2f(row[t + 1]) : 0.f;
  return w0 * xm + w1 * x0 + w2 * xp + bias;
}

__device__ __forceinline__ void conv8(const bf16_t* row, int t0, float w0, float w1, float w2, float bias, float (&out)[8]) {
  const u32x4 v = *(const u32x4*)(row + t0);
  float x[10];
  x[0] = (t0 > 0) ? bf2f(row[t0 - 1]) : 0.f;
  x[1] = bflo(v.x); x[2] = bfhi(v.x); x[3] = bflo(v.y); x[4] = bfhi(v.y);
  x[5] = bflo(v.z); x[6] = bfhi(v.z); x[7] = bflo(v.w); x[8] = bfhi(v.w);
  x[9] = (t0 + 8 < SEQ) ? bf2f(row[t0 + 8]) : 0.f;
#pragma unroll
  for (int k = 0; k < 8; ++k) out[k] = w0 * x[k] + w1 * x[k + 1] + w2 * x[k + 2] + bias;
}

struct RawRow { u32x4 v; float lo, hi; };
__device__ __forceinline__ RawRow load_raw(const bf16_t* row, int t0) {
  RawRow r;
  r.v = *(const u32x4*)(row + t0);
  r.lo = (t0 > 0) ? bf2f(row[t0 - 1]) : 0.f;
  r.hi = (t0 + 8 < SEQ) ? bf2f(row[t0 + 8]) : 0.f;
  return r;
}
__device__ __forceinline__ void conv8_raw(const RawRow& r, float w0, float w1, float w2, float bias, float (&out)[8]) {
  float x[10];
  x[0] = r.lo;
  x[1] = bflo(r.v.x); x[2] = bfhi(r.v.x); x[3] = bflo(r.v.y); x[4] = bfhi(r.v.y);
  x[5] = bflo(r.v.z); x[6] = bfhi(r.v.z); x[7] = bflo(r.v.w); x[8] = bfhi(r.v.w);
  x[9] = r.hi;
#pragma unroll
  for (int k = 0; k < 8; ++k) out[k] = w0 * x[k] + w1 * x[k + 1] + w2 * x[k + 2] + bias;
}

__device__ __forceinline__ void fft_mid(float2* sm, const f32x4 (&hpre)[8]) {
#pragma unroll
  for (int it = 0; it < 8; ++it) {
    const int T = threadIdx.x + it * NTHREADS;
    const float2 a = sm[PADI(2 * T)], b = sm[PADI(2 * T + 1)];
    const f32x4 h = hpre[it];
    const float sx = a.x + b.x, sy = a.y + b.y, dx = a.x - b.x, dy = a.y - b.y;
    const float Ax = sx * h[0] - sy * h[1], Ay = sx * h[1] + sy * h[0];
    const float Bx = dx * h[2] - dy * h[3], By = dx * h[3] + dy * h[2];
    sm[PADI(2 * T)] = make_float2(Ax + Bx, Ay + By);
    sm[PADI(2 * T + 1)] = make_float2(Ax - Bx, Ay - By);
  }
  __syncthreads();
}

template <int ORD>
__device__ void hyena_phase(const P& p, int l, char* smem) {
  float2* sm = (float2*)smem;
  float2* tws = (float2*)(smem + TW_LDS_OFF);
  int tid_ = threadIdx.x;
  asm volatile("" : "+v"(tid_));
  const int tid = tid_;
  for (int i = tid; i < 8192; i += NTHREADS) tws[i] = p.tw[i];
  const float* cw = p.conv_w + (size_t)l * 3 * 1152;
  const float* cb = p.conv_b + (size_t)l * 1152;
  const int t0 = tid * 8;
  for (int job = vblock(); job < 1536; job += gridDim.x) {
    const int pair = job & 3, c = job >> 2;
    const int b1 = pair * 2, b2 = b1 + 1;
    const int gc = (ORD == 0 ? 384 : 768) + c;
    const RawRow gr1 = load_raw(p.hyT + ((size_t)(b1 * 1152 + gc)) * 4096, t0);
    const RawRow gr2 = load_raw(p.hyT + ((size_t)(b2 * 1152 + gc)) * 4096, t0);
    __syncthreads();
    {
      float u1[8], u2[8];
      if (ORD == 0) {
        const bf16_t* r1 = p.hyT + ((size_t)(b1 * 1152 + c)) * 4096;
        const bf16_t* r2 = p.hyT + ((size_t)(b2 * 1152 + c)) * 4096;
        const float w0 = cw[c], w1 = cw[1152 + c], w2 = cw[2304 + c], bi = cb[c];
        conv8(r1, t0, w0, w1, w2, bi, u1);
        conv8(r2, t0, w0, w1, w2, bi, u2);
      } else {
        const u32x4 a0 = *(const u32x4*)(p.z1T + ((size_t)(b1 * 384 + c)) * 4096 + t0);
        const u32x4 c0_ = *(const u32x4*)(p.z1T + ((size_t)(b2 * 384 + c)) * 4096 + t0);
        u1[0] = bflo(a0.x); u1[1] = bfhi(a0.x); u1[2] = bflo(a0.y); u1[3] = bfhi(a0.y); u1[4] = bflo(a0.z); u1[5] = bfhi(a0.z); u1[6] = bflo(a0.w); u1[7] = bfhi(a0.w);
        u2[0] = bflo(c0_.x); u2[1] = bfhi(c0_.x); u2[2] = bflo(c0_.y); u2[3] = bfhi(c0_.y); u2[4] = bflo(c0_.z); u2[5] = bfhi(c0_.z); u2[6] = bflo(c0_.w); u2[7] = bfhi(c0_.w);
      }
#pragma unroll
      for (int k = 0; k < 8; ++k) {
        sm[PADI(t0 + k)] = make_float2(u1[k], u2[k]);
      }
    }
    __syncthreads();
    fft_pass<4, 4096, false, true, false>(sm, tws);
    fft_pass<4, 256, false>(sm, tws);
    f32x4 hpre[8];
    {
      const float2* H = p.H2 + ((size_t)(ORD * 384 + c)) * 8192;
#pragma unroll
      for (int it = 0; it < 8; ++it) hpre[it] = *(const f32x4*)(H + 2 * (tid + it * NTHREADS));
    }
    fft_pass<4, 16, false>(sm, tws);
    fft_mid(sm, hpre);
    fft_pass<4, 16, true>(sm, tws);
    fft_pass<4, 256, true>(sm, tws);
    fft_pass<4, 4096, true, false, true>(sm, tws);
    {
      const float w0 = cw[gc], w1 = cw[1152 + gc], w2 = cw[2304 + gc], bi = cb[gc];
      float q1[8], q2[8];
      conv8_raw(gr1, w0, w1, w2, bi, q1);
      conv8_raw(gr2, w0, w1, w2, bi, q2);
#pragma unroll
      for (int k = 0; k < 8; ++k) {
        const float2 yv = sm[PADI(t0 + k)];
        q1[k] *= yv.x;
        q2[k] *= yv.y;
      }
      {
        bf16_t* dbase = (ORD == 0) ? p.z1T : p.ybT;
        u32x4 w1_, w2_;
        w1_.x = cvt_pk_bf16(q1[0], q1[1]); w1_.y = cvt_pk_bf16(q1[2], q1[3]); w1_.z = cvt_pk_bf16(q1[4], q1[5]); w1_.w = cvt_pk_bf16(q1[6], q1[7]);
        w2_.x = cvt_pk_bf16(q2[0], q2[1]); w2_.y = cvt_pk_bf16(q2[2], q2[3]); w2_.z = cvt_pk_bf16(q2[4], q2[5]); w2_.w = cvt_pk_bf16(q2[6], q2[7]);
        *(u32x4*)(dbase + ((size_t)(b1 * 384 + c)) * 4096 + t0) = w1_;
        *(u32x4*)(dbase + ((size_t)(b2 * 384 + c)) * 4096 + t0) = w2_;
      }
    }
  }
}

constexpr int KROW = 208;
constexpr int VROW = 136;
constexpr int KBUF = 64 * KROW, VBUF = 64 * VROW;

constexpr int NK_ROW = 528;
constexpr int NK_BUF = 32 * NK_ROW;
constexpr int NV_ROW = 72;
constexpr int NV_BUF = 256 * NV_ROW;
constexpr int NRPB_OFF = 2 * NK_BUF + 2 * NV_BUF;

__device__ void natten_phase(const P& p, int l, char* smem) {
  int tid_ = threadIdx.x;
  asm volatile("" : "+v"(tid_));
  const int tid = tid_, lane = tid & 63, wave = tid >> 6, l15 = lane & 15, g = lane >> 4;
  const int hw = wave >> 1, qh = wave & 1;
  char* Ks = smem;
  char* Vs = smem + 2 * NK_BUF;
  float* rp = (float*)(smem + NRPB_OFF);
  __syncthreads();
  for (int i = tid; i < 4 * 15 * 31; i += NTHREADS) rp[i] = p.rpb[(size_t)l * 4 * 15 * 31 + i] * 1.4426950408889634f;
  const float qscale = 0.125f * 1.4426950408889634f;
  for (int job = blockIdx.x; job < 512; job += gridDim.x) {
    const int r = job & 63, b = job >> 6;
    const int r0 = min(max(r - 4, 0), 56);
    bf16x8 qf[2][2];
    int cq[2], c0[2];
#pragma unroll
    for (int nt = 0; nt < 2; ++nt) {
      cq[nt] = qh * 32 + nt * 16 + l15;
      c0[nt] = min(max(cq[nt] - 8, 0), 48);
      const bf16_t* qp = p.na + (size_t)(b * 4096 + r * 64 + cq[nt]) * 768 + hw * 64;
#pragma unroll
      for (int ks = 0; ks < 2; ++ks) qf[nt][ks] = *(const bf16x8*)(qp + ks * 32 + g * 8);
    }
    f32x4 o[4][2];
#pragma unroll
    for (int a = 0; a < 4; ++a)
#pragma unroll
      for (int n = 0; n < 2; ++n) o[a][n] = (f32x4){0.f, 0.f, 0.f, 0.f};
    float mrow[2] = {-1e30f, -1e30f}, lrow[2] = {0.f, 0.f};
    u32x4 rk[2], rv[2];
    auto gload = [&](int t) {
      const int kr = r0 + (t >> 1), kh = (t & 1) * 32;
      const bf16_t* kbase = p.na + (size_t)(b * 4096 + kr * 64 + kh) * 768 + 256;
#pragma unroll
      for (int i = 0; i < 2; ++i) {
        const int c = tid + 512 * i, key = c >> 5, cc = c & 31;
        rk[i] = *(const u32x4*)(kbase + (size_t)key * 768 + cc * 8);
      }
#pragma unroll
      for (int i = 0; i < 2; ++i) {
        const int c = tid + 512 * i, row = c >> 2, cc = c & 3;
        rv[i] = *(const u32x4*)(p.naVT + ((size_t)(b * 256 + row)) * 4096 + kr * 64 + kh + cc * 8);
      }
    };
    auto lstore = [&](int buf) {
      char* kb_ = Ks + buf * NK_BUF;
      char* vb_ = Vs + buf * NV_BUF;
#pragma unroll
      for (int i = 0; i < 2; ++i) {
        const int c = tid + 512 * i, key = c >> 5, cc = c & 31;
        *(u32x4*)(kb_ + key * NK_ROW + cc * 16) = rk[i];
      }
#pragma unroll
      for (int i = 0; i < 2; ++i) {
        const int c = tid + 512 * i, row = c >> 2, cc = c & 3;
        u32x2 lo, hi;
        lo.x = rv[i].x; lo.y = rv[i].y; hi.x = rv[i].z; hi.y = rv[i].w;
        *(u32x2*)(vb_ + row * NV_ROW + cc * 16) = lo;
        *(u32x2*)(vb_ + row * NV_ROW + cc * 16 + 8) = hi;
      }
    };
    gload(0);
    __syncthreads();
    lstore(0);
    gload(1);
    for (int t = 0; t < 16; ++t) {
      __syncthreads();
      if (t + 1 < 16) {
        lstore((t + 1) & 1);
        if (t + 2 < 16) gload(t + 2);
      }
      __builtin_amdgcn_sched_barrier(0);
      const char* kb_ = Ks + (t & 1) * NK_BUF;
      const char* vb_ = Vs + (t & 1) * NV_BUF + hw * 64 * NV_ROW;
      const int kh = (t & 1) * 32;
      f32x4 s[2][2];
#pragma unroll
      for (int a = 0; a < 2; ++a)
#pragma unroll
        for (int n = 0; n < 2; ++n) s[a][n] = (f32x4){0.f, 0.f, 0.f, 0.f};
#pragma unroll
      for (int mt = 0; mt < 2; ++mt)
#pragma unroll
        for (int ks = 0; ks < 2; ++ks) {
          const bf16x8 kf = *(const bf16x8*)(kb_ + (mt * 16 + l15) * NK_ROW + hw * 128 + ks * 64 + g * 16);
#pragma unroll
          for (int nt = 0; nt < 2; ++nt)
            s[mt][nt] = __builtin_amdgcn_mfma_f32_16x16x32_bf16(kf, qf[nt][ks], s[mt][nt], 0, 0, 0);
        }
      const float* brow = rp + (hw * 15 + (r0 + (t >> 1) - r + 7)) * 31;
      bf16x8 pf[2];
#pragma unroll
      for (int nt = 0; nt < 2; ++nt) {
        float mx = -1e30f;
#pragma unroll
        for (int mt = 0; mt < 2; ++mt)
#pragma unroll
          for (int j = 0; j < 4; ++j) {
            const int kc = kh + mt * 16 + g * 4 + j;
            const bool valid = (unsigned)(kc - c0[nt]) < 16u;
            const int dc = min(max(kc - cq[nt] + 15, 0), 30);
            const float sc = valid ? (s[mt][nt][j] * qscale + brow[dc]) : -1e30f;
            s[mt][nt][j] = sc;
            mx = fmaxf(mx, sc);
          }
        mx = fmaxf(mx, __shfl_xor(mx, 16));
        mx = fmaxf(mx, __shfl_xor(mx, 32));
        const float mnew = fmaxf(mrow[nt], mx);
        const float alpha = __builtin_amdgcn_exp2f(mrow[nt] - mnew);
        mrow[nt] = mnew;
        float ls = 0.f;
#pragma unroll
        for (int mt = 0; mt < 2; ++mt)
#pragma unroll
          for (int j = 0; j < 4; ++j) {
            const float e = (s[mt][nt][j] > -1e29f) ? __builtin_amdgcn_exp2f(s[mt][nt][j] - mnew) : 0.f;
            s[mt][nt][j] = e;
            ls += e;
          }
        lrow[nt] = lrow[nt] * alpha + ls;
#pragma unroll
        for (int a = 0; a < 4; ++a) o[a][nt] *= alpha;
        u32x4 w;
        w.x = cvt_pk_bf16(s[0][nt][0], s[0][nt][1]);
        w.y = cvt_pk_bf16(s[0][nt][2], s[0][nt][3]);
        w.z = cvt_pk_bf16(s[1][nt][0], s[1][nt][1]);
        w.w = cvt_pk_bf16(s[1][nt][2], s[1][nt][3]);
        pf[nt] = __builtin_bit_cast(bf16x8, w);
      }
#pragma unroll
      for (int mt = 0; mt < 4; ++mt) {
        const u32x2 lo = *(const u32x2*)(vb_ + (mt * 16 + l15) * NV_ROW + (4 * g) * 2);
        const u32x2 hi = *(const u32x2*)(vb_ + (mt * 16 + l15) * NV_ROW + (16 + 4 * g) * 2);
        u32x4 w;
        w.x = lo.x; w.y = lo.y; w.z = hi.x; w.w = hi.y;
        const bf16x8 vf = __builtin_bit_cast(bf16x8, w);
#pragma unroll
        for (int nt = 0; nt < 2; ++nt)
          o[mt][nt] = __builtin_amdgcn_mfma_f32_16x16x32_bf16(vf, pf[nt], o[mt][nt], 0, 0, 0);
      }
    }
#pragma unroll
    for (int nt = 0; nt < 2; ++nt) {
      float lt = lrow[nt];
      lt += __shfl_xor(lt, 16);
      lt += __shfl_xor(lt, 32);
      const float inv = 1.0f / lt;
      const int tok = b * 4096 + r * 64 + cq[nt];
#pragma unroll
      for (int mt = 0; mt < 4; ++mt) {
        u32x2 w;
        w.x = cvt_pk_bf16(o[mt][nt][0] * inv, o[mt][nt][1] * inv);
        w.y = cvt_pk_bf16(o[mt][nt][2] * inv, o[mt][nt][3] * inv);
        *(u32x2*)(p.o_c + (size_t)tok * 256 + hw * 64 + mt * 16 + g * 4) = w;
      }
    }
  }
}


__device__ void attn_phase(const P& p, char* smem) {
  int tid_ = threadIdx.x;
  asm volatile("" : "+v"(tid_));
  const int tid = tid_, lane = tid & 63, wave = tid >> 6, l15 = lane & 15, g = lane >> 4;
  char* Ks = smem;
  char* Vs = smem + 2 * KBUF;
  for (int job = vblock(); job < 768; job += gridDim.x) {
    const int qblk = job & 15, bh = job >> 4;
    const int b = bh / 6, h = bh % 6;
    const bf16_t* Q = p.qb + (size_t)bh * 4096 * 96;
    const bf16_t* Kg = p.kb + (size_t)bh * 4096 * 96;
    const bf16_t* Vt = p.vT + (size_t)bh * 64 * 4096;
    const int q0 = qblk * 256 + wave * 32;
    bf16x8 qf[2][3];
#pragma unroll
    for (int nt = 0; nt < 2; ++nt)
#pragma unroll
      for (int ks = 0; ks < 3; ++ks)
        qf[nt][ks] = *(const bf16x8*)(Q + (size_t)(q0 + nt * 16 + l15) * 96 + ks * 32 + g * 8);
    f32x4 o[4][2];
#pragma unroll
    for (int a = 0; a < 4; ++a)
#pragma unroll
      for (int n = 0; n < 2; ++n) o[a][n] = (f32x4){0.f, 0.f, 0.f, 0.f};
    float mrow[2] = {-1e30f, -1e30f}, lrow[2] = {0.f, 0.f};

    u32x4 rk[2];
    u32x4 rv;
    const int kr1 = (tid + 512) / 12, kc1 = (tid + 512) - kr1 * 12;
    const int kr0 = tid / 12, kc0 = tid - kr0 * 12;
    auto gload = [&](int kt) {
      const u32x4* kp = (const u32x4*)(Kg + (size_t)kt * 64 * 96);
      rk[0] = kp[tid];
      if (tid < 256) rk[1] = kp[tid + 512];
      rv = *(const u32x4*)(Vt + (size_t)(tid >> 3) * 4096 + kt * 64 + (tid & 7) * 8);
    };
    auto lstore = [&](int buf) {
      char* kb_ = Ks + buf * KBUF;
      char* vb_ = Vs + buf * VBUF;
      *(u32x4*)(kb_ + kr0 * KROW + kc0 * 16) = rk[0];
      if (tid < 256) *(u32x4*)(kb_ + kr1 * KROW + kc1 * 16) = rk[1];
      u32x2 lo, hi;
      lo.x = rv.x; lo.y = rv.y; hi.x = rv.z; hi.y = rv.w;
      *(u32x2*)(vb_ + (tid >> 3) * VROW + (tid & 7) * 16) = lo;
      *(u32x2*)(vb_ + (tid >> 3) * VROW + (tid & 7) * 16 + 8) = hi;
    };
    const int NKT = 64;
    gload(0);
    __syncthreads();
    lstore(0);
    gload(1);
    for (int kt = 0; kt < NKT; ++kt) {
      __syncthreads();
      if (kt + 1 < NKT) {
        lstore((kt + 1) & 1);
        if (kt + 2 < NKT) gload(kt + 2);
      }
      __builtin_amdgcn_sched_barrier(0);
      const char* kb_ = Ks + (kt & 1) * KBUF;
      const char* vb_ = Vs + (kt & 1) * VBUF;
      f32x4 s[4][2];
#pragma unroll
      for (int a = 0; a < 4; ++a)
#pragma unroll
        for (int n = 0; n < 2; ++n) s[a][n] = (f32x4){0.f, 0.f, 0.f, 0.f};
#pragma unroll
      for (int mt = 0; mt < 4; ++mt)
#pragma unroll
        for (int ks = 0; ks < 3; ++ks) {
          const bf16x8 kf = *(const bf16x8*)(kb_ + (mt * 16 + l15) * KROW + (ks * 32 + g * 8) * 2);
#pragma unroll
          for (int nt = 0; nt < 2; ++nt)
            s[mt][nt] = __builtin_amdgcn_mfma_f32_16x16x32_bf16(kf, qf[nt][ks], s[mt][nt], 0, 0, 0);
        }
      bf16x8 pf[2][2];
#pragma unroll
      for (int nt = 0; nt < 2; ++nt) {
        float mx = s[0][nt][0];
#pragma unroll
        for (int mt = 0; mt < 4; ++mt)
#pragma unroll
          for (int j = 0; j < 4; ++j) mx = fmaxf(mx, s[mt][nt][j]);
        mx = fmaxf(mx, __shfl_xor(mx, 16));
        mx = fmaxf(mx, __shfl_xor(mx, 32));
        if (__any(mx > mrow[nt] + 8.0f)) {
          const float mnew = fmaxf(mrow[nt], mx);
          const float alpha = __builtin_amdgcn_exp2f(mrow[nt] - mnew);
          mrow[nt] = mnew;
          lrow[nt] *= alpha;
#pragma unroll
          for (int a = 0; a < 4; ++a) o[a][nt] *= alpha;
        }
        const float mref = mrow[nt];
        float ls = 0.f;
#pragma unroll
        for (int mt = 0; mt < 4; ++mt)
#pragma unroll
          for (int j = 0; j < 4; ++j) {
            const float e = __builtin_amdgcn_exp2f(s[mt][nt][j] - mref);
            s[mt][nt][j] = e;
            ls += e;
          }
        lrow[nt] += ls;
#pragma unroll
        for (int kk = 0; kk < 2; ++kk) {
          u32x4 w;
          w.x = cvt_pk_bf16(s[2 * kk][nt][0], s[2 * kk][nt][1]);
          w.y = cvt_pk_bf16(s[2 * kk][nt][2], s[2 * kk][nt][3]);
          w.z = cvt_pk_bf16(s[2 * kk + 1][nt][0], s[2 * kk + 1][nt][1]);
          w.w = cvt_pk_bf16(s[2 * kk + 1][nt][2], s[2 * kk + 1][nt][3]);
          pf[kk][nt] = __builtin_bit_cast(bf16x8, w);
        }
      }
#pragma unroll
      for (int kk = 0; kk < 2; ++kk)
#pragma unroll
        for (int mt = 0; mt < 4; ++mt) {
          const u32x2 lo = *(const u32x2*)(vb_ + (mt * 16 + l15) * VROW + (32 * kk + 4 * g) * 2);
          const u32x2 hi = *(const u32x2*)(vb_ + (mt * 16 + l15) * VROW + (32 * kk + 16 + 4 * g) * 2);
          u32x4 w;
          w.x = lo.x; w.y = lo.y; w.z = hi.x; w.w = hi.y;
          const bf16x8 vf = __builtin_bit_cast(bf16x8, w);
#pragma unroll
          for (int nt = 0; nt < 2; ++nt)
            o[mt][nt] = __builtin_amdgcn_mfma_f32_16x16x32_bf16(vf, pf[kk][nt], o[mt][nt], 0, 0, 0);
        }
    }
#pragma unroll
    for (int nt = 0; nt < 2; ++nt) {
      float lt = lrow[nt];
      lt += __shfl_xor(lt, 16);
      lt += __shfl_xor(lt, 32);
      const float inv = 1.0f / lt;
      const int tok = b * 4096 + q0 + nt * 16 + l15;
#pragma unroll
      for (int mt = 0; mt < 4; ++mt) {
        u32x2 w;
        w.x = cvt_pk_bf16(o[mt][nt][0] * inv, o[mt][nt][1] * inv);
        w.y = cvt_pk_bf16(o[mt][nt][2] * inv, o[mt][nt][3] * inv);
        *(u32x2*)(p.o_a + (size_t)tok * 384 + h * 64 + mt * 16 + g * 4) = w;
      }
    }
  }
}

__device__ void mixnorm_phase(const P& p, char* smem) {
  int tid_ = threadIdx.x;
  asm volatile("" : "+v"(tid_));
  const int tid = tid_;
  for (int job = blockIdx.x; job < NTOK / 32; job += gridDim.x) {
    const int tok0 = job * 32, b = tok0 >> 12, s0 = tok0 & 4095;
    __syncthreads();
#pragma unroll
    for (int i = 0; i < 3; ++i) {
      const int c = tid + 512 * i, row = c / 48, cc = c % 48;
      *(u32x4*)(smem + row * 2048 + cc * 16) = *(const u32x4*)(p.o_a + (size_t)(tok0 + row) * 384 + cc * 8);
    }
#pragma unroll
    for (int i = 0; i < 2; ++i) {
      const int c = tid + 512 * i, row = c >> 5, cc = c & 31;
      *(u32x4*)(smem + row * 2048 + 1536 + cc * 16) = *(const u32x4*)(p.o_c + (size_t)(tok0 + row) * 256 + cc * 8);
    }
#pragma unroll
    for (int i = 0; i < 3; ++i) {
      const int c = tid + 512 * i, ch = c >> 2, tc = c & 3;
      const u32x4 v = *(const u32x4*)(p.ybT + ((size_t)(b * 384 + ch)) * 4096 + s0 + tc * 8);
      bf16_t* dst = (bf16_t*)smem + (size_t)(tc * 8) * 1024 + 384 + ch;
      dst[0 * 1024] = (bf16_t)(v.x & 0xffff); dst[1 * 1024] = (bf16_t)(v.x >> 16);
      dst[2 * 1024] = (bf16_t)(v.y & 0xffff); dst[3 * 1024] = (bf16_t)(v.y >> 16);
      dst[4 * 1024] = (bf16_t)(v.z & 0xffff); dst[5 * 1024] = (bf16_t)(v.z >> 16);
      dst[6 * 1024] = (bf16_t)(v.w & 0xffff); dst[7 * 1024] = (bf16_t)(v.w >> 16);
    }
    __syncthreads();
    const int tok = tid >> 4, sub = tid & 15;
    float ss[3] = {0.f, 0.f, 0.f};
#pragma unroll
    for (int gi = 0; gi < 3; ++gi) {
      const int i0 = (gi == 0) ? 0 : (gi == 1 ? 3 : 6), i1 = (gi == 0) ? 3 : (gi == 1 ? 6 : 8);
      float acc = 0.f;
#pragma unroll 2
      for (int i = i0; i < i1; ++i) {
        const u32x4 v = *(const u32x4*)(smem + tok * 2048 + (sub + 16 * i) * 16);
        float a;
        a = bflo(v.x); acc += a * a; a = bfhi(v.x); acc += a * a;
        a = bflo(v.y); acc += a * a; a = bfhi(v.y); acc += a * a;
        a = bflo(v.z); acc += a * a; a = bfhi(v.z); acc += a * a;
        a = bflo(v.w); acc += a * a; a = bfhi(v.w); acc += a * a;
      }
      acc += __shfl_xor(acc, 1);
      acc += __shfl_xor(acc, 2);
      acc += __shfl_xor(acc, 4);
      acc += __shfl_xor(acc, 8);
      ss[gi] = acc;
    }
    float rs[3];
    rs[0] = rsqrtf(ss[0] * (1.0f / 384.0f) + 1e-6f);
    rs[1] = rsqrtf(ss[1] * (1.0f / 384.0f) + 1e-6f);
    rs[2] = rsqrtf(ss[2] * (1.0f / 256.0f) + 1e-6f);
#pragma unroll
    for (int gi = 0; gi < 3; ++gi) {
      const int i0 = (gi == 0) ? 0 : (gi == 1 ? 3 : 6), i1 = (gi == 0) ? 3 : (gi == 1 ? 6 : 8);
      const float r = rs[gi];
#pragma unroll 2
      for (int i = i0; i < i1; ++i) {
        const u32x4 v = *(const u32x4*)(smem + tok * 2048 + (sub + 16 * i) * 16);
        u32x4 w;
        w.x = cvt_pk_bf16(bflo(v.x) * r, bfhi(v.x) * r);
        w.y = cvt_pk_bf16(bflo(v.y) * r, bfhi(v.y) * r);
        w.z = cvt_pk_bf16(bflo(v.z) * r, bfhi(v.z) * r);
        w.w = cvt_pk_bf16(bflo(v.w) * r, bfhi(v.w) * r);
        *(u32x4*)(p.y + (size_t)(tok0 + tok) * 1024 + (sub + 16 * i) * 8) = w;
      }
    }
  }
}

__device__ __forceinline__ void store_T4(bf16_t* colbase  , const f32x4& v, bool odd) {
  const float s0 = odd ? v[0] : v[2], s1 = odd ? v[1] : v[3];
  const float x0 = __shfl_xor(s0, 1), x1 = __shfl_xor(s1, 1);
  if (!odd) {
    *(unsigned*)(colbase) = cvt_pk_bf16(v[0], x0);
    *(unsigned*)(colbase + 4096) = cvt_pk_bf16(v[1], x1);
  } else {
    *(unsigned*)(colbase + 2 * 4096 - 1) = cvt_pk_bf16(x0, v[2]);
    *(unsigned*)(colbase + 3 * 4096 - 1) = cvt_pk_bf16(x1, v[3]);
  }
}

enum { EPI_INPROJ = 0, EPI_QUP = 1, EPI_KVUP = 2, EPI_OUTPROJ = 3, EPI_SWIGLU = 4, EPI_DOWN = 5 };

template <int EPI>
__device__ void gemm_phase(const P& p, int l, const bf16_t* __restrict__ A, int lda, const bf16_t* __restrict__ Bt,
                           int K, int nN, char* smem) {
  int tid_ = threadIdx.x;
  asm volatile("" : "+v"(tid_));
  const int tid = tid_, lane = tid & 63, wave = tid >> 6, wm = wave >> 2, wn = wave & 3, l15 = lane & 15,
            g = lane >> 4;
  const int ntiles = 128 * nN;
  const int srow = tid >> 3, skc = tid & 7;
  const int sw_off = srow * 128 + ((skc ^ ((srow >> 1) & 7)) * 16);
  const int rsw = (l15 >> 1) & 7;
  for (int tile = vblock(); tile < ntiles; tile += gridDim.x) {
    const int gsz_ = 4 * nN, grp_ = tile / gsz_, w_ = tile - grp_ * gsz_;
    const int ni = w_ >> 2, mi = grp_ * 4 + (w_ & 3);
    const int m0 = mi * 256, n0 = ni * 256;
    f32x4 acc[8][4];
#pragma unroll
    for (int a = 0; a < 8; ++a)
#pragma unroll
      for (int b = 0; b < 4; ++b) acc[a][b] = (f32x4){0.f, 0.f, 0.f, 0.f};
    const bf16_t* Ag = A + (size_t)(m0 + srow) * lda + skc * 8;
    const bf16_t* Bg = Bt + (size_t)(n0 + srow) * K + skc * 8;
    u32x4 ra[4], rb[4];
    auto gl = [&](int kt) {
#pragma unroll
      for (int i = 0; i < 4; ++i) ra[i] = *(const u32x4*)(Ag + (size_t)i * 64 * lda + kt * 64);
#pragma unroll
      for (int i = 0; i < 4; ++i) rb[i] = *(const u32x4*)(Bg + (size_t)i * 64 * K + kt * 64);
    };
    auto st = [&](int buf) {
      char* nb = smem + buf * 65536;
#pragma unroll
      for (int i = 0; i < 4; ++i) *(u32x4*)(nb + sw_off + i * 8192) = ra[i];
#pragma unroll
      for (int i = 0; i < 4; ++i) *(u32x4*)(nb + 32768 + sw_off + i * 8192) = rb[i];
    };
    const int nk = K / 64;
    gl(0);
    float rs_row = 1.f;
    if (EPI == EPI_INPROJ || EPI == EPI_SWIGLU) {
      if (tid < 256) {
        const f32x4* pp = (const f32x4*)(p.part_x + (size_t)(m0 + tid) * 16);
        const f32x4 a0 = pp[0], a1 = pp[1], a2 = pp[2], a3 = pp[3];
        const float tot = (a0[0] + a0[1] + a0[2] + a0[3]) + (a1[0] + a1[1] + a1[2] + a1[3]) +
                          (a2[0] + a2[1] + a2[2] + a2[3]) + (a3[0] + a3[1] + a3[2] + a3[3]);
        rs_row = rsqrtf(tot * (1.0f / 1024.0f) + 1e-6f);
      }
    } else if (EPI == EPI_QUP) {
      if (tid < 256) {
        const f32x4 a0 = *(const f32x4*)(p.part_q + (size_t)(m0 + tid) * 4);
        rs_row = rsqrtf((a0[0] + a0[1] + a0[2] + a0[3]) * (1.0f / 256.0f) + 1e-6f);
      }
    } else if (EPI == EPI_KVUP) {
      if (tid < 256) {
        const float2 a0 = *(const float2*)(p.part_kv + (size_t)(m0 + tid) * 2);
        rs_row = rsqrtf((a0.x + a0.y) * (1.0f / 128.0f) + 1e-6f);
      }
    }
    float* s_rs = (float*)(smem + 131072);
    __syncthreads();
    st(0);
    if (EPI != EPI_OUTPROJ && EPI != EPI_DOWN && true) {
      if (tid < 256) s_rs[tid] = rs_row;
    }
    __syncthreads();
    for (int kt = 0; kt < nk; ++kt) {
      if (kt + 1 < nk) gl(kt + 1);
      __builtin_amdgcn_sched_barrier(0);
      const char* Ab = smem + (kt & 1) * 65536;
      const char* Bb = Ab + 32768;
#pragma unroll
      for (int ks = 0; ks < 2; ++ks) {
        bf16x8 bfr[4];
#pragma unroll
        for (int nt = 0; nt < 4; ++nt)
          bfr[nt] = *(const bf16x8*)(Bb + (wn * 64 + nt * 16 + l15) * 128 + (((ks * 4 + g) ^ rsw) * 16));
        bf16x8 af[2][2];
#pragma unroll
        for (int mt = 0; mt < 2; ++mt)
          af[0][mt] = *(const bf16x8*)(Ab + (wm * 128 + mt * 16 + l15) * 128 + (((ks * 4 + g) ^ rsw) * 16));
#pragma unroll
        for (int mh = 0; mh < 4; ++mh) {
          if (mh < 3) {
#pragma unroll
            for (int mt = 0; mt < 2; ++mt)
              af[(mh + 1) & 1][mt] = *(const bf16x8*)(Ab + (wm * 128 + ((mh + 1) * 2 + mt) * 16 + l15) * 128 + (((ks * 4 + g) ^ rsw) * 16));
          }
          __builtin_amdgcn_sched_barrier(0);
#pragma unroll
          for (int mt = 0; mt < 2; ++mt)
#pragma unroll
            for (int nt = 0; nt < 4; ++nt)
              acc[mh * 2 + mt][nt] = __builtin_amdgcn_mfma_f32_16x16x32_bf16(bfr[nt], af[mh & 1][mt], acc[mh * 2 + mt][nt], 0, 0, 0);
          __builtin_amdgcn_sched_barrier(0);
        }
      }
      if (kt + 1 < nk) st((kt + 1) & 1);
      __syncthreads();
    }
    int opq_ = 0;
    asm volatile("" : "+v"(opq_));
    const int rbase = m0 + wm * 128 + l15 + opq_;
    const int cbase = n0 + wn * 64 + g * 4 + opq_;
    if (EPI == EPI_INPROJ) {
      const int wc0 = n0 + wn * 64;
#pragma unroll
      for (int mt = 0; mt < 8; ++mt) {
        const int row = rbase + mt * 16;
        const float rs = s_rs[row - m0];
        const int bb = row >> 12, ss = row & 4095;
        float sq = 0.f;
#pragma unroll
        for (int nt = 0; nt < 4; ++nt) {
          const int ct = wc0 + nt * 16;
          const int col = cbase + nt * 16;
          f32x4 v = acc[mt][nt] * rs;
          if (ct < 384) {
            if ((nt & 1) == 0) {
              const f32x4 v1 = acc[mt][(nt + 1) & 3] * rs;
              sq += v[0] * v[0] + v[1] * v[1] + v[2] * v[2] + v[3] * v[3];
              sq += v1[0] * v1[0] + v1[1] * v1[1] + v1[2] * v1[2] + v1[3] * v1[3];
              u32x4 w;
              w.x = cvt_pk_bf16(v[0], v[1]);
              w.y = cvt_pk_bf16(v[2], v[3]);
              w.z = cvt_pk_bf16(v1[0], v1[1]);
              w.w = cvt_pk_bf16(v1[2], v1[3]);
              *(u32x4*)(p.projA + (size_t)row * 416 + wc0 + (nt >> 1) * 32 + g * 8) = w;
            }
          } else if (ct == 384) {
            if (nt < 3) {
              const f32x4 v2 = acc[mt][(nt + 1) & 3] * rs;
              const int i0 = col - 384;
              const float2* cs = p.ropecs + ss * 16 + i0;
              float o1[4], o2[4];
#pragma unroll
              for (int j = 0; j < 4; ++j) {
                const float2 c_s = cs[j];
                o1[j] = v[j] * c_s.x - v2[j] * c_s.y;
                o2[j] = v[j] * c_s.y + v2[j] * c_s.x;
              }
              u32x2 w;
              w.x = cvt_pk_bf16(o1[0], o1[1]);
              w.y = cvt_pk_bf16(o1[2], o1[3]);
              *(u32x2*)(p.projA + (size_t)row * 416 + 384 + i0) = w;
              w.x = cvt_pk_bf16(o2[0], o2[1]);
              w.y = cvt_pk_bf16(o2[2], o2[3]);
              *(u32x2*)(p.projA + (size_t)row * 416 + 400 + i0) = w;
            }
          } else if (ct == 400) {
          } else if (ct < 1568) {
            const int hc = col - 416;
            store_T4(p.hyT + ((size_t)(bb * 1152 + hc)) * 4096 + ss, v, (l15 & 1) != 0);
          } else if (ct < 2080) {
            if ((nt & 1) == 0) {
              const f32x4 v1 = acc[mt][(nt + 1) & 3] * rs;
              u32x4 w;
              w.x = cvt_pk_bf16(v[0], v[1]);
              w.y = cvt_pk_bf16(v[2], v[3]);
              w.z = cvt_pk_bf16(v1[0], v1[1]);
              w.w = cvt_pk_bf16(v1[2], v1[3]);
              *(u32x4*)(p.na + (size_t)row * 768 + (wc0 + (nt >> 1) * 32 + g * 8 - 1568)) = w;
            }
          } else if (ct < 2336) {
            const int vc = col - 2080;
            store_T4(p.naVT + ((size_t)(bb * 256 + vc)) * 4096 + ss, v, (l15 & 1) != 0);
          }
        }
        if (wc0 < 384) {
          sq += __shfl_xor(sq, 16);
          sq += __shfl_xor(sq, 32);
          if (g == 0) {
            if (wc0 < 256) p.part_q[(size_t)row * 4 + (wc0 >> 6)] = sq;
            else p.part_kv[(size_t)row * 2 + ((wc0 - 256) >> 6)] = sq;
          }
        }
      }
    } else if (EPI == EPI_QUP) {
      const int wc0 = n0 + wn * 64;
      const float qscale = 0.10206207261596575f * 1.4426950408889634f;
#pragma unroll
      for (int mt = 0; mt < 8; ++mt) {
        const int row = rbase + mt * 16;
        const float rs = s_rs[row - m0] * qscale;
        const int bb = row >> 12, ss = row & 4095;
#pragma unroll
        for (int nt = 0; nt < 4; ++nt) {
          const int T = (wc0 >> 4) + nt;
          if (T < 36) {
            const int hh = T / 6, tt = T % 6;
            bf16_t* qrow = p.qb + ((size_t)((bb * 6 + hh) * 4096 + ss)) * 96;
            const f32x4 v = acc[mt][nt] * rs;
            if (tt < 4) {
              if ((tt & 1) == 0) {
                const f32x4 v1 = acc[mt][(nt + 1) & 3] * rs;
                u32x4 w;
                w.x = cvt_pk_bf16(v[0], v[1]);
                w.y = cvt_pk_bf16(v[2], v[3]);
                w.z = cvt_pk_bf16(v1[0], v1[1]);
                w.w = cvt_pk_bf16(v1[2], v1[3]);
                *(u32x4*)(qrow + (tt >> 1) * 32 + g * 8) = w;
              }
            } else if (tt == 4) {
              if (nt < 3) {
                const f32x4 v2 = acc[mt][(nt + 1) & 3] * rs;
                const float2* cs = p.ropecs + ss * 16 + g * 4;
                float o1[4], o2[4];
#pragma unroll
                for (int j = 0; j < 4; ++j) {
                  const float2 c_s = cs[j];
                  o1[j] = v[j] * c_s.x - v2[j] * c_s.y;
                  o2[j] = v[j] * c_s.y + v2[j] * c_s.x;
                }
                u32x2 w;
                w.x = cvt_pk_bf16(o1[0], o1[1]);
                w.y = cvt_pk_bf16(o1[2], o1[3]);
                *(u32x2*)(qrow + 64 + g * 4) = w;
                w.x = cvt_pk_bf16(o2[0], o2[1]);
                w.y = cvt_pk_bf16(o2[2], o2[3]);
                *(u32x2*)(qrow + 80 + g * 4) = w;
              }
            }
          }
        }
      }
    } else if (EPI == EPI_KVUP) {
      const int hh = ni * 2 + (wn >> 1);
#pragma unroll
      for (int mt = 0; mt < 8; ++mt) {
        const int row = rbase + mt * 16;
        const float rs = s_rs[row - m0];
        const int bb = row >> 12, ss = row & 4095;
#pragma unroll
        for (int nt = 0; nt < 4; ++nt) {
          const f32x4 v = acc[mt][nt] * rs;
          if ((wn & 1) == 0) {
            if ((nt & 1) == 0) {
              const f32x4 v1 = acc[mt][(nt + 1) & 3] * rs;
              u32x4 w;
              w.x = cvt_pk_bf16(v[0], v[1]);
              w.y = cvt_pk_bf16(v[2], v[3]);
              w.z = cvt_pk_bf16(v1[0], v1[1]);
              w.w = cvt_pk_bf16(v1[2], v1[3]);
              *(u32x4*)(p.kb + ((size_t)((bb * 6 + hh) * 4096 + ss)) * 96 + (nt >> 1) * 32 + g * 8) = w;
            }
          } else {
            const int dv = nt * 16 + g * 4;
            bf16_t* dst = p.vT + ((size_t)((bb * 6 + hh) * 64 + dv)) * 4096 + ss;
            dst[0] = f2bf(v[0]);
            dst[4096] = f2bf(v[1]);
            dst[2 * 4096] = f2bf(v[2]);
            dst[3 * 4096] = f2bf(v[3]);
          }
        }
      }
#pragma unroll
      for (int i = 0; i < 2; ++i) {
        const int c = tid + 512 * i, rr = c >> 2, cc = c & 3;
        const int row = m0 + rr, bb = row >> 12, ss = row & 4095;
        const u32x4 v = *(const u32x4*)(p.projA + (size_t)row * 416 + 384 + cc * 8);
        *(u32x4*)(p.kb + ((size_t)((bb * 6 + ni * 2) * 4096 + ss)) * 96 + 64 + cc * 8) = v;
        *(u32x4*)(p.kb + ((size_t)((bb * 6 + ni * 2 + 1) * 4096 + ss)) * 96 + 64 + cc * 8) = v;
      }
    } else if (EPI == EPI_OUTPROJ || EPI == EPI_DOWN) {
      const int slot = (n0 + wn * 64) >> 6;
      const int cb8 = n0 + wn * 64 + g * 8;
#pragma unroll
      for (int mt = 0; mt < 8; ++mt) {
        const int row = rbase + mt * 16;
        float sq = 0.f;
#pragma unroll
        for (int q = 0; q < 2; ++q) {
          const int col = cb8 + q * 32;
          const u32x4 xr = *(const u32x4*)(p.xb + (size_t)row * 1024 + col);
          const f32x4 v0 = acc[mt][2 * q] + (f32x4){bflo(xr.x), bfhi(xr.x), bflo(xr.y), bfhi(xr.y)};
          const f32x4 v1 = acc[mt][2 * q + 1] + (f32x4){bflo(xr.z), bfhi(xr.z), bflo(xr.w), bfhi(xr.w)};
          sq += v0[0] * v0[0] + v0[1] * v0[1] + v0[2] * v0[2] + v0[3] * v0[3];
          sq += v1[0] * v1[0] + v1[1] * v1[1] + v1[2] * v1[2] + v1[3] * v1[3];
          u32x4 w;
          w.x = cvt_pk_bf16(v0[0], v0[1]);
          w.y = cvt_pk_bf16(v0[2], v0[3]);
          w.z = cvt_pk_bf16(v1[0], v1[1]);
          w.w = cvt_pk_bf16(v1[2], v1[3]);
          *(u32x4*)(p.xb + (size_t)row * 1024 + col) = w;
        }
        sq += __shfl_xor(sq, 16);
        sq += __shfl_xor(sq, 32);
        if (g == 0) p.part_x[(size_t)row * 16 + slot] = sq;
      }
    } else if (EPI == EPI_SWIGLU) {
      const int fbase = ((n0 + wn * 64) >> 1) + g * 8;
#pragma unroll
      for (int mt = 0; mt < 8; ++mt) {
        const int row = rbase + mt * 16;
        const float rs = s_rs[row - m0];
        float hv[8];
#pragma unroll
        for (int i = 0; i < 2; ++i) {
          const f32x4 gt = acc[mt][i] * rs, up = acc[mt][2 + i] * rs;
#pragma unroll
          for (int j = 0; j < 4; ++j) hv[i * 4 + j] = gt[j] * __builtin_amdgcn_rcpf(1.0f + __expf(-gt[j])) * up[j];
        }
        u32x4 w;
        w.x = cvt_pk_bf16(hv[0], hv[1]);
        w.y = cvt_pk_bf16(hv[2], hv[3]);
        w.z = cvt_pk_bf16(hv[4], hv[5]);
        w.w = cvt_pk_bf16(hv[6], hv[7]);
        *(u32x4*)(p.hidden + (size_t)row * 2816 + fbase) = w;
      }
    }
  }
}

__device__ void final_norm_phase(const P& p) {
  int tid_ = threadIdx.x;
  asm volatile("" : "+v"(tid_));
  const int tid = tid_, lane = tid & 63, wave = tid >> 6;
  for (int row = blockIdx.x * 8 + wave; row < NTOK; row += gridDim.x * 8) {
    const f32x4* pp = (const f32x4*)(p.part_x + (size_t)row * 16);
    const f32x4 a0 = pp[0], a1 = pp[1], a2 = pp[2], a3 = pp[3];
    const float tot = (a0[0] + a0[1] + a0[2] + a0[3]) + (a1[0] + a1[1] + a1[2] + a1[3]) +
                      (a2[0] + a2[1] + a2[2] + a2[3]) + (a3[0] + a3[1] + a3[2] + a3[3]);
    const float rs = rsqrtf(tot * (1.0f / 1024.0f) + 1e-6f);
    const bf16_t* xr = p.xb + (size_t)row * 1024;
    float* orow = p.out + (size_t)row * 1024;
#pragma unroll
    for (int i = 0; i < 2; ++i) {
      const int c0 = lane * 8 + 512 * i;
      const u32x4 xv = *(const u32x4*)(xr + c0);
      const f32x4 g0 = *(const f32x4*)(p.final_g + c0), g1 = *(const f32x4*)(p.final_g + c0 + 4);
      f32x4 o0 = (f32x4){bflo(xv.x), bfhi(xv.x), bflo(xv.y), bfhi(xv.y)};
      f32x4 o1 = (f32x4){bflo(xv.z), bfhi(xv.z), bflo(xv.w), bfhi(xv.w)};
      o0 = o0 * rs * g0;
      o1 = o1 * rs * g1;
      *(f32x4*)(orow + c0) = o0;
      *(f32x4*)(orow + c0 + 4) = o1;
    }
  }
}


template <int S>
__device__ __forceinline__ void run_stage(const P& p, int l, char* smem) {
  if (S == 0) prep_phase(p, l, smem);
  if (S == 1) {
    filt_fft_phase(p, l, smem);
    gemm_phase<EPI_INPROJ>(p, l, p.xb, 1024, p.Win, 1024, 10, smem);
  }
  if (S == 2) {
    hyena_phase<0>(p, l, smem);
    gemm_phase<EPI_QUP>(p, l, p.projA, 416, p.Wuq, 256, 3, smem);
    gemm_phase<EPI_KVUP>(p, l, p.projA + 256, 416, p.Wukv, 128, 3, smem);
    natten_phase(p, l, smem);
  }
  if (S == 3) {
    hyena_phase<1>(p, l, smem);
    attn_phase(p, smem);
  }
  if (S == 4) mixnorm_phase(p, smem);
  if (S == 5) gemm_phase<EPI_OUTPROJ>(p, l, p.y, 1024, p.Wout, 1024, 4, smem);
  if (S == 6) gemm_phase<EPI_SWIGLU>(p, l, p.xb, 1024, p.Wgu, 1024, 22, smem);
  if (S == 7) gemm_phase<EPI_DOWN>(p, l, p.hidden, 2816, p.Wdown, 2816, 4, smem);
  if (S == 8) final_norm_phase(p);
}

__device__ __forceinline__ void grid_barrier(unsigned* bar, unsigned target) {
  asm volatile("s_waitcnt vmcnt(0)" ::: "memory");
  __syncthreads();
  if (threadIdx.x == 0) {
    __builtin_amdgcn_fence(__ATOMIC_RELEASE, "agent");
    asm volatile("s_waitcnt vmcnt(0)" ::: "memory");
    __hip_atomic_fetch_add(bar, 1u, __ATOMIC_RELAXED, __HIP_MEMORY_SCOPE_AGENT);
    unsigned spins = 0;
    while (__hip_atomic_load(bar, __ATOMIC_RELAXED, __HIP_MEMORY_SCOPE_AGENT) < target && spins < (1u << 22)) {
      __builtin_amdgcn_s_sleep(1);
      ++spins;
    }
    __builtin_amdgcn_fence(__ATOMIC_ACQUIRE, "agent");
    asm volatile("s_waitcnt vmcnt(0)" ::: "memory");
  }
  __syncthreads();
}

__global__ void __launch_bounds__(NTHREADS) k_main(P p) {
  extern __shared__ __attribute__((aligned(16))) char smem[];
  cg::grid_group grid = cg::this_grid();
  if (blockIdx.x == 0 && threadIdx.x == 0) __hip_atomic_store(p.bar, 0u, __ATOMIC_RELAXED, __HIP_MEMORY_SCOPE_AGENT);
  run_stage<0>(p, 0, smem); grid.sync();
  run_stage<1>(p, 0, smem); grid_barrier(p.bar, 1u * gridDim.x);
  run_stage<2>(p, 0, smem); grid_barrier(p.bar, 2u * gridDim.x);
  run_stage<3>(p, 0, smem); grid_barrier(p.bar, 3u * gridDim.x);
  run_stage<4>(p, 0, smem); grid_barrier(p.bar, 4u * gridDim.x);
  run_stage<5>(p, 0, smem); grid_barrier(p.bar, 5u * gridDim.x);
  run_stage<6>(p, 0, smem); grid_barrier(p.bar, 6u * gridDim.x);
  run_stage<7>(p, 0, smem); grid_barrier(p.bar, 7u * gridDim.x);
  run_stage<0>(p, 1, smem); grid_barrier(p.bar, 8u * gridDim.x);
  run_stage<1>(p, 1, smem); grid_barrier(p.bar, 9u * gridDim.x);
  run_stage<2>(p, 1, smem); grid_barrier(p.bar, 10u * gridDim.x);
  run_stage<3>(p, 1, smem); grid_barrier(p.bar, 11u * gridDim.x);
  run_stage<4>(p, 1, smem); grid_barrier(p.bar, 12u * gridDim.x);
  run_stage<5>(p, 1, smem); grid_barrier(p.bar, 13u * gridDim.x);
  run_stage<6>(p, 1, smem); grid_barrier(p.bar, 14u * gridDim.x);
  run_stage<7>(p, 1, smem); grid_barrier(p.bar, 15u * gridDim.x);
  run_stage<8>(p, 1, smem);
}


extern "C" void kernel_launch(void* const* d_in, const int* in_sizes, int n_in, void* d_out, int out_size, void* d_ws,
                              size_t ws_size, hipStream_t stream) {
  static int grid_blocks = 0;
  if (!grid_blocks) {
    int dev = 0, cus = 0;
    (void)hipGetDevice(&dev);
    (void)hipDeviceGetAttribute(&cus, hipDeviceAttributeMultiprocessorCount, dev);
    if (cus <= 0) cus = 256;
    int per_cu = 0;
    (void)hipFuncSetAttribute((const void*)k_main, hipFuncAttributeMaxDynamicSharedMemorySize, LDS_BYTES);
    (void)hipOccupancyMaxActiveBlocksPerMultiprocessor(&per_cu, k_main, NTHREADS, LDS_BYTES);
    if (per_cu > 1) per_cu = 1;
    if (per_cu < 1) per_cu = 1;
    grid_blocks = cus * per_cu;
  }
  P p;
  memset(&p, 0, sizeof(p));
  const float* const* in = (const float* const*)d_in;
  p.x = in[0]; p.norm1_g = in[1]; p.w_in = in[2]; p.q_norm_g = in[3]; p.w_uq = in[4]; p.kv_norm_g = in[5];
  p.w_ukv = in[6]; p.conv_w = in[7]; p.conv_b = in[8]; p.fw1 = in[9]; p.fb1 = in[10]; p.ff1 = in[11];
  p.fw2 = in[12]; p.fb2 = in[13]; p.ff2 = in[14]; p.fw3 = in[15]; p.skip = in[16]; p.rpb = in[17];
  p.mix_g = in[18]; p.w_out = in[19]; p.norm2_g = in[20]; p.w_gate = in[21]; p.w_up = in[22]; p.w_down = in[23];
  p.final_g = in[24];
  p.out = (float*)d_out;
  char* ws = (char*)d_ws;
  size_t off = 0;
  auto take = [&](size_t bytes) {
    char* r = ws + off;
    off += (bytes + 255) & ~(size_t)255;
    return r;
  };
  p.Win = (bf16_t*)take((size_t)2560 * 1024 * 2);
  p.Wuq = (bf16_t*)take((size_t)768 * 256 * 2);
  p.Wukv = (bf16_t*)take((size_t)768 * 128 * 2);
  p.Wout = (bf16_t*)take((size_t)1024 * 1024 * 2);
  p.Wgu = (bf16_t*)take((size_t)5632 * 1024 * 2);
  p.Wdown = (bf16_t*)take((size_t)1024 * 2816 * 2);
  p.ropecs = (float2*)take((size_t)65536 * 8);
  p.tw = (float2*)take((size_t)8192 * 8);
  p.bar = (unsigned*)take(256);
  p.part_x = (float*)take((size_t)NTOK * 16 * 4);
  p.part_q = (float*)take((size_t)NTOK * 4 * 4);
  p.part_kv = (float*)take((size_t)NTOK * 2 * 4);
  p.xb = (bf16_t*)take((size_t)NTOK * 1024 * 2);
  p.H2 = (float2*)take((size_t)768 * 8192 * 8);
  p.z1T = (bf16_t*)take((size_t)1536 * 4096 * 4);
  p.filtT = (float*)p.z1T;
  p.vT = (bf16_t*)take((size_t)8 * 6 * 64 * 4096 * 2);
  p.o_a = (bf16_t*)take((size_t)NTOK * 384 * 2);
  p.o_c = (bf16_t*)take((size_t)NTOK * 256 * 2);
  char* big = take(0);
  p.projA = (bf16_t*)take((size_t)NTOK * 416 * 2);
  p.hyT = (bf16_t*)take((size_t)8 * 1152 * 4096 * 2);
  p.na = (bf16_t*)take((size_t)NTOK * 768 * 2);
  p.qb = (bf16_t*)take((size_t)8 * 6 * 4096 * 96 * 2);
  p.kb = (bf16_t*)take((size_t)8 * 6 * 4096 * 96 * 2);
  p.hidden = (bf16_t*)big;
  p.ybT = (bf16_t*)take((size_t)8 * 384 * 4096 * 2);
  p.naVT = (bf16_t*)take((size_t)8 * 4 * 64 * 4096 * 2);
  p.y = p.qb;
  if (off > ws_size) {
    fprintf(stderr, "workspace too small: need %zu have %zu\n", off, ws_size);
    return;
  }
  void* args[] = {&p};
  hipError_t e = hipLaunchCooperativeKernel((void*)k_main, dim3(grid_blocks), dim3(NTHREADS), args, LDS_BYTES, stream);
  if (e != hipSuccess) fprintf(stderr, "cooperative launch failed: %s (grid %d)\n", hipGetErrorString(e), grid_blocks);
}
```
